# Optimizing an MI355X kernel written in HIP

```python
import math
import jax, jax.numpy as jnp
from jax import lax
import numpy as np

D_MODEL = 1024
BATCH = 16
SEQ = 2048
DEPTH = 4

GRID_W = 64
CTX_LEN = 256

N_EVEN = (DEPTH + 1) // 2
N_ODD = DEPTH // 2
DN_ALPHA = (2 * DEPTH) ** 0.25
DN_BETA = (8 * DEPTH) ** -0.25
LN_EPS = 1e-6
D_FF = 2816

HY_W = D_MODEL // 2
HY_ORDER = 2
HY_IN = (HY_ORDER + 1) * HY_W
HY_EMB = 33
HY_FO = 64
HY_TARGET = 1e-2
HY_FAST = 0.3
HY_SLOW = 1.5

RW_W = D_MODEL - HY_W
RW_N = 64
RW_H = RW_W // RW_N
RW_DECAY_LORA = 64
RW_A_LORA = 64
RW_GATE_LORA = 128
RW_GN_EPS = 64e-5
RW_IN = 3 * RW_W + 2 * RW_DECAY_LORA + 2 * RW_A_LORA + RW_GATE_LORA
EV_IN = HY_IN + RW_IN

GLA_H = 4
GLA_DK = D_MODEL // 2
GLA_DV = D_MODEL
GLA_HK = GLA_DK // GLA_H
GLA_HV = GLA_DV // GLA_H
GLA_GATE_LORA = 16
GLA_NORMALIZER = 16.0
GLA_CHUNK = 64
GLA_EPS = 1e-5
OD_IN = 2 * GLA_DK + 2 * GLA_DV + 2 * GLA_GATE_LORA

kernel_name = "hyena_rwkv7_gla_prefix_trunk"


def split_sizes(z, sizes):
    idx = [sum(sizes[:i + 1]) for i in range(len(sizes) - 1)]
    return jnp.split(z, idx, axis=-1)


def layer_norm(h, g, b):
    hf = h.astype(jnp.float32)
    mu = jnp.mean(hf, -1, keepdims=True)
    var = jnp.mean(jnp.square(hf - mu), -1, keepdims=True)
    return ((hf - mu) * lax.rsqrt(var + LN_EPS)).astype(h.dtype) * g + b


def modulate(h, shift, scale):
    return h * (1 + scale) + shift


def post_norm_residual(h, y, gate, weight, g, b):
    return layer_norm(DN_ALPHA * h + weight * gate * y, g, b)


def swiglu(h, wg, wu, wd):
    return (jax.nn.silu(h @ wg) * (h @ wu)) @ wd


def neighbours(z):
    zp = jnp.pad(z, ((0, 0), (1, 1), (0, 0)))
    return zp[:, :-2], zp[:, 2:]


def conv3_centered(z, w, b):
    prev, nxt = neighbours(z)
    return prev * w[0] + z * w[1] + nxt * w[2] + b


def raster_to_columns(z):
    B, T = z.shape[:2]
    rows = T // GRID_W
    return z.reshape(B, rows, GRID_W, *z.shape[2:]).swapaxes(1, 2).reshape(z.shape)


def columns_to_raster(z):
    B, T = z.shape[:2]
    rows = T // GRID_W
    return z.reshape(B, GRID_W, rows, *z.shape[2:]).swapaxes(1, 2).reshape(z.shape)


def hyena_filters(L, w1, b1, f1, w2, b2, f2, w3):
    f32 = jnp.float32
    t = jnp.linspace(0.0, 1.0, L, dtype=f32)[:, None]
    bands = (HY_EMB - 1) // 2
    w = 2.0 * math.pi * jnp.arange(L, dtype=f32)[:, None] / L
    f = jnp.linspace(1e-4, bands - 1, bands, dtype=f32)[None, :]
    z = jnp.concatenate([t, jnp.cos(f * w), -jnp.sin(f * w)], axis=-1)
    h = jnp.sin(f1 * (z @ w1 + b1))
    h = jnp.sin(f2 * (h @ w2 + b2))
    h = (h @ w3).astype(f32).reshape(L, HY_ORDER, 2, HY_W)
    deltas = jnp.linspace(math.log(HY_TARGET) / HY_SLOW, math.log(HY_TARGET) / HY_FAST, HY_W, dtype=f32)
    window = jnp.exp(-t * jnp.abs(deltas))
    return h * window[:, None, None, :]


def bidir_long_conv(u, h_fwd, h_bwd, skip):
    L = u.shape[1]
    k = jnp.concatenate([h_fwd, jnp.zeros_like(h_fwd[:1]), h_bwd[:0:-1]], axis=0)
    uf = u.astype(jnp.float32)
    y = jnp.fft.irfft(jnp.fft.rfft(uf, n=2 * L, axis=1) * jnp.fft.rfft(k, n=2 * L, axis=0)[None],
                      n=2 * L, axis=1)[:, :L]
    return y + uf * skip


def hyena_segment(zh, conv_w, conv_b, filt, skip):
    zh = conv3_centered(zh, conv_w, conv_b)
    v, x1, x2 = jnp.split(zh, 3, axis=-1)
    y = x1.astype(jnp.float32) * bidir_long_conv(v, filt[:, 0, 0], filt[:, 0, 1], skip[0])
    y = x2.astype(jnp.float32) * bidir_long_conv(y, filt[:, 1, 0], filt[:, 1, 1], skip[1])
    return y.astype(zh.dtype)


def rwkv_prepare(zr, mu, w0, w_up, a0, a_up, g_up, k_k, k_a):
    f32 = jnp.float32
    B, T, _ = zr.shape
    prev, nxt = neighbours(zr)
    zr = zr + mu * (0.5 * (prev + nxt) - zr)
    r, k, v, wdf, wdb, adf, adb, gd = split_sizes(
        zr, [RW_W, RW_W, RW_W, RW_DECAY_LORA, RW_DECAY_LORA, RW_A_LORA, RW_A_LORA, RW_GATE_LORA])
    heads = lambda t: t.astype(f32).reshape(B, T, RW_H, RW_N)
    g = jax.nn.sigmoid(gd) @ g_up
    kk = heads(k * k_k)
    kk = kk / jnp.maximum(jnp.sqrt(jnp.sum(kk * kk, -1, keepdims=True)), 1e-12)
    dirs = []
    for d, (wd, ad) in enumerate(((wdf, adf), (wdb, adb))):
        w_log = -jax.nn.softplus(-(w0[d] + jnp.tanh(wd) @ w_up[d]).astype(f32)) - 0.5
        decay = jnp.exp(-jnp.exp(w_log))
        a = jax.nn.sigmoid((a0[d] + ad @ a_up[d]).astype(f32))
        kd = k.astype(f32) * (1 + (a - 1) * k_a)
        dirs.append((heads(decay), heads(kd), heads(a)))
    return heads(r), heads(v), kk, g, dirs


def rwkv7_scan(r, decay, k, v, kk, a, s0, reverse):
    def step(S, inp):
        r_t, w_t, k_t, v_t, kk_t, a_t = inp
        sa = jnp.einsum('bhvk,bhk->bhv', S, -kk_t)
        S = (S * w_t[:, :, None, :] + sa[..., None] * (kk_t * a_t)[:, :, None, :]
             + v_t[..., None] * k_t[:, :, None, :])
        return S, jnp.einsum('bhvk,bhk->bhv', S, r_t)
    xs = tuple(jnp.moveaxis(t, 1, 0) for t in (r, decay, k, v, kk, a))
    S, out = lax.scan(step, s0, xs, reverse=reverse)
    return jnp.moveaxis(out, 0, 1), S


def rwkv_bidir(prep, inits):
    r, v, kk, _, dirs = prep
    o_sum, k_sum, finals = 0.0, 0.0, []
    for d, ((decay, kd, a), s0) in enumerate(zip(dirs, inits)):
        o, S = rwkv7_scan(r, decay, kd, v, kk, a, s0, reverse=(d == 1))
        o_sum = o_sum + o
        k_sum = k_sum + kd
        finals.append(S)
    return o_sum, k_sum, tuple(finals)


def rwkv_readout(o, prep, k_sum, r_k, gn_g, gn_b):
    r, v, _, g, _ = prep
    B, T = o.shape[:2]
    mu = jnp.mean(o, -1, keepdims=True)
    var = jnp.mean(jnp.square(o - mu), -1, keepdims=True)
    y = ((o - mu) * lax.rsqrt(var + RW_GN_EPS)).reshape(B, T, RW_W) * gn_g + gn_b
    bonus = jnp.sum(r * k_sum * r_k, -1, keepdims=True) * v
    return (y + bonus.reshape(B, T, RW_W)) * g


def even_mixer(u_ctx, u_lat, w_in, w_out, conv_w, conv_b, f_w1, f_b1, f_freq1, f_w2, f_b2, f_freq2, f_w3,
               skip, mu, w0, w_up, a0, a_up, g_up, k_k, k_a, r_k, gn_g, gn_b, ctx_out):
    z_ctx, z_lat = u_ctx @ w_in, u_lat @ w_in

    def hyena(z):
        filt = hyena_filters(z.shape[1], f_w1, f_b1, f_freq1, f_w2, f_b2, f_freq2, f_w3)
        return hyena_segment(z[..., :HY_IN], conv_w, conv_b, filt, skip)

    p_ctx = rwkv_prepare(z_ctx[..., HY_IN:], mu, w0, w_up, a0, a_up, g_up, k_k, k_a)
    p_lat = rwkv_prepare(z_lat[..., HY_IN:], mu, w0, w_up, a0, a_up, g_up, k_k, k_a)
    s0 = jnp.zeros((z_ctx.shape[0], RW_H, RW_N, RW_N), jnp.float32)
    o_ctx, ks_ctx, fin_ctx = rwkv_bidir(p_ctx, (s0, s0))
    o_lat, ks_lat, _ = rwkv_bidir(p_lat, fin_ctx)
    y_lat = jnp.concatenate([hyena(z_lat).astype(u_lat.dtype),
                             rwkv_readout(o_lat, p_lat, ks_lat, r_k, gn_g, gn_b).astype(u_lat.dtype)], -1) @ w_out
    y_ctx = None
    if ctx_out:
        y_ctx = jnp.concatenate([hyena(z_ctx).astype(u_ctx.dtype),
                                 rwkv_readout(o_ctx, p_ctx, ks_ctx, r_k, gn_g, gn_b).astype(u_ctx.dtype)], -1) @ w_out
    return y_ctx, y_lat


def gla_prepare(z, g_up, g_b):
    f32 = jnp.float32
    B, T, _ = z.shape
    q, k, v, gdf, gdb, og = split_sizes(z, [GLA_DK, GLA_DK, GLA_DV, GLA_GATE_LORA, GLA_GATE_LORA, GLA_DV])
    logs = [(jax.nn.log_sigmoid((gd @ g_up[d] + g_b[d]).astype(f32)) / GLA_NORMALIZER).reshape(B, T, GLA_H, GLA_HK)
            for d, gd in enumerate((gdf, gdb))]
    q = q.astype(f32).reshape(B, T, GLA_H, GLA_HK) * GLA_HK ** -0.5
    k = k.astype(f32).reshape(B, T, GLA_H, GLA_HK)
    v = v.astype(f32).reshape(B, T, GLA_H, GLA_HV)
    return q, k, v, logs, og


def gla_chunked(q, k, v, g, s0):
    B, T, H, K = q.shape
    V = v.shape[-1]
    C = GLA_CHUNK
    n = T // C
    ch = lambda t: t.reshape(B, n, C, H, t.shape[-1]).transpose(0, 1, 3, 2, 4)
    q, k, v, g = ch(q), ch(k), ch(v), ch(g)
    b = jnp.cumsum(g, axis=3)
    b_ref = b[:, :, :, C // 2:C // 2 + 1]
    b_last = b[:, :, :, -1:]
    scores = jnp.einsum('bnhck,bnhsk->bnhcs', q * jnp.exp(b - b_ref), k * jnp.exp(b_ref - b))
    lower = jnp.tril(jnp.ones((C, C), bool))
    o_intra = jnp.einsum('bnhcs,bnhsv->bnhcv', jnp.where(lower, scores, 0.0), v)
    q_in = q * jnp.exp(b)
    k_out = k * jnp.exp(b_last - b)
    d_last = jnp.exp(b_last[:, :, :, 0])

    def step(S, inp):
        qc, kc, vc, dc = inp
        o = jnp.einsum('bhck,bhkv->bhcv', qc, S)
        S = S * dc[..., None] + jnp.einsum('bhck,bhcv->bhkv', kc, vc)
        return S, o
    S, o_inter = lax.scan(step, s0, tuple(jnp.moveaxis(t, 1, 0) for t in (q_in, k_out, v, d_last)))
    o = o_intra + jnp.moveaxis(o_inter, 0, 1)
    return o.transpose(0, 1, 3, 2, 4).reshape(B, T, H, V), S


def gla_bidir(q, k, v, logs, inits):
    flip = lambda t: jnp.flip(t, axis=1)
    o_f, S_f = gla_chunked(q, k, v, logs[0], inits[0])
    o_b, S_b = gla_chunked(flip(q), flip(k), flip(v), flip(logs[1]), inits[1])
    return o_f + flip(o_b), (S_f, S_b)


def gla_readout(o, og, norm_g):
    B, T = o.shape[:2]
    y = o * lax.rsqrt(jnp.mean(jnp.square(o), -1, keepdims=True) + GLA_EPS) * norm_g
    return y.reshape(B, T, GLA_DV) * jax.nn.silu(og.astype(jnp.float32))


def odd_mixer(u_ctx, u_lat, w_in, w_out, g_up, g_b, norm_g, ctx_out):
    qc, kc, vc, lc, ogc = gla_prepare(u_ctx @ w_in, g_up, g_b)
    ql, kl, vl, ll, ogl = gla_prepare(u_lat @ w_in, g_up, g_b)
    s0 = jnp.zeros((u_ctx.shape[0], GLA_H, GLA_HK, GLA_HV), jnp.float32)
    o_ctx, fin_ctx = gla_bidir(qc, kc, vc, lc, (s0, s0))
    o_lat, _ = gla_bidir(raster_to_columns(ql), raster_to_columns(kl), raster_to_columns(vl),
                         [raster_to_columns(t) for t in ll], fin_ctx)
    o_lat = columns_to_raster(o_lat)
    y_lat = gla_readout(o_lat, ogl, norm_g).astype(u_lat.dtype) @ w_out
    y_ctx = None
    if ctx_out:
        y_ctx = gla_readout(o_ctx, ogc, norm_g).astype(u_ctx.dtype) @ w_out
    return y_ctx, y_lat


def setup_inputs(seed: int = 0) -> dict:
    key = jax.random.key(seed)
    ks = iter(jax.random.split(key, 48))
    f32 = jnp.float32
    D, F, NE, NO = D_MODEL, D_FF, N_EVEN, N_ODD

    def nrm(shape, scale):
        return scale * jax.random.normal(next(ks), shape, f32)

    def near(shape, center, spread):
        return center + spread * jax.random.normal(next(ks), shape, f32)

    return {
        "x": nrm((BATCH, SEQ, D), 1.0),
        "c": nrm((BATCH, D), 1.0),
        "ctx": nrm((BATCH, CTX_LEN, D), 1.0),
        "c_ctx": nrm((D,), 1.0),
        "ada_w": nrm((DEPTH, D, 9 * D), 0.5 * D ** -0.5),
        "ada_b": nrm((DEPTH, 9 * D), 0.02),
        "ln_g": near((DEPTH, 3, D), 1.0, 0.02),
        "ln_b": nrm((DEPTH, 3, D), 0.02),
        "ffn_wg": nrm((DEPTH, 2, D, F), D ** -0.5),
        "ffn_wu": nrm((DEPTH, 2, D, F), D ** -0.5),
        "ffn_wd": nrm((DEPTH, 2, F, D), DN_BETA * F ** -0.5),
        "ev_w_in": nrm((NE, D, EV_IN), D ** -0.5),
        "ev_w_out": nrm((NE, D, D), DN_BETA * D ** -0.5),
        "hy_conv_w": nrm((NE, 3, HY_IN), 3 ** -0.5),
        "hy_conv_b": nrm((NE, HY_IN), 0.02),
        "hy_f_w1": nrm((NE, HY_EMB, HY_FO), HY_EMB ** -0.5),
        "hy_f_b1": nrm((NE, HY_FO), 0.1),
        "hy_f_freq1": near((NE, HY_FO), 1.0, 0.02),
        "hy_f_w2": nrm((NE, HY_FO, HY_FO), HY_FO ** -0.5),
        "hy_f_b2": nrm((NE, HY_FO), 0.1),
        "hy_f_freq2": near((NE, HY_FO), 1.0, 0.02),
        "hy_f_w3": nrm((NE, HY_FO, 2 * HY_ORDER * HY_W), 0.1 * HY_FO ** -0.5),
        "hy_skip": nrm((NE, HY_ORDER, HY_W), 0.5),
        "rw_mu": jax.random.uniform(next(ks), (NE, RW_IN), f32),
        "rw_w0": jax.random.uniform(next(ks), (NE, 2, RW_W), f32, -2.0, 1.0),
        "rw_w_up": nrm((NE, 2, RW_DECAY_LORA, RW_W), 0.5 * RW_DECAY_LORA ** -0.5),
        "rw_a0": nrm((NE, 2, RW_W), 0.5),
        "rw_a_up": nrm((NE, 2, RW_A_LORA, RW_W), 0.5 * RW_A_LORA ** -0.5),
        "rw_g_up": nrm((NE, RW_GATE_LORA, RW_W), RW_GATE_LORA ** -0.5),
        "rw_k_k": near((NE, RW_W), 0.85, 0.02),
        "rw_k_a": near((NE, RW_W), 1.0, 0.02),
        "rw_r_k": nrm((NE, RW_H, RW_N), 0.1),
        "rw_gn_g": near((NE, RW_W), 1.0, 0.02),
        "rw_gn_b": nrm((NE, RW_W), 0.02),
        "od_w_in": nrm((NO, D, OD_IN), D ** -0.5),
        "od_w_out": nrm((NO, GLA_DV, D), DN_BETA * GLA_DV ** -0.5),
        "gla_g_up": nrm((NO, 2, GLA_GATE_LORA, GLA_DK), GLA_GATE_LORA ** -0.5),
        "gla_g_b": nrm((NO, 2, GLA_DK), 0.5),
        "gla_norm_g": near((NO, GLA_HV), 1.0, 0.02),
    }


def reference(x, c, ctx, c_ctx, ada_w, ada_b, ln_g, ln_b, ffn_wg, ffn_wu, ffn_wd, ev_w_in, ev_w_out,
              hy_conv_w, hy_conv_b, hy_f_w1, hy_f_b1, hy_f_freq1, hy_f_w2, hy_f_b2, hy_f_freq2, hy_f_w3, hy_skip,
              rw_mu, rw_w0, rw_w_up, rw_a0, rw_a_up, rw_g_up, rw_k_k, rw_k_a, rw_r_k, rw_gn_g, rw_gn_b,
              od_w_in, od_w_out, gla_g_up, gla_g_b, gla_norm_g):
    h_lat, h_ctx = x, ctx
    s_lat = jax.nn.silu(c)[:, None, :]
    s_ctx = jax.nn.silu(c_ctx)[None, None, :]
    for l in range(DEPTH):
        last = l == DEPTH - 1
        m_lat = jnp.split(s_lat @ ada_w[l] + ada_b[l], 9, axis=-1)
        m_ctx = jnp.split(s_ctx @ ada_w[l] + ada_b[l], 9, axis=-1)

        h_lat = post_norm_residual(
            h_lat, swiglu(modulate(h_lat, m_lat[0], m_lat[1]), ffn_wg[l, 0], ffn_wu[l, 0], ffn_wd[l, 0]),
            m_lat[2], 0.5, ln_g[l, 0], ln_b[l, 0])
        h_ctx = post_norm_residual(
            h_ctx, swiglu(modulate(h_ctx, m_ctx[0], m_ctx[1]), ffn_wg[l, 0], ffn_wu[l, 0], ffn_wd[l, 0]),
            m_ctx[2], 0.5, ln_g[l, 0], ln_b[l, 0])

        u_lat = modulate(h_lat, m_lat[3], m_lat[4])
        u_ctx = modulate(h_ctx, m_ctx[3], m_ctx[4])
        if l % 2 == 0:
            e = l // 2
            y_ctx, y_lat = even_mixer(
                u_ctx, u_lat, ev_w_in[e], ev_w_out[e], hy_conv_w[e], hy_conv_b[e], hy_f_w1[e], hy_f_b1[e],
                hy_f_freq1[e], hy_f_w2[e], hy_f_b2[e], hy_f_freq2[e], hy_f_w3[e], hy_skip[e], rw_mu[e], rw_w0[e],
                rw_w_up[e], rw_a0[e], rw_a_up[e], rw_g_up[e], rw_k_k[e], rw_k_a[e], rw_r_k[e], rw_gn_g[e], rw_gn_b[e],
                ctx_out=not last)
        else:
            o = l // 2
            y_ctx, y_lat = odd_mixer(u_ctx, u_lat, od_w_in[o], od_w_out[o], gla_g_up[o], gla_g_b[o],
                                     gla_norm_g[o], ctx_out=not last)
        h_lat = post_norm_residual(h_lat, y_lat, m_lat[5], 1.0, ln_g[l, 1], ln_b[l, 1])

        h_lat = post_norm_residual(
            h_lat, swiglu(modulate(h_lat, m_lat[6], m_lat[7]), ffn_wg[l, 1], ffn_wu[l, 1], ffn_wd[l, 1]),
            m_lat[8], 0.5, ln_g[l, 2], ln_b[l, 2])
        if not last:
            h_ctx = post_norm_residual(h_ctx, y_ctx, m_ctx[5], 1.0, ln_g[l, 1], ln_b[l, 1])
            h_ctx = post_norm_residual(
                h_ctx, swiglu(modulate(h_ctx, m_ctx[6], m_ctx[7]), ffn_wg[l, 1], ffn_wu[l, 1], ffn_wd[l, 1]),
                m_ctx[8], 0.5, ln_g[l, 2], ln_b[l, 2])
    return h_lat
```

```cpp
#include <hip/hip_runtime.h>
#include <hip/hip_cooperative_groups.h>
#include <cstdio>
namespace pg8 {
#define PG8_LAS __attribute__((address_space(3)))
typedef unsigned short bf16_t;
typedef short bf16x8 __attribute__((ext_vector_type(8)));
typedef float f32x4 __attribute__((ext_vector_type(4)));
typedef unsigned u32x4 __attribute__((ext_vector_type(4)));
constexpr int BM = 256, BK = 64, HALF = 128, HTB = HALF * BK * 2  , STAGE_BYTES = 8 * HTB, NXCD = 8, WGM = 8;

__host__ __device__ __forceinline__ int lds_byte(int r, int c) { const int st = (r >> 4) * 2 + (c >> 5), rr = r & 15, cc = c & 31, ob = rr * 64 + cc * 2; return st * 1024 + (ob ^ (((ob >> 9) & 1) << 5)); }
__host__ __device__ __forceinline__ void stage_rc(int b, int& R, int& C) { const int st = b / 1024, sb = b % 1024, swz = sb ^ (((sb >> 9) & 1) << 5); R = (st >> 1) * 16 + swz / 64; C = (st & 1) * 32 + (swz % 64) / 2; }
__host__ __device__ __forceinline__ int perm32(int rho) { const int n = rho >> 4, i = rho & 15; return 8 * (i >> 2) + 4 * n + (i & 3); }

struct Unit { int pm, pn; };
struct Gemm { const bf16_t* A; const bf16_t* Bt; int M, N, K; };

struct StaticOrder {
    int nM, nN, nwg, G, c;
    __host__ __device__ void init(int M, int N, int G_, int c_) { nM = M / BM; nN = N / BM; nwg = nM * nN; G = G_; c = c_; }
    __host__ __device__ bool next(int i, Unit& u) const {
        const long L = (long)i * G + c; if (L >= nwg) return false;
        int wgid = (int)L; { const int q = nwg / NXCD, r = nwg % NXCD, xcd = wgid % NXCD, off = wgid / NXCD; wgid = (xcd < r ? xcd * (q + 1) : r * (q + 1) + (xcd - r) * q) + off; }
        const int nig = WGM * nN, gid = wgid / nig, fm = gid * WGM, gsz = (nM - fm) < WGM ? (nM - fm) : WGM;
        u.pm = fm + ((wgid % nig) % gsz); u.pn = (wgid % nig) / gsz; return true;
    }
    __device__ __forceinline__ void a_ready(const Unit&) const {}
    __device__ __forceinline__ void done(const Unit&) const {}
};
__device__ __forceinline__ unsigned cvt_pk_bf16(float lo, float hi) { unsigned r; asm volatile("v_cvt_pk_bf16_f32 %0, %1, %2" : "=v"(r) : "v"(lo), "v"(hi)); return r; }
typedef float f32x2 __attribute__((ext_vector_type(2)));

template <class Epi, class Sched, bool STAMP = false>
__device__ __forceinline__ void gemm_phase(PG8_LAS unsigned char* lds, const Gemm g, const Sched& S, const Epi& E, unsigned long long* stamps) {
    const int tid = threadIdx.x, wid = __builtin_amdgcn_readfirstlane(tid >> 6), lane = tid & 63, wr = wid >> 2, wc = wid & 3, fr = lane & 15, fq = lane >> 4;
    const int K = g.K, nt = K / BK;
    int ts_lo = 0, ts_hi = 0, nts = 0; const unsigned long long rt_entry = STAMP ? (unsigned long long)wall_clock64() : 0ull;
#define PG8_STAMP() do { if (STAMP && wid == 0 && nts < 64) { const unsigned long long _c = (unsigned long long)clock64(); \
        ts_lo = (lane == nts) ? (int)(unsigned)_c : ts_lo; ts_hi = (lane == nts) ? (int)(unsigned)(_c >> 32) : ts_hi; ++nts; } } while (0)
    PG8_STAMP();
    unsigned voffA[2], voffB[2];
#pragma unroll
    for (int i = 0; i < 2; ++i) { int R, C; stage_rc(tid * 16 + i * 8192, R, C); const int Rb = Epi::PERM ? ((R & ~31) + perm32(R & 31)) : R;
        voffA[i] = (unsigned)(R * K + C) * 2u; voffB[i] = (unsigned)(Rb * K + C) * 2u; }
    const size_t kstep = (size_t)(BK * 2);
    const size_t hstep = (size_t)HALF * K * 2;
    const size_t tstep = 2 * hstep;
    const unsigned ldsw = (unsigned)wid * 1024u;
    const int aoff = lds_byte(wr * 64 + fr, fq * 8), boff = lds_byte(wc * 32 + fr, fq * 8);
#define PG8_SA(b, h) (((b) * 2 + (h)) * HTB)
#define PG8_SB(b, h) ((4 + (b) * 2 + (h)) * HTB)
#define PG8_STAGE(bufoff, gbase, voff) do { _Pragma("unroll") for (int _i = 0; _i < 2; ++_i) \
        __builtin_amdgcn_global_load_lds((const unsigned*)((const char*)(gbase) + (voff)[_i]), (PG8_LAS unsigned*)(lds + (bufoff) + ldsw + _i * 8192), 16, 0, 0); } while (0)
#define PG8_LDA(dst, b, h) do { _Pragma("unroll") for (int m = 0; m < 4; ++m) _Pragma("unroll") for (int k = 0; k < 2; ++k) dst[m][k] = *(const PG8_LAS bf16x8*)(lds + PG8_SA(b, h) + aoff + m * 2048 + k * 1024); } while (0)
#define PG8_LDB(dst, b, h) do { _Pragma("unroll") for (int n = 0; n < 2; ++n) _Pragma("unroll") for (int k = 0; k < 2; ++k) dst[n][k] = *(const PG8_LAS bf16x8*)(lds + PG8_SB(b, h) + boff + n * 2048 + k * 1024); } while (0)
#define PG8_MMA(ai, bj, At, Bt) do { __builtin_amdgcn_s_setprio(1); _Pragma("unroll") for (int m = 0; m < 4; ++m) _Pragma("unroll") for (int n = 0; n < 2; ++n) _Pragma("unroll") for (int k = 0; k < 2; ++k) \
        acc[ai][bj][m][n] = __builtin_amdgcn_mfma_f32_16x16x32_bf16(Bt[n][k], At[m][k], acc[ai][bj][m][n], 0, 0, 0); __builtin_amdgcn_s_setprio(0); } while (0)
#define PG8_WAIT_V(n) asm volatile("s_waitcnt vmcnt(" #n ")" ::: "memory")
#define PG8_WAIT_L(n) asm volatile("s_waitcnt lgkmcnt(" #n ")" ::: "memory")
#define PG8_BAR __builtin_amdgcn_s_barrier()
#define PG8_SCHED __builtin_amdgcn_sched_barrier(0)
    Unit cur, nxt; int ui = 0;
    if (!S.next(0, cur)) return;
    f32x4 acc[2][2][4][2];
#pragma unroll
    for (int a = 0; a < 2; ++a)
#pragma unroll
        for (int b = 0; b < 2; ++b)
#pragma unroll
            for (int m = 0; m < 4; ++m)
#pragma unroll
                for (int n = 0; n < 2; ++n) acc[a][b][m][n] = (f32x4){0.f, 0.f, 0.f, 0.f};
    bf16x8 At[4][2], B0[2][2], B1[2][2];
    const char* cA = (const char*)g.A + (size_t)cur.pm * tstep; const char* cB = (const char*)g.Bt + (size_t)cur.pn * tstep;
    S.a_ready(cur);
    PG8_STAGE(PG8_SB(0, 0), cB, voffB); PG8_STAGE(PG8_SA(0, 0), cA, voffA); PG8_STAGE(PG8_SB(0, 1), cB + hstep, voffB); PG8_STAGE(PG8_SA(0, 1), cA + hstep, voffA);
    if (wr == 1) PG8_BAR;
    PG8_WAIT_V(4); PG8_BAR;
    PG8_STAGE(PG8_SB(1, 0), cB + kstep, voffB); PG8_STAGE(PG8_SA(1, 0), cA + kstep, voffA); PG8_STAGE(PG8_SB(1, 1), cB + hstep + kstep, voffB);
    PG8_WAIT_V(6); PG8_BAR;
    PG8_STAMP();
    for (;;) {
        const bool has_next = S.next(ui + 1, nxt);
        const char* nA = has_next ? (const char*)g.A + (size_t)nxt.pm * tstep : cA; const char* nB = has_next ? (const char*)g.Bt + (size_t)nxt.pn * tstep : cB;
        for (int t = 0; t < nt; t += 2) {
            const bool last = (t == nt - 2);
            const char* a1 = cA + (size_t)(t + 1) * kstep;
            const char* a2 = last ? nA : cA + (size_t)(t + 2) * kstep; const char* b2 = last ? nB : cB + (size_t)(t + 2) * kstep;
            const char* a3 = a2 + kstep; const char* b3 = b2 + kstep;
            if (last && has_next) S.a_ready(nxt);
            PG8_LDB(B0, 0, 0); PG8_SCHED; PG8_LDA(At, 0, 0); PG8_STAGE(PG8_SA(1, 1), a1 + hstep, voffA);
            PG8_WAIT_L(8); PG8_BAR; PG8_WAIT_L(0); PG8_MMA(0, 0, At, B0); PG8_BAR; PG8_SCHED;
            PG8_LDB(B1, 0, 1); PG8_STAGE(PG8_SB(0, 0), b2, voffB);
            PG8_BAR; PG8_WAIT_L(0); PG8_MMA(0, 1, At, B1); PG8_BAR;
            PG8_LDA(At, 0, 1); PG8_STAGE(PG8_SA(0, 0), a2, voffA);
            PG8_BAR; PG8_WAIT_L(0); PG8_MMA(1, 0, At, B0); PG8_BAR; PG8_SCHED;
            PG8_STAGE(PG8_SB(0, 1), b2 + hstep, voffB);
            PG8_WAIT_V(6); PG8_BAR; PG8_MMA(1, 1, At, B1); PG8_BAR;
            PG8_LDB(B0, 1, 0); PG8_SCHED; PG8_LDA(At, 1, 0); PG8_STAGE(PG8_SA(0, 1), a2 + hstep, voffA);
            PG8_WAIT_L(8); PG8_BAR; PG8_WAIT_L(0); PG8_MMA(0, 0, At, B0); PG8_BAR; PG8_SCHED;
            PG8_LDB(B1, 1, 1); PG8_STAGE(PG8_SB(1, 0), b3, voffB);
            PG8_BAR; PG8_WAIT_L(0); PG8_MMA(0, 1, At, B1); PG8_BAR;
            PG8_LDA(At, 1, 1); PG8_STAGE(PG8_SA(1, 0), a3, voffA);
            PG8_BAR; PG8_WAIT_L(0); PG8_MMA(1, 0, At, B0); PG8_BAR; PG8_SCHED;
            PG8_STAGE(PG8_SB(1, 1), b3 + hstep, voffB);
            PG8_WAIT_V(6); PG8_BAR; PG8_MMA(1, 1, At, B1); PG8_BAR;
        }
        PG8_STAMP();
        if constexpr (!Epi::AFTER_DRAIN) { E(acc, cur, wr, wc, fr, fq); S.done(cur); }
        PG8_STAMP();
        if (!has_next) break;
#pragma unroll
        for (int a = 0; a < 2; ++a)
#pragma unroll
            for (int b = 0; b < 2; ++b)
#pragma unroll
                for (int m = 0; m < 4; ++m)
#pragma unroll
                    for (int n = 0; n < 2; ++n) acc[a][b][m][n] = (f32x4){0.f, 0.f, 0.f, 0.f};
        cur = nxt; cA = nA; cB = nB; ++ui;
    }
    PG8_WAIT_V(0);
    if (wr == 0) PG8_BAR;
    PG8_BAR;
    if constexpr (Epi::AFTER_DRAIN) { E.fused(acc, cur, wr, wc, fr, fq, lds, wid, lane); S.done(cur); }
    PG8_STAMP();
    if (STAMP && wid == 0) { stamps[lane] = lane < nts ? (((unsigned long long)(unsigned)ts_hi << 32) | (unsigned)ts_lo) : 0ull;
        if (lane == 62) stamps[62] = rt_entry; if (lane == 63) stamps[63] = (unsigned long long)wall_clock64(); }
#undef PG8_STAMP
#undef PG8_SA
#undef PG8_SB
#undef PG8_STAGE
#undef PG8_LDA
#undef PG8_LDB
#undef PG8_MMA
#undef PG8_WAIT_V
#undef PG8_WAIT_L
#undef PG8_BAR
#undef PG8_SCHED
}
}
namespace cg = cooperative_groups;
typedef unsigned short bf16_t;
using pg8::bf16x8; using pg8::f32x4;
#define LAS __attribute__((address_space(3)))

constexpr int D = 1024, NB = 16, TL = 2048, TCX = 256, FF = 2816;
constexpr int MLAT = NB * TL, MCTX = NB * TCX, MTOT = MLAT + MCTX;
constexpr float DN_ALPHA = 1.681792830507429f;
constexpr int NTHR = 512;
constexpr int LDS_BYTES = 155648;

constexpr size_t al256(size_t x) { return (x + 255) & ~(size_t)255; }
constexpr size_t WS_MOD = 4096;
constexpr size_t WS_FT = al256(WS_MOD + (size_t)4 * 17 * 9216 * 4);
constexpr size_t FT_LAT = (size_t)2 * 512 * 4096, FT_CTX = (size_t)2 * 512 * 512, FT_E = FT_LAT + FT_CTX;
constexpr size_t WS_WUP = al256(WS_FT + 2 * FT_E * 2);
constexpr size_t WS_WDN = WS_WUP + (size_t)2 * 5632 * 1024 * 2;
constexpr size_t WS_WIN = WS_WDN + (size_t)2 * 1024 * 2816 * 2;
constexpr size_t WS_WOUT = WS_WIN + (size_t)3584 * 1024 * 2;
constexpr size_t WS_H = WS_WOUT + (size_t)1024 * 1024 * 2;
constexpr size_t WS_A = WS_H + (size_t)MTOT * 1024 * 4;
constexpr size_t WS_BON = WS_A + (size_t)MTOT * 1024 * 2;
constexpr size_t WS_BIG = al256(WS_BON + (size_t)2 * MTOT * 8 * 4);
constexpr size_t BIG_ZR = (size_t)1536 * MTOT * 2;
constexpr size_t BIG_ORW = BIG_ZR + (size_t)MTOT * 1920 * 2;
constexpr size_t BIG_EVEN_END = BIG_ORW + (size_t)2 * MTOT * 512 * 2;
constexpr size_t BIG_OGL = al256((size_t)MTOT * 3104 * 2);
constexpr size_t WS_END = WS_BIG + BIG_EVEN_END;

struct Params { const float* in[41]; };
#define PH_PRO int tid_ = threadIdx.x; asm volatile("" : "+v"(tid_)); int bid_ = blockIdx.x; asm volatile("" : "+s"(bid_)); int gdim_ = gridDim.x; asm volatile("" : "+s"(gdim_));
extern __shared__ __attribute__((aligned(16))) unsigned char smem_g[];
constexpr int TBL_OFF = LDS_BYTES - 512;
#define IN(i) (((const float* const*)(smem_g + TBL_OFF))[i])
#define OUT_ ((float*)IN(39))
#define WS_ ((unsigned char*)IN(40))

__device__ __forceinline__ float bf2f(bf16_t b) { return __uint_as_float(((unsigned)b) << 16); }
__device__ __forceinline__ bf16_t f2bf(float f) { unsigned u = __float_as_uint(f); u += 0x7FFFu + ((u >> 16) & 1u); return (bf16_t)(u >> 16); }
__device__ __forceinline__ unsigned pk2(float lo, float hi) { return (unsigned)f2bf(lo) | ((unsigned)f2bf(hi) << 16); }
__device__ __forceinline__ float wsum(float v) {
#pragma unroll
    for (int o = 32; o; o >>= 1) v += __shfl_xor(v, o);
    return v;
}
__device__ __forceinline__ float sigm(float x) { return 1.f / (1.f + __expf(-x)); }
__device__ __forceinline__ float silu_(float x) { return x / (1.f + __expf(-x)); }
__device__ __forceinline__ float softplus_(float y) { return fmaxf(y, 0.f) + log1pf(__expf(-fabsf(y))); }

struct EpiStore {
    static constexpr bool PERM = true, AFTER_DRAIN = false;
    bf16_t* O; int ldc; int nvalid;
    __device__ __forceinline__ void operator()(const f32x4 (&acc)[2][2][4][2], const pg8::Unit& u, int wr, int wc, int fr, int fq) const {
        const int row0 = u.pm * 256 + wr * 64 + fr, col0 = u.pn * 256 + wc * 32 + 8 * fq;
#pragma unroll
        for (int ai = 0; ai < 2; ++ai)
#pragma unroll
            for (int m = 0; m < 4; ++m) {
                bf16_t* rowp = O + (size_t)(row0 + ai * 128 + m * 16) * ldc;
#pragma unroll
                for (int bj = 0; bj < 2; ++bj) {
                    const int col = col0 + bj * 128;
                    if (col < nvalid) {
                        const f32x4 v0 = acc[ai][bj][m][0], v1 = acc[ai][bj][m][1];
                        uint4 o; o.x = pk2(v0[0], v0[1]); o.y = pk2(v0[2], v0[3]); o.z = pk2(v1[0], v1[1]); o.w = pk2(v1[2], v1[3]);
                        *(uint4*)(rowp + col) = o;
                    }
                }
            }
    }
};
struct EpiSwiglu {
    static constexpr bool PERM = true, AFTER_DRAIN = false;
    bf16_t* G;
    __device__ __forceinline__ void operator()(const f32x4 (&acc)[2][2][4][2], const pg8::Unit& u, int wr, int wc, int fr, int fq) const {
        const int row0 = u.pm * 256 + wr * 64 + fr, col0 = u.pn * 128 + wc * 32 + 8 * fq;
#pragma unroll
        for (int ai = 0; ai < 2; ++ai)
#pragma unroll
            for (int m = 0; m < 4; ++m) {
                bf16_t* rowp = G + (size_t)(row0 + ai * 128 + m * 16) * FF + col0;
                float o[8];
#pragma unroll
                for (int n = 0; n < 2; ++n)
#pragma unroll
                    for (int e = 0; e < 4; ++e) o[n * 4 + e] = silu_(acc[ai][0][m][n][e]) * acc[ai][1][m][n][e];
                uint4 q; q.x = pk2(o[0], o[1]); q.y = pk2(o[2], o[3]); q.z = pk2(o[4], o[5]); q.w = pk2(o[6], o[7]);
                *(uint4*)rowp = q;
            }
    }
};
struct EpiResid {
    static constexpr bool PERM = false, AFTER_DRAIN = false;
    float* H; const float* gate; float wgt;
    __device__ __forceinline__ void operator()(const f32x4 (&acc)[2][2][4][2], const pg8::Unit& u, int wr, int wc, int fr, int fq) const {
        const int row0 = u.pm * 256 + wr * 64 + fr, col0 = u.pn * 256 + wc * 32 + 4 * fq;
        const int midx = u.pm < 128 ? (u.pm >> 3) : 16;
        const float* gp = gate + (size_t)midx * 9216 + col0;
#pragma unroll
        for (int ai = 0; ai < 2; ++ai)
#pragma unroll
            for (int m = 0; m < 4; ++m) {
                float* rowp = H + (size_t)(row0 + ai * 128 + m * 16) * D + col0;
#pragma unroll
                for (int bj = 0; bj < 2; ++bj)
#pragma unroll
                    for (int n = 0; n < 2; ++n) {
                        f32x4 h = *(const f32x4*)(rowp + bj * 128 + n * 16);
                        const f32x4 gvv = *(const f32x4*)(gp + bj * 128 + n * 16) * wgt; h = h * DN_ALPHA + gvv * acc[ai][bj][m][n];
                        *(f32x4*)(rowp + bj * 128 + n * 16) = h;
                    }
            }
    }
};

template <class Epi>
__device__ __forceinline__ void run_gemm(unsigned char* smem, const bf16_t* A, const bf16_t* Bt, int M, int N, int K, const Epi& E, int bid_, int gdim_) {
    pg8::Gemm g; g.A = A; g.Bt = Bt; g.M = M; g.N = N; g.K = K;
    pg8::StaticOrder S; S.init(M, N, gdim_, bid_);
    pg8::gemm_phase<Epi, pg8::StaticOrder, false>((PG8_LAS unsigned char*)smem, g, S, E, nullptr);
}

__device__ __forceinline__ void phase_mod(const Params& p, unsigned char* smem) {
    PH_PRO
    float* s = (float*)smem;
    float* part = s + 17 * 1024;
    const int tid = tid_;
    const float* c = IN(1); const float* cc = IN(3);
    float* MOD = (float*)(WS_ + WS_MOD);
    if (bid_ >= 288) return;
    for (int idx = tid; idx < 17 * 1024; idx += NTHR) { const int i = idx >> 10, k = idx & 1023; const float v = i < 16 ? c[i * 1024 + k] : cc[k]; s[idx] = silu_(v); }
    __syncthreads();
    for (int item = bid_; item < 288; item += gdim_) {
        const int l = item / 72, j0 = (item % 72) * 128;
        const int col = tid & 127, kq = tid >> 7;
        const float* w = IN(4) + ((size_t)l * 1024 + kq * 256) * 9216 + j0 + col;
        float acc[17];
#pragma unroll
        for (int i = 0; i < 17; ++i) acc[i] = 0.f;
        for (int k = 0; k < 256; ++k) {
            const float wv = w[(size_t)k * 9216];
#pragma unroll
            for (int i = 0; i < 17; ++i) acc[i] += s[i * 1024 + kq * 256 + k] * wv;
        }
#pragma unroll
        for (int i = 0; i < 17; ++i) part[(kq * 17 + i) * 128 + col] = acc[i];
        __syncthreads();
        for (int idx = tid; idx < 17 * 128; idx += NTHR) {
            const int i = idx >> 7, cl = idx & 127;
            const float v = part[(0 * 17 + i) * 128 + cl] + part[(1 * 17 + i) * 128 + cl] + part[(2 * 17 + i) * 128 + cl] + part[(3 * 17 + i) * 128 + cl] + IN(5)[l * 9216 + j0 + cl];
            MOD[((size_t)l * 17 + i) * 9216 + j0 + cl] = v;
        }
        __syncthreads();
    }
}

__device__ __forceinline__ void conv_tile(const float* src, int ld, int nvalid, bf16_t* dst, int ldd, float* tile) {
    PH_PRO
    const int tid = tid_;
#pragma unroll
    for (int i = 0; i < 8; ++i) { const int k = (tid >> 6) + 8 * i, c = tid & 63; tile[k * 65 + c] = (c < nvalid) ? src[(size_t)k * ld + c] : 0.f; }
    __syncthreads();
    const int n = tid >> 3, ks = (tid & 7) * 8;
    uint4 o;
    o.x = pk2(tile[(ks + 0) * 65 + n], tile[(ks + 1) * 65 + n]); o.y = pk2(tile[(ks + 2) * 65 + n], tile[(ks + 3) * 65 + n]);
    o.z = pk2(tile[(ks + 4) * 65 + n], tile[(ks + 5) * 65 + n]); o.w = pk2(tile[(ks + 6) * 65 + n], tile[(ks + 7) * 65 + n]);
    *(uint4*)(dst + (size_t)n * ldd + ks) = o;
    __syncthreads();
}
__device__ __forceinline__ void conv_weights(const Params& p, int l, unsigned char* smem) {
    PH_PRO
    float* tile = (float*)smem;
    const bool even = !(l & 1); const int eo = l >> 1;
    const int NIN = even ? 3456 : 3104, nint = (even ? 3584 : 3328) / 64;
    const int total = 2816 + 1408 + nint * 16 + 256;
    bf16_t* WUP = (bf16_t*)(WS_ + WS_WUP); bf16_t* WDN = (bf16_t*)(WS_ + WS_WDN); bf16_t* WIN = (bf16_t*)(WS_ + WS_WIN); bf16_t* WOUT = (bf16_t*)(WS_ + WS_WOUT);
    for (int idx = bid_; idx < total; idx += gdim_) {
        if (idx < 2816) {
            const int f = idx / 1408, r = idx % 1408, nt = r / 16, kt = r % 16, n0 = nt * 64;
            const int pn = n0 >> 8, bj = (n0 & 255) >> 7, j = n0 & 127, col = pn * 128 + j;
            const float* src = (bj ? IN(9) : IN(8)) + ((size_t)(l * 2 + f) * 1024 + kt * 64) * FF + col;
            conv_tile(src, FF, 64, WUP + ((size_t)f * 5632 + n0) * 1024 + kt * 64, 1024, tile);
        } else if (idx < 4224) {
            int r = idx - 2816; const int f = r / 704; r %= 704; const int kt = r / 16, nt = r % 16;
            const float* src = IN(10) + ((size_t)(l * 2 + f) * FF + kt * 64) * 1024 + nt * 64;
            conv_tile(src, 1024, 64, WDN + ((size_t)f * 1024 + nt * 64) * FF + kt * 64, FF, tile);
        } else if (idx < 4224 + nint * 16) {
            const int r = idx - 4224, nt = r / 16, kt = r % 16, n0 = nt * 64;
            int nv = NIN - n0; nv = nv < 0 ? 0 : (nv > 64 ? 64 : nv);
            const float* src = (even ? IN(11) : IN(34)) + ((size_t)eo * 1024 + kt * 64) * NIN + n0;
            conv_tile(src, NIN, nv, WIN + (size_t)n0 * 1024 + kt * 64, 1024, tile);
        } else {
            const int r = idx - 4224 - nint * 16, nt = r / 16, kt = r % 16;
            const float* src = (even ? IN(12) : IN(35)) + ((size_t)eo * 1024 + kt * 64) * 1024 + nt * 64;
            conv_tile(src, 1024, 64, WOUT + (size_t)nt * 64 * 1024 + kt * 64, 1024, tile);
        }
    }
}

__device__ __forceinline__ void filt_gen(const Params& p, unsigned char* smem) {
    PH_PRO
    float* z = (float*)smem;
    float* h1 = z + 64 * 33;
    float* h2 = h1 + 64 * 65;
    const int tid = tid_;
    bf16_t* FT = (bf16_t*)(WS_ + WS_FT);
    for (int item = bid_; item < 2 * 1152; item += gdim_) {
        const int e = item / 1152; int r = item % 1152;
        const int seg = r >= 1024; if (seg) r -= 1024;
        const int L = seg ? 256 : 2048;
        const int jb = r >> 5, cb = r & 31;
        const float* w1 = IN(15) + e * 33 * 64; const float* b1 = IN(16) + e * 64; const float* f1 = IN(17) + e * 64;
        const float* w2 = IN(18) + e * 64 * 64; const float* b2 = IN(19) + e * 64; const float* f2 = IN(20) + e * 64;
        const float* w3 = IN(21) + (size_t)e * 64 * 2048; const float* skip = IN(22) + e * 1024;
        for (int idx = tid; idx < 64 * 33; idx += NTHR) {
            const int jj = idx / 33, i = idx % 33; const int j = jb * 64 + jj;
            float v;
            if (i == 0) v = (float)j / (float)(L - 1);
            else { const int bi = (i - 1) & 15; const float f = 1e-4f + (float)bi * ((15.f - 1e-4f) / 15.f); const float w = 6.283185307179586f * (float)j / (float)L; v = (i <= 16) ? cosf(f * w) : -sinf(f * w); }
            z[idx] = v;
        }
        __syncthreads();
        for (int idx = tid; idx < 4096; idx += NTHR) {
            const int jj = idx >> 6, o = idx & 63; float a = b1[o];
            for (int i = 0; i < 33; ++i) a += z[jj * 33 + i] * w1[i * 64 + o];
            h1[jj * 65 + o] = sinf(f1[o] * a);
        }
        __syncthreads();
        for (int idx = tid; idx < 4096; idx += NTHR) {
            const int jj = idx >> 6, o = idx & 63; float a = b2[o];
            for (int k = 0; k < 64; ++k) a += h1[jj * 65 + k] * w2[k * 64 + o];
            h2[jj * 65 + o] = sinf(f2[o] * a);
        }
        __syncthreads();
        const int jj = tid & 63, cq = tid >> 6; const int j = jb * 64 + jj;
        float acc[8];
#pragma unroll
        for (int i = 0; i < 8; ++i) acc[i] = 0.f;
        for (int k = 0; k < 64; ++k) {
            const float hv = h2[jj * 65 + k];
#pragma unroll
            for (int i = 0; i < 8; ++i) acc[i] += hv * w3[(size_t)k * 2048 + cb * 64 + cq + 8 * i];
        }
        const float tj = (float)j / (float)(L - 1);
        bf16_t* base = FT + (size_t)e * FT_E + (seg ? FT_LAT : 0);
#pragma unroll
        for (int i = 0; i < 8; ++i) {
            const int col = cb * 64 + cq + 8 * i; const int ord = col >> 10, dir = (col >> 9) & 1, c = col & 511;
            const float lo = -4.605170185988091f / 1.5f, hi = -4.605170185988091f / 0.3f;
            const float delta = lo + (hi - lo) * (float)c / 511.f;
            float v = acc[i] * __expf(-tj * fabsf(delta));
            if (dir == 0 && j == 0) v += skip[ord * 512 + c];
            if (!(dir == 1 && j == 0)) {
                const int m = dir == 0 ? (L - 1 - j) : (L - 1 + j);
                base[((size_t)ord * 512 + c) * (2 * L) + m] = f2bf(v);
            }
        }
        __syncthreads();
    }
}

__device__ __forceinline__ void row_phase(const Params& p, int mode, int l_ln, int which, int l_mod, int sidx, bool fin) {
    PH_PRO
    const int lane = tid_ & 63, wid = tid_ >> 6;
    float* H = (float*)(WS_ + WS_H); bf16_t* A = (bf16_t*)(WS_ + WS_A);
    const float* MOD = (const float*)(WS_ + WS_MOD);
    const float* lg = IN(6) + (l_ln * 3 + which) * 1024; const float* lb = IN(7) + (l_ln * 3 + which) * 1024;
    const int nrows = fin ? MLAT : MTOT;
    for (int row = bid_ * 8 + wid; row < nrows; row += gdim_ * 8) {
        const float* src = mode ? H + (size_t)row * D : (row < MLAT ? IN(0) + (size_t)row * D : IN(2) + (size_t)(row - MLAT) * D);
        float4 v[4];
#pragma unroll
        for (int i = 0; i < 4; ++i) v[i] = *(const float4*)(src + 4 * lane + 256 * i);
        if (mode) {
            float s = 0.f;
#pragma unroll
            for (int i = 0; i < 4; ++i) s += v[i].x + v[i].y + v[i].z + v[i].w;
            const float mu = wsum(s) * (1.f / 1024.f);
            float q = 0.f;
#pragma unroll
            for (int i = 0; i < 4; ++i) { v[i].x -= mu; v[i].y -= mu; v[i].z -= mu; v[i].w -= mu; q += v[i].x * v[i].x + v[i].y * v[i].y + v[i].z * v[i].z + v[i].w * v[i].w; }
            const float rstd = rsqrtf(wsum(q) * (1.f / 1024.f) + 1e-6f);
#pragma unroll
            for (int i = 0; i < 4; ++i) {
                const float4 g = *(const float4*)(lg + 4 * lane + 256 * i), b = *(const float4*)(lb + 4 * lane + 256 * i);
                v[i].x = v[i].x * rstd * g.x + b.x; v[i].y = v[i].y * rstd * g.y + b.y; v[i].z = v[i].z * rstd * g.z + b.z; v[i].w = v[i].w * rstd * g.w + b.w;
            }
        }
        if (fin) {
#pragma unroll
            for (int i = 0; i < 4; ++i) *(float4*)(OUT_ + (size_t)row * D + 4 * lane + 256 * i) = v[i];
            continue;
        }
        const int midx = row < MLAT ? (row >> 11) : 16;
        const float* mp = MOD + ((size_t)l_mod * 17 + midx) * 9216 + sidx * 1024;
#pragma unroll
        for (int i = 0; i < 4; ++i) {
            *(float4*)(H + (size_t)row * D + 4 * lane + 256 * i) = v[i];
            const float4 sh = *(const float4*)(mp + 4 * lane + 256 * i), sc = *(const float4*)(mp + 1024 + 4 * lane + 256 * i);
            uint2 o; o.x = pk2(v[i].x * (1.f + sc.x) + sh.x, v[i].y * (1.f + sc.y) + sh.y); o.y = pk2(v[i].z * (1.f + sc.z) + sh.z, v[i].w * (1.f + sc.w) + sh.w);
            *(uint2*)(A + (size_t)row * D + 4 * lane + 256 * i) = o;
        }
    }
}
template <int L>
__device__ __forceinline__ void hyena_item(const Params& p, int e, int c, int segbase, const bf16_t* ft, unsigned char* smem) {
    PH_PRO
    constexpr int CPS = 2 * L + 16, UTS = L + 8, TPW = (L / 16) / 8;
    bf16_t* COP = (bf16_t*)smem;
    bf16_t* UT = COP + 8 * CPS;
    const int tid = tid_, lane = tid & 63, wid = tid >> 6;
    bf16_t* ZHT = (bf16_t*)(WS_ + WS_BIG);
    bf16_t* zv = ZHT + (size_t)c * MTOT + segbase;
    const bf16_t* zx1 = ZHT + (size_t)(512 + c) * MTOT + segbase;
    const bf16_t* zx2 = ZHT + (size_t)(1024 + c) * MTOT + segbase;
    const float* cw = IN(13) + e * 3 * 1536; const float* cbp = IN(14) + e * 1536;
    const float vw0 = cw[c], vw1 = cw[1536 + c], vw2 = cw[3072 + c], vb = cbp[c];
    const float aw0 = cw[512 + c], aw1 = cw[1536 + 512 + c], aw2 = cw[3072 + 512 + c], ab = cbp[512 + c];
    const float bw0 = cw[1024 + c], bw1 = cw[1536 + 1024 + c], bw2 = cw[3072 + 1024 + c], bb = cbp[1024 + c];
    for (int idx = tid; idx < 16 * L; idx += NTHR) {
        const int b = idx / L, s = idx % L; const bf16_t* q = zv + b * L;
        const float z0 = bf2f(q[s]), zp = s > 0 ? bf2f(q[s - 1]) : 0.f, zn = s < L - 1 ? bf2f(q[s + 1]) : 0.f;
        UT[b * UTS + s] = f2bf(zp * vw0 + z0 * vw1 + zn * vw2 + vb);
    }
    const int r = lane & 15, g = lane >> 4, a = 7 - (r & 7);
    const bf16_t* cop_a = COP + a * CPS;
    f32x4 acc[TPW];
#pragma unroll 1
    for (int ord = 0; ord < 2; ++ord) {
        const bf16_t* fo = ft + ((size_t)ord * 512 + c) * (2 * L);
        for (int idx = tid; idx < 8 * (CPS / 8); idx += NTHR) {
            const int ca = idx / (CPS / 8), x8 = (idx % (CPS / 8)) * 8;
            unsigned short v[8];
#pragma unroll
            for (int j = 0; j < 8; ++j) { const int m = x8 + ca + j; v[j] = (m <= 2 * L - 2) ? fo[m] : (unsigned short)0; }
            uint4 o; o.x = v[0] | ((unsigned)v[1] << 16); o.y = v[2] | ((unsigned)v[3] << 16); o.z = v[4] | ((unsigned)v[5] << 16); o.w = v[6] | ((unsigned)v[7] << 16);
            *(uint4*)(COP + ca * CPS + x8) = o;
        }
        __syncthreads();
#pragma unroll
        for (int i = 0; i < TPW; ++i) acc[i] = (f32x4){0.f, 0.f, 0.f, 0.f};
        for (int s0 = 0; s0 < L; s0 += 32) {
            const bf16x8 bfr = *(const bf16x8*)(UT + r * UTS + s0 + 8 * g);
#pragma unroll
            for (int i = 0; i < TPW; ++i) {
                const int t0 = (wid * TPW + i) * 16;
                const int n8 = s0 - t0 + 8 * g - r + L - 1 - a;
                const bf16x8 afr = *(const bf16x8*)(cop_a + n8);
                acc[i] = __builtin_amdgcn_mfma_f32_16x16x32_bf16(afr, bfr, acc[i], 0, 0, 0);
            }
        }
        __syncthreads();
        if (ord == 0) {
#pragma unroll
            for (int i = 0; i < TPW; ++i) {
                const int t0 = (wid * TPW + i) * 16 + 4 * g; const bf16_t* q = zx1 + r * L;
                float y[4];
#pragma unroll
                for (int j = 0; j < 4; ++j) {
                    const int t = t0 + j;
                    const float z0 = bf2f(q[t]), zp = t > 0 ? bf2f(q[t - 1]) : 0.f, zn = t < L - 1 ? bf2f(q[t + 1]) : 0.f;
                    y[j] = (zp * aw0 + z0 * aw1 + zn * aw2 + ab) * acc[i][j];
                }
                uint2 o; o.x = pk2(y[0], y[1]); o.y = pk2(y[2], y[3]);
                *(uint2*)(UT + r * UTS + t0) = o;
            }
        } else {
#pragma unroll
            for (int i = 0; i < TPW; ++i) {
                const int t0 = (wid * TPW + i) * 16 + 4 * g; const bf16_t* q = zx2 + r * L;
                float y[4];
#pragma unroll
                for (int j = 0; j < 4; ++j) {
                    const int t = t0 + j;
                    const float z0 = bf2f(q[t]), zp = t > 0 ? bf2f(q[t - 1]) : 0.f, zn = t < L - 1 ? bf2f(q[t + 1]) : 0.f;
                    y[j] = (zp * bw0 + z0 * bw1 + zn * bw2 + bb) * acc[i][j];
                }
                uint2 o; o.x = pk2(y[0], y[1]); o.y = pk2(y[2], y[3]);
                *(uint2*)(zv + r * L + t0) = o;
            }
        }
    }
    __syncthreads();
}
__device__ __forceinline__ void hyena_phase(const Params& p, int e, unsigned char* smem) {
    PH_PRO
    const bf16_t* FT = (const bf16_t*)(WS_ + WS_FT) + (size_t)e * FT_E;
    for (int item = bid_; item < 1024; item += gdim_) {
        if (item < 512) hyena_item<2048>(p, e, item, 0, FT, smem);
        else hyena_item<256>(p, e, item - 512, MLAT, FT + FT_LAT, smem);
    }
}

__device__ __forceinline__ void rwkv_scan_phase(const Params& p, int e, unsigned char* smem) {
    PH_PRO
    const int chain = bid_; if (chain >= 256) return;
    const int d = chain >> 7, b = (chain >> 3) & 15, h = chain & 7;
    const int tid = tid_, lane = tid & 63, wid = tid >> 6;
    float* WUP = (float*)smem;
    float* AUP = WUP + 4096;
    float* sR = AUP + 4096;
    float* sKK = sR + 4096;
    float* sW = sKK + 4096;
    float* sKD = sW + 4096;
    float* sKKA = sKD + 4096;
    float* sV = sKKA + 4096;
    const bf16_t* ZR = (const bf16_t*)(WS_ + WS_BIG + BIG_ZR);
    bf16_t* ORW = (bf16_t*)(WS_ + WS_BIG + BIG_ORW) + (size_t)d * MTOT * 512;
    float* BON = (float*)(WS_ + WS_BON) + (size_t)d * MTOT * 8;
    const float* mu = IN(23) + e * 1920;
    const float* w0 = IN(24) + (e * 2 + d) * 512 + 64 * h;
    const float* a0 = IN(26) + (e * 2 + d) * 512 + 64 * h;
    const float* wup_g = IN(25) + (size_t)(e * 2 + d) * 64 * 512 + 64 * h;
    const float* aup_g = IN(27) + (size_t)(e * 2 + d) * 64 * 512 + 64 * h;
    const float kk_c = IN(29)[e * 512 + 64 * h + lane], ka_c = IN(30)[e * 512 + 64 * h + lane], rk_c = IN(31)[e * 512 + 64 * h + lane];
    const float w0_c = w0[lane], a0_c = a0[lane];
    const float mu_r = mu[64 * h + lane], mu_k = mu[512 + 64 * h + lane], mu_v = mu[1024 + 64 * h + lane], mu_w = mu[1536 + 64 * d + lane], mu_a = mu[1664 + 64 * d + lane];
    for (int idx = tid; idx < 4096; idx += NTHR) { const int j = idx >> 6, k = idx & 63; WUP[idx] = wup_g[(size_t)j * 512 + k]; AUP[idx] = aup_g[(size_t)j * 512 + k]; }
    float S[64];
#pragma unroll
    for (int k = 0; k < 64; ++k) S[k] = 0.f;
    __syncthreads();
#pragma unroll 1
    for (int seg = 0; seg < 2; ++seg) {
        const int L = seg ? TL : TCX; const int rowbase = seg ? b * TL : MLAT + b * TCX;
#pragma unroll 1
        for (int ch = 0; ch < L / 64; ++ch) {
            float r8[8], kr8[8], kk8[8];
#pragma unroll
            for (int i = 0; i < 8; ++i) {
                const int tau = wid + 8 * i; const int pp = ch * 64 + tau; const int t = d ? (L - 1 - pp) : pp;
                const bf16_t* zr = ZR + (size_t)(rowbase + t) * 1920;
                const bool hp = t > 0, hn = t < L - 1;
#define ZS(col, muv) ({ const float z0_ = bf2f(zr[col]); const float zp_ = hp ? bf2f(zr[(col) - 1920]) : 0.f; const float zn_ = hn ? bf2f(zr[(col) + 1920]) : 0.f; z0_ + (muv) * (0.5f * (zp_ + zn_) - z0_); })
                const float rr = ZS(64 * h + lane, mu_r);
                const float kr = ZS(512 + 64 * h + lane, mu_k);
                const float vv = ZS(1024 + 64 * h + lane, mu_v);
                const float wd = ZS(1536 + 64 * d + lane, mu_w);
                const float ad = ZS(1664 + 64 * d + lane, mu_a);
#undef ZS
                const float kkv = kr * kk_c; const float n2 = wsum(kkv * kkv);
                const float kk = kkv / fmaxf(sqrtf(n2), 1e-12f);
                r8[i] = rr; kr8[i] = kr; kk8[i] = kk;
                sR[tau * 64 + lane] = rr; sKK[tau * 64 + lane] = kk; sV[tau * 64 + lane] = vv;
                sW[tau * 64 + lane] = tanhf(wd); sKKA[tau * 64 + lane] = ad;
            }
            __syncthreads();
#pragma unroll
            for (int i = 0; i < 8; ++i) {
                const int tau = wid + 8 * i; const int pp = ch * 64 + tau; const int t = d ? (L - 1 - pp) : pp;
                float wl = w0_c, al = a0_c;
                for (int j = 0; j < 64; ++j) { wl += sW[tau * 64 + j] * WUP[j * 64 + lane]; al += sKKA[tau * 64 + j] * AUP[j * 64 + lane]; }
                const float wlog = -softplus_(-wl) - 0.5f;
                const float dec = __expf(-__expf(wlog));
                const float av = sigm(al);
                const float kd = kr8[i] * (1.f + (av - 1.f) * ka_c);
                const float bon = wsum(r8[i] * kd * rk_c);
                if (lane == 0) BON[(size_t)(rowbase + t) * 8 + h] = bon;
                __builtin_amdgcn_wave_barrier();
                sW[tau * 64 + lane] = dec; sKD[tau * 64 + lane] = kd; sKKA[tau * 64 + lane] = kk8[i] * av;
            }
            __syncthreads();
            if (wid == 0) {
#pragma unroll 1
                for (int tau = 0; tau < 64; ++tau) {
                    const int pp = ch * 64 + tau; const int t = d ? (L - 1 - pp) : pp;
                    const float4* pk = (const float4*)(sKK + tau * 64);
                    float sa0 = 0.f, sa1 = 0.f;
#pragma unroll
                    for (int q = 0; q < 16; ++q) { const float4 x = pk[q]; sa0 += S[4 * q] * x.x; sa1 += S[4 * q + 1] * x.y; sa0 += S[4 * q + 2] * x.z; sa1 += S[4 * q + 3] * x.w; }
                    const float sa = -(sa0 + sa1);
                    const float vv = sV[tau * 64 + lane];
                    const float4* pw = (const float4*)(sW + tau * 64); const float4* pa = (const float4*)(sKKA + tau * 64);
                    const float4* pd = (const float4*)(sKD + tau * 64); const float4* pr = (const float4*)(sR + tau * 64);
                    float o0 = 0.f, o1 = 0.f;
#pragma unroll
                    for (int q = 0; q < 16; ++q) {
                        const float4 w = pw[q], ka = pa[q], kd = pd[q], rr = pr[q];
                        S[4 * q] = S[4 * q] * w.x + sa * ka.x + vv * kd.x; o0 += S[4 * q] * rr.x;
                        S[4 * q + 1] = S[4 * q + 1] * w.y + sa * ka.y + vv * kd.y; o1 += S[4 * q + 1] * rr.y;
                        S[4 * q + 2] = S[4 * q + 2] * w.z + sa * ka.z + vv * kd.z; o0 += S[4 * q + 2] * rr.z;
                        S[4 * q + 3] = S[4 * q + 3] * w.w + sa * ka.w + vv * kd.w; o1 += S[4 * q + 3] * rr.w;
                    }
                    ORW[(size_t)(rowbase + t) * 512 + 64 * h + lane] = f2bf(o0 + o1);
                }
            }
            __syncthreads();
        }
    }
}

__device__ __forceinline__ void even_readout_phase(const Params& p, int e, unsigned char* smem) {
    PH_PRO
    const int tid = tid_, lane = tid & 63, wid = tid >> 6;
    float* SG = (float*)smem;
    float* GU = SG + 64 * 128;
    bf16_t* TT = (bf16_t*)(GU + 128 * 64);
    const bf16_t* ZR = (const bf16_t*)(WS_ + WS_BIG + BIG_ZR);
    const bf16_t* ORW = (const bf16_t*)(WS_ + WS_BIG + BIG_ORW);
    const bf16_t* YT = (const bf16_t*)(WS_ + WS_BIG);
    const float* BON = (const float*)(WS_ + WS_BON);
    bf16_t* YM = (bf16_t*)(WS_ + WS_A);
    const float* mu = IN(23) + e * 1920;
    for (int item = bid_; item < 2 * 4608; item += gdim_) {
        if (item < 4608) {
            const int tb = item >> 3, h = item & 7; const int row0 = tb * 64;
            const int L = row0 < MLAT ? TL : TCX; const int t0 = row0 < MLAT ? (row0 & (TL - 1)) : ((row0 - MLAT) & (TCX - 1));
            const float* gup = IN(28) + (size_t)e * 128 * 512 + 64 * h;
            for (int idx = tid; idx < 128 * 64; idx += NTHR) { const int j = idx >> 6, k = idx & 63; GU[idx] = gup[(size_t)j * 512 + k]; }
            for (int idx = tid; idx < 64 * 128; idx += NTHR) {
                const int tau = idx >> 7, j = idx & 127; const int t = t0 + tau; const bf16_t* zr = ZR + (size_t)(row0 + tau) * 1920 + 1792 + j;
                const float z0 = bf2f(zr[0]), zp = t > 0 ? bf2f(zr[-1920]) : 0.f, zn = t < L - 1 ? bf2f(zr[1920]) : 0.f;
                SG[idx] = sigm(z0 + mu[1792 + j] * (0.5f * (zp + zn) - z0));
            }
            __syncthreads();
            const float gng = IN(32)[e * 512 + 64 * h + lane], gnb = IN(33)[e * 512 + 64 * h + lane], muv = mu[1024 + 64 * h + lane];
#pragma unroll 1
            for (int i = 0; i < 8; ++i) {
                const int tau = wid + 8 * i; const int row = row0 + tau, t = t0 + tau;
                float gg = 0.f;
                for (int j = 0; j < 128; ++j) gg += SG[tau * 128 + j] * GU[j * 64 + lane];
                const float o = bf2f(ORW[(size_t)row * 512 + 64 * h + lane]) + bf2f(ORW[(size_t)(MTOT + row) * 512 + 64 * h + lane]);
                const float mean = wsum(o) * (1.f / 64.f); const float dd = o - mean; const float var = wsum(dd * dd) * (1.f / 64.f);
                const float y = dd * rsqrtf(var + 64e-5f) * gng + gnb;
                const bf16_t* zr = ZR + (size_t)row * 1920 + 1024 + 64 * h + lane;
                const float z0 = bf2f(zr[0]), zp = t > 0 ? bf2f(zr[-1920]) : 0.f, zn = t < L - 1 ? bf2f(zr[1920]) : 0.f;
                const float vv = z0 + muv * (0.5f * (zp + zn) - z0);
                const float bon = BON[(size_t)row * 8 + h] + BON[(size_t)(MTOT + row) * 8 + h];
                YM[(size_t)row * D + 512 + 64 * h + lane] = f2bf((y + bon * vv) * gg);
            }
            __syncthreads();
        } else {
            const int it = item - 4608; const int tb = it >> 3, cb = it & 7; const int row0 = tb * 64;
#pragma unroll
            for (int i = 0; i < 8; ++i) { const int cc = wid + 8 * i; TT[cc * 72 + lane] = YT[(size_t)(cb * 64 + cc) * MTOT + row0 + lane]; }
            __syncthreads();
#pragma unroll
            for (int i = 0; i < 8; ++i) { const int tau = wid + 8 * i; YM[(size_t)(row0 + tau) * D + cb * 64 + lane] = TT[lane * 72 + tau]; }
            __syncthreads();
        }
    }
}
__device__ __forceinline__ void gla_phase(const Params& p, int o_idx, unsigned char* smem) {
    PH_PRO
    const int item = bid_; if (item >= 256) return;
    const int b = item >> 4, h = (item >> 2) & 3, dvs = item & 3;
    const int tid = tid_, lane = tid & 63, wid = tid >> 6, r = lane & 15, g = lane >> 4;
    constexpr int QST = 136, SST = 72;
    bf16_t* QS = (bf16_t*)smem;
    bf16_t* KS = QS + 64 * QST;
    bf16_t* QI = KS + 64 * QST;
    bf16_t* ST = QI + 64 * QST;
    bf16_t* KOT = ST + 64 * QST;
    bf16_t* VT = KOT + 128 * SST;
    bf16_t* PP = VT + 64 * SST;
    float* GB = (float*)(PP + 64 * SST);
    float* GUP = GB + 64 * 128;
    float* GD = GUP + 16 * 128;
    float* DL = GD + 64 * 16;
    int* ROWS = (int*)(DL + 128);
    const bf16_t* Z = (const bf16_t*)(WS_ + WS_BIG);
    bf16_t* OGL = (bf16_t*)(WS_ + WS_BIG + BIG_OGL);
    const float qscale = 0.08838834764831845f;
    f32x4 Sacc[4];
#pragma unroll 1
    for (int d = 0; d < 2; ++d) {
        const float* gup_g = IN(36) + (size_t)(o_idx * 2 + d) * 16 * 512 + 128 * h;
        const float* gb_g = IN(37) + (o_idx * 2 + d) * 512 + 128 * h;
        __syncthreads();
        for (int idx = tid; idx < 16 * 128; idx += NTHR) GUP[idx] = gup_g[(size_t)(idx >> 7) * 512 + (idx & 127)];
#pragma unroll
        for (int j = 0; j < 4; ++j) Sacc[j] = (f32x4){0.f, 0.f, 0.f, 0.f};
#pragma unroll 1
        for (int seg = 0; seg < 2; ++seg) {
            const int L = seg ? TL : TCX;
#pragma unroll 1
            for (int ch = 0; ch < L / 64; ++ch) {
                __syncthreads();
                if (tid < 64) {
                    const int pf = ch * 64 + tid; const int pp = d ? (L - 1 - pf) : pf;
                    ROWS[tid] = seg ? (b * TL + (pp & 31) * 64 + (pp >> 5)) : (MLAT + b * TCX + pp);
                }
#pragma unroll
                for (int j = 0; j < 4; ++j) {
                    uint2 o; o.x = pk2(Sacc[j][0], Sacc[j][1]); o.y = pk2(Sacc[j][2], Sacc[j][3]);
                    *(uint2*)(ST + (16 * j + r) * QST + 16 * wid + 4 * g) = o;
                }
                __syncthreads();
                for (int idx = tid; idx < 64 * 16; idx += NTHR) { const int tau = idx >> 4, j = idx & 15; GD[idx] = bf2f(Z[(size_t)ROWS[tau] * 3104 + 2048 + 16 * d + j]); }
#pragma unroll
                for (int i = 0; i < 8; ++i) { const int tau = wid + 8 * i; VT[lane * SST + tau] = Z[(size_t)ROWS[tau] * 3104 + 1024 + 256 * h + 64 * dvs + lane]; }
                __syncthreads();
                {
                    const int k = tid & 127, tq = tid >> 7; const float gbv = gb_g[k];
                    for (int i = 0; i < 16; ++i) {
                        const int tau = tq + 4 * i; float a = gbv;
#pragma unroll
                        for (int j = 0; j < 16; ++j) a += GD[tau * 16 + j] * GUP[j * 128 + k];
                        GB[tau * 128 + k] = -softplus_(-a) * (1.f / 16.f);
                    }
                }
                __syncthreads();
                if (tid < 128) { float a = 0.f; for (int tau = 0; tau < 64; ++tau) { a += GB[tau * 128 + tid]; GB[tau * 128 + tid] = a; } DL[tid] = __expf(a); }
                __syncthreads();
                {
                    const int k = tid & 127, tq = tid >> 7; const float bref = GB[32 * 128 + k], blast = GB[63 * 128 + k];
                    for (int i = 0; i < 16; ++i) {
                        const int tau = tq + 4 * i; const bf16_t* zr = Z + (size_t)ROWS[tau] * 3104;
                        const float q = bf2f(zr[128 * h + k]) * qscale, kv = bf2f(zr[512 + 128 * h + k]); const float bb = GB[tau * 128 + k];
                        QS[tau * QST + k] = f2bf(q * __expf(bb - bref)); KS[tau * QST + k] = f2bf(kv * __expf(bref - bb));
                        QI[tau * QST + k] = f2bf(q * __expf(bb)); KOT[k * SST + tau] = f2bf(kv * __expf(blast - bb));
                    }
                }
                __syncthreads();
                const int tr = wid >> 1;
                f32x4 sc[2];
#pragma unroll
                for (int j = 0; j < 2; ++j) sc[j] = (f32x4){0.f, 0.f, 0.f, 0.f};
#pragma unroll
                for (int ks = 0; ks < 4; ++ks) {
                    const bf16x8 af = *(const bf16x8*)(QS + (16 * tr + r) * QST + 32 * ks + 8 * g);
#pragma unroll
                    for (int j = 0; j < 2; ++j) {
                        const int tc = 2 * (wid & 1) + j;
                        const bf16x8 bfr = *(const bf16x8*)(KS + (16 * tc + r) * QST + 32 * ks + 8 * g);
                        sc[j] = __builtin_amdgcn_mfma_f32_16x16x32_bf16(af, bfr, sc[j], 0, 0, 0);
                    }
                }
#pragma unroll
                for (int j = 0; j < 2; ++j) {
                    const int tc = 2 * (wid & 1) + j; const int s = 16 * tc + r;
#pragma unroll
                    for (int q = 0; q < 4; ++q) { const int c = 16 * tr + 4 * g + q; PP[c * SST + s] = f2bf(s <= c ? sc[j][q] : 0.f); }
                }
                __syncthreads();
                f32x4 oc[2];
#pragma unroll
                for (int j = 0; j < 2; ++j) oc[j] = (f32x4){0.f, 0.f, 0.f, 0.f};
#pragma unroll
                for (int ks = 0; ks < 2; ++ks) {
                    const bf16x8 af = *(const bf16x8*)(PP + (16 * tr + r) * SST + 32 * ks + 8 * g);
#pragma unroll
                    for (int j = 0; j < 2; ++j) {
                        const int tc = 2 * (wid & 1) + j;
                        const bf16x8 bfr = *(const bf16x8*)(VT + (16 * tc + r) * SST + 32 * ks + 8 * g);
                        oc[j] = __builtin_amdgcn_mfma_f32_16x16x32_bf16(af, bfr, oc[j], 0, 0, 0);
                    }
                }
#pragma unroll
                for (int ks = 0; ks < 4; ++ks) {
                    const bf16x8 af = *(const bf16x8*)(QI + (16 * tr + r) * QST + 32 * ks + 8 * g);
#pragma unroll
                    for (int j = 0; j < 2; ++j) {
                        const int tc = 2 * (wid & 1) + j;
                        const bf16x8 bfr = *(const bf16x8*)(ST + (16 * tc + r) * QST + 32 * ks + 8 * g);
                        oc[j] = __builtin_amdgcn_mfma_f32_16x16x32_bf16(af, bfr, oc[j], 0, 0, 0);
                    }
                }
#pragma unroll
                for (int j = 0; j < 2; ++j) {
                    const int tc = 2 * (wid & 1) + j; const int dv = 16 * tc + r;
#pragma unroll
                    for (int q = 0; q < 4; ++q) {
                        const int c = 16 * tr + 4 * g + q;
                        bf16_t* op = OGL + (size_t)ROWS[c] * D + 256 * h + 64 * dvs + dv;
                        float v = oc[j][q]; if (d) v += bf2f(*op);
                        *op = f2bf(v);
                    }
                }
#pragma unroll
                for (int j = 0; j < 4; ++j)
#pragma unroll
                    for (int q = 0; q < 4; ++q) Sacc[j][q] *= DL[16 * wid + 4 * g + q];
#pragma unroll
                for (int ks = 0; ks < 2; ++ks) {
                    const bf16x8 af = *(const bf16x8*)(KOT + (16 * wid + r) * SST + 32 * ks + 8 * g);
#pragma unroll
                    for (int j = 0; j < 4; ++j) {
                        const bf16x8 bfr = *(const bf16x8*)(VT + (16 * j + r) * SST + 32 * ks + 8 * g);
                        Sacc[j] = __builtin_amdgcn_mfma_f32_16x16x32_bf16(af, bfr, Sacc[j], 0, 0, 0);
                    }
                }
            }
        }
    }
}

__device__ __forceinline__ void odd_readout_phase(const Params& p, int o_idx) {
    PH_PRO
    const int lane = tid_ & 63, wid = tid_ >> 6;
    const bf16_t* Z = (const bf16_t*)(WS_ + WS_BIG);
    const bf16_t* OGL = (const bf16_t*)(WS_ + WS_BIG + BIG_OGL);
    bf16_t* YM = (bf16_t*)(WS_ + WS_A);
    const float4 ng = *(const float4*)(IN(38) + o_idx * 256 + 4 * lane);
    for (int row = bid_ * 8 + wid; row < MTOT; row += gdim_ * 8) {
#pragma unroll
        for (int hh = 0; hh < 4; ++hh) {
            const uint2 ov = *(const uint2*)(OGL + (size_t)row * D + 256 * hh + 4 * lane);
            const uint2 gv = *(const uint2*)(Z + (size_t)row * 3104 + 2080 + 256 * hh + 4 * lane);
            const float o0 = __uint_as_float(ov.x << 16), o1 = __uint_as_float(ov.x & 0xffff0000u), o2 = __uint_as_float(ov.y << 16), o3 = __uint_as_float(ov.y & 0xffff0000u);
            const float g0 = __uint_as_float(gv.x << 16), g1 = __uint_as_float(gv.x & 0xffff0000u), g2 = __uint_as_float(gv.y << 16), g3 = __uint_as_float(gv.y & 0xffff0000u);
            const float ms = wsum(o0 * o0 + o1 * o1 + o2 * o2 + o3 * o3) * (1.f / 256.f);
            const float rs = rsqrtf(ms + 1e-5f);
            uint2 y; y.x = pk2(o0 * rs * ng.x * silu_(g0), o1 * rs * ng.y * silu_(g1)); y.y = pk2(o2 * rs * ng.z * silu_(g2), o3 * rs * ng.w * silu_(g3));
            *(uint2*)(YM + (size_t)row * D + 256 * hh + 4 * lane) = y;
        }
    }
}

#define LAUNDER() do { bid_ = blockIdx.x; asm volatile("" : "+s"(bid_)); gdim_ = gridDim.x; asm volatile("" : "+s"(gdim_)); } while (0)
__global__ void __launch_bounds__(NTHR, 2) mega(Params p) {
    unsigned char* smem = smem_g;
    cg::grid_group grid = cg::this_grid();
    int bid_, gdim_; LAUNDER();
    if (threadIdx.x == 0) {
        const float** tb = (const float**)(smem_g + TBL_OFF);
#pragma unroll
        for (int i = 0; i < 41; ++i) tb[i] = p.in[i];
    }
    __syncthreads();
    phase_mod(p, smem);
    __syncthreads();
    conv_weights(p, 0, smem);
    filt_gen(p, smem);
    grid.sync();
    row_phase(p, 0, 0, 0, 0, 0, false);
    grid.sync();
#pragma unroll 1
    for (int l = 0; l < 4; ++l) {
#pragma unroll 1
        for (int f = 0; f < 2; ++f) {
            if (f == 1) {
                if (!(l & 1)) {
                    const int e = l >> 1;
                    LAUNDER();
                    { EpiStore E; E.O = (bf16_t*)(WS_ + WS_BIG); E.ldc = MTOT; E.nvalid = MTOT; run_gemm(smem, (const bf16_t*)(WS_ + WS_WIN), (const bf16_t*)(WS_ + WS_A), 1536, MTOT, 1024, E, bid_, gdim_); }
                    LAUNDER();
                    { EpiStore E; E.O = (bf16_t*)(WS_ + WS_BIG + BIG_ZR); E.ldc = 1920; E.nvalid = 1920; run_gemm(smem, (const bf16_t*)(WS_ + WS_A), (const bf16_t*)(WS_ + WS_WIN) + (size_t)1536 * 1024, MTOT, 2048, 1024, E, bid_, gdim_); }
                    grid.sync();
                    hyena_phase(p, e, smem);
                    rwkv_scan_phase(p, e, smem);
                    grid.sync();
                    even_readout_phase(p, e, smem);
                    grid.sync();
                } else {
                    const int o = l >> 1;
                    LAUNDER();
                    { EpiStore E; E.O = (bf16_t*)(WS_ + WS_BIG); E.ldc = 3104; E.nvalid = 3104; run_gemm(smem, (const bf16_t*)(WS_ + WS_A), (const bf16_t*)(WS_ + WS_WIN), MTOT, 3328, 1024, E, bid_, gdim_); }
                    grid.sync();
                    gla_phase(p, o, smem);
                    grid.sync();
                    odd_readout_phase(p, o);
                    grid.sync();
                }
                LAUNDER();
                { EpiResid E; E.H = (float*)(WS_ + WS_H); E.gate = (const float*)(WS_ + WS_MOD) + (size_t)l * 17 * 9216 + 5 * 1024; E.wgt = 1.0f; run_gemm(smem, (const bf16_t*)(WS_ + WS_A), (const bf16_t*)(WS_ + WS_WOUT), MTOT, 1024, 1024, E, bid_, gdim_); }
                grid.sync();
                row_phase(p, 1, l, 1, l, 6, false);
                grid.sync();
            }
            LAUNDER();
            { EpiSwiglu E; E.G = (bf16_t*)(WS_ + WS_BIG); run_gemm(smem, (const bf16_t*)(WS_ + WS_A), (const bf16_t*)(WS_ + WS_WUP) + (size_t)f * 5632 * 1024, MTOT, 5632, 1024, E, bid_, gdim_); }
            grid.sync();
            LAUNDER();
            { EpiResid E; E.H = (float*)(WS_ + WS_H); E.gate = (const float*)(WS_ + WS_MOD) + (size_t)l * 17 * 9216 + (f ? 8 : 2) * 1024; E.wgt = 0.5f; run_gemm(smem, (const bf16_t*)(WS_ + WS_BIG), (const bf16_t*)(WS_ + WS_WDN) + (size_t)f * 1024 * FF, MTOT, 1024, FF, E, bid_, gdim_); }
            grid.sync();
            if (f == 0) { row_phase(p, 1, l, 0, l, 3, false); grid.sync(); }
        }
        if (l < 3) { row_phase(p, 1, l, 2, l + 1, 0, false); conv_weights(p, l + 1, smem); }
        else row_phase(p, 1, l, 2, 0, 0, true);
        grid.sync();
    }
}

extern "C" void kernel_launch(void* const* d_in, const int* in_sizes, int n_in, void* d_out, int out_size, void* d_ws, size_t ws_size, hipStream_t stream) {
    static int grid = 0;
    if (grid == 0) {
        if (n_in != 39 || ws_size < WS_END) { fprintf(stderr, "kernel_launch: need 39 inputs and %zu bytes of workspace; got %d, %zu\n", (size_t)WS_END, n_in, ws_size); grid = -1; return; }
        int dev = 0, cus = 0, per_cu = 0;
        (void)hipGetDevice(&dev);
        (void)hipDeviceGetAttribute(&cus, hipDeviceAttributeMultiprocessorCount, dev);
        if (hipFuncSetAttribute((const void*)mega, hipFuncAttributeMaxDynamicSharedMemorySize, LDS_BYTES) != hipSuccess) { fprintf(stderr, "kernel_launch: hipFuncSetAttribute failed\n"); grid = -1; return; }
        (void)hipOccupancyMaxActiveBlocksPerMultiprocessor(&per_cu, (const void*)mega, NTHR, LDS_BYTES);
        if (per_cu < 1) fprintf(stderr, "kernel_launch: occupancy query says %d blocks/CU\n", per_cu);
        (void)hipGetLastError();
        grid = cus;
        if (grid > 256) grid = 256;
    }
    if (grid < 0) return;
    Params p{};
    for (int i = 0; i < 39; ++i) p.in[i] = (const float*)d_in[i];
    p.in[39] = (const float*)d_out; p.in[40] = (const float*)d_ws;
    void* args[] = {&p};
    hipError_t e = hipLaunchCooperativeKernel((const void*)mega, dim3(grid), dim3(NTHR), args, LDS_BYTES, stream);
    if (e != hipSuccess) fprintf(stderr, "cooperative launch failed: %s (grid %d)\n", hipGetErrorString(e), grid);
}
```

```cpp
#include <hip/hip_runtime.h>
#include <hip/hip_cooperative_groups.h>
#include <cstdio>
namespace pg8 {
#define PG8_LAS __attribute__((address_space(3)))
typedef unsigned short bf16_t;
typedef short bf16x8 __attribute__((ext_vector_type(8)));
typedef float f32x4 __attribute__((ext_vector_type(4)));
typedef unsigned u32x4 __attribute__((ext_vector_type(4)));
constexpr int BM = 256, BK = 64, HALF = 128, HTB = HALF * BK * 2  , STAGE_BYTES = 8 * HTB, NXCD = 8, WGM = 4;

__host__ __device__ __forceinline__ int lds_byte(int r, int c) { const int st = (r >> 4) * 2 + (c >> 5), rr = r & 15, cc = c & 31, ob = rr * 64 + cc * 2; return st * 1024 + (ob ^ (((ob >> 9) & 1) << 5)); }
__host__ __device__ __forceinline__ void stage_rc(int b, int& R, int& C) { const int st = b / 1024, sb = b % 1024, swz = sb ^ (((sb >> 9) & 1) << 5); R = (st >> 1) * 16 + swz / 64; C = (st & 1) * 32 + (swz % 64) / 2; }
__host__ __device__ __forceinline__ int perm32(int rho) { const int n = rho >> 4, i = rho & 15; return 8 * (i >> 2) + 4 * n + (i & 3); }

struct Unit { int pm, pn; };
struct Gemm { const bf16_t* A; const bf16_t* Bt; int M, N, K; };

struct StaticOrder {
    int nM, nN, nwg, G, c;
    __host__ __device__ void init(int M, int N, int G_, int c_) { nM = M / BM; nN = N / BM; nwg = nM * nN; G = G_; c = c_; }
    __host__ __device__ bool next(int i, Unit& u) const {
        const long L = (long)i * G + c; if (L >= nwg) return false;
        int wgid = (int)L; { const int q = nwg / NXCD, r = nwg % NXCD, xcd = wgid % NXCD, off = wgid / NXCD; wgid = (xcd < r ? xcd * (q + 1) : r * (q + 1) + (xcd - r) * q) + off; }
        const int nig = WGM * nN, gid = wgid / nig, fm = gid * WGM, gsz = (nM - fm) < WGM ? (nM - fm) : WGM;
        u.pm = fm + ((wgid % nig) % gsz); u.pn = (wgid % nig) / gsz; return true;
    }
    __device__ __forceinline__ void a_ready(const Unit&) const {}
    __device__ __forceinline__ void done(const Unit&) const {}
};
__device__ __forceinline__ unsigned cvt_pk_bf16(float lo, float hi) { unsigned r; asm volatile("v_cvt_pk_bf16_f32 %0, %1, %2" : "=v"(r) : "v"(lo), "v"(hi)); return r; }
typedef float f32x2 __attribute__((ext_vector_type(2)));

template <class Epi, class Sched, bool STAMP = false>
__device__ __forceinline__ void gemm_phase(PG8_LAS unsigned char* lds, const Gemm g, const Sched& S, const Epi& E, unsigned long long* stamps) {
    int tid_l_ = threadIdx.x; asm volatile("" : "+v"(tid_l_)); const int tid = tid_l_, wid = __builtin_amdgcn_readfirstlane(tid >> 6), lane = tid & 63, wr = wid >> 2, wc = wid & 3, fr = lane & 15, fq = lane >> 4;
    const int K = g.K, nt = K / BK;
    int ts_lo = 0, ts_hi = 0, nts = 0; const unsigned long long rt_entry = STAMP ? (unsigned long long)wall_clock64() : 0ull;
#define PG8_STAMP() do { if (STAMP && wid == 0 && nts < 64) { const unsigned long long _c = (unsigned long long)clock64(); \
        ts_lo = (lane == nts) ? (int)(unsigned)_c : ts_lo; ts_hi = (lane == nts) ? (int)(unsigned)(_c >> 32) : ts_hi; ++nts; } } while (0)
    PG8_STAMP();
    unsigned voffA[2], voffB[2];
#pragma unroll
    for (int i = 0; i < 2; ++i) { int R, C; stage_rc(tid * 16 + i * 8192, R, C); const int Rb = Epi::PERM ? ((R & ~31) + perm32(R & 31)) : R;
        voffA[i] = (unsigned)(R * K + C) * 2u; voffB[i] = (unsigned)(Rb * K + C) * 2u; }
    const size_t kstep = (size_t)(BK * 2);
    const size_t hstep = (size_t)HALF * K * 2;
    const size_t tstep = 2 * hstep;
    const unsigned ldsw = (unsigned)wid * 1024u;
    const int aoff = lds_byte(wr * 64 + fr, fq * 8), boff = lds_byte(wc * 32 + fr, fq * 8);
#define PG8_SA(b, h) (((b) * 2 + (h)) * HTB)
#define PG8_SB(b, h) ((4 + (b) * 2 + (h)) * HTB)
#define PG8_STAGE(bufoff, gbase, voff) do { _Pragma("unroll") for (int _i = 0; _i < 2; ++_i) \
        __builtin_amdgcn_global_load_lds((const unsigned*)((const char*)(gbase) + (voff)[_i]), (PG8_LAS unsigned*)(lds + (bufoff) + ldsw + _i * 8192), 16, 0, 0); } while (0)
#define PG8_LDA(dst, b, h) do { _Pragma("unroll") for (int m = 0; m < 4; ++m) _Pragma("unroll") for (int k = 0; k < 2; ++k) dst[m][k] = *(const PG8_LAS bf16x8*)(lds + PG8_SA(b, h) + aoff + m * 2048 + k * 1024); } while (0)
#define PG8_LDB(dst, b, h) do { _Pragma("unroll") for (int n = 0; n < 2; ++n) _Pragma("unroll") for (int k = 0; k < 2; ++k) dst[n][k] = *(const PG8_LAS bf16x8*)(lds + PG8_SB(b, h) + boff + n * 2048 + k * 1024); } while (0)
#define PG8_MMA(ai, bj, At, Bt) do { __builtin_amdgcn_s_setprio(1); _Pragma("unroll") for (int m = 0; m < 4; ++m) _Pragma("unroll") for (int n = 0; n < 2; ++n) _Pragma("unroll") for (int k = 0; k < 2; ++k) \
        acc[ai][bj][m][n] = __builtin_amdgcn_mfma_f32_16x16x32_bf16(Bt[n][k], At[m][k], acc[ai][bj][m][n], 0, 0, 0); __builtin_amdgcn_s_setprio(0); } while (0)
#define PG8_WAIT_V(n) asm volatile("s_waitcnt vmcnt(" #n ")" ::: "memory")
#define PG8_WAIT_L(n) asm volatile("s_waitcnt lgkmcnt(" #n ")" ::: "memory")
#define PG8_BAR __builtin_amdgcn_s_barrier()
#define PG8_SCHED __builtin_amdgcn_sched_barrier(0)
    Unit cur, nxt; int ui = 0;
    if (!S.next(0, cur)) return;
    f32x4 acc[2][2][4][2];
#pragma unroll
    for (int a = 0; a < 2; ++a)
#pragma unroll
        for (int b = 0; b < 2; ++b)
#pragma unroll
            for (int m = 0; m < 4; ++m)
#pragma unroll
                for (int n = 0; n < 2; ++n) acc[a][b][m][n] = (f32x4){0.f, 0.f, 0.f, 0.f};
    bf16x8 At[4][2], B0[2][2], B1[2][2];
    const char* cA = (const char*)g.A + (size_t)cur.pm * tstep; const char* cB = (const char*)g.Bt + (size_t)cur.pn * tstep;
    S.a_ready(cur);
    PG8_STAGE(PG8_SB(0, 0), cB, voffB); PG8_STAGE(PG8_SA(0, 0), cA, voffA); PG8_STAGE(PG8_SB(0, 1), cB + hstep, voffB); PG8_STAGE(PG8_SA(0, 1), cA + hstep, voffA);
    if (wr == 1) PG8_BAR;
    PG8_WAIT_V(4); PG8_BAR;
    PG8_STAGE(PG8_SB(1, 0), cB + kstep, voffB); PG8_STAGE(PG8_SA(1, 0), cA + kstep, voffA); PG8_STAGE(PG8_SB(1, 1), cB + hstep + kstep, voffB);
    PG8_WAIT_V(6); PG8_BAR;
    PG8_STAMP();
    for (;;) {
        const bool has_next = S.next(ui + 1, nxt);
        const char* nA = has_next ? (const char*)g.A + (size_t)nxt.pm * tstep : cA; const char* nB = has_next ? (const char*)g.Bt + (size_t)nxt.pn * tstep : cB;
        for (int t = 0; t < nt; t += 2) {
            const bool last = (t == nt - 2);
            const char* a1 = cA + (size_t)(t + 1) * kstep;
            const char* a2 = last ? nA : cA + (size_t)(t + 2) * kstep; const char* b2 = last ? nB : cB + (size_t)(t + 2) * kstep;
            const char* a3 = a2 + kstep; const char* b3 = b2 + kstep;
            if (last && has_next) S.a_ready(nxt);
            PG8_LDB(B0, 0, 0); PG8_SCHED; PG8_LDA(At, 0, 0); PG8_STAGE(PG8_SA(1, 1), a1 + hstep, voffA);
            PG8_WAIT_L(8); PG8_BAR; PG8_WAIT_L(0); PG8_MMA(0, 0, At, B0); PG8_BAR; PG8_SCHED;
            PG8_LDB(B1, 0, 1); PG8_STAGE(PG8_SB(0, 0), b2, voffB);
            PG8_BAR; PG8_WAIT_L(0); PG8_MMA(0, 1, At, B1); PG8_BAR;
            PG8_LDA(At, 0, 1); PG8_STAGE(PG8_SA(0, 0), a2, voffA);
            PG8_BAR; PG8_WAIT_L(0); PG8_MMA(1, 0, At, B0); PG8_BAR; PG8_SCHED;
            PG8_STAGE(PG8_SB(0, 1), b2 + hstep, voffB);
            PG8_WAIT_V(6); PG8_BAR; PG8_MMA(1, 1, At, B1); PG8_BAR;
            PG8_LDB(B0, 1, 0); PG8_SCHED; PG8_LDA(At, 1, 0); PG8_STAGE(PG8_SA(0, 1), a2 + hstep, voffA);
            PG8_WAIT_L(8); PG8_BAR; PG8_WAIT_L(0); PG8_MMA(0, 0, At, B0); PG8_BAR; PG8_SCHED;
            PG8_LDB(B1, 1, 1); PG8_STAGE(PG8_SB(1, 0), b3, voffB);
            PG8_BAR; PG8_WAIT_L(0); PG8_MMA(0, 1, At, B1); PG8_BAR;
            PG8_LDA(At, 1, 1); PG8_STAGE(PG8_SA(1, 0), a3, voffA);
            PG8_BAR; PG8_WAIT_L(0); PG8_MMA(1, 0, At, B0); PG8_BAR; PG8_SCHED;
            PG8_STAGE(PG8_SB(1, 1), b3 + hstep, voffB);
            PG8_WAIT_V(6); PG8_BAR; PG8_MMA(1, 1, At, B1); PG8_BAR;
        }
        PG8_STAMP();
        if constexpr (!Epi::AFTER_DRAIN) { E(acc, cur, wr, wc, fr, fq); S.done(cur); }
        PG8_STAMP();
        if (!has_next) break;
#pragma unroll
        for (int a = 0; a < 2; ++a)
#pragma unroll
            for (int b = 0; b < 2; ++b)
#pragma unroll
                for (int m = 0; m < 4; ++m)
#pragma unroll
                    for (int n = 0; n < 2; ++n) acc[a][b][m][n] = (f32x4){0.f, 0.f, 0.f, 0.f};
        cur = nxt; cA = nA; cB = nB; ++ui;
    }
    PG8_WAIT_V(0);
    if (wr == 0) PG8_BAR;
    PG8_BAR;
    if constexpr (Epi::AFTER_DRAIN) { E.fused(acc, cur, wr, wc, fr, fq, lds, wid, lane); S.done(cur); }
    PG8_STAMP();
    if (STAMP && wid == 0) { stamps[lane] = lane < nts ? (((unsigned long long)(unsigned)ts_hi << 32) | (unsigned)ts_lo) : 0ull;
        if (lane == 62) stamps[62] = rt_entry; if (lane == 63) stamps[63] = (unsigned long long)wall_clock64(); }
#undef PG8_STAMP
#undef PG8_SA
#undef PG8_SB
#undef PG8_STAGE
#undef PG8_LDA
#undef PG8_LDB
#undef PG8_MMA
#undef PG8_WAIT_V
#undef PG8_WAIT_L
#undef PG8_BAR
#undef PG8_SCHED
}
}
#define XB_TMO      128
#define XB_XCNT(j)  (256  + 64 * (j))
#define XB_XSUB(j)  (1280 + 64 * (j))
#define XB_XGEN(j)  (2304 + 64 * (j))
#define XB_TOP      3328
#define XB_TOPGEN   3392
#define XCD_BAR_WORDS 3456
#define XB_SPIN_CAP (1u << 18)
#define XB_LAS __attribute__((address_space(3)))

__device__ __forceinline__ unsigned xb_ld(unsigned* p)              { return __hip_atomic_load(p, __ATOMIC_RELAXED, __HIP_MEMORY_SCOPE_AGENT); }
__device__ __forceinline__ unsigned xb_add(unsigned* p, unsigned v) { return __hip_atomic_fetch_add(p, v, __ATOMIC_RELAXED, __HIP_MEMORY_SCOPE_AGENT); }
__device__ __forceinline__ unsigned xb_xcc_id() { return (unsigned)__builtin_amdgcn_s_getreg((3 << 11) | 20) & 0xFu; }
#define XB_SPIN(cond, bar) do { unsigned _sp = 0; while (cond) { __builtin_amdgcn_s_sleep(1); \
    if ((++_sp & 255u) == 0u) { if (xb_ld(&(bar)[XB_TMO])) break; if (_sp > XB_SPIN_CAP) { atomicAdd(&(bar)[XB_TMO], 1u); break; } } } } while (0)

struct XcdBarrier {
    unsigned* bar; unsigned x;
    volatile XB_LAS unsigned* st;
};

__device__ __forceinline__ XcdBarrier xcd_barrier_post(unsigned* bar, volatile XB_LAS unsigned* st) {
    XcdBarrier b; b.bar = bar; b.x = xb_xcc_id(); b.st = st;
    if (threadIdx.x == 0) (void)xb_add(&bar[XB_XCNT(b.x)], 1u);
    return b;
}
__device__ __forceinline__ void xcd_barrier_complete(unsigned* bar, unsigned x, unsigned& nloc, unsigned& nx) {
    const unsigned G = gridDim.x * gridDim.y * gridDim.z;
    unsigned sum, cnt, mine, sp = 0u;
    for (;;) {
        sum = 0u; cnt = 0u; mine = 0u;
#pragma unroll
        for (unsigned j = 0; j < 16; ++j) { const unsigned c = xb_ld(&bar[XB_XCNT(j)]); sum += c; cnt += (c > 0u) ? 1u : 0u; mine = (j == x) ? c : mine; }
        if (sum == G) break;
        __builtin_amdgcn_s_sleep(1);
        if ((++sp & 255u) == 0u) { if (xb_ld(&bar[XB_TMO])) break; if (sp > XB_SPIN_CAP) { atomicAdd(&bar[XB_TMO], 1u); break; } }
    }
    nloc = mine > 0u ? mine : 1u; nx = cnt > 0u ? cnt : 1u;
}

__device__ __forceinline__ void xcd_barrier(const XcdBarrier& b) {
    asm volatile("s_waitcnt vmcnt(0)" ::: "memory");
    __syncthreads();
    if (threadIdx.x == 0) {
        unsigned* bar = b.bar;
        __builtin_amdgcn_s_waitcnt(0);
        unsigned nloc = b.st[0], nx = b.st[1];
        if (nloc == 0u) { xcd_barrier_complete(bar, b.x, nloc, nx); b.st[0] = nloc; b.st[1] = nx; }
        const unsigned old = xb_add(&bar[XB_XSUB(b.x)], 1u);
        const unsigned gen = old / nloc;
        if (old + 1u == (gen + 1u) * nloc) {
            __builtin_amdgcn_fence(__ATOMIC_RELEASE, "agent");
            asm volatile("s_waitcnt vmcnt(0)" ::: "memory");
            const unsigned og = xb_add(&bar[XB_TOP], 1u);
            const unsigned tg = og / nx;
            if (og + 1u == (tg + 1u) * nx) xb_add(&bar[XB_TOPGEN], 1u);
            else XB_SPIN(xb_ld(&bar[XB_TOPGEN]) == tg, bar);
            __builtin_amdgcn_fence(__ATOMIC_ACQUIRE, "agent");
            xb_add(&bar[XB_XGEN(b.x)], 1u);
            asm volatile("s_waitcnt vmcnt(0)" ::: "memory");
        } else {
            XB_SPIN(xb_ld(&bar[XB_XGEN(b.x)]) == gen, bar);
            __builtin_amdgcn_fence(__ATOMIC_ACQUIRE, "agent");
            asm volatile("s_waitcnt vmcnt(0)" ::: "memory");
        }
    }
    __syncthreads();
}

namespace cg = cooperative_groups;
typedef unsigned short bf16_t;
using pg8::bf16x8; using pg8::f32x4;
#define LAS __attribute__((address_space(3)))

constexpr int D = 1024, NB = 16, TL = 2048, TCX = 256, FF = 2816;
constexpr int MLAT = NB * TL, MCTX = NB * TCX, MTOT = MLAT + MCTX;
constexpr float DN_ALPHA = 1.681792830507429f;
constexpr int NTHR = 512;
constexpr int LDS_BYTES = 155648;

constexpr size_t al256(size_t x) { return (x + 255) & ~(size_t)255; }
constexpr size_t WS_MOD = 16384;
constexpr size_t WS_FT = al256(WS_MOD + (size_t)4 * 17 * 9216 * 4);
constexpr size_t FT_LAT = (size_t)2 * 512 * 4096, FT_CTX = (size_t)2 * 512 * 512, FT_E = FT_LAT + FT_CTX;
constexpr size_t WS_WUP = al256(WS_FT + 2 * FT_E * 2);
constexpr size_t WS_WDN = WS_WUP + (size_t)2 * 5632 * 1024 * 2;
constexpr size_t WS_WIN = WS_WDN + (size_t)2 * 1024 * 2816 * 2;
constexpr size_t WS_WOUT = WS_WIN + (size_t)3584 * 1024 * 2;
constexpr size_t WS_H = WS_WOUT + (size_t)1024 * 1024 * 2;
constexpr size_t WS_A = WS_H + (size_t)MTOT * 1024 * 4;
constexpr size_t WS_BON = WS_A + (size_t)MTOT * 1024 * 2;
constexpr size_t WS_STATS = al256(WS_BON + (size_t)2 * MTOT * 8 * 4);
constexpr size_t WS_BIG = al256(WS_STATS + (size_t)MTOT * 2 * 4);
constexpr size_t BIG_ZR = (size_t)1536 * MTOT * 2;
constexpr size_t BIG_ORW = BIG_ZR + (size_t)MTOT * 1920 * 2;
constexpr size_t BIG_EVEN_END = BIG_ORW + (size_t)2 * MTOT * 512 * 2;
constexpr size_t BIG_OGL = al256((size_t)MTOT * 3104 * 2);
constexpr size_t WS_END = WS_BIG + BIG_EVEN_END;

struct Params { const float* in[41]; };
#define PH_PRO int tid_ = threadIdx.x; asm volatile("" : "+v"(tid_)); int bid_ = blockIdx.x; asm volatile("" : "+s"(bid_)); int gdim_ = gridDim.x; asm volatile("" : "+s"(gdim_));
extern __shared__ __attribute__((aligned(16))) unsigned char smem_g[];
constexpr int TBL_OFF = LDS_BYTES - 512;
typedef const float __attribute__((address_space(1)))* gfptr_;
#define IN(i) ((const float*)(((const gfptr_*)(smem_g + TBL_OFF))[i]))
#define OUT_ ((float*)IN(39))
#define WS_ ((unsigned char*)IN(40))

__device__ __forceinline__ float bf2f(bf16_t b) { return __uint_as_float(((unsigned)b) << 16); }
typedef __bf16 bf16x2_t_ __attribute__((ext_vector_type(2)));
typedef float f32x2_t_ __attribute__((ext_vector_type(2)));
__device__ __forceinline__ unsigned pk2(float lo, float hi) { f32x2_t_ v = {lo, hi}; bf16x2_t_ b = __builtin_convertvector(v, bf16x2_t_); return __builtin_bit_cast(unsigned, b); }
__device__ __forceinline__ bf16_t f2bf(float f) { return (bf16_t)(pk2(f, 0.f) & 0xffffu); }
__device__ __forceinline__ bf16x8 ld8(const bf16_t* p) { const uint2 a = *(const uint2*)p, b = *(const uint2*)(p + 4); uint4 v; v.x = a.x; v.y = a.y; v.z = b.x; v.w = b.y; return __builtin_bit_cast(bf16x8, v); }
#define DPPF(v, ctrl) __builtin_bit_cast(float, __builtin_amdgcn_update_dpp(0, __builtin_bit_cast(int, (v)), (ctrl), 0xF, 0xF, true))
__device__ __forceinline__ float wsum(float v) {
    v += DPPF(v, 0xB1); v += DPPF(v, 0x4E); v += DPPF(v, 0x141); v += DPPF(v, 0x140);
    const int iv = __builtin_bit_cast(int, v);
    return __builtin_bit_cast(float, __builtin_amdgcn_readlane(iv, 0)) + __builtin_bit_cast(float, __builtin_amdgcn_readlane(iv, 16)) +
           __builtin_bit_cast(float, __builtin_amdgcn_readlane(iv, 32)) + __builtin_bit_cast(float, __builtin_amdgcn_readlane(iv, 48));
}
__device__ __forceinline__ float sigm(float x) { return __builtin_amdgcn_rcpf(1.f + __expf(-x)); }
__device__ __forceinline__ float silu_(float x) { return x * __builtin_amdgcn_rcpf(1.f + __expf(-x)); }
__device__ __forceinline__ float softplus_(float y) { return fmaxf(y, 0.f) + __logf(1.f + __expf(-fabsf(y))); }
__device__ __forceinline__ float tanh_(float x) { return 1.f - 2.f * __builtin_amdgcn_rcpf(1.f + __expf(2.f * x)); }

struct EpiStore {
    static constexpr bool PERM = true, AFTER_DRAIN = false;
    bf16_t* O; int ldc; int nvalid;
    __device__ __forceinline__ void operator()(const f32x4 (&acc)[2][2][4][2], const pg8::Unit& u, int wr, int wc, int fr, int fq) const {
        const int row0 = u.pm * 256 + wr * 64 + fr, col0 = u.pn * 256 + wc * 32 + 8 * fq;
#pragma unroll
        for (int ai = 0; ai < 2; ++ai)
#pragma unroll
            for (int m = 0; m < 4; ++m) {
                bf16_t* rowp = O + (size_t)(row0 + ai * 128 + m * 16) * ldc;
#pragma unroll
                for (int bj = 0; bj < 2; ++bj) {
                    const int col = col0 + bj * 128;
                    if (col < nvalid) {
                        const f32x4 v0 = acc[ai][bj][m][0], v1 = acc[ai][bj][m][1];
                        uint4 o; o.x = pk2(v0[0], v0[1]); o.y = pk2(v0[2], v0[3]); o.z = pk2(v1[0], v1[1]); o.w = pk2(v1[2], v1[3]);
                        *(uint4*)(rowp + col) = o;
                    }
                }
            }
    }
};
struct EpiSwiglu {
    static constexpr bool PERM = true, AFTER_DRAIN = false;
    bf16_t* G;
    __device__ __forceinline__ void operator()(const f32x4 (&acc)[2][2][4][2], const pg8::Unit& u, int wr, int wc, int fr, int fq) const {
        const int row0 = u.pm * 256 + wr * 64 + fr, col0 = u.pn * 128 + wc * 32 + 8 * fq;
#pragma unroll
        for (int ai = 0; ai < 2; ++ai)
#pragma unroll
            for (int m = 0; m < 4; ++m) {
                bf16_t* rowp = G + (size_t)(row0 + ai * 128 + m * 16) * FF + col0;
                float o[8];
#pragma unroll
                for (int n = 0; n < 2; ++n)
#pragma unroll
                    for (int e = 0; e < 4; ++e) o[n * 4 + e] = silu_(acc[ai][0][m][n][e]) * acc[ai][1][m][n][e];
                uint4 q; q.x = pk2(o[0], o[1]); q.y = pk2(o[2], o[3]); q.z = pk2(o[4], o[5]); q.w = pk2(o[6], o[7]);
                { typedef unsigned u32x4_nt __attribute__((ext_vector_type(4))); const u32x4_nt qq = {q.x, q.y, q.z, q.w}; __builtin_nontemporal_store(qq, (u32x4_nt*)rowp); }
            }
    }
};
struct EpiResid {
    static constexpr bool PERM = false, AFTER_DRAIN = false;
    int gate_off; float wgt; int ln_idx;
    __device__ __forceinline__ void operator()(const f32x4 (&acc)[2][2][4][2], const pg8::Unit& u, int wr, int wc, int fr, int fq) const {
        float* H = (float*)(WS_ + WS_H); const float* gate = (const float*)(WS_ + WS_MOD) + gate_off;
        const float* stats = ln_idx >= 0 ? (const float*)(WS_ + WS_STATS) : nullptr;
        const float* Hin = ln_idx >= 0 ? H : (u.pm < 128 ? IN(0) : IN(2) - (size_t)MLAT * D);
        const float* lg = IN(6) + (ln_idx < 0 ? 0 : ln_idx) * 1024; const float* lb = IN(7) + (ln_idx < 0 ? 0 : ln_idx) * 1024;
        const int row0 = u.pm * 256 + wr * 64 + fr, col0 = u.pn * 256 + wc * 32 + 4 * fq;
        const int midx = u.pm < 128 ? (u.pm >> 3) : 16;
        const float* gp = gate + (size_t)midx * 9216 + col0;
        float mu[2][4], rs[2][4];
#pragma unroll
        for (int ai = 0; ai < 2; ++ai)
#pragma unroll
            for (int m = 0; m < 4; ++m) {
                if (stats) { const float2 st = *(const float2*)(stats + 2 * (size_t)(row0 + ai * 128 + m * 16)); mu[ai][m] = st.x; rs[ai][m] = st.y; }
                else { mu[ai][m] = 0.f; rs[ai][m] = 1.f; }
            }
#pragma unroll
        for (int bj = 0; bj < 2; ++bj)
#pragma unroll
            for (int n = 0; n < 2; ++n) {
                const int co = bj * 128 + n * 16;
                const f32x4 gvv = *(const f32x4*)(gp + co) * wgt;
                f32x4 g4 = (f32x4){1.f, 1.f, 1.f, 1.f}, b4 = (f32x4){0.f, 0.f, 0.f, 0.f};
                if (stats) { g4 = *(const f32x4*)(lg + col0 + co); b4 = *(const f32x4*)(lb + col0 + co); }
#pragma unroll
                for (int ai = 0; ai < 2; ++ai)
#pragma unroll
                    for (int m = 0; m < 4; ++m) {
                        float* rowp = H + (size_t)(row0 + ai * 128 + m * 16) * D + col0 + co;
                        f32x4 h = *(const f32x4*)(Hin + (size_t)(row0 + ai * 128 + m * 16) * D + col0 + co);
                        h = (h - mu[ai][m]) * rs[ai][m] * g4 + b4;
                        h = h * DN_ALPHA + gvv * acc[ai][bj][m][n];
                        *(f32x4*)rowp = h;
                    }
            }
    }
};

template <class Epi>
__device__ __forceinline__ void run_gemm(unsigned char* smem, const bf16_t* A, const bf16_t* Bt, int M, int N, int K, const Epi& E, int bid_, int gdim_) {
    pg8::Gemm g; g.A = A; g.Bt = Bt; g.M = M; g.N = N; g.K = K;
    pg8::StaticOrder S; S.init(M, N, gdim_, bid_);
    pg8::gemm_phase<Epi, pg8::StaticOrder, false>((PG8_LAS unsigned char*)smem, g, S, E, nullptr);
}

__device__ __forceinline__ void phase_mod(const Params& p, unsigned char* smem) {
    PH_PRO
    float* s = (float*)smem;
    float* part = s + 17 * 1024;
    const int tid = tid_;
    const float* c = IN(1); const float* cc = IN(3);
    float* MOD = (float*)(WS_ + WS_MOD);
    if (bid_ >= 288) return;
    for (int idx = tid; idx < 17 * 1024; idx += NTHR) { const int i = idx >> 10, k = idx & 1023; const float v = i < 16 ? c[i * 1024 + k] : cc[k]; s[idx] = silu_(v); }
    __syncthreads();
    for (int item = bid_; item < 288; item += gdim_) {
        const int l = item / 72, j0 = (item % 72) * 128;
        const int col = tid & 127, kq = tid >> 7;
        const float* w = IN(4) + ((size_t)l * 1024 + kq * 256) * 9216 + j0 + col;
        float acc[17];
#pragma unroll
        for (int i = 0; i < 17; ++i) acc[i] = 0.f;
        for (int k = 0; k < 256; ++k) {
            const float wv = w[(size_t)k * 9216];
#pragma unroll
            for (int i = 0; i < 17; ++i) acc[i] += s[i * 1024 + kq * 256 + k] * wv;
        }
#pragma unroll
        for (int i = 0; i < 17; ++i) part[(kq * 17 + i) * 128 + col] = acc[i];
        __syncthreads();
        for (int idx = tid; idx < 17 * 128; idx += NTHR) {
            const int i = idx >> 7, cl = idx & 127;
            const float v = part[(0 * 17 + i) * 128 + cl] + part[(1 * 17 + i) * 128 + cl] + part[(2 * 17 + i) * 128 + cl] + part[(3 * 17 + i) * 128 + cl] + IN(5)[l * 9216 + j0 + cl];
            MOD[((size_t)l * 17 + i) * 9216 + j0 + cl] = v;
        }
        __syncthreads();
    }
}

__device__ __forceinline__ void conv_tile(const float* src, int ld, int nvalid, bf16_t* dst, int ldd, float* tile) {
    PH_PRO
    const int tid = tid_;
#pragma unroll
    for (int i = 0; i < 2; ++i) {
        const int k = (tid >> 4) + 32 * i, c4 = (tid & 15) * 4;
        float4 v = make_float4(0.f, 0.f, 0.f, 0.f);
        if (c4 < nvalid) v = *(const float4*)(src + (size_t)k * ld + c4);
        tile[k * 65 + c4] = v.x; tile[k * 65 + c4 + 1] = v.y; tile[k * 65 + c4 + 2] = v.z; tile[k * 65 + c4 + 3] = v.w;
    }
    __syncthreads();
    const int n = tid >> 3, ks = (tid & 7) * 8;
    uint4 o;
    o.x = pk2(tile[(ks + 0) * 65 + n], tile[(ks + 1) * 65 + n]); o.y = pk2(tile[(ks + 2) * 65 + n], tile[(ks + 3) * 65 + n]);
    o.z = pk2(tile[(ks + 4) * 65 + n], tile[(ks + 5) * 65 + n]); o.w = pk2(tile[(ks + 6) * 65 + n], tile[(ks + 7) * 65 + n]);
    *(uint4*)(dst + (size_t)n * ldd + ks) = o;
    __syncthreads();
}
__device__ __forceinline__ void conv_weights(const Params& p, int l, unsigned char* smem) {
    PH_PRO
    float* tile = (float*)smem;
    const bool even = !(l & 1); const int eo = l >> 1;
    const int NIN = even ? 3456 : 3104, nint = (even ? 3584 : 3328) / 64;
    const int total = 2816 + 1408 + nint * 16 + 256;
    bf16_t* WUP = (bf16_t*)(WS_ + WS_WUP); bf16_t* WDN = (bf16_t*)(WS_ + WS_WDN); bf16_t* WIN = (bf16_t*)(WS_ + WS_WIN); bf16_t* WOUT = (bf16_t*)(WS_ + WS_WOUT);
    for (int idx = bid_; idx < total; idx += gdim_) {
        if (idx < 2816) {
            const int f = idx / 1408, r = idx % 1408, nt = r / 16, kt = r % 16, n0 = nt * 64;
            const int pn = n0 >> 8, bj = (n0 & 255) >> 7, j = n0 & 127, col = pn * 128 + j;
            const float* src = (bj ? IN(9) : IN(8)) + ((size_t)(l * 2 + f) * 1024 + kt * 64) * FF + col;
            conv_tile(src, FF, 64, WUP + ((size_t)f * 5632 + n0) * 1024 + kt * 64, 1024, tile);
        } else if (idx < 4224) {
            int r = idx - 2816; const int f = r / 704; r %= 704; const int kt = r / 16, nt = r % 16;
            const float* src = IN(10) + ((size_t)(l * 2 + f) * FF + kt * 64) * 1024 + nt * 64;
            conv_tile(src, 1024, 64, WDN + ((size_t)f * 1024 + nt * 64) * FF + kt * 64, FF, tile);
        } else if (idx < 4224 + nint * 16) {
            const int r = idx - 4224, nt = r / 16, kt = r % 16, n0 = nt * 64;
            int nv = NIN - n0; nv = nv < 0 ? 0 : (nv > 64 ? 64 : nv);
            const float* src = (even ? IN(11) : IN(34)) + ((size_t)eo * 1024 + kt * 64) * NIN + n0;
            conv_tile(src, NIN, nv, WIN + (size_t)n0 * 1024 + kt * 64, 1024, tile);
        } else {
            const int r = idx - 4224 - nint * 16, nt = r / 16, kt = r % 16;
            const float* src = (even ? IN(12) : IN(35)) + ((size_t)eo * 1024 + kt * 64) * 1024 + nt * 64;
            conv_tile(src, 1024, 64, WOUT + (size_t)nt * 64 * 1024 + kt * 64, 1024, tile);
        }
    }
}

__device__ __forceinline__ void filt_gen(const Params& p, unsigned char* smem) {
    PH_PRO
    float* z = (float*)smem;
    float* h1 = z + 64 * 33;
    float* h2 = h1 + 64 * 65;
    const int tid = tid_, lane = tid & 63, wid = __builtin_amdgcn_readfirstlane(tid >> 6);
    bf16_t* FT = (bf16_t*)(WS_ + WS_FT);
    for (int item = (bid_ + gdim_ / 2) % gdim_; item < 2 * 36 * 4; item += gdim_) {
        const int e = item / 144; int r = item % 144; const int cg = r & 3; r >>= 2;
        const int seg = r >= 32; const int jb = seg ? r - 32 : r;
        const int L = seg ? 256 : 2048;
        const float* w1 = IN(15) + e * 33 * 64; const float* b1 = IN(16) + e * 64; const float* f1 = IN(17) + e * 64;
        const float* w2 = IN(18) + e * 64 * 64; const float* b2 = IN(19) + e * 64; const float* f2 = IN(20) + e * 64;
        const float* w3 = IN(21) + (size_t)e * 64 * 2048; const float* skip = IN(22) + e * 1024;
        __syncthreads();
        for (int idx = tid; idx < 64 * 33; idx += NTHR) {
            const int jj = idx / 33, i = idx % 33; const int j = jb * 64 + jj;
            float v;
            if (i == 0) v = (float)j / (float)(L - 1);
            else { const int bi = (i - 1) & 15; const float f = 1e-4f + (float)bi * ((15.f - 1e-4f) / 15.f); const float w = 6.283185307179586f * (float)j / (float)L; v = (i <= 16) ? cosf(f * w) : -sinf(f * w); }
            z[idx] = v;
        }
        __syncthreads();
        for (int idx = tid; idx < 4096; idx += NTHR) {
            const int jj = idx >> 6, o = idx & 63; float a = b1[o];
            for (int i = 0; i < 33; ++i) a += z[jj * 33 + i] * w1[i * 64 + o];
            h1[jj * 65 + o] = sinf(f1[o] * a);
        }
        __syncthreads();
        for (int idx = tid; idx < 4096; idx += NTHR) {
            const int jj = idx >> 6, o = idx & 63; float a = b2[o];
            for (int k = 0; k < 64; ++k) a += h1[jj * 65 + k] * w2[k * 64 + o];
            h2[jj * 65 + o] = sinf(f2[o] * a);
        }
        __syncthreads();
        bf16_t* base = FT + (size_t)e * FT_E + (seg ? FT_LAT : 0);
#pragma unroll 1
        for (int ps = 0; ps < 2; ++ps) {
            const int col0 = cg * 512 + ps * 256 + 4 * lane;
            float acc[8][4];
#pragma unroll
            for (int i = 0; i < 8; ++i)
#pragma unroll
                for (int c = 0; c < 4; ++c) acc[i][c] = 0.f;
#pragma unroll 4
            for (int k = 0; k < 64; ++k) {
                const float4 wv = *(const float4*)(w3 + (size_t)k * 2048 + col0);
#pragma unroll
                for (int i = 0; i < 8; ++i) { const float hv = h2[(8 * wid + i) * 65 + k]; acc[i][0] += hv * wv.x; acc[i][1] += hv * wv.y; acc[i][2] += hv * wv.z; acc[i][3] += hv * wv.w; }
            }
            const int ord = col0 >> 10, dir = (col0 >> 9) & 1;
            const float lo = -4.605170185988091f / 1.5f, hi = -4.605170185988091f / 0.3f;
#pragma unroll
            for (int c = 0; c < 4; ++c) {
                const int ch = (col0 + c) & 511;
                const float adl = fabsf(lo + (hi - lo) * (float)ch / 511.f);
                bf16_t* fp = base + ((size_t)ord * 512 + ch) * (2 * L);
#pragma unroll
                for (int i = 0; i < 8; ++i) {
                    const int j = jb * 64 + 8 * wid + i; const float tj = (float)j / (float)(L - 1);
                    float v = acc[i][c] * __expf(-tj * adl);
                    if (dir == 0 && j == 0) v += skip[ord * 512 + ch];
                    if (!(dir == 1 && j == 0)) fp[dir == 0 ? (L - 1 - j) : (L - 1 + j)] = f2bf(v);
                }
            }
        }
    }
    __syncthreads();
}

__device__ __forceinline__ void row_phase(const Params& p, int mode, int l_ln, int which, int l_mod, int sidx, bool fin, int nrows_in = MTOT) {
    PH_PRO
    const int lane = tid_ & 63, wid = tid_ >> 6;
    float* H = (float*)(WS_ + WS_H); bf16_t* A = (bf16_t*)(WS_ + WS_A);
    const float* MOD = (const float*)(WS_ + WS_MOD);
    const float* lg = IN(6) + (l_ln * 3 + which) * 1024; const float* lb = IN(7) + (l_ln * 3 + which) * 1024;
    const int nrows = fin ? MLAT : nrows_in;
    constexpr int RU = 1;
    for (int rowb = bid_ * 8 + wid; rowb < nrows; rowb += gdim_ * 8 * RU) {
        float4 v[RU][4]; int rows[RU]; bool okr[RU];
#pragma unroll
        for (int u = 0; u < RU; ++u) {
            const int row = rowb + u * gdim_ * 8; okr[u] = row < nrows; rows[u] = okr[u] ? row : rowb;
            const float* src = mode ? H + (size_t)rows[u] * D : (rows[u] < MLAT ? IN(0) + (size_t)rows[u] * D : IN(2) + (size_t)(rows[u] - MLAT) * D);
#pragma unroll
            for (int i = 0; i < 4; ++i) v[u][i] = *(const float4*)(src + 4 * lane + 256 * i);
        }
#pragma unroll
        for (int u = 0; u < RU; ++u) {
            const int row = rows[u];
            if (mode) {
                float s = 0.f;
#pragma unroll
                for (int i = 0; i < 4; ++i) s += v[u][i].x + v[u][i].y + v[u][i].z + v[u][i].w;
                const float mu = wsum(s) * (1.f / 1024.f);
                float q = 0.f;
#pragma unroll
                for (int i = 0; i < 4; ++i) { v[u][i].x -= mu; v[u][i].y -= mu; v[u][i].z -= mu; v[u][i].w -= mu; q += v[u][i].x * v[u][i].x + v[u][i].y * v[u][i].y + v[u][i].z * v[u][i].z + v[u][i].w * v[u][i].w; }
                const float rstd = rsqrtf(wsum(q) * (1.f / 1024.f) + 1e-6f);
                if (lane == 0 && !fin && okr[u]) *(float2*)((float*)(WS_ + WS_STATS) + 2 * (size_t)row) = make_float2(mu, rstd);
#pragma unroll
                for (int i = 0; i < 4; ++i) {
                    const float4 g = *(const float4*)(lg + 4 * lane + 256 * i), b = *(const float4*)(lb + 4 * lane + 256 * i);
                    v[u][i].x = v[u][i].x * rstd * g.x + b.x; v[u][i].y = v[u][i].y * rstd * g.y + b.y; v[u][i].z = v[u][i].z * rstd * g.z + b.z; v[u][i].w = v[u][i].w * rstd * g.w + b.w;
                }
            }
            if (!okr[u]) continue;
            if (fin) {
#pragma unroll
                for (int i = 0; i < 4; ++i) *(float4*)(OUT_ + (size_t)row * D + 4 * lane + 256 * i) = v[u][i];
            } else {
                const int midx = row < MLAT ? (row >> 11) : 16;
                const float* mp = MOD + ((size_t)l_mod * 17 + midx) * 9216 + sidx * 1024;
#pragma unroll
                for (int i = 0; i < 4; ++i) {
                    const float4 sh = *(const float4*)(mp + 4 * lane + 256 * i), sc = *(const float4*)(mp + 1024 + 4 * lane + 256 * i);
                    uint2 o; o.x = pk2(v[u][i].x * (1.f + sc.x) + sh.x, v[u][i].y * (1.f + sc.y) + sh.y); o.y = pk2(v[u][i].z * (1.f + sc.z) + sh.z, v[u][i].w * (1.f + sc.w) + sh.w);
                    *(uint2*)(A + (size_t)row * D + 4 * lane + 256 * i) = o;
                }
            }
        }
    }
}
template <int L>
__device__ __forceinline__ void hyena_item(const Params& p, int e, int c, int segbase, const bf16_t* ft, unsigned char* smem) {
    PH_PRO
    constexpr int CPS = 2 * L + 16, UTS = L + 8, TPW = (L / 16) / 8;
    bf16_t* COP = (bf16_t*)smem;
    bf16_t* UT = COP + 8 * CPS;
    const int tid = tid_, lane = tid & 63, wid = tid >> 6;
    bf16_t* ZHT = (bf16_t*)(WS_ + WS_BIG);
    bf16_t* zv = ZHT + (size_t)c * MTOT + segbase;
    const bf16_t* zx1 = ZHT + (size_t)(512 + c) * MTOT + segbase;
    const bf16_t* zx2 = ZHT + (size_t)(1024 + c) * MTOT + segbase;
    const float* cw = IN(13) + e * 3 * 1536; const float* cbp = IN(14) + e * 1536;
    const float vw0 = cw[c], vw1 = cw[1536 + c], vw2 = cw[3072 + c], vb = cbp[c];
    const float aw0 = cw[512 + c], aw1 = cw[1536 + 512 + c], aw2 = cw[3072 + 512 + c], ab = cbp[512 + c];
    const float bw0 = cw[1024 + c], bw1 = cw[1536 + 1024 + c], bw2 = cw[3072 + 1024 + c], bb = cbp[1024 + c];
    auto conv4 = [&](const bf16_t* q, int t0, float w0, float w1, float w2, float bias, float (&y)[4]) {
        const uint2 mid = *(const uint2*)(q + t0);
        float zm = bf2f(q[t0 > 0 ? t0 - 1 : 0]); zm = t0 > 0 ? zm : 0.f;
        float zq = bf2f(q[t0 + 4 < L ? t0 + 4 : L - 1]); zq = t0 + 4 < L ? zq : 0.f;
        const float z0 = __uint_as_float(mid.x << 16), z1 = __uint_as_float(mid.x & 0xffff0000u), z2 = __uint_as_float(mid.y << 16), z3 = __uint_as_float(mid.y & 0xffff0000u);
        y[0] = zm * w0 + z0 * w1 + z1 * w2 + bias; y[1] = z0 * w0 + z1 * w1 + z2 * w2 + bias;
        y[2] = z1 * w0 + z2 * w1 + z3 * w2 + bias; y[3] = z2 * w0 + z3 * w1 + zq * w2 + bias;
    };
#pragma unroll 4
    for (int idx = tid; idx < 4 * L; idx += NTHR) {
        const int b = idx / (L / 4), s4 = (idx % (L / 4)) * 4;
        float y[4]; conv4(zv + b * L, s4, vw0, vw1, vw2, vb, y);
        uint2 o; o.x = pk2(y[0], y[1]); o.y = pk2(y[2], y[3]);
        *(uint2*)(UT + b * UTS + s4) = o;
    }
    const int r = lane & 15, g = lane >> 4, a = 7 - (r & 7);
    const bf16_t* cop_a = COP + a * CPS;
    f32x4 acc[TPW];
#pragma unroll 1
    for (int ord = 0; ord < 2; ++ord) {
        const bf16_t* fo = ft + ((size_t)ord * 512 + c) * (2 * L);
        for (int cidx = tid; cidx < (2 * L) / 8; cidx += NTHR) {
            const uint4 raw = *(const uint4*)(fo + 8 * cidx);
            unsigned short v[8] = {(unsigned short)(raw.x & 0xffffu), (unsigned short)(raw.x >> 16), (unsigned short)(raw.y & 0xffffu), (unsigned short)(raw.y >> 16),
                                   (unsigned short)(raw.z & 0xffffu), (unsigned short)(raw.z >> 16), (unsigned short)(raw.w & 0xffffu), (unsigned short)(raw.w >> 16)};
            if (cidx == (2 * L) / 8 - 1) v[7] = 0;
#pragma unroll
            for (int ca = 0; ca < 8; ++ca)
#pragma unroll
                for (int j = 0; j < 8; ++j) { const int x = 8 * cidx - ca + j; COP[ca * CPS + (x < 0 ? 0 : x)] = v[j]; }
        }
        __syncthreads();
#pragma unroll
        for (int i = 0; i < TPW; ++i) acc[i] = (f32x4){0.f, 0.f, 0.f, 0.f};
        if constexpr (TPW == 16) {
            const bf16_t* fbase = cop_a + (8 * g - r + L - 1 - a) - wid * 256;
            bf16x8 F[16];
#pragma unroll
            for (int dd = -15; dd <= 0; ++dd) F[dd & 15] = *(const bf16x8*)(fbase + 16 * dd);
#pragma unroll 1
            for (int S0 = 0; S0 < L / 32; S0 += 8) {
#pragma unroll
                for (int u = 0; u < 8; ++u) {
                    const int S = S0 + u;
                    if (S > 0) { F[(2 * u) & 15] = *(const bf16x8*)(fbase + 32 * S); F[(2 * u - 1) & 15] = *(const bf16x8*)(fbase + 32 * S - 16); }
                    const bf16x8 bfr = *(const bf16x8*)(UT + r * UTS + 32 * S + 8 * g);
#pragma unroll
                    for (int i = 0; i < 16; ++i) acc[i] = __builtin_amdgcn_mfma_f32_16x16x32_bf16(F[(2 * u - i) & 15], bfr, acc[i], 0, 0, 0);
                }
            }
        } else {
        for (int s0 = 0; s0 < L; s0 += 32) {
            const bf16x8 bfr = *(const bf16x8*)(UT + r * UTS + s0 + 8 * g);
#pragma unroll
            for (int i = 0; i < TPW; ++i) {
                const int t0 = (wid * TPW + i) * 16;
                const int n8 = s0 - t0 + 8 * g - r + L - 1 - a;
                const bf16x8 afr = *(const bf16x8*)(cop_a + n8);
                acc[i] = __builtin_amdgcn_mfma_f32_16x16x32_bf16(afr, bfr, acc[i], 0, 0, 0);
            }
        }
        }
        __syncthreads();
        int rl = r * L, tb0 = wid * TPW * 16 + 4 * g; asm volatile("" : "+v"(rl), "+v"(tb0));
        if (ord == 0) {
#pragma unroll
            for (int i = 0; i < TPW; ++i) {
                const int t0 = tb0 + i * 16;
                float y[4]; conv4(zx1 + rl, t0, aw0, aw1, aw2, ab, y);
                uint2 o; o.x = pk2(y[0] * acc[i][0], y[1] * acc[i][1]); o.y = pk2(y[2] * acc[i][2], y[3] * acc[i][3]);
                *(uint2*)(UT + r * UTS + t0) = o;
                if ((i & 3) == 3) __builtin_amdgcn_sched_barrier(0);
            }
        } else {
#pragma unroll
            for (int i = 0; i < TPW; ++i) {
                const int t0 = tb0 + i * 16;
                float y[4]; conv4(zx2 + rl, t0, bw0, bw1, bw2, bb, y);
                uint2 o; o.x = pk2(y[0] * acc[i][0], y[1] * acc[i][1]); o.y = pk2(y[2] * acc[i][2], y[3] * acc[i][3]);
                *(uint2*)(zv + rl + t0) = o;
                if ((i & 3) == 3) __builtin_amdgcn_sched_barrier(0);
            }
        }
    }
    __syncthreads();
}
__device__ __forceinline__ void hyena_phase(const Params& p, int e, unsigned char* smem) {
    PH_PRO
    const bf16_t* FT = (const bf16_t*)(WS_ + WS_FT) + (size_t)e * FT_E;
    for (int item = bid_; item < 1024; item += gdim_) {
        if (item < 512) hyena_item<2048>(p, e, item, 0, FT, smem);
        else hyena_item<256>(p, e, item - 512, MLAT, FT + FT_LAT, smem);
    }
}

__device__ __forceinline__ void rwkv_scan_phase(const Params& p, int e, unsigned char* smem) {
    PH_PRO
    const int chain = bid_; if (chain >= 256) return;
    const int d = chain >> 7, b = (chain >> 3) & 15, h = chain & 7;
    const int tid = tid_, lane = tid & 63, wid = tid >> 6;
    bf16_t* WUPT = (bf16_t*)smem;
    bf16_t* AUPT = WUPT + 4096;
    float* sBONp = (float*)(AUPT + 4096);
    float* sR = (float*)smem + 8192;
    float* sKK = sR + 4096;
    float* sW = sKK + 4096;
    float* sKD = sW + 4096;
    float* sKKA = sKD + 4096;
    float* sV = sKKA + 4096;
    float* sO = sV + 4096;
    bf16_t* TWb = (bf16_t*)sO;
    bf16_t* ADb = TWb + 4096;
    const bf16_t* ZR = (const bf16_t*)(WS_ + WS_BIG + BIG_ZR);
    bf16_t* ORW = (bf16_t*)(WS_ + WS_BIG + BIG_ORW) + (size_t)d * MTOT * 512;
    float* BON = (float*)(WS_ + WS_BON) + (size_t)d * MTOT * 8;
    const float* mu = IN(23) + e * 1920;
    const float* w0 = IN(24) + (e * 2 + d) * 512 + 64 * h;
    const float* a0 = IN(26) + (e * 2 + d) * 512 + 64 * h;
    const float* wup_g = IN(25) + (size_t)(e * 2 + d) * 64 * 512 + 64 * h;
    const float* aup_g = IN(27) + (size_t)(e * 2 + d) * 64 * 512 + 64 * h;
    const float kk_c = IN(29)[e * 512 + 64 * h + lane];
    const float mu_r = mu[64 * h + lane], mu_k = mu[512 + 64 * h + lane], mu_v = mu[1024 + 64 * h + lane], mu_w = mu[1536 + 64 * d + lane], mu_a = mu[1664 + 64 * d + lane];
    for (int idx = tid; idx < 4096; idx += NTHR) { const int j = idx >> 6, k = idx & 63; WUPT[k * 64 + j] = f2bf(wup_g[(size_t)j * 512 + k]); AUPT[k * 64 + j] = f2bf(aup_g[(size_t)j * 512 + k]); }
    const int r16 = lane & 15, g4 = lane >> 4, tr = wid & 3, tcb = 2 * (wid >> 2);
    float c_w0[2], c_a0[2], c_ka[2], c_rk[2];
#pragma unroll
    for (int jt = 0; jt < 2; ++jt) { const int kc = 16 * (tcb + jt) + r16; c_w0[jt] = w0[kc]; c_a0[jt] = a0[kc]; c_ka[jt] = IN(30)[e * 512 + 64 * h + kc]; c_rk[jt] = IN(31)[e * 512 + 64 * h + kc]; }
    typedef float f32x2 __attribute__((ext_vector_type(2)));
    f32x2 S2[4];
#pragma unroll
    for (int k = 0; k < 4; ++k) S2[k] = (f32x2){0.f, 0.f};
    __syncthreads();
    bf16_t pr_[10], pk_[10], pv_[10], pw_[10], pa_[10];
    auto issue = [&](int cidx) {
        const int seg = cidx >= 4; const int L = seg ? TL : TCX; const int rowbase = seg ? b * TL : MLAT + b * TCX; const int ch = seg ? cidx - 4 : cidx;
        const int tlo = d ? (L - 1 - (ch * 64 + 8 * wid + 7)) : (ch * 64 + 8 * wid);
#pragma unroll
        for (int q = 0; q < 10; ++q) {
            const int t = tlo - 1 + q; const int tc = t < 0 ? 0 : (t > L - 1 ? L - 1 : t);
            const bf16_t* zr = ZR + (size_t)(rowbase + tc) * 1920;
            pr_[q] = zr[64 * h + lane]; pk_[q] = zr[512 + 64 * h + lane]; pv_[q] = zr[1024 + 64 * h + lane]; pw_[q] = zr[1536 + 64 * d + lane]; pa_[q] = zr[1664 + 64 * d + lane];
        }
    };
    issue(0);
#pragma unroll 1
    for (int cidx = 0; cidx < 36; ++cidx) {
        {
            const int seg = cidx >= 4; const int L = seg ? TL : TCX; const int rowbase = seg ? b * TL : MLAT + b * TCX; const int ch = seg ? cidx - 4 : cidx;
            const int tlo = d ? (L - 1 - (ch * 64 + 8 * wid + 7)) : (ch * 64 + 8 * wid);
            {
                float zr_[10], zk_[10], zv_[10], zw_[10], za_[10];
#pragma unroll
                for (int q = 0; q < 10; ++q) {
                    const int t = tlo - 1 + q; const bool ok = (t >= 0) && (t < L);
                    const float a0 = bf2f(pr_[q]), a1 = bf2f(pk_[q]), a2 = bf2f(pv_[q]), a3 = bf2f(pw_[q]), a4 = bf2f(pa_[q]);
                    zr_[q] = ok ? a0 : 0.f; zk_[q] = ok ? a1 : 0.f; zv_[q] = ok ? a2 : 0.f; zw_[q] = ok ? a3 : 0.f; za_[q] = ok ? a4 : 0.f;
                }
#pragma unroll
                for (int sl = 0; sl < 8; ++sl) {
                    const int tau = 8 * wid + (d ? 7 - sl : sl);
#define ZS(arr, muv) (arr[sl + 1] + (muv) * (0.5f * (arr[sl] + arr[sl + 2]) - arr[sl + 1]))
                    const float rr = ZS(zr_, mu_r), kr = ZS(zk_, mu_k), vv = ZS(zv_, mu_v), wd = ZS(zw_, mu_w), ad = ZS(za_, mu_a);
#undef ZS
                    const float kkv = kr * kk_c; const float n2 = wsum(kkv * kkv);
                    const float kk = kkv * __builtin_amdgcn_rcpf(fmaxf(__builtin_amdgcn_sqrtf(n2), 1e-12f));
                    sR[tau * 64 + lane] = rr; sKK[tau * 64 + lane] = kk; sV[tau * 64 + lane] = vv; sKD[tau * 64 + lane] = kr;
                    TWb[tau * 64 + lane] = f2bf(tanh_(wd)); ADb[tau * 64 + lane] = f2bf(ad);
                }
            }
            __syncthreads();
            {
                const bf16x8 aw0 = *(const bf16x8*)(TWb + (16 * tr + r16) * 64 + 8 * g4), aw1 = *(const bf16x8*)(TWb + (16 * tr + r16) * 64 + 32 + 8 * g4);
                const bf16x8 aa0 = *(const bf16x8*)(ADb + (16 * tr + r16) * 64 + 8 * g4), aa1 = *(const bf16x8*)(ADb + (16 * tr + r16) * 64 + 32 + 8 * g4);
                float bonp[4] = {0.f, 0.f, 0.f, 0.f};
#pragma unroll
                for (int jt = 0; jt < 2; ++jt) {
                    const int kc = 16 * (tcb + jt) + r16;
                    const bf16x8 bw0 = *(const bf16x8*)(WUPT + kc * 64 + 8 * g4), bw1 = *(const bf16x8*)(WUPT + kc * 64 + 32 + 8 * g4);
                    const bf16x8 ba0 = *(const bf16x8*)(AUPT + kc * 64 + 8 * g4), ba1 = *(const bf16x8*)(AUPT + kc * 64 + 32 + 8 * g4);
                    f32x4 cw = (f32x4){0.f, 0.f, 0.f, 0.f}, ca = (f32x4){0.f, 0.f, 0.f, 0.f};
                    cw = __builtin_amdgcn_mfma_f32_16x16x32_bf16(aw0, bw0, cw, 0, 0, 0); cw = __builtin_amdgcn_mfma_f32_16x16x32_bf16(aw1, bw1, cw, 0, 0, 0);
                    ca = __builtin_amdgcn_mfma_f32_16x16x32_bf16(aa0, ba0, ca, 0, 0, 0); ca = __builtin_amdgcn_mfma_f32_16x16x32_bf16(aa1, ba1, ca, 0, 0, 0);
#pragma unroll
                    for (int q = 0; q < 4; ++q) {
                        const int tau = 16 * tr + 4 * g4 + q;
                        const float wlog = -softplus_(-(c_w0[jt] + cw[q])) - 0.5f;
                        const float dec = __expf(-__expf(wlog));
                        const float av = sigm(c_a0[jt] + ca[q]);
                        const float kd = sKD[tau * 64 + kc] * (1.f + (av - 1.f) * c_ka[jt]);
                        bonp[q] += sR[tau * 64 + kc] * kd * c_rk[jt];
                        sW[tau * 64 + kc] = dec; sKD[tau * 64 + kc] = kd; sKKA[tau * 64 + kc] = sKK[tau * 64 + kc] * av;
                    }
                }
#pragma unroll
                for (int q = 0; q < 4; ++q) {
                    float v = bonp[q];
                    v += DPPF(v, 0xB1); v += DPPF(v, 0x4E); v += DPPF(v, 0x141); v += DPPF(v, 0x140);
                    if (r16 == 0) sBONp[(16 * tr + 4 * g4 + q) * 2 + (wid >> 2)] = v;
                }
            }
            __syncthreads();
            if (tid < 64) { const int pp = ch * 64 + tid; const int t = d ? (L - 1 - pp) : pp; BON[(size_t)(rowbase + t) * 8 + h] = sBONp[2 * tid] + sBONp[2 * tid + 1]; }
            if (cidx + 1 < 36) issue(cidx + 1);
            {
                const int vrow = 8 * wid + (lane >> 3), kq = lane & 7;
                const float* pb = sR + 8 * kq;
                constexpr int O_R = 0, O_KK = 4096, O_W = 8192, O_KD = 12288, O_KA = 16384;
                struct Ops { float4 kk0, kk1, w0, w1, ka0, ka1, kd0, kd1, r0, r1; float vv; };
                auto ldops = [&](Ops& o, int tau) {
                    const float* q = pb + tau * 64;
                    o.kk0 = *(const float4*)(q + O_KK); o.kk1 = *(const float4*)(q + O_KK + 4); o.w0 = *(const float4*)(q + O_W); o.w1 = *(const float4*)(q + O_W + 4);
                    o.ka0 = *(const float4*)(q + O_KA); o.ka1 = *(const float4*)(q + O_KA + 4); o.kd0 = *(const float4*)(q + O_KD); o.kd1 = *(const float4*)(q + O_KD + 4);
                    o.r0 = *(const float4*)(q + O_R); o.r1 = *(const float4*)(q + O_R + 4); o.vv = sV[tau * 64 + vrow];
                };
                auto step = [&](const Ops& o, int tau) {
                    const f32x2 kk[4] = {{o.kk0.x, o.kk0.y}, {o.kk0.z, o.kk0.w}, {o.kk1.x, o.kk1.y}, {o.kk1.z, o.kk1.w}};
                    const f32x2 w[4] = {{o.w0.x, o.w0.y}, {o.w0.z, o.w0.w}, {o.w1.x, o.w1.y}, {o.w1.z, o.w1.w}};
                    const f32x2 ka[4] = {{o.ka0.x, o.ka0.y}, {o.ka0.z, o.ka0.w}, {o.ka1.x, o.ka1.y}, {o.ka1.z, o.ka1.w}};
                    const f32x2 kd[4] = {{o.kd0.x, o.kd0.y}, {o.kd0.z, o.kd0.w}, {o.kd1.x, o.kd1.y}, {o.kd1.z, o.kd1.w}};
                    const f32x2 rr[4] = {{o.r0.x, o.r0.y}, {o.r0.z, o.r0.w}, {o.r1.x, o.r1.y}, {o.r1.z, o.r1.w}};
                    f32x2 da = S2[0] * kk[0] + S2[1] * kk[1]; f32x2 db = S2[2] * kk[2] + S2[3] * kk[3]; da = da + db;
                    float dt = da.x + da.y;
                    dt += DPPF(dt, 0xB1); dt += DPPF(dt, 0x4E); dt += DPPF(dt, 0x141);
                    const f32x2 sa2 = {-dt, -dt}; const f32x2 vv2 = {o.vv, o.vv};
#pragma unroll
                    for (int q = 0; q < 4; ++q) S2[q] = S2[q] * w[q] + (sa2 * ka[q] + vv2 * kd[q]);
                    f32x2 oa = S2[0] * rr[0] + S2[1] * rr[1]; f32x2 ob = S2[2] * rr[2] + S2[3] * rr[3]; oa = oa + ob;
                    float ot = oa.x + oa.y;
                    ot += DPPF(ot, 0xB1); ot += DPPF(ot, 0x4E); ot += DPPF(ot, 0x141);
                    if (kq == 0) sO[tau * 64 + vrow] = ot;
                };
                Ops oa_, ob_;
                ldops(oa_, 0);
#pragma unroll 1
                for (int tau = 0; tau < 64; tau += 2) {
                    ldops(ob_, tau + 1);
                    step(oa_, tau);
                    ldops(oa_, tau + 2 < 64 ? tau + 2 : 63);
                    step(ob_, tau + 1);
                }
            }
            __syncthreads();
#pragma unroll
            for (int i = 0; i < 8; ++i) {
                const int tau = wid + 8 * i; const int pp = ch * 64 + tau; const int t = d ? (L - 1 - pp) : pp;
                ORW[(size_t)(rowbase + t) * 512 + 64 * h + lane] = f2bf(sO[tau * 64 + lane]);
            }
            __syncthreads();
        }
    }
}

__device__ __forceinline__ void even_readout_phase(const Params& p, int e, unsigned char* smem) {
    PH_PRO
    const int tid = tid_, lane = tid & 63, wid = __builtin_amdgcn_readfirstlane(tid >> 6);
    bf16_t* SGb = (bf16_t*)smem;
    float* GG = (float*)(SGb + 64 * 128);
    bf16_t* GUT = (bf16_t*)(GG + 64 * 64);
    bf16_t* TT = GUT + 64 * 128;
    const int r16 = lane & 15, g4 = lane >> 4, tr = wid & 3, tcb = 2 * (wid >> 2);
    const bf16_t* ZR = (const bf16_t*)(WS_ + WS_BIG + BIG_ZR);
    const bf16_t* ORW = (const bf16_t*)(WS_ + WS_BIG + BIG_ORW);
    const bf16_t* YT = (const bf16_t*)(WS_ + WS_BIG);
    const float* BON = (const float*)(WS_ + WS_BON);
    bf16_t* YM = (bf16_t*)(WS_ + WS_A);
    const float* mu = IN(23) + e * 1920;
    const int h = bid_ & 7;
    {
        const float* gup = IN(28) + (size_t)e * 128 * 512 + 64 * h;
        for (int idx = tid; idx < 128 * 64; idx += NTHR) { const int j = idx >> 6, k = idx & 63; GUT[k * 128 + j] = f2bf(gup[(size_t)j * 512 + k]); }
    }
    const float gng = IN(32)[e * 512 + 64 * h + lane], gnb = IN(33)[e * 512 + 64 * h + lane], muv = mu[1024 + 64 * h + lane];
    for (int item = bid_; item < 4608; item += gdim_) {
        const int tb = item >> 3; const int row0 = tb * 64;
        const int hh = item & 7;
        const int L = row0 < MLAT ? TL : TCX; const int t0 = row0 < MLAT ? (row0 & (TL - 1)) : ((row0 - MLAT) & (TCX - 1));
        __syncthreads();
        if (hh != h) {
            const float* gup = IN(28) + (size_t)e * 128 * 512 + 64 * hh;
            for (int idx = tid; idx < 128 * 64; idx += NTHR) { const int j = idx >> 6, k = idx & 63; GUT[k * 128 + j] = f2bf(gup[(size_t)j * 512 + k]); }
        }
        {
            const int j = tid & 127, tq = wid >> 1; const float muj = mu[1792 + j];
            float zz[18];
#pragma unroll
            for (int q = 0; q < 18; ++q) {
                const int t = t0 + 16 * tq - 1 + q; const bool ok = (t >= 0) && (t < L); const int tc = t < 0 ? 0 : (t > L - 1 ? L - 1 : t);
                const float a = bf2f(ZR[(size_t)(row0 - t0 + tc) * 1920 + 1792 + j]); zz[q] = ok ? a : 0.f;
            }
#pragma unroll
            for (int i = 0; i < 16; ++i) SGb[(16 * tq + i) * 128 + j] = f2bf(sigm(zz[i + 1] + muj * (0.5f * (zz[i] + zz[i + 2]) - zz[i + 1])));
        }
        float ov[8], vv[8], bon[8];
        const float gngh = hh == h ? gng : IN(32)[e * 512 + 64 * hh + lane], gnbh = hh == h ? gnb : IN(33)[e * 512 + 64 * hh + lane], muvh = hh == h ? muv : mu[1024 + 64 * hh + lane];
        {
            float zv[10];
#pragma unroll
            for (int q = 0; q < 10; ++q) {
                const int t = t0 + 8 * wid - 1 + q; const bool ok = (t >= 0) && (t < L); const int tc = t < 0 ? 0 : (t > L - 1 ? L - 1 : t);
                const float a = bf2f(ZR[(size_t)(row0 - t0 + tc) * 1920 + 1024 + 64 * hh + lane]); zv[q] = ok ? a : 0.f;
            }
#pragma unroll
            for (int i = 0; i < 8; ++i) {
                const int row = row0 + 8 * wid + i;
                ov[i] = bf2f(ORW[(size_t)row * 512 + 64 * hh + lane]) + bf2f(ORW[(size_t)(MTOT + row) * 512 + 64 * hh + lane]);
                vv[i] = zv[i + 1] + muvh * (0.5f * (zv[i] + zv[i + 2]) - zv[i + 1]);
                bon[i] = BON[(size_t)row * 8 + hh] + BON[(size_t)(MTOT + row) * 8 + hh];
            }
        }
        __syncthreads();
        {
            f32x4 c0 = (f32x4){0.f, 0.f, 0.f, 0.f}, c1 = (f32x4){0.f, 0.f, 0.f, 0.f};
#pragma unroll
            for (int ks = 0; ks < 4; ++ks) {
                const bf16x8 af = *(const bf16x8*)(SGb + (16 * tr + r16) * 128 + 32 * ks + 8 * g4);
                const bf16x8 b0 = *(const bf16x8*)(GUT + (16 * tcb + r16) * 128 + 32 * ks + 8 * g4), b1 = *(const bf16x8*)(GUT + (16 * (tcb + 1) + r16) * 128 + 32 * ks + 8 * g4);
                c0 = __builtin_amdgcn_mfma_f32_16x16x32_bf16(af, b0, c0, 0, 0, 0); c1 = __builtin_amdgcn_mfma_f32_16x16x32_bf16(af, b1, c1, 0, 0, 0);
            }
#pragma unroll
            for (int q = 0; q < 4; ++q) { GG[(16 * tr + 4 * g4 + q) * 64 + 16 * tcb + r16] = c0[q]; GG[(16 * tr + 4 * g4 + q) * 64 + 16 * (tcb + 1) + r16] = c1[q]; }
        }
        __syncthreads();
        float gg[8];
#pragma unroll
        for (int i = 0; i < 8; ++i) gg[i] = GG[(8 * wid + i) * 64 + lane];
#pragma unroll
        for (int i = 0; i < 8; ++i) {
            const int row = row0 + 8 * wid + i;
            const float mean = wsum(ov[i]) * (1.f / 64.f); const float dd = ov[i] - mean; const float var = wsum(dd * dd) * (1.f / 64.f);
            const float y = dd * rsqrtf(var + 64e-5f) * gngh + gnbh;
            YM[(size_t)row * D + 512 + 64 * hh + lane] = f2bf((y + bon[i] * vv[i]) * gg[i]);
        }
    }
    __syncthreads();
    for (int it = bid_; it < 4608; it += gdim_) {
        const int tb = it >> 3, cb = it & 7; const int row0 = tb * 64;
#pragma unroll
        for (int i = 0; i < 8; ++i) { const int cc = wid + 8 * i; TT[cc * 72 + lane] = YT[(size_t)(cb * 64 + cc) * MTOT + row0 + lane]; }
        __syncthreads();
#pragma unroll
        for (int i = 0; i < 8; ++i) { const int tau = wid + 8 * i; YM[(size_t)(row0 + tau) * D + cb * 64 + lane] = TT[lane * 72 + tau]; }
        __syncthreads();
    }
}
__device__ __forceinline__ void gla_phase(const Params& p, int o_idx, unsigned char* smem) {
    PH_PRO
    const int item = bid_; if (item >= 256) return;
    const int b = item >> 4, h = (item >> 2) & 3, d = (item >> 1) & 1, dvh = item & 1;
    const int tid = tid_, lane = tid & 63, wid = __builtin_amdgcn_readfirstlane(tid >> 6), r = lane & 15, g = lane >> 4;
    constexpr int QST = 136, SST = 68;
    bf16_t* QS = (bf16_t*)smem;
    bf16_t* KS = QS + 64 * QST;
    bf16_t* ST = KS + 64 * QST;
    bf16_t* KST = ST + 128 * QST;
    bf16_t* VT = KST + 128 * SST;
    bf16_t* PP = VT + 128 * SST;
    float* GD = (float*)(PP + 64 * SST);
    float* DL = GD + 64 * 16;
    float* E1 = DL + 128;
    float* E2 = E1 + 128;
    float* TOT = E2 + 128;
    float* BR = TOT + 512;
    int* ROWS = (int*)(BR + 128);
    const bf16_t* Z = (const bf16_t*)(WS_ + WS_BIG);
    bf16_t* OG = d ? (bf16_t*)OUT_ : (bf16_t*)(WS_ + WS_BIG + BIG_OGL);
    const float qscale = 0.08838834764831845f;
    const int k = tid & 127, tq = wid >> 1, tr = wid >> 1, tcb = 4 * (wid & 1);
    auto rowof = [&](int c, int tau) -> int {
        const int seg = c >= 4; const int L = seg ? TL : TCX; const int pf = (seg ? c - 4 : c) * 64 + tau; const int pp = d ? (L - 1 - pf) : pf;
        return seg ? (b * TL + (pp & 31) * 64 + (pp >> 5)) : (MLAT + b * TCX + pp);
    };
    bf16_t nq[16], nk[16], nv[16], ngd[2];
    auto prefetch = [&](int c) {
        const long r0 = rowof(c, 16 * tq); const long st = (long)(c >= 4 ? 64 : 1) * (d ? -1 : 1) * 3104;
        const bf16_t* zb = Z + r0 * 3104 + 128 * h + k;
#pragma unroll
        for (int i = 0; i < 16; ++i) { const bf16_t* zr = zb + i * st; nq[i] = zr[0]; nk[i] = zr[512]; nv[i] = zr[1024 + 128 * h + 128 * dvh]; }
#pragma unroll
        for (int i = 0; i < 2; ++i) { const int idx = tid + NTHR * i; ngd[i] = Z[(size_t)rowof(c, idx >> 4) * 3104 + 2048 + 16 * d + (idx & 15)]; }
    };
    f32x4 Sacc[8];
#pragma unroll
    for (int j = 0; j < 8; ++j) Sacc[j] = (f32x4){0.f, 0.f, 0.f, 0.f};
    float gu[16];
    {
        const float* gup_g = IN(36) + (size_t)(o_idx * 2 + d) * 16 * 512 + 128 * h + k;
#pragma unroll
        for (int j = 0; j < 16; ++j) gu[j] = gup_g[(size_t)j * 512];
    }
    const float gbv = IN(37)[(o_idx * 2 + d) * 512 + 128 * h + k];
    prefetch(0);
#pragma unroll 1
    for (int c = 0; c < 36; ++c) {
        __syncthreads();
        if (tid < 64) ROWS[tid] = rowof(c, tid);
#pragma unroll
        for (int i = 0; i < 2; ++i) GD[tid + NTHR * i] = bf2f(ngd[i]);
#pragma unroll
        for (int i = 0; i < 16; ++i) VT[k * SST + 16 * tq + i] = nv[i];
        bf16_t cq[16], ck[16];
#pragma unroll
        for (int i = 0; i < 16; ++i) { cq[i] = nq[i]; ck[i] = nk[i]; }
        __syncthreads();
        if (c + 1 < 36) prefetch(c + 1);
        float bl[16]; float run = 0.f;
#pragma unroll
        for (int i = 0; i < 16; ++i) {
            const float4* gd4 = (const float4*)(GD + (16 * tq + i) * 16);
            const float4 g0 = gd4[0], g1 = gd4[1], g2 = gd4[2], g3 = gd4[3];
            float a = gbv + g0.x * gu[0] + g0.y * gu[1] + g0.z * gu[2] + g0.w * gu[3] + g1.x * gu[4] + g1.y * gu[5] + g1.z * gu[6] + g1.w * gu[7]
                    + g2.x * gu[8] + g2.y * gu[9] + g2.z * gu[10] + g2.w * gu[11] + g3.x * gu[12] + g3.y * gu[13] + g3.z * gu[14] + g3.w * gu[15];
            run -= __logf(1.f + __expf(-a)) * (1.f / 16.f);
            bl[i] = run;
        }
        TOT[tq * 128 + k] = run; if (tq == 2) BR[k] = bl[0];
        __syncthreads();
        {
            const float t0 = TOT[k], t1 = TOT[128 + k], t2 = TOT[256 + k], t3 = TOT[384 + k];
            const float off = tq == 0 ? 0.f : (tq == 1 ? t0 : (tq == 2 ? t0 + t1 : t0 + t1 + t2));
            const float bref = BR[k] + t0 + t1, blast = t0 + t1 + t2 + t3;
            if (tq == 0) { DL[k] = __expf(blast); E1[k] = __expf(bref); E2[k] = __expf(blast - bref); }
#pragma unroll
            for (int i = 0; i < 16; ++i) {
                const int tau = 16 * tq + i;
                const float bb = bl[i] + off; const float ef = __expf(bb - bref);
                const bf16_t ksv = f2bf(bf2f(ck[i]) * __builtin_amdgcn_rcpf(ef));
                QS[tau * QST + k] = f2bf(bf2f(cq[i]) * qscale * ef); KS[tau * QST + k] = ksv; KST[k * SST + tau] = ksv;
            }
        }
        __syncthreads();
        {
            float e1v[4];
#pragma unroll
            for (int q = 0; q < 4; ++q) e1v[q] = E1[16 * wid + 4 * g + q];
#pragma unroll
            for (int j = 0; j < 8; ++j) {
                uint2 o; o.x = pk2(Sacc[j][0] * e1v[0], Sacc[j][1] * e1v[1]); o.y = pk2(Sacc[j][2] * e1v[2], Sacc[j][3] * e1v[3]);
                *(uint2*)(ST + (16 * j + r) * QST + 16 * wid + 4 * g) = o;
            }
        }
        f32x4 sc[2];
#pragma unroll
        for (int j = 0; j < 2; ++j) sc[j] = (f32x4){0.f, 0.f, 0.f, 0.f};
#pragma unroll
        for (int ks = 0; ks < 4; ++ks) {
            const bf16x8 af = *(const bf16x8*)(QS + (16 * tr + r) * QST + 32 * ks + 8 * g);
#pragma unroll
            for (int j = 0; j < 2; ++j) {
                const bf16x8 bfr = *(const bf16x8*)(KS + (16 * (2 * (wid & 1) + j) + r) * QST + 32 * ks + 8 * g);
                sc[j] = __builtin_amdgcn_mfma_f32_16x16x32_bf16(af, bfr, sc[j], 0, 0, 0);
            }
        }
#pragma unroll
        for (int j = 0; j < 2; ++j) {
            const int sidx = 16 * (2 * (wid & 1) + j) + r;
#pragma unroll
            for (int q = 0; q < 4; ++q) { const int ci = 16 * tr + 4 * g + q; PP[ci * SST + sidx] = f2bf(sidx <= ci ? sc[j][q] : 0.f); }
        }
        __syncthreads();
        f32x4 oc[4];
#pragma unroll
        for (int j = 0; j < 4; ++j) oc[j] = (f32x4){0.f, 0.f, 0.f, 0.f};
#pragma unroll
        for (int ks = 0; ks < 2; ++ks) {
            const bf16x8 af = ld8(PP + (16 * tr + r) * SST + 32 * ks + 8 * g);
#pragma unroll
            for (int j = 0; j < 4; ++j) {
                const bf16x8 bfr = ld8(VT + (16 * (tcb + j) + r) * SST + 32 * ks + 8 * g);
                oc[j] = __builtin_amdgcn_mfma_f32_16x16x32_bf16(af, bfr, oc[j], 0, 0, 0);
            }
        }
#pragma unroll
        for (int ks = 0; ks < 4; ++ks) {
            const bf16x8 af = *(const bf16x8*)(QS + (16 * tr + r) * QST + 32 * ks + 8 * g);
#pragma unroll
            for (int j = 0; j < 4; ++j) {
                const bf16x8 bfr = *(const bf16x8*)(ST + (16 * (tcb + j) + r) * QST + 32 * ks + 8 * g);
                oc[j] = __builtin_amdgcn_mfma_f32_16x16x32_bf16(af, bfr, oc[j], 0, 0, 0);
            }
        }
#pragma unroll
        for (int j = 0; j < 4; ++j) {
            const int dv = 16 * (tcb + j) + r;
#pragma unroll
            for (int q = 0; q < 4; ++q) OG[(size_t)ROWS[16 * tr + 4 * g + q] * D + 256 * h + 128 * dvh + dv] = f2bf(oc[j][q]);
        }
        {
            f32x4 kv[8];
#pragma unroll
            for (int j = 0; j < 8; ++j) kv[j] = (f32x4){0.f, 0.f, 0.f, 0.f};
#pragma unroll
            for (int ks = 0; ks < 2; ++ks) {
                const bf16x8 af = ld8(KST + (16 * wid + r) * SST + 32 * ks + 8 * g);
#pragma unroll
                for (int j = 0; j < 8; ++j) {
                    const bf16x8 bfr = ld8(VT + (16 * j + r) * SST + 32 * ks + 8 * g);
                    kv[j] = __builtin_amdgcn_mfma_f32_16x16x32_bf16(af, bfr, kv[j], 0, 0, 0);
                }
            }
            float dl[4], e2[4];
#pragma unroll
            for (int q = 0; q < 4; ++q) { dl[q] = DL[16 * wid + 4 * g + q]; e2[q] = E2[16 * wid + 4 * g + q]; }
#pragma unroll
            for (int j = 0; j < 8; ++j)
#pragma unroll
                for (int q = 0; q < 4; ++q) Sacc[j][q] = Sacc[j][q] * dl[q] + e2[q] * kv[j][q];
        }
    }
    __syncthreads();
}

__device__ __forceinline__ void odd_readout_phase(const Params& p, int o_idx) {
    PH_PRO
    const int lane = tid_ & 63, wid = tid_ >> 6;
    const bf16_t* Z = (const bf16_t*)(WS_ + WS_BIG);
    const bf16_t* OGL = (const bf16_t*)(WS_ + WS_BIG + BIG_OGL);
    const bf16_t* OGB = (const bf16_t*)OUT_;
    bf16_t* YM = (bf16_t*)(WS_ + WS_A);
    const float4 ng = *(const float4*)(IN(38) + o_idx * 256 + 4 * lane);
    for (int row = bid_ * 8 + wid; row < MTOT; row += gdim_ * 8) {
        uint2 ovs[4], ows[4], gvs[4];
#pragma unroll
        for (int hh = 0; hh < 4; ++hh) {
            ovs[hh] = *(const uint2*)(OGL + (size_t)row * D + 256 * hh + 4 * lane);
            ows[hh] = *(const uint2*)(OGB + (size_t)row * D + 256 * hh + 4 * lane);
            gvs[hh] = *(const uint2*)(Z + (size_t)row * 3104 + 2080 + 256 * hh + 4 * lane);
        }
#pragma unroll
        for (int hh = 0; hh < 4; ++hh) {
            const uint2 ov = ovs[hh], ow = ows[hh], gv = gvs[hh];
            const float o0 = __uint_as_float(ov.x << 16) + __uint_as_float(ow.x << 16), o1 = __uint_as_float(ov.x & 0xffff0000u) + __uint_as_float(ow.x & 0xffff0000u), o2 = __uint_as_float(ov.y << 16) + __uint_as_float(ow.y << 16), o3 = __uint_as_float(ov.y & 0xffff0000u) + __uint_as_float(ow.y & 0xffff0000u);
            const float g0 = __uint_as_float(gv.x << 16), g1 = __uint_as_float(gv.x & 0xffff0000u), g2 = __uint_as_float(gv.y << 16), g3 = __uint_as_float(gv.y & 0xffff0000u);
            const float ms = wsum(o0 * o0 + o1 * o1 + o2 * o2 + o3 * o3) * (1.f / 256.f);
            const float rs = rsqrtf(ms + 1e-5f);
            uint2 y; y.x = pk2(o0 * rs * ng.x * silu_(g0), o1 * rs * ng.y * silu_(g1)); y.y = pk2(o2 * rs * ng.z * silu_(g2), o3 * rs * ng.w * silu_(g3));
            *(uint2*)(YM + (size_t)row * D + 256 * hh + 4 * lane) = y;
        }
    }
}

#ifndef REP_UP
#define REP_UP 1
#endif
#ifndef REP_SCAN
#define REP_SCAN 1
#endif
#ifndef REP_GLA
#define REP_GLA 1
#endif
#ifndef REP_HY
#define REP_HY 1
#endif
#define REPEAT(n) for (int rep_ = 0, nrep_ = ({ int t_ = (n); asm volatile("" : "+s"(t_)); t_; }); rep_ < nrep_; ++rep_)
#ifndef REP_LN
#define REP_LN 1
#endif
#ifndef REP_MISC
#define REP_MISC 1
#endif
#ifndef REP_SYNC
#define REP_SYNC 1
#endif
#define GSYNC() do { for (int s_ = 0; s_ < REP_SYNC; ++s_) { XcdBarrier xb_; xb_.bar = (unsigned*)IN(40); xb_.x = xb_xcc_id(); xb_.st = (volatile XB_LAS unsigned*)(smem_g + TBL_OFF + 448); xcd_barrier(xb_); } } while (0)
#define LAUNDER() do { bid_ = blockIdx.x; asm volatile("" : "+s"(bid_)); gdim_ = gridDim.x; asm volatile("" : "+s"(gdim_)); } while (0)
__global__ void __launch_bounds__(NTHR, 2) mega(Params p) {
    unsigned char* smem = smem_g;
    cg::grid_group grid = cg::this_grid();
    int bid_, gdim_; LAUNDER();
    if (threadIdx.x == 0) {
        const float** tb = (const float**)(smem_g + TBL_OFF);
#pragma unroll
        for (int i = 0; i < 41; ++i) tb[i] = p.in[i];
        *(uint4*)(smem_g + TBL_OFF + 448) = make_uint4(0u, 0u, 0u, 0u);
    }
    unsigned* bar_ = (unsigned*)p.in[40];
    if (blockIdx.x == 0) for (int i = threadIdx.x; i < XCD_BAR_WORDS; i += NTHR) bar_[i] = 0u;
    __syncthreads();
    grid.sync();
    (void)xcd_barrier_post(bar_, (volatile XB_LAS unsigned*)(smem_g + TBL_OFF + 448));
    REPEAT(REP_MISC) {
    phase_mod(p, smem);
    __syncthreads();
    conv_weights(p, 0, smem);
    filt_gen(p, smem);
    GSYNC();
    }
    row_phase(p, 0, 0, 0, 0, 0, false);
    GSYNC();
#pragma unroll 1
    for (int l = 0; l < 4; ++l) {
#pragma unroll 1
        for (int f = 0; f < 2; ++f) {
            if (f == 1) {
                if (!(l & 1)) {
                    const int e = l >> 1;
                    REPEAT(REP_HY) {
                    LAUNDER();
                    { EpiStore E; E.O = (bf16_t*)(WS_ + WS_BIG); E.ldc = MTOT; E.nvalid = MTOT; run_gemm(smem, (const bf16_t*)(WS_ + WS_WIN), (const bf16_t*)(WS_ + WS_A), 1536, MTOT, 1024, E, bid_, gdim_); }
                    LAUNDER();
                    { EpiStore E; E.O = (bf16_t*)(WS_ + WS_BIG + BIG_ZR); E.ldc = 1920; E.nvalid = 1920; run_gemm(smem, (const bf16_t*)(WS_ + WS_A), (const bf16_t*)(WS_ + WS_WIN) + (size_t)1536 * 1024, MTOT, 2048, 1024, E, bid_, gdim_); }
                    GSYNC();
                    hyena_phase(p, e, smem);
                    if (rep_ + 1 < nrep_) GSYNC();
                    }
                    REPEAT(REP_SCAN) rwkv_scan_phase(p, e, smem);
                    GSYNC();
                    REPEAT(REP_MISC) even_readout_phase(p, e, smem);
                    GSYNC();
                } else {
                    const int o = l >> 1;
                    LAUNDER();
                    { EpiStore E; E.O = (bf16_t*)(WS_ + WS_BIG); E.ldc = 3104; E.nvalid = 3104; run_gemm(smem, (const bf16_t*)(WS_ + WS_A), (const bf16_t*)(WS_ + WS_WIN), MTOT, 3328, 1024, E, bid_, gdim_); }
                    GSYNC();
                    REPEAT(REP_GLA) gla_phase(p, o, smem);
                    GSYNC();
                    REPEAT(REP_MISC) odd_readout_phase(p, o);
                    GSYNC();
                }
                LAUNDER();
                { EpiResid E; E.gate_off = l * 17 * 9216 + 5 * 1024; E.wgt = 1.0f; E.ln_idx = l * 3 + 0; run_gemm(smem, (const bf16_t*)(WS_ + WS_A), (const bf16_t*)(WS_ + WS_WOUT), l == 3 ? MLAT : MTOT, 1024, 1024, E, bid_, gdim_); }
                GSYNC();
                REPEAT(REP_LN) row_phase(p, 1, l, 1, l, 6, false, l == 3 ? MLAT : MTOT);
                GSYNC();
            }
#if defined(REP_UPS)
            REPEAT(REP_UPS) { LAUNDER(); { EpiStore E; E.O = (bf16_t*)(WS_ + WS_BIG); E.ldc = FF; E.nvalid = FF; run_gemm(smem, (const bf16_t*)(WS_ + WS_A), (const bf16_t*)(WS_ + WS_WUP) + (size_t)f * 5632 * 1024, (l == 3 && f == 1) ? MLAT : MTOT, 2816, 1024, E, bid_, gdim_); } }
#endif
            REPEAT(REP_UP) { LAUNDER();
            { EpiSwiglu E; E.G = (bf16_t*)(WS_ + WS_BIG); run_gemm(smem, (const bf16_t*)(WS_ + WS_A), (const bf16_t*)(WS_ + WS_WUP) + (size_t)f * 5632 * 1024, (l == 3 && f == 1) ? MLAT : MTOT, 5632, 1024, E, bid_, gdim_); } }
            GSYNC();
            LAUNDER();
            { EpiResid E; E.gate_off = l * 17 * 9216 + (f ? 8 : 2) * 1024; E.wgt = 0.5f; E.ln_idx = f ? (l * 3 + 1) : (l * 3 - 1); run_gemm(smem, (const bf16_t*)(WS_ + WS_BIG), (const bf16_t*)(WS_ + WS_WDN) + (size_t)f * 1024 * FF, (l == 3 && f == 1) ? MLAT : MTOT, 1024, FF, E, bid_, gdim_); }
#if defined(REP_DN)
            REPEAT(REP_DN) { LAUNDER(); { EpiStore E; E.O = (bf16_t*)(WS_ + WS_BIG + (size_t)208 * 1024 * 1024); E.ldc = 1024; E.nvalid = 1024; run_gemm(smem, (const bf16_t*)(WS_ + WS_BIG), (const bf16_t*)(WS_ + WS_WDN) + (size_t)f * 1024 * FF, (l == 3 && f == 1) ? MLAT : MTOT, 1024, FF, E, bid_, gdim_); } }
#endif
            GSYNC();
            if (f == 0) { REPEAT(REP_LN) row_phase(p, 1, l, 0, l, 3, false); GSYNC(); }
        }
        if (l < 3) { REPEAT(REP_LN) row_phase(p, 1, l, 2, l + 1, 0, false); conv_weights(p, l + 1, smem); }
        else row_phase(p, 1, l, 2, 0, 0, true);
        GSYNC();
    }
}

extern "C" void kernel_launch(void* const* d_in, const int* in_sizes, int n_in, void* d_out, int out_size, void* d_ws, size_t ws_size, hipStream_t stream) {
    static int grid = 0;
    if (grid == 0) {
        if (n_in != 39 || ws_size < WS_END) { fprintf(stderr, "kernel_launch: need 39 inputs and %zu bytes of workspace; got %d, %zu\n", (size_t)WS_END, n_in, ws_size); grid = -1; return; }
        int dev = 0, cus = 0, per_cu = 0;
        (void)hipGetDevice(&dev);
        (void)hipDeviceGetAttribute(&cus, hipDeviceAttributeMultiprocessorCount, dev);
        if (hipFuncSetAttribute((const void*)mega, hipFuncAttributeMaxDynamicSharedMemorySize, LDS_BYTES) != hipSuccess) { fprintf(stderr, "kernel_launch: hipFuncSetAttribute failed\n"); grid = -1; return; }
        (void)hipOccupancyMaxActiveBlocksPerMultiprocessor(&per_cu, (const void*)mega, NTHR, LDS_BYTES);
        if (per_cu < 1) fprintf(stderr, "kernel_launch: occupancy query says %d blocks/CU\n", per_cu);
        (void)hipGetLastError();
        grid = cus;
        if (grid > 256) grid = 256;
    }
    if (grid < 0) return;
    Params p{};
    for (int i = 0; i < 39; ++i) p.in[i] = (const float*)d_in[i];
    p.in[39] = (const float*)d_out; p.in[40] = (const float*)d_ws;
    void* args[] = {&p};
    hipError_t e = hipLaunchCooperativeKernel((const void*)mega, dim3(grid), dim3(NTHR), args, LDS_BYTES, stream);
    if (e != hipSuccess) fprintf(stderr, "cooperative launch failed: %s (grid %d)\n", hipGetErrorString(e), grid);
}
```

```cpp
#include <hip/hip_runtime.h>
#include <hip/hip_cooperative_groups.h>
#include <cstdio>
namespace pg8 {
#define PG8_LAS __attribute__((address_space(3)))
typedef unsigned short bf16_t;
typedef short bf16x8 __attribute__((ext_vector_type(8)));
typedef float f32x4 __attribute__((ext_vector_type(4)));
typedef unsigned u32x4 __attribute__((ext_vector_type(4)));
constexpr int BM = 256, BK = 64, HALF = 128, HTB = HALF * BK * 2  , STAGE_BYTES = 8 * HTB, NXCD = 8, WGM = 4;

__host__ __device__ __forceinline__ int lds_byte(int r, int c) { const int st = (r >> 4) * 2 + (c >> 5), rr = r & 15, cc = c & 31, ob = rr * 64 + cc * 2; return st * 1024 + (ob ^ (((ob >> 9) & 1) << 5)); }
__host__ __device__ __forceinline__ void stage_rc(int b, int& R, int& C) { const int st = b / 1024, sb = b % 1024, swz = sb ^ (((sb >> 9) & 1) << 5); R = (st >> 1) * 16 + swz / 64; C = (st & 1) * 32 + (swz % 64) / 2; }
__host__ __device__ __forceinline__ int perm32(int rho) { const int n = rho >> 4, i = rho & 15; return 8 * (i >> 2) + 4 * n + (i & 3); }

struct Unit { int pm, pn; };
struct Gemm { const bf16_t* A; const bf16_t* Bt; int M, N, K; };

struct StaticOrder {
    int nM, nN, nwg, G, c;
    __host__ __device__ void init(int M, int N, int G_, int c_) { nM = M / BM; nN = N / BM; nwg = nM * nN; G = G_; c = c_; }
    __host__ __device__ bool next(int i, Unit& u) const {
        const long L = (long)i * G + c; if (L >= nwg) return false;
        int wgid = (int)L; { const int q = nwg / NXCD, r = nwg % NXCD, xcd = wgid % NXCD, off = wgid / NXCD; wgid = (xcd < r ? xcd * (q + 1) : r * (q + 1) + (xcd - r) * q) + off; }
        const int nig = WGM * nN, gid = wgid / nig, fm = gid * WGM, gsz = (nM - fm) < WGM ? (nM - fm) : WGM;
        u.pm = fm + ((wgid % nig) % gsz); u.pn = (wgid % nig) / gsz; return true;
    }
    __device__ __forceinline__ void a_ready(const Unit&) const {}
    __device__ __forceinline__ void done(const Unit&) const {}
};
__device__ __forceinline__ unsigned cvt_pk_bf16(float lo, float hi) { unsigned r; asm volatile("v_cvt_pk_bf16_f32 %0, %1, %2" : "=v"(r) : "v"(lo), "v"(hi)); return r; }
typedef float f32x2 __attribute__((ext_vector_type(2)));

template <class Epi, class Sched, bool STAMP = false>
__device__ __forceinline__ void gemm_phase(PG8_LAS unsigned char* lds, const Gemm g, const Sched& S, const Epi& E, unsigned long long* stamps) {
    int tid_l_ = threadIdx.x; asm volatile("" : "+v"(tid_l_)); const int tid = tid_l_, wid = __builtin_amdgcn_readfirstlane(tid >> 6), lane = tid & 63, wr = wid >> 2, wc = wid & 3, fr = lane & 15, fq = lane >> 4;
    const int K = g.K, nt = K / BK;
    int ts_lo = 0, ts_hi = 0, nts = 0; const unsigned long long rt_entry = STAMP ? (unsigned long long)wall_clock64() : 0ull;
#define PG8_STAMP() do { if (STAMP && wid == 0 && nts < 64) { const unsigned long long _c = (unsigned long long)clock64(); \
        ts_lo = (lane == nts) ? (int)(unsigned)_c : ts_lo; ts_hi = (lane == nts) ? (int)(unsigned)(_c >> 32) : ts_hi; ++nts; } } while (0)
    PG8_STAMP();
    unsigned voffA[2], voffB[2];
#pragma unroll
    for (int i = 0; i < 2; ++i) { int R, C; stage_rc(tid * 16 + i * 8192, R, C); const int Rb = Epi::PERM ? ((R & ~31) + perm32(R & 31)) : R;
        voffA[i] = (unsigned)(R * K + C) * 2u; voffB[i] = (unsigned)(Rb * K + C) * 2u; }
    const size_t kstep = (size_t)(BK * 2);
    const size_t hstep = (size_t)HALF * K * 2;
    const size_t tstep = 2 * hstep;
    const unsigned ldsw = (unsigned)wid * 1024u;
    const int aoff = lds_byte(wr * 64 + fr, fq * 8), boff = lds_byte(wc * 32 + fr, fq * 8);
#define PG8_SA(b, h) (((b) * 2 + (h)) * HTB)
#define PG8_SB(b, h) ((4 + (b) * 2 + (h)) * HTB)
#define PG8_STAGE(bufoff, gbase, voff) do { _Pragma("unroll") for (int _i = 0; _i < 2; ++_i) \
        __builtin_amdgcn_global_load_lds((const unsigned*)((const char*)(gbase) + (voff)[_i]), (PG8_LAS unsigned*)(lds + (bufoff) + ldsw + _i * 8192), 16, 0, 0); } while (0)
#define PG8_LDA(dst, b, h) do { _Pragma("unroll") for (int m = 0; m < 4; ++m) _Pragma("unroll") for (int k = 0; k < 2; ++k) dst[m][k] = *(const PG8_LAS bf16x8*)(lds + PG8_SA(b, h) + aoff + m * 2048 + k * 1024); } while (0)
#define PG8_LDB(dst, b, h) do { _Pragma("unroll") for (int n = 0; n < 2; ++n) _Pragma("unroll") for (int k = 0; k < 2; ++k) dst[n][k] = *(const PG8_LAS bf16x8*)(lds + PG8_SB(b, h) + boff + n * 2048 + k * 1024); } while (0)
#define PG8_MMA(ai, bj, At, Bt) do { __builtin_amdgcn_s_setprio(1); _Pragma("unroll") for (int m = 0; m < 4; ++m) _Pragma("unroll") for (int n = 0; n < 2; ++n) _Pragma("unroll") for (int k = 0; k < 2; ++k) \
        acc[ai][bj][m][n] = __builtin_amdgcn_mfma_f32_16x16x32_bf16(Bt[n][k], At[m][k], acc[ai][bj][m][n], 0, 0, 0); __builtin_amdgcn_s_setprio(0); } while (0)
#define PG8_WAIT_V(n) asm volatile("s_waitcnt vmcnt(" #n ")" ::: "memory")
#define PG8_WAIT_L(n) asm volatile("s_waitcnt lgkmcnt(" #n ")" ::: "memory")
#define PG8_BAR __builtin_amdgcn_s_barrier()
#define PG8_SCHED __builtin_amdgcn_sched_barrier(0)
    Unit cur, nxt; int ui = 0;
    if (!S.next(0, cur)) return;
    f32x4 acc[2][2][4][2];
#pragma unroll
    for (int a = 0; a < 2; ++a)
#pragma unroll
        for (int b = 0; b < 2; ++b)
#pragma unroll
            for (int m = 0; m < 4; ++m)
#pragma unroll
                for (int n = 0; n < 2; ++n) acc[a][b][m][n] = (f32x4){0.f, 0.f, 0.f, 0.f};
    bf16x8 At[4][2], B0[2][2], B1[2][2];
    const char* cA = (const char*)g.A + (size_t)cur.pm * tstep; const char* cB = (const char*)g.Bt + (size_t)cur.pn * tstep;
    S.a_ready(cur);
    PG8_STAGE(PG8_SB(0, 0), cB, voffB); PG8_STAGE(PG8_SA(0, 0), cA, voffA); PG8_STAGE(PG8_SB(0, 1), cB + hstep, voffB); PG8_STAGE(PG8_SA(0, 1), cA + hstep, voffA);
    if (wr == 1) PG8_BAR;
    PG8_WAIT_V(4); PG8_BAR;
    PG8_STAGE(PG8_SB(1, 0), cB + kstep, voffB); PG8_STAGE(PG8_SA(1, 0), cA + kstep, voffA); PG8_STAGE(PG8_SB(1, 1), cB + hstep + kstep, voffB);
    PG8_WAIT_V(6); PG8_BAR;
    PG8_STAMP();
    for (;;) {
        const bool has_next = S.next(ui + 1, nxt);
        const char* nA = has_next ? (const char*)g.A + (size_t)nxt.pm * tstep : cA; const char* nB = has_next ? (const char*)g.Bt + (size_t)nxt.pn * tstep : cB;
        for (int t = 0; t < nt; t += 2) {
            const bool last = (t == nt - 2);
            const char* a1 = cA + (size_t)(t + 1) * kstep;
            const char* a2 = last ? nA : cA + (size_t)(t + 2) * kstep; const char* b2 = last ? nB : cB + (size_t)(t + 2) * kstep;
            const char* a3 = a2 + kstep; const char* b3 = b2 + kstep;
            if (last && has_next) S.a_ready(nxt);
            PG8_LDB(B0, 0, 0); PG8_SCHED; PG8_LDA(At, 0, 0); PG8_STAGE(PG8_SA(1, 1), a1 + hstep, voffA);
            PG8_WAIT_L(8); PG8_BAR; PG8_WAIT_L(0); PG8_MMA(0, 0, At, B0); PG8_BAR; PG8_SCHED;
            PG8_LDB(B1, 0, 1); PG8_STAGE(PG8_SB(0, 0), b2, voffB);
            PG8_BAR; PG8_WAIT_L(0); PG8_MMA(0, 1, At, B1); PG8_BAR;
            PG8_LDA(At, 0, 1); PG8_STAGE(PG8_SA(0, 0), a2, voffA);
            PG8_BAR; PG8_WAIT_L(0); PG8_MMA(1, 0, At, B0); PG8_BAR; PG8_SCHED;
            PG8_STAGE(PG8_SB(0, 1), b2 + hstep, voffB);
            PG8_WAIT_V(6); PG8_BAR; PG8_MMA(1, 1, At, B1); PG8_BAR;
            PG8_LDB(B0, 1, 0); PG8_SCHED; PG8_LDA(At, 1, 0); PG8_STAGE(PG8_SA(0, 1), a2 + hstep, voffA);
            PG8_WAIT_L(8); PG8_BAR; PG8_WAIT_L(0); PG8_MMA(0, 0, At, B0); PG8_BAR; PG8_SCHED;
            PG8_LDB(B1, 1, 1); PG8_STAGE(PG8_SB(1, 0), b3, voffB);
            PG8_BAR; PG8_WAIT_L(0); PG8_MMA(0, 1, At, B1); PG8_BAR;
            PG8_LDA(At, 1, 1); PG8_STAGE(PG8_SA(1, 0), a3, voffA);
            PG8_BAR; PG8_WAIT_L(0); PG8_MMA(1, 0, At, B0); PG8_BAR; PG8_SCHED;
            PG8_STAGE(PG8_SB(1, 1), b3 + hstep, voffB);
            PG8_WAIT_V(6); PG8_BAR; PG8_MMA(1, 1, At, B1); PG8_BAR;
        }
        PG8_STAMP();
        if constexpr (!Epi::AFTER_DRAIN) { E(acc, cur, wr, wc, fr, fq); S.done(cur); }
        PG8_STAMP();
        if (!has_next) break;
#pragma unroll
        for (int a = 0; a < 2; ++a)
#pragma unroll
            for (int b = 0; b < 2; ++b)
#pragma unroll
                for (int m = 0; m < 4; ++m)
#pragma unroll
                    for (int n = 0; n < 2; ++n) acc[a][b][m][n] = (f32x4){0.f, 0.f, 0.f, 0.f};
        cur = nxt; cA = nA; cB = nB; ++ui;
    }
    PG8_WAIT_V(0);
    if (wr == 0) PG8_BAR;
    PG8_BAR;
    if constexpr (Epi::AFTER_DRAIN) { E.fused(acc, cur, wr, wc, fr, fq, lds, wid, lane); S.done(cur); }
    PG8_STAMP();
    if (STAMP && wid == 0) { stamps[lane] = lane < nts ? (((unsigned long long)(unsigned)ts_hi << 32) | (unsigned)ts_lo) : 0ull;
        if (lane == 62) stamps[62] = rt_entry; if (lane == 63) stamps[63] = (unsigned long long)wall_clock64(); }
#undef PG8_STAMP
#undef PG8_SA
#undef PG8_SB
#undef PG8_STAGE
#undef PG8_LDA
#undef PG8_LDB
#undef PG8_MMA
#undef PG8_WAIT_V
#undef PG8_WAIT_L
#undef PG8_BAR
#undef PG8_SCHED
}
}
#define XB_TMO      128
#define XB_XCNT(j)  (256  + 64 * (j))
#define XB_XSUB(j)  (1280 + 64 * (j))
#define XB_XGEN(j)  (2304 + 64 * (j))
#define XB_TOP      3328
#define XB_TOPGEN   3392
#define XCD_BAR_WORDS 3456
#define XB_SPIN_CAP (1u << 18)
#define XB_LAS __attribute__((address_space(3)))

__device__ __forceinline__ unsigned xb_ld(unsigned* p)              { return __hip_atomic_load(p, __ATOMIC_RELAXED, __HIP_MEMORY_SCOPE_AGENT); }
__device__ __forceinline__ unsigned xb_add(unsigned* p, unsigned v) { return __hip_atomic_fetch_add(p, v, __ATOMIC_RELAXED, __HIP_MEMORY_SCOPE_AGENT); }
__device__ __forceinline__ unsigned xb_xcc_id() { return (unsigned)__builtin_amdgcn_s_getreg((3 << 11) | 20) & 0xFu; }
#define XB_SPIN(cond, bar) do { unsigned _sp = 0; while (cond) { __builtin_amdgcn_s_sleep(1); \
    if ((++_sp & 255u) == 0u) { if (xb_ld(&(bar)[XB_TMO])) break; if (_sp > XB_SPIN_CAP) { atomicAdd(&(bar)[XB_TMO], 1u); break; } } } } while (0)

struct XcdBarrier {
    unsigned* bar; unsigned x;
    volatile XB_LAS unsigned* st;
};

__device__ __forceinline__ XcdBarrier xcd_barrier_post(unsigned* bar, volatile XB_LAS unsigned* st) {
    XcdBarrier b; b.bar = bar; b.x = xb_xcc_id(); b.st = st;
    if (threadIdx.x == 0) (void)xb_add(&bar[XB_XCNT(b.x)], 1u);
    return b;
}
__device__ __forceinline__ void xcd_barrier_complete(unsigned* bar, unsigned x, unsigned& nloc, unsigned& nx) {
    const unsigned G = gridDim.x * gridDim.y * gridDim.z;
    unsigned sum, cnt, mine, sp = 0u;
    for (;;) {
        sum = 0u; cnt = 0u; mine = 0u;
#pragma unroll
        for (unsigned j = 0; j < 16; ++j) { const unsigned c = xb_ld(&bar[XB_XCNT(j)]); sum += c; cnt += (c > 0u) ? 1u : 0u; mine = (j == x) ? c : mine; }
        if (sum == G) break;
        __builtin_amdgcn_s_sleep(1);
        if ((++sp & 255u) == 0u) { if (xb_ld(&bar[XB_TMO])) break; if (sp > XB_SPIN_CAP) { atomicAdd(&bar[XB_TMO], 1u); break; } }
    }
    nloc = mine > 0u ? mine : 1u; nx = cnt > 0u ? cnt : 1u;
}

__device__ __forceinline__ void xcd_barrier(const XcdBarrier& b) {
    asm volatile("s_waitcnt vmcnt(0)" ::: "memory");
    __syncthreads();
    if (threadIdx.x == 0) {
        unsigned* bar = b.bar;
        __builtin_amdgcn_s_waitcnt(0);
        unsigned nloc = b.st[0], nx = b.st[1];
        if (nloc == 0u) { xcd_barrier_complete(bar, b.x, nloc, nx); b.st[0] = nloc; b.st[1] = nx; }
        const unsigned old = xb_add(&bar[XB_XSUB(b.x)], 1u);
        const unsigned gen = old / nloc;
        if (old + 1u == (gen + 1u) * nloc) {
            __builtin_amdgcn_fence(__ATOMIC_RELEASE, "agent");
            asm volatile("s_waitcnt vmcnt(0)" ::: "memory");
            const unsigned og = xb_add(&bar[XB_TOP], 1u);
            const unsigned tg = og / nx;
            if (og + 1u == (tg + 1u) * nx) xb_add(&bar[XB_TOPGEN], 1u);
            else XB_SPIN(xb_ld(&bar[XB_TOPGEN]) == tg, bar);
            __builtin_amdgcn_fence(__ATOMIC_ACQUIRE, "agent");
            xb_add(&bar[XB_XGEN(b.x)], 1u);
            asm volatile("s_waitcnt vmcnt(0)" ::: "memory");
        } else {
            XB_SPIN(xb_ld(&bar[XB_XGEN(b.x)]) == gen, bar);
            __builtin_amdgcn_fence(__ATOMIC_ACQUIRE, "agent");
            asm volatile("s_waitcnt vmcnt(0)" ::: "memory");
        }
    }
    __syncthreads();
}

namespace cg = cooperative_groups;
typedef unsigned short bf16_t;
using pg8::bf16x8; using pg8::f32x4;
#define LAS __attribute__((address_space(3)))

constexpr int D = 1024, NB = 16, TL = 2048, TCX = 256, FF = 2816;
constexpr int MLAT = NB * TL, MCTX = NB * TCX, MTOT = MLAT + MCTX;
constexpr float DN_ALPHA = 1.681792830507429f;
constexpr int NTHR = 512;
constexpr int LDS_BYTES = 155648;

constexpr size_t al256(size_t x) { return (x + 255) & ~(size_t)255; }
constexpr size_t WS_MOD = 16384;
constexpr size_t WS_FT = al256(WS_MOD + (size_t)4 * 17 * 9216 * 4);
constexpr size_t FT_LAT = (size_t)2 * 512 * 4096, FT_CTX = (size_t)2 * 512 * 512, FT_E = FT_LAT + FT_CTX;
constexpr size_t WS_WUP = al256(WS_FT + 2 * FT_E * 2);
constexpr size_t WS_WDN = WS_WUP + (size_t)2 * 5632 * 1024 * 2;
constexpr size_t WS_WIN = WS_WDN + (size_t)2 * 1024 * 2816 * 2;
constexpr size_t WS_WOUT = WS_WIN + (size_t)3584 * 1024 * 2;
constexpr size_t WS_H = WS_WOUT + (size_t)1024 * 1024 * 2;
constexpr size_t WS_A = WS_H + (size_t)MTOT * 1024 * 4;
constexpr size_t WS_BON = WS_A + (size_t)MTOT * 1024 * 2;
constexpr size_t WS_STATS = al256(WS_BON + (size_t)2 * MTOT * 8 * 4);
constexpr size_t WS_BIG = al256(WS_STATS + (size_t)MTOT * 2 * 4);
constexpr size_t BIG_ZR = (size_t)1536 * MTOT * 2;
constexpr size_t BIG_ORW = BIG_ZR + (size_t)MTOT * 1920 * 2;
constexpr size_t BIG_EVEN_END = BIG_ORW + (size_t)2 * MTOT * 512 * 2;
constexpr size_t BIG_OGL = al256((size_t)MTOT * 3104 * 2);
constexpr size_t WS_END = WS_BIG + BIG_EVEN_END;

struct Params { const float* in[41]; };
#define PH_PRO int tid_ = threadIdx.x; asm volatile("" : "+v"(tid_)); int bid_ = blockIdx.x; asm volatile("" : "+s"(bid_)); int gdim_ = gridDim.x; asm volatile("" : "+s"(gdim_));
extern __shared__ __attribute__((aligned(16))) unsigned char smem_g[];
constexpr int TBL_OFF = LDS_BYTES - 512;
typedef const float __attribute__((address_space(1)))* gfptr_;
#define IN(i) ((const float*)(((const gfptr_*)(smem_g + TBL_OFF))[i]))
#define OUT_ ((float*)IN(39))
#define WS_ ((unsigned char*)IN(40))

__device__ __forceinline__ float bf2f(bf16_t b) { return __uint_as_float(((unsigned)b) << 16); }
typedef __bf16 bf16x2_t_ __attribute__((ext_vector_type(2)));
typedef float f32x2_t_ __attribute__((ext_vector_type(2)));
__device__ __forceinline__ unsigned pk2(float lo, float hi) { f32x2_t_ v = {lo, hi}; bf16x2_t_ b = __builtin_convertvector(v, bf16x2_t_); return __builtin_bit_cast(unsigned, b); }
__device__ __forceinline__ bf16_t f2bf(float f) { return (bf16_t)(pk2(f, 0.f) & 0xffffu); }
__device__ __forceinline__ bf16x8 ld8(const bf16_t* p) { const uint2 a = *(const uint2*)p, b = *(const uint2*)(p + 4); uint4 v; v.x = a.x; v.y = a.y; v.z = b.x; v.w = b.y; return __builtin_bit_cast(bf16x8, v); }
#define DPPF(v, ctrl) __builtin_bit_cast(float, __builtin_amdgcn_update_dpp(0, __builtin_bit_cast(int, (v)), (ctrl), 0xF, 0xF, true))
__device__ __forceinline__ float wsum(float v) {
    v += DPPF(v, 0xB1); v += DPPF(v, 0x4E); v += DPPF(v, 0x141); v += DPPF(v, 0x140);
    const int iv = __builtin_bit_cast(int, v);
    return __builtin_bit_cast(float, __builtin_amdgcn_readlane(iv, 0)) + __builtin_bit_cast(float, __builtin_amdgcn_readlane(iv, 16)) +
           __builtin_bit_cast(float, __builtin_amdgcn_readlane(iv, 32)) + __builtin_bit_cast(float, __builtin_amdgcn_readlane(iv, 48));
}
__device__ __forceinline__ float sigm(float x) { return __builtin_amdgcn_rcpf(1.f + __expf(-x)); }
__device__ __forceinline__ float silu_(float x) { return x * __builtin_amdgcn_rcpf(1.f + __expf(-x)); }
__device__ __forceinline__ float softplus_(float y) { return fmaxf(y, 0.f) + __logf(1.f + __expf(-fabsf(y))); }
__device__ __forceinline__ float tanh_(float x) { return 1.f - 2.f * __builtin_amdgcn_rcpf(1.f + __expf(2.f * x)); }

struct EpiStore {
    static constexpr bool PERM = true, AFTER_DRAIN = false;
    bf16_t* O; int ldc; int nvalid;
    __device__ __forceinline__ void operator()(const f32x4 (&acc)[2][2][4][2], const pg8::Unit& u, int wr, int wc, int fr, int fq) const {
        const int row0 = u.pm * 256 + wr * 64 + fr, col0 = u.pn * 256 + wc * 32 + 8 * fq;
#pragma unroll
        for (int ai = 0; ai < 2; ++ai)
#pragma unroll
            for (int m = 0; m < 4; ++m) {
                bf16_t* rowp = O + (size_t)(row0 + ai * 128 + m * 16) * ldc;
#pragma unroll
                for (int bj = 0; bj < 2; ++bj) {
                    const int col = col0 + bj * 128;
                    if (col < nvalid) {
                        const f32x4 v0 = acc[ai][bj][m][0], v1 = acc[ai][bj][m][1];
                        uint4 o; o.x = pk2(v0[0], v0[1]); o.y = pk2(v0[2], v0[3]); o.z = pk2(v1[0], v1[1]); o.w = pk2(v1[2], v1[3]);
                        *(uint4*)(rowp + col) = o;
                    }
                }
            }
    }
};
struct EpiSwiglu {
    static constexpr bool PERM = true, AFTER_DRAIN = false;
    bf16_t* G; int pm_off;
    __device__ __forceinline__ void operator()(const f32x4 (&acc)[2][2][4][2], const pg8::Unit& u, int wr, int wc, int fr, int fq) const {
        const int row0 = (u.pm + pm_off) * 256 + wr * 64 + fr, col0 = u.pn * 128 + wc * 32 + 8 * fq;
#pragma unroll
        for (int ai = 0; ai < 2; ++ai)
#pragma unroll
            for (int m = 0; m < 4; ++m) {
                bf16_t* rowp = G + (size_t)(row0 + ai * 128 + m * 16) * FF + col0;
                float o[8];
#pragma unroll
                for (int n = 0; n < 2; ++n)
#pragma unroll
                    for (int e = 0; e < 4; ++e) o[n * 4 + e] = silu_(acc[ai][0][m][n][e]) * acc[ai][1][m][n][e];
                uint4 q; q.x = pk2(o[0], o[1]); q.y = pk2(o[2], o[3]); q.z = pk2(o[4], o[5]); q.w = pk2(o[6], o[7]);
                *(uint4*)rowp = q;
            }
    }
};
struct EpiResid {
    static constexpr bool PERM = false, AFTER_DRAIN = false;
    int gate_off; float wgt; int ln_idx; int pm_off;
    __device__ __forceinline__ void operator()(const f32x4 (&acc)[2][2][4][2], const pg8::Unit& u, int wr, int wc, int fr, int fq) const {
        float* H = (float*)(WS_ + WS_H); const float* gate = (const float*)(WS_ + WS_MOD) + gate_off;
        const float* stats = ln_idx >= 0 ? (const float*)(WS_ + WS_STATS) : nullptr;
        const float* Hin = ln_idx >= 0 ? H : ((u.pm + pm_off) < 128 ? IN(0) : IN(2) - (size_t)MLAT * D);
        const float* lg = IN(6) + (ln_idx < 0 ? 0 : ln_idx) * 1024; const float* lb = IN(7) + (ln_idx < 0 ? 0 : ln_idx) * 1024;
        const int gpm = u.pm + pm_off;
        const int row0 = gpm * 256 + wr * 64 + fr, col0 = u.pn * 256 + wc * 32 + 4 * fq;
        const int midx = gpm < 128 ? (gpm >> 3) : 16;
        const float* gp = gate + (size_t)midx * 9216 + col0;
        float mu[2][4], rs[2][4];
#pragma unroll
        for (int ai = 0; ai < 2; ++ai)
#pragma unroll
            for (int m = 0; m < 4; ++m) {
                if (stats) { const float2 st = *(const float2*)(stats + 2 * (size_t)(row0 + ai * 128 + m * 16)); mu[ai][m] = st.x; rs[ai][m] = st.y; }
                else { mu[ai][m] = 0.f; rs[ai][m] = 1.f; }
            }
#pragma unroll
        for (int bj = 0; bj < 2; ++bj)
#pragma unroll
            for (int n = 0; n < 2; ++n) {
                const int co = bj * 128 + n * 16;
                const f32x4 gvv = *(const f32x4*)(gp + co) * wgt;
                f32x4 g4 = (f32x4){1.f, 1.f, 1.f, 1.f}, b4 = (f32x4){0.f, 0.f, 0.f, 0.f};
                if (stats) { g4 = *(const f32x4*)(lg + col0 + co); b4 = *(const f32x4*)(lb + col0 + co); }
#pragma unroll
                for (int ai = 0; ai < 2; ++ai)
#pragma unroll
                    for (int m = 0; m < 4; ++m) {
                        float* rowp = H + (size_t)(row0 + ai * 128 + m * 16) * D + col0 + co;
                        f32x4 h = *(const f32x4*)(Hin + (size_t)(row0 + ai * 128 + m * 16) * D + col0 + co);
                        h = (h - mu[ai][m]) * rs[ai][m] * g4 + b4;
                        h = h * DN_ALPHA + gvv * acc[ai][bj][m][n];
                        *(f32x4*)rowp = h;
                    }
            }
    }
};

template <class Epi>
__device__ __forceinline__ void run_gemm(unsigned char* smem, const bf16_t* A, const bf16_t* Bt, int M, int N, int K, const Epi& E, int bid_, int gdim_) {
    pg8::Gemm g; g.A = A; g.Bt = Bt; g.M = M; g.N = N; g.K = K;
    pg8::StaticOrder S; S.init(M, N, gdim_, bid_);
    pg8::gemm_phase<Epi, pg8::StaticOrder, false>((PG8_LAS unsigned char*)smem, g, S, E, nullptr);
}

__device__ __forceinline__ void phase_mod(const Params& p, unsigned char* smem) {
    PH_PRO
    float* s = (float*)smem;
    float* part = s + 17 * 1024;
    const int tid = tid_;
    const float* c = IN(1); const float* cc = IN(3);
    float* MOD = (float*)(WS_ + WS_MOD);
    if (bid_ >= 288) return;
    for (int idx = tid; idx < 17 * 1024; idx += NTHR) { const int i = idx >> 10, k = idx & 1023; const float v = i < 16 ? c[i * 1024 + k] : cc[k]; s[idx] = silu_(v); }
    __syncthreads();
    for (int item = bid_; item < 288; item += gdim_) {
        const int l = item / 72, j0 = (item % 72) * 128;
        const int col = tid & 127, kq = tid >> 7;
        const float* w = IN(4) + ((size_t)l * 1024 + kq * 256) * 9216 + j0 + col;
        float acc[17];
#pragma unroll
        for (int i = 0; i < 17; ++i) acc[i] = 0.f;
        for (int k = 0; k < 256; ++k) {
            const float wv = w[(size_t)k * 9216];
#pragma unroll
            for (int i = 0; i < 17; ++i) acc[i] += s[i * 1024 + kq * 256 + k] * wv;
        }
#pragma unroll
        for (int i = 0; i < 17; ++i) part[(kq * 17 + i) * 128 + col] = acc[i];
        __syncthreads();
        for (int idx = tid; idx < 17 * 128; idx += NTHR) {
            const int i = idx >> 7, cl = idx & 127;
            const float v = part[(0 * 17 + i) * 128 + cl] + part[(1 * 17 + i) * 128 + cl] + part[(2 * 17 + i) * 128 + cl] + part[(3 * 17 + i) * 128 + cl] + IN(5)[l * 9216 + j0 + cl];
            MOD[((size_t)l * 17 + i) * 9216 + j0 + cl] = v;
        }
        __syncthreads();
    }
}

__device__ __forceinline__ void conv_tile(const float* src, int ld, int nvalid, bf16_t* dst, int ldd, float* tile) {
    PH_PRO
    const int tid = tid_;
#pragma unroll
    for (int i = 0; i < 2; ++i) {
        const int k = (tid >> 4) + 32 * i, c4 = (tid & 15) * 4;
        float4 v = make_float4(0.f, 0.f, 0.f, 0.f);
        if (c4 < nvalid) v = *(const float4*)(src + (size_t)k * ld + c4);
        tile[k * 65 + c4] = v.x; tile[k * 65 + c4 + 1] = v.y; tile[k * 65 + c4 + 2] = v.z; tile[k * 65 + c4 + 3] = v.w;
    }
    __syncthreads();
    const int n = tid >> 3, ks = (tid & 7) * 8;
    uint4 o;
    o.x = pk2(tile[(ks + 0) * 65 + n], tile[(ks + 1) * 65 + n]); o.y = pk2(tile[(ks + 2) * 65 + n], tile[(ks + 3) * 65 + n]);
    o.z = pk2(tile[(ks + 4) * 65 + n], tile[(ks + 5) * 65 + n]); o.w = pk2(tile[(ks + 6) * 65 + n], tile[(ks + 7) * 65 + n]);
    *(uint4*)(dst + (size_t)n * ldd + ks) = o;
    __syncthreads();
}
__device__ __forceinline__ void conv_weights(const Params& p, int l, unsigned char* smem) {
    PH_PRO
    float* tile = (float*)smem;
    const bool even = !(l & 1); const int eo = l >> 1;
    const int NIN = even ? 3456 : 3104, nint = (even ? 3584 : 3328) / 64;
    const int total = 2816 + 1408 + nint * 16 + 256;
    bf16_t* WUP = (bf16_t*)(WS_ + WS_WUP); bf16_t* WDN = (bf16_t*)(WS_ + WS_WDN); bf16_t* WIN = (bf16_t*)(WS_ + WS_WIN); bf16_t* WOUT = (bf16_t*)(WS_ + WS_WOUT);
    for (int idx = bid_; idx < total; idx += gdim_) {
        if (idx < 2816) {
            const int f = idx / 1408, r = idx % 1408, nt = r / 16, kt = r % 16, n0 = nt * 64;
            const int pn = n0 >> 8, bj = (n0 & 255) >> 7, j = n0 & 127, col = pn * 128 + j;
            const float* src = (bj ? IN(9) : IN(8)) + ((size_t)(l * 2 + f) * 1024 + kt * 64) * FF + col;
            conv_tile(src, FF, 64, WUP + ((size_t)f * 5632 + n0) * 1024 + kt * 64, 1024, tile);
        } else if (idx < 4224) {
            int r = idx - 2816; const int f = r / 704; r %= 704; const int kt = r / 16, nt = r % 16;
            const float* src = IN(10) + ((size_t)(l * 2 + f) * FF + kt * 64) * 1024 + nt * 64;
            conv_tile(src, 1024, 64, WDN + ((size_t)f * 1024 + nt * 64) * FF + kt * 64, FF, tile);
        } else if (idx < 4224 + nint * 16) {
            const int r = idx - 4224, nt = r / 16, kt = r % 16, n0 = nt * 64;
            int nv = NIN - n0; nv = nv < 0 ? 0 : (nv > 64 ? 64 : nv);
            const float* src = (even ? IN(11) : IN(34)) + ((size_t)eo * 1024 + kt * 64) * NIN + n0;
            conv_tile(src, NIN, nv, WIN + (size_t)n0 * 1024 + kt * 64, 1024, tile);
        } else {
            const int r = idx - 4224 - nint * 16, nt = r / 16, kt = r % 16;
            const float* src = (even ? IN(12) : IN(35)) + ((size_t)eo * 1024 + kt * 64) * 1024 + nt * 64;
            conv_tile(src, 1024, 64, WOUT + (size_t)nt * 64 * 1024 + kt * 64, 1024, tile);
        }
    }
}

__device__ __forceinline__ void filt_gen(const Params& p, unsigned char* smem) {
    PH_PRO
    float* z = (float*)smem;
    float* h1 = z + 64 * 33;
    float* h2 = h1 + 64 * 65;
    const int tid = tid_, lane = tid & 63, wid = __builtin_amdgcn_readfirstlane(tid >> 6);
    bf16_t* FT = (bf16_t*)(WS_ + WS_FT);
    for (int item = (bid_ + gdim_ / 2) % gdim_; item < 2 * 36 * 4; item += gdim_) {
        const int e = item / 144; int r = item % 144; const int cg = r & 3; r >>= 2;
        const int seg = r >= 32; const int jb = seg ? r - 32 : r;
        const int L = seg ? 256 : 2048;
        const float* w1 = IN(15) + e * 33 * 64; const float* b1 = IN(16) + e * 64; const float* f1 = IN(17) + e * 64;
        const float* w2 = IN(18) + e * 64 * 64; const float* b2 = IN(19) + e * 64; const float* f2 = IN(20) + e * 64;
        const float* w3 = IN(21) + (size_t)e * 64 * 2048; const float* skip = IN(22) + e * 1024;
        __syncthreads();
        for (int idx = tid; idx < 64 * 33; idx += NTHR) {
            const int jj = idx / 33, i = idx % 33; const int j = jb * 64 + jj;
            float v;
            if (i == 0) v = (float)j / (float)(L - 1);
            else { const int bi = (i - 1) & 15; const float f = 1e-4f + (float)bi * ((15.f - 1e-4f) / 15.f); const float w = 6.283185307179586f * (float)j / (float)L; v = (i <= 16) ? cosf(f * w) : -sinf(f * w); }
            z[idx] = v;
        }
        __syncthreads();
        for (int idx = tid; idx < 4096; idx += NTHR) {
            const int jj = idx >> 6, o = idx & 63; float a = b1[o];
            for (int i = 0; i < 33; ++i) a += z[jj * 33 + i] * w1[i * 64 + o];
            h1[jj * 65 + o] = sinf(f1[o] * a);
        }
        __syncthreads();
        for (int idx = tid; idx < 4096; idx += NTHR) {
            const int jj = idx >> 6, o = idx & 63; float a = b2[o];
            for (int k = 0; k < 64; ++k) a += h1[jj * 65 + k] * w2[k * 64 + o];
            h2[jj * 65 + o] = sinf(f2[o] * a);
        }
        __syncthreads();
        bf16_t* base = FT + (size_t)e * FT_E + (seg ? FT_LAT : 0);
#pragma unroll 1
        for (int ps = 0; ps < 2; ++ps) {
            const int col0 = cg * 512 + ps * 256 + 4 * lane;
            float acc[8][4];
#pragma unroll
            for (int i = 0; i < 8; ++i)
#pragma unroll
                for (int c = 0; c < 4; ++c) acc[i][c] = 0.f;
#pragma unroll 4
            for (int k = 0; k < 64; ++k) {
                const float4 wv = *(const float4*)(w3 + (size_t)k * 2048 + col0);
#pragma unroll
                for (int i = 0; i < 8; ++i) { const float hv = h2[(8 * wid + i) * 65 + k]; acc[i][0] += hv * wv.x; acc[i][1] += hv * wv.y; acc[i][2] += hv * wv.z; acc[i][3] += hv * wv.w; }
            }
            const int ord = col0 >> 10, dir = (col0 >> 9) & 1;
            const float lo = -4.605170185988091f / 1.5f, hi = -4.605170185988091f / 0.3f;
#pragma unroll
            for (int c = 0; c < 4; ++c) {
                const int ch = (col0 + c) & 511;
                const float adl = fabsf(lo + (hi - lo) * (float)ch / 511.f);
                bf16_t* fp = base + ((size_t)ord * 512 + ch) * (2 * L);
#pragma unroll
                for (int i = 0; i < 8; ++i) {
                    const int j = jb * 64 + 8 * wid + i; const float tj = (float)j / (float)(L - 1);
                    float v = acc[i][c] * __expf(-tj * adl);
                    if (dir == 0 && j == 0) v += skip[ord * 512 + ch];
                    if (!(dir == 1 && j == 0)) fp[dir == 0 ? (L - 1 - j) : (L - 1 + j)] = f2bf(v);
                }
            }
        }
    }
    __syncthreads();
}

__device__ __forceinline__ void row_phase(const Params& p, int mode, int l_ln, int which, int l_mod, int sidx, bool fin, int nrows_in = MTOT, int row_begin = 0, int blk_off = 0, int nblk_in = 0) {
    PH_PRO
    const int lane = tid_ & 63, wid = tid_ >> 6;
    float* H = (float*)(WS_ + WS_H); bf16_t* A = (bf16_t*)(WS_ + WS_A);
    const float* MOD = (const float*)(WS_ + WS_MOD);
    const float* lg = IN(6) + (l_ln * 3 + which) * 1024; const float* lb = IN(7) + (l_ln * 3 + which) * 1024;
    const int nrows = fin ? MLAT : nrows_in;
    constexpr int RU = 1;
    const int nblk = nblk_in ? nblk_in : gdim_;
    for (int rowb = row_begin + (bid_ - blk_off) * 8 + wid; rowb < nrows; rowb += nblk * 8 * RU) {
        float4 v[RU][4]; int rows[RU]; bool okr[RU];
#pragma unroll
        for (int u = 0; u < RU; ++u) {
            const int row = rowb + u * nblk * 8; okr[u] = row < nrows; rows[u] = okr[u] ? row : rowb;
            const float* src = mode ? H + (size_t)rows[u] * D : (rows[u] < MLAT ? IN(0) + (size_t)rows[u] * D : IN(2) + (size_t)(rows[u] - MLAT) * D);
#pragma unroll
            for (int i = 0; i < 4; ++i) v[u][i] = *(const float4*)(src + 4 * lane + 256 * i);
        }
#pragma unroll
        for (int u = 0; u < RU; ++u) {
            const int row = rows[u];
            if (mode) {
                float s = 0.f;
#pragma unroll
                for (int i = 0; i < 4; ++i) s += v[u][i].x + v[u][i].y + v[u][i].z + v[u][i].w;
                const float mu = wsum(s) * (1.f / 1024.f);
                float q = 0.f;
#pragma unroll
                for (int i = 0; i < 4; ++i) { v[u][i].x -= mu; v[u][i].y -= mu; v[u][i].z -= mu; v[u][i].w -= mu; q += v[u][i].x * v[u][i].x + v[u][i].y * v[u][i].y + v[u][i].z * v[u][i].z + v[u][i].w * v[u][i].w; }
                const float rstd = rsqrtf(wsum(q) * (1.f / 1024.f) + 1e-6f);
                if (lane == 0 && !fin && okr[u]) *(float2*)((float*)(WS_ + WS_STATS) + 2 * (size_t)row) = make_float2(mu, rstd);
#pragma unroll
                for (int i = 0; i < 4; ++i) {
                    const float4 g = *(const float4*)(lg + 4 * lane + 256 * i), b = *(const float4*)(lb + 4 * lane + 256 * i);
                    v[u][i].x = v[u][i].x * rstd * g.x + b.x; v[u][i].y = v[u][i].y * rstd * g.y + b.y; v[u][i].z = v[u][i].z * rstd * g.z + b.z; v[u][i].w = v[u][i].w * rstd * g.w + b.w;
                }
            }
            if (!okr[u]) continue;
            if (fin) {
#pragma unroll
                for (int i = 0; i < 4; ++i) *(float4*)(OUT_ + (size_t)row * D + 4 * lane + 256 * i) = v[u][i];
            } else {
                const int midx = row < MLAT ? (row >> 11) : 16;
                const float* mp = MOD + ((size_t)l_mod * 17 + midx) * 9216 + sidx * 1024;
#pragma unroll
                for (int i = 0; i < 4; ++i) {
                    const float4 sh = *(const float4*)(mp + 4 * lane + 256 * i), sc = *(const float4*)(mp + 1024 + 4 * lane + 256 * i);
                    uint2 o; o.x = pk2(v[u][i].x * (1.f + sc.x) + sh.x, v[u][i].y * (1.f + sc.y) + sh.y); o.y = pk2(v[u][i].z * (1.f + sc.z) + sh.z, v[u][i].w * (1.f + sc.w) + sh.w);
                    *(uint2*)(A + (size_t)row * D + 4 * lane + 256 * i) = o;
                }
            }
        }
    }
}
template <int L>
__device__ __forceinline__ void hyena_item(const Params& p, int e, int c, int segbase, const bf16_t* ft, unsigned char* smem) {
    PH_PRO
    constexpr int CPS = 2 * L + 16, UTS = L + 8, TPW = (L / 16) / 8;
    bf16_t* COP = (bf16_t*)smem;
    bf16_t* UT = COP + 8 * CPS;
    const int tid = tid_, lane = tid & 63, wid = tid >> 6;
    bf16_t* ZHT = (bf16_t*)(WS_ + WS_BIG);
    bf16_t* zv = ZHT + (size_t)c * MTOT + segbase;
    const bf16_t* zx1 = ZHT + (size_t)(512 + c) * MTOT + segbase;
    const bf16_t* zx2 = ZHT + (size_t)(1024 + c) * MTOT + segbase;
    const float* cw = IN(13) + e * 3 * 1536; const float* cbp = IN(14) + e * 1536;
    const float vw0 = cw[c], vw1 = cw[1536 + c], vw2 = cw[3072 + c], vb = cbp[c];
    const float aw0 = cw[512 + c], aw1 = cw[1536 + 512 + c], aw2 = cw[3072 + 512 + c], ab = cbp[512 + c];
    const float bw0 = cw[1024 + c], bw1 = cw[1536 + 1024 + c], bw2 = cw[3072 + 1024 + c], bb = cbp[1024 + c];
    auto conv4 = [&](const bf16_t* q, int t0, float w0, float w1, float w2, float bias, float (&y)[4]) {
        const uint2 mid = *(const uint2*)(q + t0);
        float zm = bf2f(q[t0 > 0 ? t0 - 1 : 0]); zm = t0 > 0 ? zm : 0.f;
        float zq = bf2f(q[t0 + 4 < L ? t0 + 4 : L - 1]); zq = t0 + 4 < L ? zq : 0.f;
        const float z0 = __uint_as_float(mid.x << 16), z1 = __uint_as_float(mid.x & 0xffff0000u), z2 = __uint_as_float(mid.y << 16), z3 = __uint_as_float(mid.y & 0xffff0000u);
        y[0] = zm * w0 + z0 * w1 + z1 * w2 + bias; y[1] = z0 * w0 + z1 * w1 + z2 * w2 + bias;
        y[2] = z1 * w0 + z2 * w1 + z3 * w2 + bias; y[3] = z2 * w0 + z3 * w1 + zq * w2 + bias;
    };
#pragma unroll 4
    for (int idx = tid; idx < 4 * L; idx += NTHR) {
        const int b = idx / (L / 4), s4 = (idx % (L / 4)) * 4;
        float y[4]; conv4(zv + b * L, s4, vw0, vw1, vw2, vb, y);
        uint2 o; o.x = pk2(y[0], y[1]); o.y = pk2(y[2], y[3]);
        *(uint2*)(UT + b * UTS + s4) = o;
    }
    const int r = lane & 15, g = lane >> 4, a = 7 - (r & 7);
    const bf16_t* cop_a = COP + a * CPS;
    f32x4 acc[TPW];
#pragma unroll 1
    for (int ord = 0; ord < 2; ++ord) {
        const bf16_t* fo = ft + ((size_t)ord * 512 + c) * (2 * L);
        for (int cidx = tid; cidx < (2 * L) / 8; cidx += NTHR) {
            const uint4 raw = *(const uint4*)(fo + 8 * cidx);
            unsigned short v[8] = {(unsigned short)(raw.x & 0xffffu), (unsigned short)(raw.x >> 16), (unsigned short)(raw.y & 0xffffu), (unsigned short)(raw.y >> 16),
                                   (unsigned short)(raw.z & 0xffffu), (unsigned short)(raw.z >> 16), (unsigned short)(raw.w & 0xffffu), (unsigned short)(raw.w >> 16)};
            if (cidx == (2 * L) / 8 - 1) v[7] = 0;
#pragma unroll
            for (int ca = 0; ca < 8; ++ca)
#pragma unroll
                for (int j = 0; j < 8; ++j) { const int x = 8 * cidx - ca + j; COP[ca * CPS + (x < 0 ? 0 : x)] = v[j]; }
        }
        __syncthreads();
#pragma unroll
        for (int i = 0; i < TPW; ++i) acc[i] = (f32x4){0.f, 0.f, 0.f, 0.f};
        if constexpr (TPW == 16) {
            const bf16_t* fbase = cop_a + (8 * g - r + L - 1 - a) - wid * 256;
            bf16x8 F[16];
#pragma unroll
            for (int dd = -15; dd <= 0; ++dd) F[dd & 15] = *(const bf16x8*)(fbase + 16 * dd);
#pragma unroll 1
            for (int S0 = 0; S0 < L / 32; S0 += 8) {
#pragma unroll
                for (int u = 0; u < 8; ++u) {
                    const int S = S0 + u;
                    if (S > 0) { F[(2 * u) & 15] = *(const bf16x8*)(fbase + 32 * S); F[(2 * u - 1) & 15] = *(const bf16x8*)(fbase + 32 * S - 16); }
                    const bf16x8 bfr = *(const bf16x8*)(UT + r * UTS + 32 * S + 8 * g);
#pragma unroll
                    for (int i = 0; i < 16; ++i) acc[i] = __builtin_amdgcn_mfma_f32_16x16x32_bf16(F[(2 * u - i) & 15], bfr, acc[i], 0, 0, 0);
                }
            }
        } else {
        for (int s0 = 0; s0 < L; s0 += 32) {
            const bf16x8 bfr = *(const bf16x8*)(UT + r * UTS + s0 + 8 * g);
#pragma unroll
            for (int i = 0; i < TPW; ++i) {
                const int t0 = (wid * TPW + i) * 16;
                const int n8 = s0 - t0 + 8 * g - r + L - 1 - a;
                const bf16x8 afr = *(const bf16x8*)(cop_a + n8);
                acc[i] = __builtin_amdgcn_mfma_f32_16x16x32_bf16(afr, bfr, acc[i], 0, 0, 0);
            }
        }
        }
        __syncthreads();
        int rl = r * L, tb0 = wid * TPW * 16 + 4 * g; asm volatile("" : "+v"(rl), "+v"(tb0));
        if (ord == 0) {
#pragma unroll
            for (int i = 0; i < TPW; ++i) {
                const int t0 = tb0 + i * 16;
                float y[4]; conv4(zx1 + rl, t0, aw0, aw1, aw2, ab, y);
                uint2 o; o.x = pk2(y[0] * acc[i][0], y[1] * acc[i][1]); o.y = pk2(y[2] * acc[i][2], y[3] * acc[i][3]);
                *(uint2*)(UT + r * UTS + t0) = o;
                if ((i & 3) == 3) __builtin_amdgcn_sched_barrier(0);
            }
        } else {
#pragma unroll
            for (int i = 0; i < TPW; ++i) {
                const int t0 = tb0 + i * 16;
                float y[4]; conv4(zx2 + rl, t0, bw0, bw1, bw2, bb, y);
                uint2 o; o.x = pk2(y[0] * acc[i][0], y[1] * acc[i][1]); o.y = pk2(y[2] * acc[i][2], y[3] * acc[i][3]);
                *(uint2*)(zv + rl + t0) = o;
                if ((i & 3) == 3) __builtin_amdgcn_sched_barrier(0);
            }
        }
    }
    __syncthreads();
}
__device__ __forceinline__ void hyena_phase(const Params& p, int e, unsigned char* smem) {
    PH_PRO
    const bf16_t* FT = (const bf16_t*)(WS_ + WS_FT) + (size_t)e * FT_E;
    for (int item = bid_; item < 1024; item += gdim_) {
        if (item < 512) hyena_item<2048>(p, e, item, 0, FT, smem);
        else hyena_item<256>(p, e, item - 512, MLAT, FT + FT_LAT, smem);
    }
}

__device__ __forceinline__ void rwkv_scan_phase(const Params& p, int e, unsigned char* smem) {
    PH_PRO
    const int chain = bid_; if (chain >= 256) return;
    const int d = chain >> 7, b = (chain >> 3) & 15, h = chain & 7;
    const int tid = tid_, lane = tid & 63, wid = tid >> 6;
    bf16_t* WUPT = (bf16_t*)smem;
    bf16_t* AUPT = WUPT + 4096;
    float* sBONp = (float*)(AUPT + 4096);
    float* sOP = (float*)smem + 8192;
    float* sR = sOP;
    float* sKK = sR + 4096;
    float* sW = sKK + 4096;
    float* sKD = sW + 4096;
    float* sKKA = sKD + 4096;
    float* sV = sKKA + 4096;
    float* sO = sV + 4096;
    bf16_t* TWb = (bf16_t*)sO;
    bf16_t* ADb = TWb + 4096;
    const bf16_t* ZR = (const bf16_t*)(WS_ + WS_BIG + BIG_ZR);
    bf16_t* ORW = (bf16_t*)(WS_ + WS_BIG + BIG_ORW) + (size_t)d * MTOT * 512;
    float* BON = (float*)(WS_ + WS_BON) + (size_t)d * MTOT * 8;
    const float* mu = IN(23) + e * 1920;
    const float* w0 = IN(24) + (e * 2 + d) * 512 + 64 * h;
    const float* a0 = IN(26) + (e * 2 + d) * 512 + 64 * h;
    const float* wup_g = IN(25) + (size_t)(e * 2 + d) * 64 * 512 + 64 * h;
    const float* aup_g = IN(27) + (size_t)(e * 2 + d) * 64 * 512 + 64 * h;
    const float kk_c = IN(29)[e * 512 + 64 * h + lane];
    const float mu_r = mu[64 * h + lane], mu_k = mu[512 + 64 * h + lane], mu_v = mu[1024 + 64 * h + lane], mu_w = mu[1536 + 64 * d + lane], mu_a = mu[1664 + 64 * d + lane];
    for (int idx = tid; idx < 4096; idx += NTHR) { const int j = idx >> 6, k = idx & 63; WUPT[k * 64 + j] = f2bf(wup_g[(size_t)j * 512 + k]); AUPT[k * 64 + j] = f2bf(aup_g[(size_t)j * 512 + k]); }
    const int r16 = lane & 15, g4 = lane >> 4, tr = wid & 3, tcb = 2 * (wid >> 2);
    float c_w0[2], c_a0[2], c_ka[2], c_rk[2];
#pragma unroll
    for (int jt = 0; jt < 2; ++jt) { const int kc = 16 * (tcb + jt) + r16; c_w0[jt] = w0[kc]; c_a0[jt] = a0[kc]; c_ka[jt] = IN(30)[e * 512 + 64 * h + kc]; c_rk[jt] = IN(31)[e * 512 + 64 * h + kc]; }
    typedef float f32x2 __attribute__((ext_vector_type(2)));
    f32x2 S2[4];
#pragma unroll
    for (int k = 0; k < 4; ++k) S2[k] = (f32x2){0.f, 0.f};
    __syncthreads();
    bf16_t pr_[10], pk_[10], pv_[10], pw_[10], pa_[10];
    auto issue = [&](int cidx) {
        const int seg = cidx >= 4; const int L = seg ? TL : TCX; const int rowbase = seg ? b * TL : MLAT + b * TCX; const int ch = seg ? cidx - 4 : cidx;
        const int tlo = d ? (L - 1 - (ch * 64 + 8 * wid + 7)) : (ch * 64 + 8 * wid);
#pragma unroll
        for (int q = 0; q < 10; ++q) {
            const int t = tlo - 1 + q; const int tc = t < 0 ? 0 : (t > L - 1 ? L - 1 : t);
            const bf16_t* zr = ZR + (size_t)(rowbase + tc) * 1920;
            pr_[q] = zr[64 * h + lane]; pk_[q] = zr[512 + 64 * h + lane]; pv_[q] = zr[1024 + 64 * h + lane]; pw_[q] = zr[1536 + 64 * d + lane]; pa_[q] = zr[1664 + 64 * d + lane];
        }
    };
    issue(0);
#pragma unroll 1
    for (int cidx = 0; cidx < 36; ++cidx) {
        {
            const int seg = cidx >= 4; const int L = seg ? TL : TCX; const int rowbase = seg ? b * TL : MLAT + b * TCX; const int ch = seg ? cidx - 4 : cidx;
            const int tlo = d ? (L - 1 - (ch * 64 + 8 * wid + 7)) : (ch * 64 + 8 * wid);
            {
                float zr_[10], zk_[10], zv_[10], zw_[10], za_[10];
#pragma unroll
                for (int q = 0; q < 10; ++q) {
                    const int t = tlo - 1 + q; const bool ok = (t >= 0) && (t < L);
                    const float a0 = bf2f(pr_[q]), a1 = bf2f(pk_[q]), a2 = bf2f(pv_[q]), a3 = bf2f(pw_[q]), a4 = bf2f(pa_[q]);
                    zr_[q] = ok ? a0 : 0.f; zk_[q] = ok ? a1 : 0.f; zv_[q] = ok ? a2 : 0.f; zw_[q] = ok ? a3 : 0.f; za_[q] = ok ? a4 : 0.f;
                }
#pragma unroll
                for (int sl = 0; sl < 8; ++sl) {
                    const int tau = 8 * wid + (d ? 7 - sl : sl);
#define ZS(arr, muv) (arr[sl + 1] + (muv) * (0.5f * (arr[sl] + arr[sl + 2]) - arr[sl + 1]))
                    const float rr = ZS(zr_, mu_r), kr = ZS(zk_, mu_k), vv = ZS(zv_, mu_v), wd = ZS(zw_, mu_w), ad = ZS(za_, mu_a);
#undef ZS
                    const float kkv = kr * kk_c; const float n2 = wsum(kkv * kkv);
                    const float kk = kkv * __builtin_amdgcn_rcpf(fmaxf(__builtin_amdgcn_sqrtf(n2), 1e-12f));
                    sOP[tau * 320 + 0 + lane] = rr; sOP[tau * 320 + 64 + lane] = kk; sV[tau * 64 + lane] = vv; sOP[tau * 320 + 192 + lane] = kr;
                    TWb[tau * 64 + lane] = f2bf(tanh_(wd)); ADb[tau * 64 + lane] = f2bf(ad);
                }
            }
            __syncthreads();
            {
                const bf16x8 aw0 = *(const bf16x8*)(TWb + (16 * tr + r16) * 64 + 8 * g4), aw1 = *(const bf16x8*)(TWb + (16 * tr + r16) * 64 + 32 + 8 * g4);
                const bf16x8 aa0 = *(const bf16x8*)(ADb + (16 * tr + r16) * 64 + 8 * g4), aa1 = *(const bf16x8*)(ADb + (16 * tr + r16) * 64 + 32 + 8 * g4);
                float bonp[4] = {0.f, 0.f, 0.f, 0.f};
#pragma unroll
                for (int jt = 0; jt < 2; ++jt) {
                    const int kc = 16 * (tcb + jt) + r16;
                    const bf16x8 bw0 = *(const bf16x8*)(WUPT + kc * 64 + 8 * g4), bw1 = *(const bf16x8*)(WUPT + kc * 64 + 32 + 8 * g4);
                    const bf16x8 ba0 = *(const bf16x8*)(AUPT + kc * 64 + 8 * g4), ba1 = *(const bf16x8*)(AUPT + kc * 64 + 32 + 8 * g4);
                    f32x4 cw = (f32x4){0.f, 0.f, 0.f, 0.f}, ca = (f32x4){0.f, 0.f, 0.f, 0.f};
                    cw = __builtin_amdgcn_mfma_f32_16x16x32_bf16(aw0, bw0, cw, 0, 0, 0); cw = __builtin_amdgcn_mfma_f32_16x16x32_bf16(aw1, bw1, cw, 0, 0, 0);
                    ca = __builtin_amdgcn_mfma_f32_16x16x32_bf16(aa0, ba0, ca, 0, 0, 0); ca = __builtin_amdgcn_mfma_f32_16x16x32_bf16(aa1, ba1, ca, 0, 0, 0);
#pragma unroll
                    for (int q = 0; q < 4; ++q) {
                        const int tau = 16 * tr + 4 * g4 + q;
                        const float wlog = -softplus_(-(c_w0[jt] + cw[q])) - 0.5f;
                        const float dec = __expf(-__expf(wlog));
                        const float av = sigm(c_a0[jt] + ca[q]);
                        const float kd = sOP[tau * 320 + 192 + kc] * (1.f + (av - 1.f) * c_ka[jt]);
                        bonp[q] += sOP[tau * 320 + 0 + kc] * kd * c_rk[jt];
                        sOP[tau * 320 + 128 + kc] = dec; sOP[tau * 320 + 192 + kc] = kd; sOP[tau * 320 + 256 + kc] = sOP[tau * 320 + 64 + kc] * av;
                    }
                }
#pragma unroll
                for (int q = 0; q < 4; ++q) {
                    float v = bonp[q];
                    v += DPPF(v, 0xB1); v += DPPF(v, 0x4E); v += DPPF(v, 0x141); v += DPPF(v, 0x140);
                    if (r16 == 0) sBONp[(16 * tr + 4 * g4 + q) * 2 + (wid >> 2)] = v;
                }
            }
            __syncthreads();
            if (tid < 64) { const int pp = ch * 64 + tid; const int t = d ? (L - 1 - pp) : pp; BON[(size_t)(rowbase + t) * 8 + h] = sBONp[2 * tid] + sBONp[2 * tid + 1]; }
            if (cidx + 1 < 36) issue(cidx + 1);
            {
                const int vrow = 8 * wid + (lane >> 3), kq = lane & 7;
                const float* pb = sOP + 8 * kq;
                constexpr int O_R = 0, O_KK = 64, O_W = 128, O_KD = 192, O_KA = 256;
                struct Ops { float4 kk0, kk1, w0, w1, ka0, ka1, kd0, kd1, r0, r1; float vv; };
                auto ldops = [&](Ops& o, int tau) {
                    const float* q = pb + tau * 320;
                    o.kk0 = *(const float4*)(q + O_KK); o.kk1 = *(const float4*)(q + O_KK + 4); o.w0 = *(const float4*)(q + O_W); o.w1 = *(const float4*)(q + O_W + 4);
                    o.ka0 = *(const float4*)(q + O_KA); o.ka1 = *(const float4*)(q + O_KA + 4); o.kd0 = *(const float4*)(q + O_KD); o.kd1 = *(const float4*)(q + O_KD + 4);
                    o.r0 = *(const float4*)(q + O_R); o.r1 = *(const float4*)(q + O_R + 4); o.vv = sV[tau * 64 + vrow];
                };
                auto step = [&](const Ops& o, int tau) {
                    const f32x2 kk[4] = {{o.kk0.x, o.kk0.y}, {o.kk0.z, o.kk0.w}, {o.kk1.x, o.kk1.y}, {o.kk1.z, o.kk1.w}};
                    const f32x2 w[4] = {{o.w0.x, o.w0.y}, {o.w0.z, o.w0.w}, {o.w1.x, o.w1.y}, {o.w1.z, o.w1.w}};
                    const f32x2 ka[4] = {{o.ka0.x, o.ka0.y}, {o.ka0.z, o.ka0.w}, {o.ka1.x, o.ka1.y}, {o.ka1.z, o.ka1.w}};
                    const f32x2 kd[4] = {{o.kd0.x, o.kd0.y}, {o.kd0.z, o.kd0.w}, {o.kd1.x, o.kd1.y}, {o.kd1.z, o.kd1.w}};
                    const f32x2 rr[4] = {{o.r0.x, o.r0.y}, {o.r0.z, o.r0.w}, {o.r1.x, o.r1.y}, {o.r1.z, o.r1.w}};
                    f32x2 da = S2[0] * kk[0] + S2[1] * kk[1]; f32x2 db = S2[2] * kk[2] + S2[3] * kk[3]; da = da + db;
                    float dt = da.x + da.y;
                    dt += DPPF(dt, 0xB1); dt += DPPF(dt, 0x4E); dt += DPPF(dt, 0x141);
                    const f32x2 sa2 = {-dt, -dt}; const f32x2 vv2 = {o.vv, o.vv};
#pragma unroll
                    for (int q = 0; q < 4; ++q) S2[q] = S2[q] * w[q] + (sa2 * ka[q] + vv2 * kd[q]);
                    f32x2 oa = S2[0] * rr[0] + S2[1] * rr[1]; f32x2 ob = S2[2] * rr[2] + S2[3] * rr[3]; oa = oa + ob;
                    float ot = oa.x + oa.y;
                    ot += DPPF(ot, 0xB1); ot += DPPF(ot, 0x4E); ot += DPPF(ot, 0x141);
                    if (kq == 0) sO[tau * 64 + vrow] = ot;
                };
                Ops oa_, ob_;
                ldops(oa_, 0);
#pragma unroll 1
                for (int tau = 0; tau < 64; tau += 2) {
                    ldops(ob_, tau + 1);
                    step(oa_, tau);
                    ldops(oa_, tau + 2 < 64 ? tau + 2 : 63);
                    step(ob_, tau + 1);
                }
            }
            __syncthreads();
#pragma unroll
            for (int i = 0; i < 8; ++i) {
                const int tau = wid + 8 * i; const int pp = ch * 64 + tau; const int t = d ? (L - 1 - pp) : pp;
                ORW[(size_t)(rowbase + t) * 512 + 64 * h + lane] = f2bf(sO[tau * 64 + lane]);
            }
            __syncthreads();
        }
    }
}

__device__ __forceinline__ void even_readout_phase(const Params& p, int e, unsigned char* smem) {
    PH_PRO
    const int tid = tid_, lane = tid & 63, wid = __builtin_amdgcn_readfirstlane(tid >> 6);
    bf16_t* SGb = (bf16_t*)smem;
    float* GG = (float*)(SGb + 64 * 128);
    bf16_t* GUT = (bf16_t*)(GG + 64 * 64);
    bf16_t* TT = GUT + 64 * 128;
    const int r16 = lane & 15, g4 = lane >> 4, tr = wid & 3, tcb = 2 * (wid >> 2);
    const bf16_t* ZR = (const bf16_t*)(WS_ + WS_BIG + BIG_ZR);
    const bf16_t* ORW = (const bf16_t*)(WS_ + WS_BIG + BIG_ORW);
    const bf16_t* YT = (const bf16_t*)(WS_ + WS_BIG);
    const float* BON = (const float*)(WS_ + WS_BON);
    bf16_t* YM = (bf16_t*)(WS_ + WS_A);
    const float* mu = IN(23) + e * 1920;
    const int h = bid_ & 7;
    {
        const float* gup = IN(28) + (size_t)e * 128 * 512 + 64 * h;
        for (int idx = tid; idx < 128 * 64; idx += NTHR) { const int j = idx >> 6, k = idx & 63; GUT[k * 128 + j] = f2bf(gup[(size_t)j * 512 + k]); }
    }
    const float gng = IN(32)[e * 512 + 64 * h + lane], gnb = IN(33)[e * 512 + 64 * h + lane], muv = mu[1024 + 64 * h + lane];
    for (int item = bid_; item < 4608; item += gdim_) {
        const int tb = item >> 3; const int row0 = tb * 64;
        const int hh = item & 7;
        const int L = row0 < MLAT ? TL : TCX; const int t0 = row0 < MLAT ? (row0 & (TL - 1)) : ((row0 - MLAT) & (TCX - 1));
        __syncthreads();
        if (hh != h) {
            const float* gup = IN(28) + (size_t)e * 128 * 512 + 64 * hh;
            for (int idx = tid; idx < 128 * 64; idx += NTHR) { const int j = idx >> 6, k = idx & 63; GUT[k * 128 + j] = f2bf(gup[(size_t)j * 512 + k]); }
        }
        {
            const int j = tid & 127, tq = wid >> 1; const float muj = mu[1792 + j];
            float zz[18];
#pragma unroll
            for (int q = 0; q < 18; ++q) {
                const int t = t0 + 16 * tq - 1 + q; const bool ok = (t >= 0) && (t < L); const int tc = t < 0 ? 0 : (t > L - 1 ? L - 1 : t);
                const float a = bf2f(ZR[(size_t)(row0 - t0 + tc) * 1920 + 1792 + j]); zz[q] = ok ? a : 0.f;
            }
#pragma unroll
            for (int i = 0; i < 16; ++i) SGb[(16 * tq + i) * 128 + j] = f2bf(sigm(zz[i + 1] + muj * (0.5f * (zz[i] + zz[i + 2]) - zz[i + 1])));
        }
        float ov[8], vv[8], bon[8];
        const float gngh = hh == h ? gng : IN(32)[e * 512 + 64 * hh + lane], gnbh = hh == h ? gnb : IN(33)[e * 512 + 64 * hh + lane], muvh = hh == h ? muv : mu[1024 + 64 * hh + lane];
        {
            float zv[10];
#pragma unroll
            for (int q = 0; q < 10; ++q) {
                const int t = t0 + 8 * wid - 1 + q; const bool ok = (t >= 0) && (t < L); const int tc = t < 0 ? 0 : (t > L - 1 ? L - 1 : t);
                const float a = bf2f(ZR[(size_t)(row0 - t0 + tc) * 1920 + 1024 + 64 * hh + lane]); zv[q] = ok ? a : 0.f;
            }
#pragma unroll
            for (int i = 0; i < 8; ++i) {
                const int row = row0 + 8 * wid + i;
                ov[i] = bf2f(ORW[(size_t)row * 512 + 64 * hh + lane]) + bf2f(ORW[(size_t)(MTOT + row) * 512 + 64 * hh + lane]);
                vv[i] = zv[i + 1] + muvh * (0.5f * (zv[i] + zv[i + 2]) - zv[i + 1]);
                bon[i] = BON[(size_t)row * 8 + hh] + BON[(size_t)(MTOT + row) * 8 + hh];
            }
        }
        __syncthreads();
        {
            f32x4 c0 = (f32x4){0.f, 0.f, 0.f, 0.f}, c1 = (f32x4){0.f, 0.f, 0.f, 0.f};
#pragma unroll
            for (int ks = 0; ks < 4; ++ks) {
                const bf16x8 af = *(const bf16x8*)(SGb + (16 * tr + r16) * 128 + 32 * ks + 8 * g4);
                const bf16x8 b0 = *(const bf16x8*)(GUT + (16 * tcb + r16) * 128 + 32 * ks + 8 * g4), b1 = *(const bf16x8*)(GUT + (16 * (tcb + 1) + r16) * 128 + 32 * ks + 8 * g4);
                c0 = __builtin_amdgcn_mfma_f32_16x16x32_bf16(af, b0, c0, 0, 0, 0); c1 = __builtin_amdgcn_mfma_f32_16x16x32_bf16(af, b1, c1, 0, 0, 0);
            }
#pragma unroll
            for (int q = 0; q < 4; ++q) { GG[(16 * tr + 4 * g4 + q) * 64 + 16 * tcb + r16] = c0[q]; GG[(16 * tr + 4 * g4 + q) * 64 + 16 * (tcb + 1) + r16] = c1[q]; }
        }
        __syncthreads();
        float gg[8];
#pragma unroll
        for (int i = 0; i < 8; ++i) gg[i] = GG[(8 * wid + i) * 64 + lane];
#pragma unroll
        for (int i = 0; i < 8; ++i) {
            const int row = row0 + 8 * wid + i;
            const float mean = wsum(ov[i]) * (1.f / 64.f); const float dd = ov[i] - mean; const float var = wsum(dd * dd) * (1.f / 64.f);
            const float y = dd * rsqrtf(var + 64e-5f) * gngh + gnbh;
            YM[(size_t)row * D + 512 + 64 * hh + lane] = f2bf((y + bon[i] * vv[i]) * gg[i]);
        }
    }
    __syncthreads();
    for (int it = bid_; it < 4608; it += gdim_) {
        const int tb = it >> 3, cb = it & 7; const int row0 = tb * 64;
#pragma unroll
        for (int i = 0; i < 8; ++i) { const int cc = wid + 8 * i; TT[cc * 72 + lane] = YT[(size_t)(cb * 64 + cc) * MTOT + row0 + lane]; }
        __syncthreads();
#pragma unroll
        for (int i = 0; i < 8; ++i) { const int tau = wid + 8 * i; YM[(size_t)(row0 + tau) * D + cb * 64 + lane] = TT[lane * 72 + tau]; }
        __syncthreads();
    }
}
__device__ __forceinline__ void gla_phase(const Params& p, int o_idx, unsigned char* smem) {
    PH_PRO
    const int item = bid_; if (item >= 256) return;
    const int b = item >> 4, h = (item >> 2) & 3, d = (item >> 1) & 1, dvh = item & 1;
    const int tid = tid_, lane = tid & 63, wid = __builtin_amdgcn_readfirstlane(tid >> 6), r = lane & 15, g = lane >> 4;
    constexpr int QST = 136, SST = 68;
    bf16_t* QS = (bf16_t*)smem;
    bf16_t* KS = QS + 64 * QST;
    bf16_t* ST = KS + 64 * QST;
    bf16_t* KST = ST + 128 * QST;
    bf16_t* VT = KST + 128 * SST;
    bf16_t* PP = VT + 128 * SST;
    float* GD = (float*)(PP + 64 * SST);
    float* DL = GD + 64 * 16;
    float* E1 = DL + 128;
    float* E2 = E1 + 128;
    float* TOT = E2 + 128;
    float* BR = TOT + 512;
    int* ROWS = (int*)(BR + 128);
    const bf16_t* Z = (const bf16_t*)(WS_ + WS_BIG);
    bf16_t* OG = d ? (bf16_t*)OUT_ : (bf16_t*)(WS_ + WS_BIG + BIG_OGL);
    const float qscale = 0.08838834764831845f;
    const int k = tid & 127, tq = wid >> 1, tr = wid >> 1, tcb = 4 * (wid & 1);
    auto rowof = [&](int c, int tau) -> int {
        const int seg = c >= 4; const int L = seg ? TL : TCX; const int pf = (seg ? c - 4 : c) * 64 + tau; const int pp = d ? (L - 1 - pf) : pf;
        return seg ? (b * TL + (pp & 31) * 64 + (pp >> 5)) : (MLAT + b * TCX + pp);
    };
    bf16_t nq[16], nk[16], nv[16], ngd[2];
    auto prefetch = [&](int c) {
        const long r0 = rowof(c, 16 * tq); const long st = (long)(c >= 4 ? 64 : 1) * (d ? -1 : 1) * 3104;
        const bf16_t* zb = Z + r0 * 3104 + 128 * h + k;
#pragma unroll
        for (int i = 0; i < 16; ++i) { const bf16_t* zr = zb + i * st; nq[i] = zr[0]; nk[i] = zr[512]; nv[i] = zr[1024 + 128 * h + 128 * dvh]; }
#pragma unroll
        for (int i = 0; i < 2; ++i) { const int idx = tid + NTHR * i; ngd[i] = Z[(size_t)rowof(c, idx >> 4) * 3104 + 2048 + 16 * d + (idx & 15)]; }
    };
    f32x4 Sacc[8];
#pragma unroll
    for (int j = 0; j < 8; ++j) Sacc[j] = (f32x4){0.f, 0.f, 0.f, 0.f};
    float gu[16];
    {
        const float* gup_g = IN(36) + (size_t)(o_idx * 2 + d) * 16 * 512 + 128 * h + k;
#pragma unroll
        for (int j = 0; j < 16; ++j) gu[j] = gup_g[(size_t)j * 512];
    }
    const float gbv = IN(37)[(o_idx * 2 + d) * 512 + 128 * h + k];
    prefetch(0);
#pragma unroll 1
    for (int c = 0; c < 36; ++c) {
        __syncthreads();
        if (tid < 64) ROWS[tid] = rowof(c, tid);
#pragma unroll
        for (int i = 0; i < 2; ++i) GD[tid + NTHR * i] = bf2f(ngd[i]);
#pragma unroll
        for (int i = 0; i < 16; ++i) VT[k * SST + 16 * tq + i] = nv[i];
        bf16_t cq[16], ck[16];
#pragma unroll
        for (int i = 0; i < 16; ++i) { cq[i] = nq[i]; ck[i] = nk[i]; }
        __syncthreads();
        if (c + 1 < 36) prefetch(c + 1);
        float bl[16]; float run = 0.f;
#pragma unroll
        for (int i = 0; i < 16; ++i) {
            const float4* gd4 = (const float4*)(GD + (16 * tq + i) * 16);
            const float4 g0 = gd4[0], g1 = gd4[1], g2 = gd4[2], g3 = gd4[3];
            float a = gbv + g0.x * gu[0] + g0.y * gu[1] + g0.z * gu[2] + g0.w * gu[3] + g1.x * gu[4] + g1.y * gu[5] + g1.z * gu[6] + g1.w * gu[7]
                    + g2.x * gu[8] + g2.y * gu[9] + g2.z * gu[10] + g2.w * gu[11] + g3.x * gu[12] + g3.y * gu[13] + g3.z * gu[14] + g3.w * gu[15];
            run -= __logf(1.f + __expf(-a)) * (1.f / 16.f);
            bl[i] = run;
        }
        TOT[tq * 128 + k] = run; if (tq == 2) BR[k] = bl[0];
        __syncthreads();
        {
            const float t0 = TOT[k], t1 = TOT[128 + k], t2 = TOT[256 + k], t3 = TOT[384 + k];
            const float off = tq == 0 ? 0.f : (tq == 1 ? t0 : (tq == 2 ? t0 + t1 : t0 + t1 + t2));
            const float bref = BR[k] + t0 + t1, blast = t0 + t1 + t2 + t3;
            if (tq == 0) { DL[k] = __expf(blast); E1[k] = __expf(bref); E2[k] = __expf(blast - bref); }
#pragma unroll
            for (int i = 0; i < 16; ++i) {
                const int tau = 16 * tq + i;
                const float bb = bl[i] + off; const float ef = __expf(bb - bref);
                const bf16_t ksv = f2bf(bf2f(ck[i]) * __builtin_amdgcn_rcpf(ef));
                QS[tau * QST + k] = f2bf(bf2f(cq[i]) * qscale * ef); KS[tau * QST + k] = ksv; KST[k * SST + tau] = ksv;
            }
        }
        __syncthreads();
        {
            float e1v[4];
#pragma unroll
            for (int q = 0; q < 4; ++q) e1v[q] = E1[16 * wid + 4 * g + q];
#pragma unroll
            for (int j = 0; j < 8; ++j) {
                uint2 o; o.x = pk2(Sacc[j][0] * e1v[0], Sacc[j][1] * e1v[1]); o.y = pk2(Sacc[j][2] * e1v[2], Sacc[j][3] * e1v[3]);
                *(uint2*)(ST + (16 * j + r) * QST + 16 * wid + 4 * g) = o;
            }
        }
        f32x4 sc[2];
#pragma unroll
        for (int j = 0; j < 2; ++j) sc[j] = (f32x4){0.f, 0.f, 0.f, 0.f};
#pragma unroll
        for (int ks = 0; ks < 4; ++ks) {
            const bf16x8 af = *(const bf16x8*)(QS + (16 * tr + r) * QST + 32 * ks + 8 * g);
#pragma unroll
            for (int j = 0; j < 2; ++j) {
                const bf16x8 bfr = *(const bf16x8*)(KS + (16 * (2 * (wid & 1) + j) + r) * QST + 32 * ks + 8 * g);
                sc[j] = __builtin_amdgcn_mfma_f32_16x16x32_bf16(af, bfr, sc[j], 0, 0, 0);
            }
        }
#pragma unroll
        for (int j = 0; j < 2; ++j) {
            const int sidx = 16 * (2 * (wid & 1) + j) + r;
#pragma unroll
            for (int q = 0; q < 4; ++q) { const int ci = 16 * tr + 4 * g + q; PP[ci * SST + sidx] = f2bf(sidx <= ci ? sc[j][q] : 0.f); }
        }
        __syncthreads();
        f32x4 oc[4];
#pragma unroll
        for (int j = 0; j < 4; ++j) oc[j] = (f32x4){0.f, 0.f, 0.f, 0.f};
#pragma unroll
        for (int ks = 0; ks < 2; ++ks) {
            const bf16x8 af = ld8(PP + (16 * tr + r) * SST + 32 * ks + 8 * g);
#pragma unroll
            for (int j = 0; j < 4; ++j) {
                const bf16x8 bfr = ld8(VT + (16 * (tcb + j) + r) * SST + 32 * ks + 8 * g);
                oc[j] = __builtin_amdgcn_mfma_f32_16x16x32_bf16(af, bfr, oc[j], 0, 0, 0);
            }
        }
#pragma unroll
        for (int ks = 0; ks < 4; ++ks) {
            const bf16x8 af = *(const bf16x8*)(QS + (16 * tr + r) * QST + 32 * ks + 8 * g);
#pragma unroll
            for (int j = 0; j < 4; ++j) {
                const bf16x8 bfr = *(const bf16x8*)(ST + (16 * (tcb + j) + r) * QST + 32 * ks + 8 * g);
                oc[j] = __builtin_amdgcn_mfma_f32_16x16x32_bf16(af, bfr, oc[j], 0, 0, 0);
            }
        }
#pragma unroll
        for (int j = 0; j < 4; ++j) {
            const int dv = 16 * (tcb + j) + r;
#pragma unroll
            for (int q = 0; q < 4; ++q) OG[(size_t)ROWS[16 * tr + 4 * g + q] * D + 256 * h + 128 * dvh + dv] = f2bf(oc[j][q]);
        }
        {
            f32x4 kv[8];
#pragma unroll
            for (int j = 0; j < 8; ++j) kv[j] = (f32x4){0.f, 0.f, 0.f, 0.f};
#pragma unroll
            for (int ks = 0; ks < 2; ++ks) {
                const bf16x8 af = ld8(KST + (16 * wid + r) * SST + 32 * ks + 8 * g);
#pragma unroll
                for (int j = 0; j < 8; ++j) {
                    const bf16x8 bfr = ld8(VT + (16 * j + r) * SST + 32 * ks + 8 * g);
                    kv[j] = __builtin_amdgcn_mfma_f32_16x16x32_bf16(af, bfr, kv[j], 0, 0, 0);
                }
            }
            float dl[4], e2[4];
#pragma unroll
            for (int q = 0; q < 4; ++q) { dl[q] = DL[16 * wid + 4 * g + q]; e2[q] = E2[16 * wid + 4 * g + q]; }
#pragma unroll
            for (int j = 0; j < 8; ++j)
#pragma unroll
                for (int q = 0; q < 4; ++q) Sacc[j][q] = Sacc[j][q] * dl[q] + e2[q] * kv[j][q];
        }
    }
    __syncthreads();
}

__device__ __forceinline__ void odd_readout_phase(const Params& p, int o_idx) {
    PH_PRO
    const int lane = tid_ & 63, wid = tid_ >> 6;
    const bf16_t* Z = (const bf16_t*)(WS_ + WS_BIG);
    const bf16_t* OGL = (const bf16_t*)(WS_ + WS_BIG + BIG_OGL);
    const bf16_t* OGB = (const bf16_t*)OUT_;
    bf16_t* YM = (bf16_t*)(WS_ + WS_A);
    const float4 ng = *(const float4*)(IN(38) + o_idx * 256 + 4 * lane);
    for (int row = bid_ * 8 + wid; row < MTOT; row += gdim_ * 8) {
        uint2 ovs[4], ows[4], gvs[4];
#pragma unroll
        for (int hh = 0; hh < 4; ++hh) {
            ovs[hh] = *(const uint2*)(OGL + (size_t)row * D + 256 * hh + 4 * lane);
            ows[hh] = *(const uint2*)(OGB + (size_t)row * D + 256 * hh + 4 * lane);
            gvs[hh] = *(const uint2*)(Z + (size_t)row * 3104 + 2080 + 256 * hh + 4 * lane);
        }
#pragma unroll
        for (int hh = 0; hh < 4; ++hh) {
            const uint2 ov = ovs[hh], ow = ows[hh], gv = gvs[hh];
            const float o0 = __uint_as_float(ov.x << 16) + __uint_as_float(ow.x << 16), o1 = __uint_as_float(ov.x & 0xffff0000u) + __uint_as_float(ow.x & 0xffff0000u), o2 = __uint_as_float(ov.y << 16) + __uint_as_float(ow.y << 16), o3 = __uint_as_float(ov.y & 0xffff0000u) + __uint_as_float(ow.y & 0xffff0000u);
            const float g0 = __uint_as_float(gv.x << 16), g1 = __uint_as_float(gv.x & 0xffff0000u), g2 = __uint_as_float(gv.y << 16), g3 = __uint_as_float(gv.y & 0xffff0000u);
            const float ms = wsum(o0 * o0 + o1 * o1 + o2 * o2 + o3 * o3) * (1.f / 256.f);
            const float rs = rsqrtf(ms + 1e-5f);
            uint2 y; y.x = pk2(o0 * rs * ng.x * silu_(g0), o1 * rs * ng.y * silu_(g1)); y.y = pk2(o2 * rs * ng.z * silu_(g2), o3 * rs * ng.w * silu_(g3));
            *(uint2*)(YM + (size_t)row * D + 256 * hh + 4 * lane) = y;
        }
    }
}

#ifndef REP_UP
#define REP_UP 1
#endif
#ifndef REP_SCAN
#define REP_SCAN 1
#endif
#ifndef REP_GLA
#define REP_GLA 1
#endif
#ifndef REP_HY
#define REP_HY 1
#endif
#define REPEAT(n) for (int rep_ = 0, nrep_ = ({ int t_ = (n); asm volatile("" : "+s"(t_)); t_; }); rep_ < nrep_; ++rep_)
#ifndef REP_LN
#define REP_LN 1
#endif
#ifndef REP_MISC
#define REP_MISC 1
#endif
#ifndef REP_SYNC
#define REP_SYNC 1
#endif
#define GSYNC() do { for (int s_ = 0; s_ < REP_SYNC; ++s_) { XcdBarrier xb_; xb_.bar = (unsigned*)IN(40); xb_.x = xb_xcc_id(); xb_.st = (volatile XB_LAS unsigned*)(smem_g + TBL_OFF + 448); xcd_barrier(xb_); } } while (0)
#define LAUNDER() do { bid_ = blockIdx.x; asm volatile("" : "+s"(bid_)); gdim_ = gridDim.x; asm volatile("" : "+s"(gdim_)); } while (0)
__global__ void __launch_bounds__(NTHR, 2) mega(Params p) {
    unsigned char* smem = smem_g;
    cg::grid_group grid = cg::this_grid();
    int bid_, gdim_; LAUNDER();
    if (threadIdx.x == 0) {
        const float** tb = (const float**)(smem_g + TBL_OFF);
#pragma unroll
        for (int i = 0; i < 41; ++i) tb[i] = p.in[i];
        *(uint4*)(smem_g + TBL_OFF + 448) = make_uint4(0u, 0u, 0u, 0u);
    }
    unsigned* bar_ = (unsigned*)p.in[40];
    if (blockIdx.x == 0) for (int i = threadIdx.x; i < XCD_BAR_WORDS; i += NTHR) bar_[i] = 0u;
    __syncthreads();
    grid.sync();
    (void)xcd_barrier_post(bar_, (volatile XB_LAS unsigned*)(smem_g + TBL_OFF + 448));
    REPEAT(REP_MISC) {
    phase_mod(p, smem);
    __syncthreads();
    conv_weights(p, 0, smem);
    filt_gen(p, smem);
    GSYNC();
    }
    row_phase(p, 0, 0, 0, 0, 0, false);
    GSYNC();
#pragma unroll 1
    for (int l = 0; l < 4; ++l) {
#pragma unroll 1
        for (int f = 0; f < 2; ++f) {
            if (f == 1) {
                if (!(l & 1)) {
                    const int e = l >> 1;
                    REPEAT(REP_HY) {
                    LAUNDER();
                    { EpiStore E; E.O = (bf16_t*)(WS_ + WS_BIG); E.ldc = MTOT; E.nvalid = MTOT; run_gemm(smem, (const bf16_t*)(WS_ + WS_WIN), (const bf16_t*)(WS_ + WS_A), 1536, MTOT, 1024, E, bid_, gdim_); }
                    LAUNDER();
                    { EpiStore E; E.O = (bf16_t*)(WS_ + WS_BIG + BIG_ZR); E.ldc = 1920; E.nvalid = 1920; run_gemm(smem, (const bf16_t*)(WS_ + WS_A), (const bf16_t*)(WS_ + WS_WIN) + (size_t)1536 * 1024, MTOT, 2048, 1024, E, bid_, gdim_); }
                    GSYNC();
                    hyena_phase(p, e, smem);
                    if (rep_ + 1 < nrep_) GSYNC();
                    }
                    REPEAT(REP_SCAN) rwkv_scan_phase(p, e, smem);
                    GSYNC();
                    REPEAT(REP_MISC) even_readout_phase(p, e, smem);
                    GSYNC();
                } else {
                    const int o = l >> 1;
                    LAUNDER();
                    { EpiStore E; E.O = (bf16_t*)(WS_ + WS_BIG); E.ldc = 3104; E.nvalid = 3104; run_gemm(smem, (const bf16_t*)(WS_ + WS_A), (const bf16_t*)(WS_ + WS_WIN), MTOT, 3328, 1024, E, bid_, gdim_); }
                    GSYNC();
                    REPEAT(REP_GLA) gla_phase(p, o, smem);
                    GSYNC();
                    REPEAT(REP_MISC) odd_readout_phase(p, o);
                    GSYNC();
                }
                LAUNDER();
                { EpiResid E; E.gate_off = l * 17 * 9216 + 5 * 1024; E.wgt = 1.0f; E.ln_idx = l * 3 + 0; E.pm_off = 0; run_gemm(smem, (const bf16_t*)(WS_ + WS_A), (const bf16_t*)(WS_ + WS_WOUT), l == 3 ? MLAT : MTOT, 1024, 1024, E, bid_, gdim_); }
                GSYNC();
                REPEAT(REP_LN) row_phase(p, 1, l, 1, l, 6, false, l == 3 ? MLAT : MTOT);
                GSYNC();
            }
            const bool latonly = (l == 3 && f == 1);
#pragma unroll 1
            for (int s = 0; s < 4; ++s) {
                if (s == 3 && latonly) break;
                LAUNDER();
                if ((s == 1) || (s == 2 && !latonly && bid_ < 64)) {
                    const int part = s - 1;
                    EpiResid E; E.gate_off = l * 17 * 9216 + (f ? 8 : 2) * 1024; E.wgt = 0.5f; E.ln_idx = f ? (l * 3 + 1) : (l * 3 - 1); E.pm_off = part ? 128 : 0;
                    run_gemm(smem, (const bf16_t*)(WS_ + WS_BIG) + (size_t)part * MLAT * FF, (const bf16_t*)(WS_ + WS_WDN) + (size_t)f * 1024 * FF, part ? MCTX : MLAT, 1024, FF, E, bid_, part ? 64 : gdim_);
                }
                if (s == 0 || (s == 1 && !latonly)) {
                    LAUNDER();
                    EpiSwiglu E; E.G = (bf16_t*)(WS_ + WS_BIG); E.pm_off = s ? 128 : 0;
                    run_gemm(smem, (const bf16_t*)(WS_ + WS_A) + (size_t)s * MLAT * 1024, (const bf16_t*)(WS_ + WS_WUP) + (size_t)f * 5632 * 1024, s ? MCTX : MLAT, 5632, 1024, E, bid_, gdim_);
                }
                if (s == 2) {
                    if (latonly) row_phase(p, 1, l, 2, 0, 0, true);
                    else if (bid_ >= 64) { if (f == 0) row_phase(p, 1, l, 0, l, 3, false, MLAT, 0, 64, gdim_ - 64); else row_phase(p, 1, l, 2, l + 1, 0, false, MLAT, 0, 64, gdim_ - 64); }
                }
                if (s == 3) {
                    if (f == 0) row_phase(p, 1, l, 0, l, 3, false, MTOT, MLAT);
                    else { if (l < 3) { row_phase(p, 1, l, 2, l + 1, 0, false, MTOT, MLAT); conv_weights(p, l + 1, smem); } else row_phase(p, 1, l, 2, 0, 0, false, MTOT, MLAT); }
                }
                GSYNC();
            }
        }
    }
}

extern "C" void kernel_launch(void* const* d_in, const int* in_sizes, int n_in, void* d_out, int out_size, void* d_ws, size_t ws_size, hipStream_t stream) {
    static int grid = 0;
    if (grid == 0) {
        if (n_in != 39 || ws_size < WS_END) { fprintf(stderr, "kernel_launch: need 39 inputs and %zu bytes of workspace; got %d, %zu\n", (size_t)WS_END, n_in, ws_size); grid = -1; return; }
        int dev = 0, cus = 0, per_cu = 0;
        (void)hipGetDevice(&dev);
        (void)hipDeviceGetAttribute(&cus, hipDeviceAttributeMultiprocessorCount, dev);
        if (hipFuncSetAttribute((const void*)mega, hipFuncAttributeMaxDynamicSharedMemorySize, LDS_BYTES) != hipSuccess) { fprintf(stderr, "kernel_launch: hipFuncSetAttribute failed\n"); grid = -1; return; }
        (void)hipOccupancyMaxActiveBlocksPerMultiprocessor(&per_cu, (const void*)mega, NTHR, LDS_BYTES);
        if (per_cu < 1) fprintf(stderr, "kernel_launch: occupancy query says %d blocks/CU\n", per_cu);
        (void)hipGetLastError();
        grid = cus;
        if (grid > 256) grid = 256;
    }
    if (grid < 0) return;
    Params p{};
    for (int i = 0; i < 39; ++i) p.in[i] = (const float*)d_in[i];
    p.in[39] = (const float*)d_out; p.in[40] = (const float*)d_ws;
    void* args[] = {&p};
    hipError_t e = hipLaunchCooperativeKernel((const void*)mega, dim3(grid), dim3(NTHR), args, LDS_BYTES, stream);
    if (e != hipSuccess) fprintf(stderr, "cooperative launch failed: %s (grid %d)\n", hipGetErrorString(e), grid);
}
```

```cpp
#include <hip/hip_runtime.h>
#include <hip/hip_cooperative_groups.h>
#include <cstdio>
namespace pg8 {
#define PG8_LAS __attribute__((address_space(3)))
typedef unsigned short bf16_t;
typedef short bf16x8 __attribute__((ext_vector_type(8)));
typedef float f32x4 __attribute__((ext_vector_type(4)));
typedef unsigned u32x4 __attribute__((ext_vector_type(4)));
constexpr int BM = 256, BK = 64, HALF = 128, HTB = HALF * BK * 2  , STAGE_BYTES = 8 * HTB, NXCD = 8, WGM = 4;

__host__ __device__ __forceinline__ int lds_byte(int r, int c) { const int st = (r >> 4) * 2 + (c >> 5), rr = r & 15, cc = c & 31, ob = rr * 64 + cc * 2; return st * 1024 + (ob ^ (((ob >> 9) & 1) << 5)); }
__host__ __device__ __forceinline__ void stage_rc(int b, int& R, int& C) { const int st = b / 1024, sb = b % 1024, swz = sb ^ (((sb >> 9) & 1) << 5); R = (st >> 1) * 16 + swz / 64; C = (st & 1) * 32 + (swz % 64) / 2; }
__host__ __device__ __forceinline__ int perm32(int rho) { const int n = rho >> 4, i = rho & 15; return 8 * (i >> 2) + 4 * n + (i & 3); }

struct Unit { int pm, pn; };
struct Gemm { const bf16_t* A; const bf16_t* Bt; int M, N, K; };

struct StaticOrder {
    int nM, nN, nwg, G, c;
    __host__ __device__ void init(int M, int N, int G_, int c_) { nM = M / BM; nN = N / BM; nwg = nM * nN; G = G_; c = c_; }
    __host__ __device__ bool next(int i, Unit& u) const {
        const long L = (long)i * G + c; if (L >= nwg) return false;
        int wgid = (int)L; { const int q = nwg / NXCD, r = nwg % NXCD, xcd = wgid % NXCD, off = wgid / NXCD; wgid = (xcd < r ? xcd * (q + 1) : r * (q + 1) + (xcd - r) * q) + off; }
        const int nig = WGM * nN, gid = wgid / nig, fm = gid * WGM, gsz = (nM - fm) < WGM ? (nM - fm) : WGM;
        u.pm = fm + ((wgid % nig) % gsz); u.pn = (wgid % nig) / gsz; return true;
    }
    __device__ __forceinline__ void a_ready(const Unit&) const {}
    __device__ __forceinline__ void done(const Unit&) const {}
};
__device__ __forceinline__ unsigned cvt_pk_bf16(float lo, float hi) { unsigned r; asm volatile("v_cvt_pk_bf16_f32 %0, %1, %2" : "=v"(r) : "v"(lo), "v"(hi)); return r; }
typedef float f32x2 __attribute__((ext_vector_type(2)));

template <class Epi, class Sched, bool STAMP = false>
__device__ __forceinline__ void gemm_phase(PG8_LAS unsigned char* lds, const Gemm g, const Sched& S, const Epi& E, unsigned long long* stamps) {
    int tid_l_ = threadIdx.x; asm volatile("" : "+v"(tid_l_)); const int tid = tid_l_, wid = __builtin_amdgcn_readfirstlane(tid >> 6), lane = tid & 63, wr = wid >> 2, wc = wid & 3, fr = lane & 15, fq = lane >> 4;
    const int K = g.K, nt = K / BK;
    int ts_lo = 0, ts_hi = 0, nts = 0; const unsigned long long rt_entry = STAMP ? (unsigned long long)wall_clock64() : 0ull;
#define PG8_STAMP() do { if (STAMP && wid == 0 && nts < 64) { const unsigned long long _c = (unsigned long long)clock64(); \
        ts_lo = (lane == nts) ? (int)(unsigned)_c : ts_lo; ts_hi = (lane == nts) ? (int)(unsigned)(_c >> 32) : ts_hi; ++nts; } } while (0)
    PG8_STAMP();
    unsigned voffA[2], voffB[2];
#pragma unroll
    for (int i = 0; i < 2; ++i) { int R, C; stage_rc(tid * 16 + i * 8192, R, C); const int Rb = Epi::PERM ? ((R & ~31) + perm32(R & 31)) : R;
        voffA[i] = (unsigned)(R * K + C) * 2u; voffB[i] = (unsigned)(Rb * K + C) * 2u; }
    const size_t kstep = (size_t)(BK * 2);
    const size_t hstep = (size_t)HALF * K * 2;
    const size_t tstep = 2 * hstep;
    const unsigned ldsw = (unsigned)wid * 1024u;
    const int aoff = lds_byte(wr * 64 + fr, fq * 8), boff = lds_byte(wc * 32 + fr, fq * 8);
#define PG8_SA(b, h) (((b) * 2 + (h)) * HTB)
#define PG8_SB(b, h) ((4 + (b) * 2 + (h)) * HTB)
#define PG8_STAGE(bufoff, gbase, voff) do { _Pragma("unroll") for (int _i = 0; _i < 2; ++_i) \
        __builtin_amdgcn_global_load_lds((const unsigned*)((const char*)(gbase) + (voff)[_i]), (PG8_LAS unsigned*)(lds + (bufoff) + ldsw + _i * 8192), 16, 0, 0); } while (0)
#define PG8_LDA(dst, b, h) do { _Pragma("unroll") for (int m = 0; m < 4; ++m) _Pragma("unroll") for (int k = 0; k < 2; ++k) dst[m][k] = *(const PG8_LAS bf16x8*)(lds + PG8_SA(b, h) + aoff + m * 2048 + k * 1024); } while (0)
#define PG8_LDB(dst, b, h) do { _Pragma("unroll") for (int n = 0; n < 2; ++n) _Pragma("unroll") for (int k = 0; k < 2; ++k) dst[n][k] = *(const PG8_LAS bf16x8*)(lds + PG8_SB(b, h) + boff + n * 2048 + k * 1024); } while (0)
#define PG8_MMA(ai, bj, At, Bt) do { __builtin_amdgcn_s_setprio(1); _Pragma("unroll") for (int m = 0; m < 4; ++m) _Pragma("unroll") for (int n = 0; n < 2; ++n) _Pragma("unroll") for (int k = 0; k < 2; ++k) \
        acc[ai][bj][m][n] = __builtin_amdgcn_mfma_f32_16x16x32_bf16(Bt[n][k], At[m][k], acc[ai][bj][m][n], 0, 0, 0); __builtin_amdgcn_s_setprio(0); } while (0)
#define PG8_WAIT_V(n) asm volatile("s_waitcnt vmcnt(" #n ")" ::: "memory")
#define PG8_WAIT_L(n) asm volatile("s_waitcnt lgkmcnt(" #n ")" ::: "memory")
#define PG8_BAR __builtin_amdgcn_s_barrier()
#define PG8_SCHED __builtin_amdgcn_sched_barrier(0)
    Unit cur, nxt; int ui = 0;
    if (!S.next(0, cur)) return;
    f32x4 acc[2][2][4][2];
#pragma unroll
    for (int a = 0; a < 2; ++a)
#pragma unroll
        for (int b = 0; b < 2; ++b)
#pragma unroll
            for (int m = 0; m < 4; ++m)
#pragma unroll
                for (int n = 0; n < 2; ++n) acc[a][b][m][n] = (f32x4){0.f, 0.f, 0.f, 0.f};
    bf16x8 At[4][2], B0[2][2], B1[2][2];
    const char* cA = (const char*)g.A + (size_t)cur.pm * tstep; const char* cB = (const char*)g.Bt + (size_t)cur.pn * tstep;
    S.a_ready(cur);
    PG8_STAGE(PG8_SB(0, 0), cB, voffB); PG8_STAGE(PG8_SA(0, 0), cA, voffA); PG8_STAGE(PG8_SB(0, 1), cB + hstep, voffB); PG8_STAGE(PG8_SA(0, 1), cA + hstep, voffA);
    if (wr == 1) PG8_BAR;
    PG8_WAIT_V(4); PG8_BAR;
    PG8_STAGE(PG8_SB(1, 0), cB + kstep, voffB); PG8_STAGE(PG8_SA(1, 0), cA + kstep, voffA); PG8_STAGE(PG8_SB(1, 1), cB + hstep + kstep, voffB);
    PG8_WAIT_V(6); PG8_BAR;
    PG8_STAMP();
    for (;;) {
        const bool has_next = S.next(ui + 1, nxt);
        const char* nA = has_next ? (const char*)g.A + (size_t)nxt.pm * tstep : cA; const char* nB = has_next ? (const char*)g.Bt + (size_t)nxt.pn * tstep : cB;
        for (int t = 0; t < nt; t += 2) {
            const bool last = (t == nt - 2);
            const char* a1 = cA + (size_t)(t + 1) * kstep;
            const char* a2 = last ? nA : cA + (size_t)(t + 2) * kstep; const char* b2 = last ? nB : cB + (size_t)(t + 2) * kstep;
            const char* a3 = a2 + kstep; const char* b3 = b2 + kstep;
            if (last && has_next) S.a_ready(nxt);
            PG8_LDB(B0, 0, 0); PG8_SCHED; PG8_LDA(At, 0, 0); PG8_STAGE(PG8_SA(1, 1), a1 + hstep, voffA);
            PG8_WAIT_L(8); PG8_BAR; PG8_WAIT_L(0); PG8_MMA(0, 0, At, B0); PG8_BAR; PG8_SCHED;
            PG8_LDB(B1, 0, 1); PG8_STAGE(PG8_SB(0, 0), b2, voffB);
            PG8_BAR; PG8_WAIT_L(0); PG8_MMA(0, 1, At, B1); PG8_BAR;
            PG8_LDA(At, 0, 1); PG8_STAGE(PG8_SA(0, 0), a2, voffA);
            PG8_BAR; PG8_WAIT_L(0); PG8_MMA(1, 0, At, B0); PG8_BAR; PG8_SCHED;
            PG8_STAGE(PG8_SB(0, 1), b2 + hstep, voffB);
            PG8_WAIT_V(6); PG8_BAR; PG8_MMA(1, 1, At, B1); PG8_BAR;
            PG8_LDB(B0, 1, 0); PG8_SCHED; PG8_LDA(At, 1, 0); PG8_STAGE(PG8_SA(0, 1), a2 + hstep, voffA);
            PG8_WAIT_L(8); PG8_BAR; PG8_WAIT_L(0); PG8_MMA(0, 0, At, B0); PG8_BAR; PG8_SCHED;
            PG8_LDB(B1, 1, 1); PG8_STAGE(PG8_SB(1, 0), b3, voffB);
            PG8_BAR; PG8_WAIT_L(0); PG8_MMA(0, 1, At, B1); PG8_BAR;
            PG8_LDA(At, 1, 1); PG8_STAGE(PG8_SA(1, 0), a3, voffA);
            PG8_BAR; PG8_WAIT_L(0); PG8_MMA(1, 0, At, B0); PG8_BAR; PG8_SCHED;
            PG8_STAGE(PG8_SB(1, 1), b3 + hstep, voffB);
            PG8_WAIT_V(6); PG8_BAR; PG8_MMA(1, 1, At, B1); PG8_BAR;
        }
        PG8_STAMP();
        if constexpr (!Epi::AFTER_DRAIN) { E(acc, cur, wr, wc, fr, fq); S.done(cur); }
        PG8_STAMP();
        if (!has_next) break;
#pragma unroll
        for (int a = 0; a < 2; ++a)
#pragma unroll
            for (int b = 0; b < 2; ++b)
#pragma unroll
                for (int m = 0; m < 4; ++m)
#pragma unroll
                    for (int n = 0; n < 2; ++n) acc[a][b][m][n] = (f32x4){0.f, 0.f, 0.f, 0.f};
        cur = nxt; cA = nA; cB = nB; ++ui;
    }
    PG8_WAIT_V(0);
    if (wr == 0) PG8_BAR;
    PG8_BAR;
    if constexpr (Epi::AFTER_DRAIN) { E.fused(acc, cur, wr, wc, fr, fq, lds, wid, lane); S.done(cur); }
    PG8_STAMP();
    if (STAMP && wid == 0) { stamps[lane] = lane < nts ? (((unsigned long long)(unsigned)ts_hi << 32) | (unsigned)ts_lo) : 0ull;
        if (lane == 62) stamps[62] = rt_entry; if (lane == 63) stamps[63] = (unsigned long long)wall_clock64(); }
#undef PG8_STAMP
#undef PG8_SA
#undef PG8_SB
#undef PG8_STAGE
#undef PG8_LDA
#undef PG8_LDB
#undef PG8_MMA
#undef PG8_WAIT_V
#undef PG8_WAIT_L
#undef PG8_BAR
#undef PG8_SCHED
}
}
#define XB_TMO      128
#define XB_XCNT(j)  (256  + 64 * (j))
#define XB_XSUB(j)  (1280 + 64 * (j))
#define XB_XGEN(j)  (2304 + 64 * (j))
#define XB_TOP      3328
#define XB_TOPGEN   3392
#define XCD_BAR_WORDS 3456
#define XB_SPIN_CAP (1u << 18)
#define XB_LAS __attribute__((address_space(3)))

__device__ __forceinline__ unsigned xb_ld(unsigned* p)              { return __hip_atomic_load(p, __ATOMIC_RELAXED, __HIP_MEMORY_SCOPE_AGENT); }
__device__ __forceinline__ unsigned xb_add(unsigned* p, unsigned v) { return __hip_atomic_fetch_add(p, v, __ATOMIC_RELAXED, __HIP_MEMORY_SCOPE_AGENT); }
__device__ __forceinline__ unsigned xb_xcc_id() { return (unsigned)__builtin_amdgcn_s_getreg((3 << 11) | 20) & 0xFu; }
#define XB_SPIN(cond, bar) do { unsigned _sp = 0; while (cond) { __builtin_amdgcn_s_sleep(1); \
    if ((++_sp & 255u) == 0u) { if (xb_ld(&(bar)[XB_TMO])) break; if (_sp > XB_SPIN_CAP) { atomicAdd(&(bar)[XB_TMO], 1u); break; } } } } while (0)

struct XcdBarrier {
    unsigned* bar; unsigned x;
    volatile XB_LAS unsigned* st;
};

__device__ __forceinline__ XcdBarrier xcd_barrier_post(unsigned* bar, volatile XB_LAS unsigned* st) {
    XcdBarrier b; b.bar = bar; b.x = xb_xcc_id(); b.st = st;
    if (threadIdx.x == 0) (void)xb_add(&bar[XB_XCNT(b.x)], 1u);
    return b;
}
__device__ __forceinline__ void xcd_barrier_complete(unsigned* bar, unsigned x, unsigned& nloc, unsigned& nx) {
    const unsigned G = gridDim.x * gridDim.y * gridDim.z;
    unsigned sum, cnt, mine, sp = 0u;
    for (;;) {
        sum = 0u; cnt = 0u; mine = 0u;
#pragma unroll
        for (unsigned j = 0; j < 16; ++j) { const unsigned c = xb_ld(&bar[XB_XCNT(j)]); sum += c; cnt += (c > 0u) ? 1u : 0u; mine = (j == x) ? c : mine; }
        if (sum == G) break;
        __builtin_amdgcn_s_sleep(1);
        if ((++sp & 255u) == 0u) { if (xb_ld(&bar[XB_TMO])) break; if (sp > XB_SPIN_CAP) { atomicAdd(&bar[XB_TMO], 1u); break; } }
    }
    nloc = mine > 0u ? mine : 1u; nx = cnt > 0u ? cnt : 1u;
}

__device__ __forceinline__ void xcd_barrier(const XcdBarrier& b) {
    asm volatile("s_waitcnt vmcnt(0)" ::: "memory");
    __syncthreads();
    if (threadIdx.x == 0) {
        unsigned* bar = b.bar;
        __builtin_amdgcn_s_waitcnt(0);
        unsigned nloc = b.st[0], nx = b.st[1];
        if (nloc == 0u) { xcd_barrier_complete(bar, b.x, nloc, nx); b.st[0] = nloc; b.st[1] = nx; }
        const unsigned old = xb_add(&bar[XB_XSUB(b.x)], 1u);
        const unsigned gen = old / nloc;
        if (old + 1u == (gen + 1u) * nloc) {
            __builtin_amdgcn_fence(__ATOMIC_RELEASE, "agent");
            asm volatile("s_waitcnt vmcnt(0)" ::: "memory");
            const unsigned og = xb_add(&bar[XB_TOP], 1u);
            const unsigned tg = og / nx;
            if (og + 1u == (tg + 1u) * nx) xb_add(&bar[XB_TOPGEN], 1u);
            else XB_SPIN(xb_ld(&bar[XB_TOPGEN]) == tg, bar);
            __builtin_amdgcn_fence(__ATOMIC_ACQUIRE, "agent");
            xb_add(&bar[XB_XGEN(b.x)], 1u);
            asm volatile("s_waitcnt vmcnt(0)" ::: "memory");
        } else {
            XB_SPIN(xb_ld(&bar[XB_XGEN(b.x)]) == gen, bar);
            __builtin_amdgcn_fence(__ATOMIC_ACQUIRE, "agent");
            asm volatile("s_waitcnt vmcnt(0)" ::: "memory");
        }
    }
    __syncthreads();
}

namespace cg = cooperative_groups;
typedef unsigned short bf16_t;
using pg8::bf16x8; using pg8::f32x4;
#define LAS __attribute__((address_space(3)))

constexpr int D = 1024, NB = 16, TL = 2048, TCX = 256, FF = 2816;
constexpr int MLAT = NB * TL, MCTX = NB * TCX, MTOT = MLAT + MCTX;
constexpr float DN_ALPHA = 1.681792830507429f;
constexpr int NTHR = 512;
constexpr int LDS_BYTES = 155648;

constexpr size_t al256(size_t x) { return (x + 255) & ~(size_t)255; }
constexpr size_t WS_MOD = 16384;
constexpr size_t WS_FT = al256(WS_MOD + (size_t)4 * 17 * 9216 * 4);
constexpr size_t FT_LAT = (size_t)2 * 512 * 4096, FT_CTX = (size_t)2 * 512 * 512, FT_E = FT_LAT + FT_CTX;
constexpr size_t WS_WUP = al256(WS_FT + 2 * FT_E * 2);
constexpr size_t WS_WDN = WS_WUP + (size_t)2 * 5632 * 1024 * 2;
constexpr size_t WS_WIN = WS_WDN + (size_t)2 * 1024 * 2816 * 2;
constexpr size_t WS_WOUT = WS_WIN + (size_t)3584 * 1024 * 2;
constexpr size_t WS_H = WS_WOUT + (size_t)1024 * 1024 * 2;
constexpr size_t WS_A = WS_H + (size_t)MTOT * 1024 * 4;
constexpr size_t WS_BON = WS_A + (size_t)MTOT * 1024 * 2;
constexpr size_t WS_STATS = al256(WS_BON + (size_t)2 * MTOT * 8 * 4);
constexpr size_t WS_BIG = al256(WS_STATS + (size_t)MTOT * 2 * 4);
constexpr size_t BIG_ZR = (size_t)1536 * MTOT * 2;
constexpr size_t BIG_ORW = BIG_ZR + (size_t)MTOT * 1920 * 2;
constexpr size_t BIG_EVEN_END = BIG_ORW + (size_t)2 * MTOT * 512 * 2;
constexpr size_t BIG_OGL = al256((size_t)MTOT * 3104 * 2);
constexpr size_t WS_END = WS_BIG + BIG_EVEN_END;

struct Params { const float* in[41]; };
#define PH_PRO int tid_ = threadIdx.x; asm volatile("" : "+v"(tid_)); int bid_ = blockIdx.x; asm volatile("" : "+s"(bid_)); int gdim_ = gridDim.x; asm volatile("" : "+s"(gdim_));
extern __shared__ __attribute__((aligned(16))) unsigned char smem_g[];
constexpr int TBL_OFF = LDS_BYTES - 512;
typedef const float __attribute__((address_space(1)))* gfptr_;
#define IN(i) ((const float*)(((const gfptr_*)(smem_g + TBL_OFF))[i]))
#define OUT_ ((float*)IN(39))
#define WS_ ((unsigned char*)IN(40))

__device__ __forceinline__ float bf2f(bf16_t b) { return __uint_as_float(((unsigned)b) << 16); }
typedef __bf16 bf16x2_t_ __attribute__((ext_vector_type(2)));
typedef float f32x2_t_ __attribute__((ext_vector_type(2)));
__device__ __forceinline__ unsigned pk2(float lo, float hi) { f32x2_t_ v = {lo, hi}; bf16x2_t_ b = __builtin_convertvector(v, bf16x2_t_); return __builtin_bit_cast(unsigned, b); }
__device__ __forceinline__ bf16_t f2bf(float f) { return (bf16_t)(pk2(f, 0.f) & 0xffffu); }
__device__ __forceinline__ bf16x8 ld8(const bf16_t* p) { const uint2 a = *(const uint2*)p, b = *(const uint2*)(p + 4); uint4 v; v.x = a.x; v.y = a.y; v.z = b.x; v.w = b.y; return __builtin_bit_cast(bf16x8, v); }
#define DPPF(v, ctrl) __builtin_bit_cast(float, __builtin_amdgcn_update_dpp(0, __builtin_bit_cast(int, (v)), (ctrl), 0xF, 0xF, true))
__device__ __forceinline__ float wsum(float v) {
    v += DPPF(v, 0xB1); v += DPPF(v, 0x4E); v += DPPF(v, 0x141); v += DPPF(v, 0x140);
    const int iv = __builtin_bit_cast(int, v);
    return __builtin_bit_cast(float, __builtin_amdgcn_readlane(iv, 0)) + __builtin_bit_cast(float, __builtin_amdgcn_readlane(iv, 16)) +
           __builtin_bit_cast(float, __builtin_amdgcn_readlane(iv, 32)) + __builtin_bit_cast(float, __builtin_amdgcn_readlane(iv, 48));
}
__device__ __forceinline__ float sigm(float x) { return __builtin_amdgcn_rcpf(1.f + __expf(-x)); }
__device__ __forceinline__ float silu_(float x) { return x * __builtin_amdgcn_rcpf(1.f + __expf(-x)); }
__device__ __forceinline__ float softplus_(float y) { return fmaxf(y, 0.f) + __logf(1.f + __expf(-fabsf(y))); }
__device__ __forceinline__ float tanh_(float x) { return 1.f - 2.f * __builtin_amdgcn_rcpf(1.f + __expf(2.f * x)); }

struct EpiStore {
    static constexpr bool PERM = true, AFTER_DRAIN = false;
    bf16_t* O; int ldc; int nvalid;
    __device__ __forceinline__ void operator()(const f32x4 (&acc)[2][2][4][2], const pg8::Unit& u, int wr, int wc, int fr, int fq) const {
        const int row0 = u.pm * 256 + wr * 64 + fr, col0 = u.pn * 256 + wc * 32 + 8 * fq;
#pragma unroll
        for (int ai = 0; ai < 2; ++ai)
#pragma unroll
            for (int m = 0; m < 4; ++m) {
                bf16_t* rowp = O + (size_t)(row0 + ai * 128 + m * 16) * ldc;
#pragma unroll
                for (int bj = 0; bj < 2; ++bj) {
                    const int col = col0 + bj * 128;
                    if (col < nvalid) {
                        const f32x4 v0 = acc[ai][bj][m][0], v1 = acc[ai][bj][m][1];
                        uint4 o; o.x = pk2(v0[0], v0[1]); o.y = pk2(v0[2], v0[3]); o.z = pk2(v1[0], v1[1]); o.w = pk2(v1[2], v1[3]);
                        *(uint4*)(rowp + col) = o;
                    }
                }
            }
    }
};
struct EpiSwiglu {
    static constexpr bool PERM = true, AFTER_DRAIN = false;
    bf16_t* G; int pm_off;
    __device__ __forceinline__ void operator()(const f32x4 (&acc)[2][2][4][2], const pg8::Unit& u, int wr, int wc, int fr, int fq) const {
        const int row0 = (u.pm + pm_off) * 256 + wr * 64 + fr, col0 = u.pn * 128 + wc * 32 + 8 * fq;
#pragma unroll
        for (int ai = 0; ai < 2; ++ai)
#pragma unroll
            for (int m = 0; m < 4; ++m) {
                bf16_t* rowp = G + (size_t)(row0 + ai * 128 + m * 16) * FF + col0;
                float o[8];
#pragma unroll
                for (int n = 0; n < 2; ++n)
#pragma unroll
                    for (int e = 0; e < 4; ++e) o[n * 4 + e] = silu_(acc[ai][0][m][n][e]) * acc[ai][1][m][n][e];
                uint4 q; q.x = pk2(o[0], o[1]); q.y = pk2(o[2], o[3]); q.z = pk2(o[4], o[5]); q.w = pk2(o[6], o[7]);
                *(uint4*)rowp = q;
            }
    }
};
struct EpiResid {
    static constexpr bool PERM = false, AFTER_DRAIN = false;
    int gate_off; float wgt; int ln_idx; int pm_off;
    __device__ __forceinline__ void operator()(const f32x4 (&acc)[2][2][4][2], const pg8::Unit& u, int wr, int wc, int fr, int fq) const {
        float* H = (float*)(WS_ + WS_H); const float* gate = (const float*)(WS_ + WS_MOD) + gate_off;
        const float* stats = ln_idx >= 0 ? (const float*)(WS_ + WS_STATS) : nullptr;
        const float* Hin = ln_idx >= 0 ? H : ((u.pm + pm_off) < 128 ? IN(0) : IN(2) - (size_t)MLAT * D);
        const float* lg = IN(6) + (ln_idx < 0 ? 0 : ln_idx) * 1024; const float* lb = IN(7) + (ln_idx < 0 ? 0 : ln_idx) * 1024;
        const int gpm = u.pm + pm_off;
        const int row0 = gpm * 256 + wr * 64 + fr, col0 = u.pn * 256 + wc * 32 + 4 * fq;
        const int midx = gpm < 128 ? (gpm >> 3) : 16;
        const float* gp = gate + (size_t)midx * 9216 + col0;
        float mu[2][4], rs[2][4];
#pragma unroll
        for (int ai = 0; ai < 2; ++ai)
#pragma unroll
            for (int m = 0; m < 4; ++m) {
                if (stats) { const float2 st = *(const float2*)(stats + 2 * (size_t)(row0 + ai * 128 + m * 16)); mu[ai][m] = st.x; rs[ai][m] = st.y; }
                else { mu[ai][m] = 0.f; rs[ai][m] = 1.f; }
            }
#pragma unroll
        for (int bj = 0; bj < 2; ++bj)
#pragma unroll
            for (int n = 0; n < 2; ++n) {
                const int co = bj * 128 + n * 16;
                const f32x4 gvv = *(const f32x4*)(gp + co) * wgt;
                f32x4 g4 = (f32x4){1.f, 1.f, 1.f, 1.f}, b4 = (f32x4){0.f, 0.f, 0.f, 0.f};
                if (stats) { g4 = *(const f32x4*)(lg + col0 + co); b4 = *(const f32x4*)(lb + col0 + co); }
#pragma unroll
                for (int ai = 0; ai < 2; ++ai)
#pragma unroll
                    for (int m = 0; m < 4; ++m) {
                        float* rowp = H + (size_t)(row0 + ai * 128 + m * 16) * D + col0 + co;
                        f32x4 h = *(const f32x4*)(Hin + (size_t)(row0 + ai * 128 + m * 16) * D + col0 + co);
                        h = (h - mu[ai][m]) * rs[ai][m] * g4 + b4;
                        h = h * DN_ALPHA + gvv * acc[ai][bj][m][n];
                        *(f32x4*)rowp = h;
                    }
            }
    }
};

template <class Epi>
__device__ __forceinline__ void run_gemm(unsigned char* smem, const bf16_t* A, const bf16_t* Bt, int M, int N, int K, const Epi& E, int bid_, int gdim_) {
    pg8::Gemm g; g.A = A; g.Bt = Bt; g.M = M; g.N = N; g.K = K;
    pg8::StaticOrder S; S.init(M, N, gdim_, bid_);
    pg8::gemm_phase<Epi, pg8::StaticOrder, false>((PG8_LAS unsigned char*)smem, g, S, E, nullptr);
}

__device__ __forceinline__ void phase_mod(const Params& p, unsigned char* smem) {
    PH_PRO
    float* s = (float*)smem;
    float* part = s + 17 * 1024;
    const int tid = tid_;
    const float* c = IN(1); const float* cc = IN(3);
    float* MOD = (float*)(WS_ + WS_MOD);
    if (bid_ >= 288) return;
    for (int idx = tid; idx < 17 * 1024; idx += NTHR) { const int i = idx >> 10, k = idx & 1023; const float v = i < 16 ? c[i * 1024 + k] : cc[k]; s[idx] = silu_(v); }
    __syncthreads();
    for (int item = bid_; item < 288; item += gdim_) {
        const int l = item / 72, j0 = (item % 72) * 128;
        const int col = tid & 127, kq = tid >> 7;
        const float* w = IN(4) + ((size_t)l * 1024 + kq * 256) * 9216 + j0 + col;
        float acc[17];
#pragma unroll
        for (int i = 0; i < 17; ++i) acc[i] = 0.f;
        for (int k = 0; k < 256; ++k) {
            const float wv = w[(size_t)k * 9216];
#pragma unroll
            for (int i = 0; i < 17; ++i) acc[i] += s[i * 1024 + kq * 256 + k] * wv;
        }
#pragma unroll
        for (int i = 0; i < 17; ++i) part[(kq * 17 + i) * 128 + col] = acc[i];
        __syncthreads();
        for (int idx = tid; idx < 17 * 128; idx += NTHR) {
            const int i = idx >> 7, cl = idx & 127;
            const float v = part[(0 * 17 + i) * 128 + cl] + part[(1 * 17 + i) * 128 + cl] + part[(2 * 17 + i) * 128 + cl] + part[(3 * 17 + i) * 128 + cl] + IN(5)[l * 9216 + j0 + cl];
            MOD[((size_t)l * 17 + i) * 9216 + j0 + cl] = v;
        }
        __syncthreads();
    }
}

__device__ __forceinline__ void conv_tile(const float* src, int ld, int nvalid, bf16_t* dst, int ldd, float* tile) {
    PH_PRO
    const int tid = tid_;
#pragma unroll
    for (int i = 0; i < 2; ++i) {
        const int k = (tid >> 4) + 32 * i, c4 = (tid & 15) * 4;
        float4 v = make_float4(0.f, 0.f, 0.f, 0.f);
        if (c4 < nvalid) v = *(const float4*)(src + (size_t)k * ld + c4);
        tile[k * 65 + c4] = v.x; tile[k * 65 + c4 + 1] = v.y; tile[k * 65 + c4 + 2] = v.z; tile[k * 65 + c4 + 3] = v.w;
    }
    __syncthreads();
    const int n = tid >> 3, ks = (tid & 7) * 8;
    uint4 o;
    o.x = pk2(tile[(ks + 0) * 65 + n], tile[(ks + 1) * 65 + n]); o.y = pk2(tile[(ks + 2) * 65 + n], tile[(ks + 3) * 65 + n]);
    o.z = pk2(tile[(ks + 4) * 65 + n], tile[(ks + 5) * 65 + n]); o.w = pk2(tile[(ks + 6) * 65 + n], tile[(ks + 7) * 65 + n]);
    *(uint4*)(dst + (size_t)n * ldd + ks) = o;
    __syncthreads();
}
__device__ __forceinline__ void conv_weights(const Params& p, int l, unsigned char* smem) {
    PH_PRO
    float* tile = (float*)smem;
    const bool even = !(l & 1); const int eo = l >> 1;
    const int NIN = even ? 3456 : 3104, nint = (even ? 3584 : 3328) / 64;
    const int total = 2816 + 1408 + nint * 16 + 256;
    bf16_t* WUP = (bf16_t*)(WS_ + WS_WUP); bf16_t* WDN = (bf16_t*)(WS_ + WS_WDN); bf16_t* WIN = (bf16_t*)(WS_ + WS_WIN); bf16_t* WOUT = (bf16_t*)(WS_ + WS_WOUT);
    for (int idx = bid_; idx < total; idx += gdim_) {
        if (idx < 2816) {
            const int f = idx / 1408, r = idx % 1408, nt = r / 16, kt = r % 16, n0 = nt * 64;
            const int pn = n0 >> 8, bj = (n0 & 255) >> 7, j = n0 & 127, col = pn * 128 + j;
            const float* src = (bj ? IN(9) : IN(8)) + ((size_t)(l * 2 + f) * 1024 + kt * 64) * FF + col;
            conv_tile(src, FF, 64, WUP + ((size_t)f * 5632 + n0) * 1024 + kt * 64, 1024, tile);
        } else if (idx < 4224) {
            int r = idx - 2816; const int f = r / 704; r %= 704; const int kt = r / 16, nt = r % 16;
            const float* src = IN(10) + ((size_t)(l * 2 + f) * FF + kt * 64) * 1024 + nt * 64;
            conv_tile(src, 1024, 64, WDN + ((size_t)f * 1024 + nt * 64) * FF + kt * 64, FF, tile);
        } else if (idx < 4224 + nint * 16) {
            const int r = idx - 4224, nt = r / 16, kt = r % 16, n0 = nt * 64;
            int nv = NIN - n0; nv = nv < 0 ? 0 : (nv > 64 ? 64 : nv);
            const float* src = (even ? IN(11) : IN(34)) + ((size_t)eo * 1024 + kt * 64) * NIN + n0;
            conv_tile(src, NIN, nv, WIN + (size_t)n0 * 1024 + kt * 64, 1024, tile);
        } else {
            const int r = idx - 4224 - nint * 16, nt = r / 16, kt = r % 16;
            const float* src = (even ? IN(12) : IN(35)) + ((size_t)eo * 1024 + kt * 64) * 1024 + nt * 64;
            conv_tile(src, 1024, 64, WOUT + (size_t)nt * 64 * 1024 + kt * 64, 1024, tile);
        }
    }
}

__device__ __forceinline__ void filt_gen(const Params& p, unsigned char* smem) {
    PH_PRO
    float* z = (float*)smem;
    float* h1 = z + 64 * 33;
    float* h2 = h1 + 64 * 65;
    const int tid = tid_, lane = tid & 63, wid = __builtin_amdgcn_readfirstlane(tid >> 6);
    bf16_t* FT = (bf16_t*)(WS_ + WS_FT);
    for (int item = (bid_ + gdim_ / 2) % gdim_; item < 2 * 36 * 4; item += gdim_) {
        const int e = item / 144; int r = item % 144; const int cg = r & 3; r >>= 2;
        const int seg = r >= 32; const int jb = seg ? r - 32 : r;
        const int L = seg ? 256 : 2048;
        const float* w1 = IN(15) + e * 33 * 64; const float* b1 = IN(16) + e * 64; const float* f1 = IN(17) + e * 64;
        const float* w2 = IN(18) + e * 64 * 64; const float* b2 = IN(19) + e * 64; const float* f2 = IN(20) + e * 64;
        const float* w3 = IN(21) + (size_t)e * 64 * 2048; const float* skip = IN(22) + e * 1024;
        __syncthreads();
        for (int idx = tid; idx < 64 * 33; idx += NTHR) {
            const int jj = idx / 33, i = idx % 33; const int j = jb * 64 + jj;
            float v;
            if (i == 0) v = (float)j / (float)(L - 1);
            else { const int bi = (i - 1) & 15; const float f = 1e-4f + (float)bi * ((15.f - 1e-4f) / 15.f); const float w = 6.283185307179586f * (float)j / (float)L; v = (i <= 16) ? cosf(f * w) : -sinf(f * w); }
            z[idx] = v;
        }
        __syncthreads();
        for (int idx = tid; idx < 4096; idx += NTHR) {
            const int jj = idx >> 6, o = idx & 63; float a = b1[o];
            for (int i = 0; i < 33; ++i) a += z[jj * 33 + i] * w1[i * 64 + o];
            h1[jj * 65 + o] = sinf(f1[o] * a);
        }
        __syncthreads();
        for (int idx = tid; idx < 4096; idx += NTHR) {
            const int jj = idx >> 6, o = idx & 63; float a = b2[o];
            for (int k = 0; k < 64; ++k) a += h1[jj * 65 + k] * w2[k * 64 + o];
            h2[jj * 65 + o] = sinf(f2[o] * a);
        }
        __syncthreads();
        bf16_t* base = FT + (size_t)e * FT_E + (seg ? FT_LAT : 0);
#pragma unroll 1
        for (int ps = 0; ps < 2; ++ps) {
            const int col0 = cg * 512 + ps * 256 + 4 * lane;
            float acc[8][4];
#pragma unroll
            for (int i = 0; i < 8; ++i)
#pragma unroll
                for (int c = 0; c < 4; ++c) acc[i][c] = 0.f;
#pragma unroll 4
            for (int k = 0; k < 64; ++k) {
                const float4 wv = *(const float4*)(w3 + (size_t)k * 2048 + col0);
#pragma unroll
                for (int i = 0; i < 8; ++i) { const float hv = h2[(8 * wid + i) * 65 + k]; acc[i][0] += hv * wv.x; acc[i][1] += hv * wv.y; acc[i][2] += hv * wv.z; acc[i][3] += hv * wv.w; }
            }
            const int ord = col0 >> 10, dir = (col0 >> 9) & 1;
            const float lo = -4.605170185988091f / 1.5f, hi = -4.605170185988091f / 0.3f;
#pragma unroll
            for (int c = 0; c < 4; ++c) {
                const int ch = (col0 + c) & 511;
                const float adl = fabsf(lo + (hi - lo) * (float)ch / 511.f);
                bf16_t* fp = base + ((size_t)ord * 512 + ch) * (2 * L);
#pragma unroll
                for (int i = 0; i < 8; ++i) {
                    const int j = jb * 64 + 8 * wid + i; const float tj = (float)j / (float)(L - 1);
                    float v = acc[i][c] * __expf(-tj * adl);
                    if (dir == 0 && j == 0) v += skip[ord * 512 + ch];
                    if (!(dir == 1 && j == 0)) fp[dir == 0 ? (L - 1 - j) : (L - 1 + j)] = f2bf(v);
                }
            }
        }
    }
    __syncthreads();
}

__device__ __forceinline__ void row_phase(const Params& p, int mode, int l_ln, int which, int l_mod, int sidx, bool fin, int nrows_in = MTOT, int row_begin = 0, int blk_off = 0, int nblk_in = 0) {
    PH_PRO
    const int lane = tid_ & 63, wid = tid_ >> 6;
    float* H = (float*)(WS_ + WS_H); bf16_t* A = (bf16_t*)(WS_ + WS_A);
    const float* MOD = (const float*)(WS_ + WS_MOD);
    const float* lg = IN(6) + (l_ln * 3 + which) * 1024; const float* lb = IN(7) + (l_ln * 3 + which) * 1024;
    const int nrows = fin ? MLAT : nrows_in;
    constexpr int RU = 1;
    const int nblk = nblk_in ? nblk_in : gdim_;
    for (int rowb = row_begin + (bid_ - blk_off) * 8 + wid; rowb < nrows; rowb += nblk * 8 * RU) {
        float4 v[RU][4]; int rows[RU]; bool okr[RU];
#pragma unroll
        for (int u = 0; u < RU; ++u) {
            const int row = rowb + u * nblk * 8; okr[u] = row < nrows; rows[u] = okr[u] ? row : rowb;
            const float* src = mode ? H + (size_t)rows[u] * D : (rows[u] < MLAT ? IN(0) + (size_t)rows[u] * D : IN(2) + (size_t)(rows[u] - MLAT) * D);
#pragma unroll
            for (int i = 0; i < 4; ++i) v[u][i] = *(const float4*)(src + 4 * lane + 256 * i);
        }
#pragma unroll
        for (int u = 0; u < RU; ++u) {
            const int row = rows[u];
            if (mode) {
                float s = 0.f;
#pragma unroll
                for (int i = 0; i < 4; ++i) s += v[u][i].x + v[u][i].y + v[u][i].z + v[u][i].w;
                const float mu = wsum(s) * (1.f / 1024.f);
                float q = 0.f;
#pragma unroll
                for (int i = 0; i < 4; ++i) { v[u][i].x -= mu; v[u][i].y -= mu; v[u][i].z -= mu; v[u][i].w -= mu; q += v[u][i].x * v[u][i].x + v[u][i].y * v[u][i].y + v[u][i].z * v[u][i].z + v[u][i].w * v[u][i].w; }
                const float rstd = rsqrtf(wsum(q) * (1.f / 1024.f) + 1e-6f);
                if (lane == 0 && !fin && okr[u]) *(float2*)((float*)(WS_ + WS_STATS) + 2 * (size_t)row) = make_float2(mu, rstd);
#pragma unroll
                for (int i = 0; i < 4; ++i) {
                    const float4 g = *(const float4*)(lg + 4 * lane + 256 * i), b = *(const float4*)(lb + 4 * lane + 256 * i);
                    v[u][i].x = v[u][i].x * rstd * g.x + b.x; v[u][i].y = v[u][i].y * rstd * g.y + b.y; v[u][i].z = v[u][i].z * rstd * g.z + b.z; v[u][i].w = v[u][i].w * rstd * g.w + b.w;
                }
            }
            if (!okr[u]) continue;
            if (fin) {
#pragma unroll
                for (int i = 0; i < 4; ++i) *(float4*)(OUT_ + (size_t)row * D + 4 * lane + 256 * i) = v[u][i];
            } else {
                const int midx = row < MLAT ? (row >> 11) : 16;
                const float* mp = MOD + ((size_t)l_mod * 17 + midx) * 9216 + sidx * 1024;
#pragma unroll
                for (int i = 0; i < 4; ++i) {
                    const float4 sh = *(const float4*)(mp + 4 * lane + 256 * i), sc = *(const float4*)(mp + 1024 + 4 * lane + 256 * i);
                    uint2 o; o.x = pk2(v[u][i].x * (1.f + sc.x) + sh.x, v[u][i].y * (1.f + sc.y) + sh.y); o.y = pk2(v[u][i].z * (1.f + sc.z) + sh.z, v[u][i].w * (1.f + sc.w) + sh.w);
                    *(uint2*)(A + (size_t)row * D + 4 * lane + 256 * i) = o;
                }
            }
        }
    }
}
template <int L>
__device__ __forceinline__ void hyena_item(const Params& p, int e, int c, int segbase, const bf16_t* ft, unsigned char* smem) {
    PH_PRO
    constexpr int CPS = 2 * L + 16, UTS = L + 8, TPW = (L / 16) / 8;
    bf16_t* COP = (bf16_t*)smem;
    bf16_t* UT = COP + 8 * CPS;
    const int tid = tid_, lane = tid & 63, wid = tid >> 6;
    bf16_t* ZHT = (bf16_t*)(WS_ + WS_BIG);
    bf16_t* zv = ZHT + (size_t)c * MTOT + segbase;
    const bf16_t* zx1 = ZHT + (size_t)(512 + c) * MTOT + segbase;
    const bf16_t* zx2 = ZHT + (size_t)(1024 + c) * MTOT + segbase;
    const float* cw = IN(13) + e * 3 * 1536; const float* cbp = IN(14) + e * 1536;
    const float vw0 = cw[c], vw1 = cw[1536 + c], vw2 = cw[3072 + c], vb = cbp[c];
    const float aw0 = cw[512 + c], aw1 = cw[1536 + 512 + c], aw2 = cw[3072 + 512 + c], ab = cbp[512 + c];
    const float bw0 = cw[1024 + c], bw1 = cw[1536 + 1024 + c], bw2 = cw[3072 + 1024 + c], bb = cbp[1024 + c];
    auto conv4 = [&](const bf16_t* q, int t0, float w0, float w1, float w2, float bias, float (&y)[4]) {
        const uint2 mid = *(const uint2*)(q + t0);
        float zm = bf2f(q[t0 > 0 ? t0 - 1 : 0]); zm = t0 > 0 ? zm : 0.f;
        float zq = bf2f(q[t0 + 4 < L ? t0 + 4 : L - 1]); zq = t0 + 4 < L ? zq : 0.f;
        const float z0 = __uint_as_float(mid.x << 16), z1 = __uint_as_float(mid.x & 0xffff0000u), z2 = __uint_as_float(mid.y << 16), z3 = __uint_as_float(mid.y & 0xffff0000u);
        y[0] = zm * w0 + z0 * w1 + z1 * w2 + bias; y[1] = z0 * w0 + z1 * w1 + z2 * w2 + bias;
        y[2] = z1 * w0 + z2 * w1 + z3 * w2 + bias; y[3] = z2 * w0 + z3 * w1 + zq * w2 + bias;
    };
#pragma unroll 4
    for (int idx = tid; idx < 4 * L; idx += NTHR) {
        const int b = idx / (L / 4), s4 = (idx % (L / 4)) * 4;
        float y[4]; conv4(zv + b * L, s4, vw0, vw1, vw2, vb, y);
        uint2 o; o.x = pk2(y[0], y[1]); o.y = pk2(y[2], y[3]);
        *(uint2*)(UT + b * UTS + s4) = o;
    }
    const int r = lane & 15, g = lane >> 4, a = 7 - (r & 7);
    const bf16_t* cop_a = COP + a * CPS;
    f32x4 acc[TPW];
#pragma unroll 1
    for (int ord = 0; ord < 2; ++ord) {
        const bf16_t* fo = ft + ((size_t)ord * 512 + c) * (2 * L);
        for (int cidx = tid; cidx < (2 * L) / 8; cidx += NTHR) {
            const uint4 raw = *(const uint4*)(fo + 8 * cidx);
            unsigned short v[8] = {(unsigned short)(raw.x & 0xffffu), (unsigned short)(raw.x >> 16), (unsigned short)(raw.y & 0xffffu), (unsigned short)(raw.y >> 16),
                                   (unsigned short)(raw.z & 0xffffu), (unsigned short)(raw.z >> 16), (unsigned short)(raw.w & 0xffffu), (unsigned short)(raw.w >> 16)};
            if (cidx == (2 * L) / 8 - 1) v[7] = 0;
#pragma unroll
            for (int ca = 0; ca < 8; ++ca)
#pragma unroll
                for (int j = 0; j < 8; ++j) { const int x = 8 * cidx - ca + j; COP[ca * CPS + (x < 0 ? 0 : x)] = v[j]; }
        }
        __syncthreads();
#pragma unroll
        for (int i = 0; i < TPW; ++i) acc[i] = (f32x4){0.f, 0.f, 0.f, 0.f};
        if constexpr (TPW == 16) {
            const bf16_t* fbase = cop_a + (8 * g - r + L - 1 - a) - wid * 256;
            bf16x8 F[16];
#pragma unroll
            for (int dd = -15; dd <= 0; ++dd) F[dd & 15] = *(const bf16x8*)(fbase + 16 * dd);
#pragma unroll 1
            for (int S0 = 0; S0 < L / 32; S0 += 8) {
#pragma unroll
                for (int u = 0; u < 8; ++u) {
                    const int S = S0 + u;
                    if (S > 0) { F[(2 * u) & 15] = *(const bf16x8*)(fbase + 32 * S); F[(2 * u - 1) & 15] = *(const bf16x8*)(fbase + 32 * S - 16); }
                    const bf16x8 bfr = *(const bf16x8*)(UT + r * UTS + 32 * S + 8 * g);
#pragma unroll
                    for (int i = 0; i < 16; ++i) acc[i] = __builtin_amdgcn_mfma_f32_16x16x32_bf16(F[(2 * u - i) & 15], bfr, acc[i], 0, 0, 0);
                }
            }
        } else {
        for (int s0 = 0; s0 < L; s0 += 32) {
            const bf16x8 bfr = *(const bf16x8*)(UT + r * UTS + s0 + 8 * g);
#pragma unroll
            for (int i = 0; i < TPW; ++i) {
                const int t0 = (wid * TPW + i) * 16;
                const int n8 = s0 - t0 + 8 * g - r + L - 1 - a;
                const bf16x8 afr = *(const bf16x8*)(cop_a + n8);
                acc[i] = __builtin_amdgcn_mfma_f32_16x16x32_bf16(afr, bfr, acc[i], 0, 0, 0);
            }
        }
        }
        __syncthreads();
        int rl = r * L, tb0 = wid * TPW * 16 + 4 * g; asm volatile("" : "+v"(rl), "+v"(tb0));
        if (ord == 0) {
#pragma unroll
            for (int i = 0; i < TPW; ++i) {
                const int t0 = tb0 + i * 16;
                float y[4]; conv4(zx1 + rl, t0, aw0, aw1, aw2, ab, y);
                uint2 o; o.x = pk2(y[0] * acc[i][0], y[1] * acc[i][1]); o.y = pk2(y[2] * acc[i][2], y[3] * acc[i][3]);
                *(uint2*)(UT + r * UTS + t0) = o;
                if ((i & 3) == 3) __builtin_amdgcn_sched_barrier(0);
            }
        } else {
#pragma unroll
            for (int i = 0; i < TPW; ++i) {
                const int t0 = tb0 + i * 16;
                float y[4]; conv4(zx2 + rl, t0, bw0, bw1, bw2, bb, y);
                uint2 o; o.x = pk2(y[0] * acc[i][0], y[1] * acc[i][1]); o.y = pk2(y[2] * acc[i][2], y[3] * acc[i][3]);
                *(uint2*)(zv + rl + t0) = o;
                if ((i & 3) == 3) __builtin_amdgcn_sched_barrier(0);
            }
        }
    }
    __syncthreads();
}
__device__ __forceinline__ void hyena_phase(const Params& p, int e, unsigned char* smem) {
    PH_PRO
    const bf16_t* FT = (const bf16_t*)(WS_ + WS_FT) + (size_t)e * FT_E;
    for (int item = bid_; item < 1024; item += gdim_) {
        if (item < 512) hyena_item<2048>(p, e, item, 0, FT, smem);
        else hyena_item<256>(p, e, item - 512, MLAT, FT + FT_LAT, smem);
    }
}

__device__ __forceinline__ void rwkv_scan_phase(const Params& p, int e, unsigned char* smem) {
    PH_PRO
    const int chain = bid_; if (chain >= 256) return;
    const int xcd_ = chain & 7, jx_ = chain >> 3;
    const int b = 2 * xcd_ + (jx_ >> 4), d = (jx_ >> 3) & 1, h = jx_ & 7;
    const int tid = tid_, lane = tid & 63, wid = tid >> 6;
    bf16_t* WUPT = (bf16_t*)smem;
    bf16_t* AUPT = WUPT + 4096;
    float* sBONp = (float*)(AUPT + 4096);
    constexpr int SOPS = 336;
    float* sOP = (float*)smem + 8192;
    float* sR = sOP;
    float* sKK = sR + 4096;
    float* sW = sKK + 4096;
    float* sKD = sW + 4096;
    float* sKKA = sKD + 4096;
    float* sV = sOP + 64 * SOPS;
    float* sO = sV + 4096;
    bf16_t* TWb = (bf16_t*)sO;
    bf16_t* ADb = TWb + 4096;
    const bf16_t* ZR = (const bf16_t*)(WS_ + WS_BIG + BIG_ZR);
    bf16_t* ORW = (bf16_t*)(WS_ + WS_BIG + BIG_ORW) + (size_t)d * MTOT * 512;
    float* BON = (float*)(WS_ + WS_BON) + (size_t)d * MTOT * 8;
    const float* mu = IN(23) + e * 1920;
    const float* w0 = IN(24) + (e * 2 + d) * 512 + 64 * h;
    const float* a0 = IN(26) + (e * 2 + d) * 512 + 64 * h;
    const float* wup_g = IN(25) + (size_t)(e * 2 + d) * 64 * 512 + 64 * h;
    const float* aup_g = IN(27) + (size_t)(e * 2 + d) * 64 * 512 + 64 * h;
    const float kk_c = IN(29)[e * 512 + 64 * h + lane];
    const float mu_r = mu[64 * h + lane], mu_k = mu[512 + 64 * h + lane], mu_v = mu[1024 + 64 * h + lane], mu_w = mu[1536 + 64 * d + lane], mu_a = mu[1664 + 64 * d + lane];
    for (int idx = tid; idx < 4096; idx += NTHR) { const int j = idx >> 6, k = idx & 63; WUPT[k * 64 + j] = f2bf(wup_g[(size_t)j * 512 + k]); AUPT[k * 64 + j] = f2bf(aup_g[(size_t)j * 512 + k]); }
    const int r16 = lane & 15, g4 = lane >> 4, tr = wid & 3, tcb = 2 * (wid >> 2);
    float c_w0[2], c_a0[2], c_ka[2], c_rk[2];
#pragma unroll
    for (int jt = 0; jt < 2; ++jt) { const int kc = 16 * (tcb + jt) + r16; c_w0[jt] = w0[kc]; c_a0[jt] = a0[kc]; c_ka[jt] = IN(30)[e * 512 + 64 * h + kc]; c_rk[jt] = IN(31)[e * 512 + 64 * h + kc]; }
    typedef float f32x2 __attribute__((ext_vector_type(2)));
    f32x2 S2[4];
#pragma unroll
    for (int k = 0; k < 4; ++k) S2[k] = (f32x2){0.f, 0.f};
    __syncthreads();
    bf16_t pr_[10], pk_[10], pv_[10], pw_[10], pa_[10];
    auto issue = [&](int cidx) {
        const int seg = cidx >= 4; const int L = seg ? TL : TCX; const int rowbase = seg ? b * TL : MLAT + b * TCX; const int ch = seg ? cidx - 4 : cidx;
        const int tlo = d ? (L - 1 - (ch * 64 + 8 * wid + 7)) : (ch * 64 + 8 * wid);
#pragma unroll
        for (int q = 0; q < 10; ++q) {
            const int t = tlo - 1 + q; const int tc = t < 0 ? 0 : (t > L - 1 ? L - 1 : t);
            const bf16_t* zr = ZR + (size_t)(rowbase + tc) * 1920;
            pr_[q] = zr[64 * h + lane]; pk_[q] = zr[512 + 64 * h + lane]; pv_[q] = zr[1024 + 64 * h + lane]; pw_[q] = zr[1536 + 64 * d + lane]; pa_[q] = zr[1664 + 64 * d + lane];
        }
    };
    issue(0);
#pragma unroll 1
    for (int cidx = 0; cidx < 36; ++cidx) {
        {
            const int seg = cidx >= 4; const int L = seg ? TL : TCX; const int rowbase = seg ? b * TL : MLAT + b * TCX; const int ch = seg ? cidx - 4 : cidx;
            const int tlo = d ? (L - 1 - (ch * 64 + 8 * wid + 7)) : (ch * 64 + 8 * wid);
            {
                float zr_[10], zk_[10], zv_[10], zw_[10], za_[10];
#pragma unroll
                for (int q = 0; q < 10; ++q) {
                    const int t = tlo - 1 + q; const bool ok = (t >= 0) && (t < L);
                    const float a0 = bf2f(pr_[q]), a1 = bf2f(pk_[q]), a2 = bf2f(pv_[q]), a3 = bf2f(pw_[q]), a4 = bf2f(pa_[q]);
                    zr_[q] = ok ? a0 : 0.f; zk_[q] = ok ? a1 : 0.f; zv_[q] = ok ? a2 : 0.f; zw_[q] = ok ? a3 : 0.f; za_[q] = ok ? a4 : 0.f;
                }
#pragma unroll
                for (int sl = 0; sl < 8; ++sl) {
                    const int tau = 8 * wid + (d ? 7 - sl : sl);
#define ZS(arr, muv) (arr[sl + 1] + (muv) * (0.5f * (arr[sl] + arr[sl + 2]) - arr[sl + 1]))
                    const float rr = ZS(zr_, mu_r), kr = ZS(zk_, mu_k), vv = ZS(zv_, mu_v), wd = ZS(zw_, mu_w), ad = ZS(za_, mu_a);
#undef ZS
                    const float kkv = kr * kk_c; const float n2 = wsum(kkv * kkv);
                    const float kk = kkv * __builtin_amdgcn_rcpf(fmaxf(__builtin_amdgcn_sqrtf(n2), 1e-12f));
                    sOP[tau * SOPS + 0 + lane] = rr; sOP[tau * SOPS + 64 + lane] = kk; sV[tau * 64 + lane] = vv; sOP[tau * SOPS + 192 + lane] = kr;
                    TWb[tau * 64 + lane] = f2bf(tanh_(wd)); ADb[tau * 64 + lane] = f2bf(ad);
                }
            }
            __syncthreads();
            {
                const bf16x8 aw0 = *(const bf16x8*)(TWb + (16 * tr + r16) * 64 + 8 * g4), aw1 = *(const bf16x8*)(TWb + (16 * tr + r16) * 64 + 32 + 8 * g4);
                const bf16x8 aa0 = *(const bf16x8*)(ADb + (16 * tr + r16) * 64 + 8 * g4), aa1 = *(const bf16x8*)(ADb + (16 * tr + r16) * 64 + 32 + 8 * g4);
                float bonp[4] = {0.f, 0.f, 0.f, 0.f};
#pragma unroll
                for (int jt = 0; jt < 2; ++jt) {
                    const int kc = 16 * (tcb + jt) + r16;
                    const bf16x8 bw0 = *(const bf16x8*)(WUPT + kc * 64 + 8 * g4), bw1 = *(const bf16x8*)(WUPT + kc * 64 + 32 + 8 * g4);
                    const bf16x8 ba0 = *(const bf16x8*)(AUPT + kc * 64 + 8 * g4), ba1 = *(const bf16x8*)(AUPT + kc * 64 + 32 + 8 * g4);
                    f32x4 cw = (f32x4){0.f, 0.f, 0.f, 0.f}, ca = (f32x4){0.f, 0.f, 0.f, 0.f};
                    cw = __builtin_amdgcn_mfma_f32_16x16x32_bf16(aw0, bw0, cw, 0, 0, 0); cw = __builtin_amdgcn_mfma_f32_16x16x32_bf16(aw1, bw1, cw, 0, 0, 0);
                    ca = __builtin_amdgcn_mfma_f32_16x16x32_bf16(aa0, ba0, ca, 0, 0, 0); ca = __builtin_amdgcn_mfma_f32_16x16x32_bf16(aa1, ba1, ca, 0, 0, 0);
#pragma unroll
                    for (int q = 0; q < 4; ++q) {
                        const int tau = 16 * tr + 4 * g4 + q;
                        const float wlog = -softplus_(-(c_w0[jt] + cw[q])) - 0.5f;
                        const float dec = __expf(-__expf(wlog));
                        const float av = sigm(c_a0[jt] + ca[q]);
                        const float kd = sOP[tau * SOPS + 192 + kc] * (1.f + (av - 1.f) * c_ka[jt]);
                        bonp[q] += sOP[tau * SOPS + 0 + kc] * kd * c_rk[jt];
                        sOP[tau * SOPS + 128 + kc] = dec; sOP[tau * SOPS + 192 + kc] = kd; sOP[tau * SOPS + 256 + kc] = sOP[tau * SOPS + 64 + kc] * av;
                    }
                }
#pragma unroll
                for (int q = 0; q < 4; ++q) {
                    float v = bonp[q];
                    v += DPPF(v, 0xB1); v += DPPF(v, 0x4E); v += DPPF(v, 0x141); v += DPPF(v, 0x140);
                    if (r16 == 0) sBONp[(16 * tr + 4 * g4 + q) * 2 + (wid >> 2)] = v;
                }
            }
            __syncthreads();
            if (tid < 64) { const int pp = ch * 64 + tid; const int t = d ? (L - 1 - pp) : pp; BON[(size_t)(rowbase + t) * 8 + h] = sBONp[2 * tid] + sBONp[2 * tid + 1]; }
            if (cidx + 1 < 36) issue(cidx + 1);
            {
                const int vrow = 8 * wid + (lane >> 3), kq = lane & 7;
                const float* pb = sOP + 8 * kq;
                constexpr int O_R = 0, O_KK = 64, O_W = 128, O_KD = 192, O_KA = 256;
                struct Ops { float4 kk0, kk1, w0, w1, ka0, ka1, kd0, kd1, r0, r1; float vv; };
                auto ldops = [&](Ops& o, int tau) {
                    const float* q = pb + tau * SOPS;
                    o.kk0 = *(const float4*)(q + O_KK); o.kk1 = *(const float4*)(q + O_KK + 4); o.w0 = *(const float4*)(q + O_W); o.w1 = *(const float4*)(q + O_W + 4);
                    o.ka0 = *(const float4*)(q + O_KA); o.ka1 = *(const float4*)(q + O_KA + 4); o.kd0 = *(const float4*)(q + O_KD); o.kd1 = *(const float4*)(q + O_KD + 4);
                    o.r0 = *(const float4*)(q + O_R); o.r1 = *(const float4*)(q + O_R + 4); o.vv = sV[tau * 64 + vrow];
                };
                auto step = [&](const Ops& o, int tau) {
                    const f32x2 kk[4] = {{o.kk0.x, o.kk0.y}, {o.kk0.z, o.kk0.w}, {o.kk1.x, o.kk1.y}, {o.kk1.z, o.kk1.w}};
                    const f32x2 w[4] = {{o.w0.x, o.w0.y}, {o.w0.z, o.w0.w}, {o.w1.x, o.w1.y}, {o.w1.z, o.w1.w}};
                    const f32x2 ka[4] = {{o.ka0.x, o.ka0.y}, {o.ka0.z, o.ka0.w}, {o.ka1.x, o.ka1.y}, {o.ka1.z, o.ka1.w}};
                    const f32x2 kd[4] = {{o.kd0.x, o.kd0.y}, {o.kd0.z, o.kd0.w}, {o.kd1.x, o.kd1.y}, {o.kd1.z, o.kd1.w}};
                    const f32x2 rr[4] = {{o.r0.x, o.r0.y}, {o.r0.z, o.r0.w}, {o.r1.x, o.r1.y}, {o.r1.z, o.r1.w}};
                    f32x2 da = S2[0] * kk[0] + S2[1] * kk[1]; f32x2 db = S2[2] * kk[2] + S2[3] * kk[3]; da = da + db;
                    float dt = da.x + da.y;
                    dt += DPPF(dt, 0xB1); dt += DPPF(dt, 0x4E); dt += DPPF(dt, 0x141);
                    const f32x2 sa2 = {-dt, -dt}; const f32x2 vv2 = {o.vv, o.vv};
#pragma unroll
                    for (int q = 0; q < 4; ++q) S2[q] = S2[q] * w[q] + (sa2 * ka[q] + vv2 * kd[q]);
                    f32x2 oa = S2[0] * rr[0] + S2[1] * rr[1]; f32x2 ob = S2[2] * rr[2] + S2[3] * rr[3]; oa = oa + ob;
                    float ot = oa.x + oa.y;
                    ot += DPPF(ot, 0xB1); ot += DPPF(ot, 0x4E); ot += DPPF(ot, 0x141);
                    if (kq == 0) sO[tau * 64 + vrow] = ot;
                };
                Ops oa_, ob_;
                ldops(oa_, 0);
#pragma unroll 1
                for (int tau = 0; tau < 64; tau += 2) {
                    ldops(ob_, tau + 1);
                    step(oa_, tau);
                    ldops(oa_, tau + 2 < 64 ? tau + 2 : 63);
                    step(ob_, tau + 1);
                }
            }
            __syncthreads();
#pragma unroll
            for (int i = 0; i < 8; ++i) {
                const int tau = wid + 8 * i; const int pp = ch * 64 + tau; const int t = d ? (L - 1 - pp) : pp;
                ORW[(size_t)(rowbase + t) * 512 + 64 * h + lane] = f2bf(sO[tau * 64 + lane]);
            }
            __syncthreads();
        }
    }
}

__device__ __forceinline__ void even_readout_phase(const Params& p, int e, unsigned char* smem) {
    PH_PRO
    const int tid = tid_, lane = tid & 63, wid = __builtin_amdgcn_readfirstlane(tid >> 6);
    bf16_t* SGb = (bf16_t*)smem;
    float* GG = (float*)(SGb + 64 * 128);
    bf16_t* GUT = (bf16_t*)(GG + 64 * 64);
    bf16_t* TT = GUT + 64 * 128;
    const int r16 = lane & 15, g4 = lane >> 4, tr = wid & 3, tcb = 2 * (wid >> 2);
    const bf16_t* ZR = (const bf16_t*)(WS_ + WS_BIG + BIG_ZR);
    const bf16_t* ORW = (const bf16_t*)(WS_ + WS_BIG + BIG_ORW);
    const bf16_t* YT = (const bf16_t*)(WS_ + WS_BIG);
    const float* BON = (const float*)(WS_ + WS_BON);
    bf16_t* YM = (bf16_t*)(WS_ + WS_A);
    const float* mu = IN(23) + e * 1920;
    const int h = bid_ & 7;
    {
        const float* gup = IN(28) + (size_t)e * 128 * 512 + 64 * h;
        for (int idx = tid; idx < 128 * 64; idx += NTHR) { const int j = idx >> 6, k = idx & 63; GUT[k * 128 + j] = f2bf(gup[(size_t)j * 512 + k]); }
    }
    const float gng = IN(32)[e * 512 + 64 * h + lane], gnb = IN(33)[e * 512 + 64 * h + lane], muv = mu[1024 + 64 * h + lane];
    for (int item = bid_; item < 4608; item += gdim_) {
        const int tb = item >> 3; const int row0 = tb * 64;
        const int hh = item & 7;
        const int L = row0 < MLAT ? TL : TCX; const int t0 = row0 < MLAT ? (row0 & (TL - 1)) : ((row0 - MLAT) & (TCX - 1));
        __syncthreads();
        if (hh != h) {
            const float* gup = IN(28) + (size_t)e * 128 * 512 + 64 * hh;
            for (int idx = tid; idx < 128 * 64; idx += NTHR) { const int j = idx >> 6, k = idx & 63; GUT[k * 128 + j] = f2bf(gup[(size_t)j * 512 + k]); }
        }
        {
            const int j = tid & 127, tq = wid >> 1; const float muj = mu[1792 + j];
            float zz[18];
#pragma unroll
            for (int q = 0; q < 18; ++q) {
                const int t = t0 + 16 * tq - 1 + q; const bool ok = (t >= 0) && (t < L); const int tc = t < 0 ? 0 : (t > L - 1 ? L - 1 : t);
                const float a = bf2f(ZR[(size_t)(row0 - t0 + tc) * 1920 + 1792 + j]); zz[q] = ok ? a : 0.f;
            }
#pragma unroll
            for (int i = 0; i < 16; ++i) SGb[(16 * tq + i) * 128 + j] = f2bf(sigm(zz[i + 1] + muj * (0.5f * (zz[i] + zz[i + 2]) - zz[i + 1])));
        }
        float ov[8], vv[8], bon[8];
        const float gngh = hh == h ? gng : IN(32)[e * 512 + 64 * hh + lane], gnbh = hh == h ? gnb : IN(33)[e * 512 + 64 * hh + lane], muvh = hh == h ? muv : mu[1024 + 64 * hh + lane];
        {
            float zv[10];
#pragma unroll
            for (int q = 0; q < 10; ++q) {
                const int t = t0 + 8 * wid - 1 + q; const bool ok = (t >= 0) && (t < L); const int tc = t < 0 ? 0 : (t > L - 1 ? L - 1 : t);
                const float a = bf2f(ZR[(size_t)(row0 - t0 + tc) * 1920 + 1024 + 64 * hh + lane]); zv[q] = ok ? a : 0.f;
            }
#pragma unroll
            for (int i = 0; i < 8; ++i) {
                const int row = row0 + 8 * wid + i;
                ov[i] = bf2f(ORW[(size_t)row * 512 + 64 * hh + lane]) + bf2f(ORW[(size_t)(MTOT + row) * 512 + 64 * hh + lane]);
                vv[i] = zv[i + 1] + muvh * (0.5f * (zv[i] + zv[i + 2]) - zv[i + 1]);
                bon[i] = BON[(size_t)row * 8 + hh] + BON[(size_t)(MTOT + row) * 8 + hh];
            }
        }
        __syncthreads();
        {
            f32x4 c0 = (f32x4){0.f, 0.f, 0.f, 0.f}, c1 = (f32x4){0.f, 0.f, 0.f, 0.f};
#pragma unroll
            for (int ks = 0; ks < 4; ++ks) {
                const bf16x8 af = *(const bf16x8*)(SGb + (16 * tr + r16) * 128 + 32 * ks + 8 * g4);
                const bf16x8 b0 = *(const bf16x8*)(GUT + (16 * tcb + r16) * 128 + 32 * ks + 8 * g4), b1 = *(const bf16x8*)(GUT + (16 * (tcb + 1) + r16) * 128 + 32 * ks + 8 * g4);
                c0 = __builtin_amdgcn_mfma_f32_16x16x32_bf16(af, b0, c0, 0, 0, 0); c1 = __builtin_amdgcn_mfma_f32_16x16x32_bf16(af, b1, c1, 0, 0, 0);
            }
#pragma unroll
            for (int q = 0; q < 4; ++q) { GG[(16 * tr + 4 * g4 + q) * 64 + 16 * tcb + r16] = c0[q]; GG[(16 * tr + 4 * g4 + q) * 64 + 16 * (tcb + 1) + r16] = c1[q]; }
        }
        __syncthreads();
        float gg[8];
#pragma unroll
        for (int i = 0; i < 8; ++i) gg[i] = GG[(8 * wid + i) * 64 + lane];
#pragma unroll
        for (int i = 0; i < 8; ++i) {
            const int row = row0 + 8 * wid + i;
            const float mean = wsum(ov[i]) * (1.f / 64.f); const float dd = ov[i] - mean; const float var = wsum(dd * dd) * (1.f / 64.f);
            const float y = dd * rsqrtf(var + 64e-5f) * gngh + gnbh;
            YM[(size_t)row * D + 512 + 64 * hh + lane] = f2bf((y + bon[i] * vv[i]) * gg[i]);
        }
    }
    __syncthreads();
    for (int it = bid_; it < 4608; it += gdim_) {
        const int tb = it >> 3, cb = it & 7; const int row0 = tb * 64;
#pragma unroll
        for (int i = 0; i < 8; ++i) { const int cc = wid + 8 * i; TT[cc * 72 + lane] = YT[(size_t)(cb * 64 + cc) * MTOT + row0 + lane]; }
        __syncthreads();
#pragma unroll
        for (int i = 0; i < 8; ++i) { const int tau = wid + 8 * i; YM[(size_t)(row0 + tau) * D + cb * 64 + lane] = TT[lane * 72 + tau]; }
        __syncthreads();
    }
}
__device__ __forceinline__ void gla_phase(const Params& p, int o_idx, unsigned char* smem) {
    PH_PRO
    const int item = bid_; if (item >= 256) return;
    const int xcd_ = item & 7, jx_ = item >> 3;
    const int b = 2 * xcd_ + (jx_ >> 4), h = (jx_ >> 2) & 3, d = (jx_ >> 1) & 1, dvh = jx_ & 1;
    const int tid = tid_, lane = tid & 63, wid = __builtin_amdgcn_readfirstlane(tid >> 6), r = lane & 15, g = lane >> 4;
    constexpr int QST = 136, SST = 68;
    bf16_t* QS = (bf16_t*)smem;
    bf16_t* KS = QS + 64 * QST;
    bf16_t* ST = KS + 64 * QST;
    bf16_t* KST = ST + 128 * QST;
    bf16_t* VT = KST + 128 * SST;
    bf16_t* PP = VT + 128 * SST;
    float* GD = (float*)(PP + 64 * SST);
    float* DL = GD + 64 * 16;
    float* E1 = DL + 128;
    float* E2 = E1 + 128;
    float* TOT = E2 + 128;
    float* BR = TOT + 512;
    int* ROWS = (int*)(BR + 128);
    const bf16_t* Z = (const bf16_t*)(WS_ + WS_BIG);
    bf16_t* OG = d ? (bf16_t*)OUT_ : (bf16_t*)(WS_ + WS_BIG + BIG_OGL);
    const float qscale = 0.08838834764831845f;
    const int k = tid & 127, tq = wid >> 1, tr = wid >> 1, tcb = 4 * (wid & 1);
    auto rowof = [&](int c, int tau) -> int {
        const int seg = c >= 4; const int L = seg ? TL : TCX; const int pf = (seg ? c - 4 : c) * 64 + tau; const int pp = d ? (L - 1 - pf) : pf;
        return seg ? (b * TL + (pp & 31) * 64 + (pp >> 5)) : (MLAT + b * TCX + pp);
    };
    bf16_t nq[16], nk[16], nv[16], ngd[2];
    auto prefetch = [&](int c) {
        const long r0 = rowof(c, 16 * tq); const long st = (long)(c >= 4 ? 64 : 1) * (d ? -1 : 1) * 3104;
        const bf16_t* zb = Z + r0 * 3104 + 128 * h + k;
#pragma unroll
        for (int i = 0; i < 16; ++i) { const bf16_t* zr = zb + i * st; nq[i] = zr[0]; nk[i] = zr[512]; nv[i] = zr[1024 + 128 * h + 128 * dvh]; }
#pragma unroll
        for (int i = 0; i < 2; ++i) { const int idx = tid + NTHR * i; ngd[i] = Z[(size_t)rowof(c, idx >> 4) * 3104 + 2048 + 16 * d + (idx & 15)]; }
    };
    f32x4 Sacc[8];
#pragma unroll
    for (int j = 0; j < 8; ++j) Sacc[j] = (f32x4){0.f, 0.f, 0.f, 0.f};
    float gu[16];
    {
        const float* gup_g = IN(36) + (size_t)(o_idx * 2 + d) * 16 * 512 + 128 * h + k;
#pragma unroll
        for (int j = 0; j < 16; ++j) gu[j] = gup_g[(size_t)j * 512];
    }
    const float gbv = IN(37)[(o_idx * 2 + d) * 512 + 128 * h + k];
    prefetch(0);
#pragma unroll 1
    for (int c = 0; c < 36; ++c) {
        __syncthreads();
        if (tid < 64) ROWS[tid] = rowof(c, tid);
#pragma unroll
        for (int i = 0; i < 2; ++i) GD[tid + NTHR * i] = bf2f(ngd[i]);
#pragma unroll
        for (int i = 0; i < 16; ++i) VT[k * SST + 16 * tq + i] = nv[i];
        bf16_t cq[16], ck[16];
#pragma unroll
        for (int i = 0; i < 16; ++i) { cq[i] = nq[i]; ck[i] = nk[i]; }
        __syncthreads();
        if (c + 1 < 36) prefetch(c + 1);
        float bl[16]; float run = 0.f;
#pragma unroll
        for (int i = 0; i < 16; ++i) {
            const float4* gd4 = (const float4*)(GD + (16 * tq + i) * 16);
            const float4 g0 = gd4[0], g1 = gd4[1], g2 = gd4[2], g3 = gd4[3];
            float a = gbv + g0.x * gu[0] + g0.y * gu[1] + g0.z * gu[2] + g0.w * gu[3] + g1.x * gu[4] + g1.y * gu[5] + g1.z * gu[6] + g1.w * gu[7]
                    + g2.x * gu[8] + g2.y * gu[9] + g2.z * gu[10] + g2.w * gu[11] + g3.x * gu[12] + g3.y * gu[13] + g3.z * gu[14] + g3.w * gu[15];
            run -= __logf(1.f + __expf(-a)) * (1.f / 16.f);
            bl[i] = run;
        }
        TOT[tq * 128 + k] = run; if (tq == 2) BR[k] = bl[0];
        __syncthreads();
        {
            const float t0 = TOT[k], t1 = TOT[128 + k], t2 = TOT[256 + k], t3 = TOT[384 + k];
            const float off = tq == 0 ? 0.f : (tq == 1 ? t0 : (tq == 2 ? t0 + t1 : t0 + t1 + t2));
            const float bref = BR[k] + t0 + t1, blast = t0 + t1 + t2 + t3;
            if (tq == 0) { DL[k] = __expf(blast); E1[k] = __expf(bref); E2[k] = __expf(blast - bref); }
#pragma unroll
            for (int i = 0; i < 16; ++i) {
                const int tau = 16 * tq + i;
                const float bb = bl[i] + off; const float ef = __expf(bb - bref);
                const bf16_t ksv = f2bf(bf2f(ck[i]) * __builtin_amdgcn_rcpf(ef));
                QS[tau * QST + k] = f2bf(bf2f(cq[i]) * qscale * ef); KS[tau * QST + k] = ksv; KST[k * SST + tau] = ksv;
            }
        }
        __syncthreads();
        {
            float e1v[4];
#pragma unroll
            for (int q = 0; q < 4; ++q) e1v[q] = E1[16 * wid + 4 * g + q];
#pragma unroll
            for (int j = 0; j < 8; ++j) {
                uint2 o; o.x = pk2(Sacc[j][0] * e1v[0], Sacc[j][1] * e1v[1]); o.y = pk2(Sacc[j][2] * e1v[2], Sacc[j][3] * e1v[3]);
                *(uint2*)(ST + (16 * j + r) * QST + 16 * wid + 4 * g) = o;
            }
        }
        f32x4 sc[2];
#pragma unroll
        for (int j = 0; j < 2; ++j) sc[j] = (f32x4){0.f, 0.f, 0.f, 0.f};
#pragma unroll
        for (int ks = 0; ks < 4; ++ks) {
            const bf16x8 af = *(const bf16x8*)(QS + (16 * tr + r) * QST + 32 * ks + 8 * g);
#pragma unroll
            for (int j = 0; j < 2; ++j) {
                const bf16x8 bfr = *(const bf16x8*)(KS + (16 * (2 * (wid & 1) + j) + r) * QST + 32 * ks + 8 * g);
                sc[j] = __builtin_amdgcn_mfma_f32_16x16x32_bf16(af, bfr, sc[j], 0, 0, 0);
            }
        }
#pragma unroll
        for (int j = 0; j < 2; ++j) {
            const int sidx = 16 * (2 * (wid & 1) + j) + r;
#pragma unroll
            for (int q = 0; q < 4; ++q) { const int ci = 16 * tr + 4 * g + q; PP[ci * SST + sidx] = f2bf(sidx <= ci ? sc[j][q] : 0.f); }
        }
        __syncthreads();
        f32x4 oc[4];
#pragma unroll
        for (int j = 0; j < 4; ++j) oc[j] = (f32x4){0.f, 0.f, 0.f, 0.f};
#pragma unroll
        for (int ks = 0; ks < 2; ++ks) {
            const bf16x8 af = ld8(PP + (16 * tr + r) * SST + 32 * ks + 8 * g);
#pragma unroll
            for (int j = 0; j < 4; ++j) {
                const bf16x8 bfr = ld8(VT + (16 * (tcb + j) + r) * SST + 32 * ks + 8 * g);
                oc[j] = __builtin_amdgcn_mfma_f32_16x16x32_bf16(af, bfr, oc[j], 0, 0, 0);
            }
        }
#pragma unroll
        for (int ks = 0; ks < 4; ++ks) {
            const bf16x8 af = *(const bf16x8*)(QS + (16 * tr + r) * QST + 32 * ks + 8 * g);
#pragma unroll
            for (int j = 0; j < 4; ++j) {
                const bf16x8 bfr = *(const bf16x8*)(ST + (16 * (tcb + j) + r) * QST + 32 * ks + 8 * g);
                oc[j] = __builtin_amdgcn_mfma_f32_16x16x32_bf16(af, bfr, oc[j], 0, 0, 0);
            }
        }
#pragma unroll
        for (int j = 0; j < 4; ++j) {
            const int dv = 16 * (tcb + j) + r;
#pragma unroll
            for (int q = 0; q < 4; ++q) OG[(size_t)ROWS[16 * tr + 4 * g + q] * D + 256 * h + 128 * dvh + dv] = f2bf(oc[j][q]);
        }
        {
            f32x4 kv[8];
#pragma unroll
            for (int j = 0; j < 8; ++j) kv[j] = (f32x4){0.f, 0.f, 0.f, 0.f};
#pragma unroll
            for (int ks = 0; ks < 2; ++ks) {
                const bf16x8 af = ld8(KST + (16 * wid + r) * SST + 32 * ks + 8 * g);
#pragma unroll
                for (int j = 0; j < 8; ++j) {
                    const bf16x8 bfr = ld8(VT + (16 * j + r) * SST + 32 * ks + 8 * g);
                    kv[j] = __builtin_amdgcn_mfma_f32_16x16x32_bf16(af, bfr, kv[j], 0, 0, 0);
                }
            }
            float dl[4], e2[4];
#pragma unroll
            for (int q = 0; q < 4; ++q) { dl[q] = DL[16 * wid + 4 * g + q]; e2[q] = E2[16 * wid + 4 * g + q]; }
#pragma unroll
            for (int j = 0; j < 8; ++j)
#pragma unroll
                for (int q = 0; q < 4; ++q) Sacc[j][q] = Sacc[j][q] * dl[q] + e2[q] * kv[j][q];
        }
    }
    __syncthreads();
}

__device__ __forceinline__ void odd_readout_phase(const Params& p, int o_idx) {
    PH_PRO
    const int lane = tid_ & 63, wid = tid_ >> 6;
    const bf16_t* Z = (const bf16_t*)(WS_ + WS_BIG);
    const bf16_t* OGL = (const bf16_t*)(WS_ + WS_BIG + BIG_OGL);
    const bf16_t* OGB = (const bf16_t*)OUT_;
    bf16_t* YM = (bf16_t*)(WS_ + WS_A);
    const float4 ng = *(const float4*)(IN(38) + o_idx * 256 + 4 * lane);
    for (int row = bid_ * 8 + wid; row < MTOT; row += gdim_ * 8) {
        uint2 ovs[4], ows[4], gvs[4];
#pragma unroll
        for (int hh = 0; hh < 4; ++hh) {
            ovs[hh] = *(const uint2*)(OGL + (size_t)row * D + 256 * hh + 4 * lane);
            ows[hh] = *(const uint2*)(OGB + (size_t)row * D + 256 * hh + 4 * lane);
            gvs[hh] = *(const uint2*)(Z + (size_t)row * 3104 + 2080 + 256 * hh + 4 * lane);
        }
#pragma unroll
        for (int hh = 0; hh < 4; ++hh) {
            const uint2 ov = ovs[hh], ow = ows[hh], gv = gvs[hh];
            const float o0 = __uint_as_float(ov.x << 16) + __uint_as_float(ow.x << 16), o1 = __uint_as_float(ov.x & 0xffff0000u) + __uint_as_float(ow.x & 0xffff0000u), o2 = __uint_as_float(ov.y << 16) + __uint_as_float(ow.y << 16), o3 = __uint_as_float(ov.y & 0xffff0000u) + __uint_as_float(ow.y & 0xffff0000u);
            const float g0 = __uint_as_float(gv.x << 16), g1 = __uint_as_float(gv.x & 0xffff0000u), g2 = __uint_as_float(gv.y << 16), g3 = __uint_as_float(gv.y & 0xffff0000u);
            const float ms = wsum(o0 * o0 + o1 * o1 + o2 * o2 + o3 * o3) * (1.f / 256.f);
            const float rs = rsqrtf(ms + 1e-5f);
            uint2 y; y.x = pk2(o0 * rs * ng.x * silu_(g0), o1 * rs * ng.y * silu_(g1)); y.y = pk2(o2 * rs * ng.z * silu_(g2), o3 * rs * ng.w * silu_(g3));
            *(uint2*)(YM + (size_t)row * D + 256 * hh + 4 * lane) = y;
        }
    }
}

#ifndef REP_UP
#define REP_UP 1
#endif
#ifndef REP_SCAN
#define REP_SCAN 1
#endif
#ifndef REP_GLA
#define REP_GLA 1
#endif
#ifndef REP_HY
#define REP_HY 1
#endif
#define REPEAT(n) for (int rep_ = 0, nrep_ = ({ int t_ = (n); asm volatile("" : "+s"(t_)); t_; }); rep_ < nrep_; ++rep_)
#ifndef REP_LN
#define REP_LN 1
#endif
#ifndef REP_MISC
#define REP_MISC 1
#endif
#ifndef REP_SYNC
#define REP_SYNC 1
#endif
#define GSYNC() do { for (int s_ = 0; s_ < REP_SYNC; ++s_) { XcdBarrier xb_; xb_.bar = (unsigned*)IN(40); xb_.x = xb_xcc_id(); xb_.st = (volatile XB_LAS unsigned*)(smem_g + TBL_OFF + 448); xcd_barrier(xb_); } } while (0)
#define LAUNDER() do { bid_ = blockIdx.x; asm volatile("" : "+s"(bid_)); gdim_ = gridDim.x; asm volatile("" : "+s"(gdim_)); } while (0)
__global__ void __launch_bounds__(NTHR, 2) mega(Params p) {
    unsigned char* smem = smem_g;
    cg::grid_group grid = cg::this_grid();
    int bid_, gdim_; LAUNDER();
    if (threadIdx.x == 0) {
        const float** tb = (const float**)(smem_g + TBL_OFF);
#pragma unroll
        for (int i = 0; i < 41; ++i) tb[i] = p.in[i];
        *(uint4*)(smem_g + TBL_OFF + 448) = make_uint4(0u, 0u, 0u, 0u);
    }
    unsigned* bar_ = (unsigned*)p.in[40];
    if (blockIdx.x == 0) for (int i = threadIdx.x; i < XCD_BAR_WORDS; i += NTHR) bar_[i] = 0u;
    __syncthreads();
    grid.sync();
    (void)xcd_barrier_post(bar_, (volatile XB_LAS unsigned*)(smem_g + TBL_OFF + 448));
    REPEAT(REP_MISC) {
    phase_mod(p, smem);
    __syncthreads();
    conv_weights(p, 0, smem);
    filt_gen(p, smem);
    GSYNC();
    }
    row_phase(p, 0, 0, 0, 0, 0, false);
    GSYNC();
#pragma unroll 1
    for (int l = 0; l < 4; ++l) {
#pragma unroll 1
        for (int f = 0; f < 2; ++f) {
            if (f == 1) {
                if (!(l & 1)) {
                    const int e = l >> 1;
                    REPEAT(REP_HY) {
                    LAUNDER();
                    { EpiStore E; E.O = (bf16_t*)(WS_ + WS_BIG); E.ldc = MTOT; E.nvalid = MTOT; run_gemm(smem, (const bf16_t*)(WS_ + WS_WIN), (const bf16_t*)(WS_ + WS_A), 1536, MTOT, 1024, E, bid_, gdim_); }
                    LAUNDER();
                    { EpiStore E; E.O = (bf16_t*)(WS_ + WS_BIG + BIG_ZR); E.ldc = 1920; E.nvalid = 1920; run_gemm(smem, (const bf16_t*)(WS_ + WS_A), (const bf16_t*)(WS_ + WS_WIN) + (size_t)1536 * 1024, MTOT, 2048, 1024, E, gdim_ - 1 - bid_, gdim_); }
                    GSYNC();
                    hyena_phase(p, e, smem);
                    if (rep_ + 1 < nrep_) GSYNC();
                    }
                    REPEAT(REP_SCAN) rwkv_scan_phase(p, e, smem);
                    GSYNC();
                    REPEAT(REP_MISC) even_readout_phase(p, e, smem);
                    GSYNC();
                } else {
                    const int o = l >> 1;
                    LAUNDER();
                    { EpiStore E; E.O = (bf16_t*)(WS_ + WS_BIG); E.ldc = 3104; E.nvalid = 3104; run_gemm(smem, (const bf16_t*)(WS_ + WS_A), (const bf16_t*)(WS_ + WS_WIN), MTOT, 3328, 1024, E, bid_, gdim_); }
                    GSYNC();
                    REPEAT(REP_GLA) gla_phase(p, o, smem);
                    GSYNC();
                    REPEAT(REP_MISC) odd_readout_phase(p, o);
                    GSYNC();
                }
                LAUNDER();
                { EpiResid E; E.gate_off = l * 17 * 9216 + 5 * 1024; E.wgt = 1.0f; E.ln_idx = l * 3 + 0; E.pm_off = 0; run_gemm(smem, (const bf16_t*)(WS_ + WS_A), (const bf16_t*)(WS_ + WS_WOUT), l == 3 ? MLAT : MTOT, 1024, 1024, E, bid_, gdim_); }
                GSYNC();
                REPEAT(REP_LN) row_phase(p, 1, l, 1, l, 6, false, l == 3 ? MLAT : MTOT);
                GSYNC();
            }
            const bool latonly = (l == 3 && f == 1);
#pragma unroll 1
            for (int s = 0; s < 4; ++s) {
                if (s == 3 && latonly) break;
                LAUNDER();
                if ((s == 1) || (s == 2 && !latonly && bid_ < 64)) {
                    const int part = s - 1;
                    EpiResid E; E.gate_off = l * 17 * 9216 + (f ? 8 : 2) * 1024; E.wgt = 0.5f; E.ln_idx = f ? (l * 3 + 1) : (l * 3 - 1); E.pm_off = part ? 128 : 0;
                    run_gemm(smem, (const bf16_t*)(WS_ + WS_BIG) + (size_t)part * MLAT * FF, (const bf16_t*)(WS_ + WS_WDN) + (size_t)f * 1024 * FF, part ? MCTX : MLAT, 1024, FF, E, bid_, part ? 64 : gdim_);
                }
                if (s == 0 || (s == 1 && !latonly)) {
                    LAUNDER();
                    EpiSwiglu E; E.G = (bf16_t*)(WS_ + WS_BIG); E.pm_off = s ? 128 : 0;
                    run_gemm(smem, (const bf16_t*)(WS_ + WS_A) + (size_t)s * MLAT * 1024, (const bf16_t*)(WS_ + WS_WUP) + (size_t)f * 5632 * 1024, s ? MCTX : MLAT, 5632, 1024, E, bid_, gdim_);
                }
                if (s == 2) {
                    if (latonly) row_phase(p, 1, l, 2, 0, 0, true);
                    else if (bid_ >= 64) { if (f == 0) row_phase(p, 1, l, 0, l, 3, false, MLAT, 0, 64, gdim_ - 64); else row_phase(p, 1, l, 2, l + 1, 0, false, MLAT, 0, 64, gdim_ - 64); }
                }
                if (s == 3) {
                    if (f == 0) row_phase(p, 1, l, 0, l, 3, false, MTOT, MLAT);
                    else { if (l < 3) { row_phase(p, 1, l, 2, l + 1, 0, false, MTOT, MLAT); conv_weights(p, l + 1, smem); } else row_phase(p, 1, l, 2, 0, 0, false, MTOT, MLAT); }
                }
                GSYNC();
            }
        }
    }
}

extern "C" void kernel_launch(void* const* d_in, const int* in_sizes, int n_in, void* d_out, int out_size, void* d_ws, size_t ws_size, hipStream_t stream) {
    static int grid = 0;
    if (grid == 0) {
        if (n_in != 39 || ws_size < WS_END) { fprintf(stderr, "kernel_launch: need 39 inputs and %zu bytes of workspace; got %d, %zu\n", (size_t)WS_END, n_in, ws_size); grid = -1; return; }
        int dev = 0, cus = 0, per_cu = 0;
        (void)hipGetDevice(&dev);
        (void)hipDeviceGetAttribute(&cus, hipDeviceAttributeMultiprocessorCount, dev);
        if (hipFuncSetAttribute((const void*)mega, hipFuncAttributeMaxDynamicSharedMemorySize, LDS_BYTES) != hipSuccess) { fprintf(stderr, "kernel_launch: hipFuncSetAttribute failed\n"); grid = -1; return; }
        (void)hipOccupancyMaxActiveBlocksPerMultiprocessor(&per_cu, (const void*)mega, NTHR, LDS_BYTES);
        if (per_cu < 1) fprintf(stderr, "kernel_launch: occupancy query says %d blocks/CU\n", per_cu);
        (void)hipGetLastError();
        grid = cus;
        if (grid > 256) grid = 256;
    }
    if (grid < 0) return;
    Params p{};
    for (int i = 0; i < 39; ++i) p.in[i] = (const float*)d_in[i];
    p.in[39] = (const float*)d_out; p.in[40] = (const float*)d_ws;
    void* args[] = {&p};
    hipError_t e = hipLaunchCooperativeKernel((const void*)mega, dim3(grid), dim3(NTHR), args, LDS_BYTES, stream);
    if (e != hipSuccess) fprintf(stderr, "cooperative launch failed: %s (grid %d)\n", hipGetErrorString(e), grid);
}
```

```cpp
#include <hip/hip_runtime.h>
#include <hip/hip_cooperative_groups.h>
#include <cstdio>
namespace pg8 {
#define PG8_LAS __attribute__((address_space(3)))
typedef unsigned short bf16_t;
typedef short bf16x8 __attribute__((ext_vector_type(8)));
typedef float f32x4 __attribute__((ext_vector_type(4)));
typedef unsigned u32x4 __attribute__((ext_vector_type(4)));
constexpr int BM = 256, BK = 64, HALF = 128, HTB = HALF * BK * 2  , STAGE_BYTES = 8 * HTB, NXCD = 8, WGM = 4;

__host__ __device__ __forceinline__ int lds_byte(int r, int c) { const int st = (r >> 4) * 2 + (c >> 5), rr = r & 15, cc = c & 31, ob = rr * 64 + cc * 2; return st * 1024 + (ob ^ (((ob >> 9) & 1) << 5)); }
__host__ __device__ __forceinline__ void stage_rc(int b, int& R, int& C) { const int st = b / 1024, sb = b % 1024, swz = sb ^ (((sb >> 9) & 1) << 5); R = (st >> 1) * 16 + swz / 64; C = (st & 1) * 32 + (swz % 64) / 2; }
__host__ __device__ __forceinline__ int perm32(int rho) { const int n = rho >> 4, i = rho & 15; return 8 * (i >> 2) + 4 * n + (i & 3); }

struct Unit { int pm, pn; };
struct Gemm { const bf16_t* A; const bf16_t* Bt; int M, N, K; };

struct StaticOrder {
    int nM, nN, nwg, G, c;
    __host__ __device__ void init(int M, int N, int G_, int c_) { nM = M / BM; nN = N / BM; nwg = nM * nN; G = G_; c = c_; }
    __host__ __device__ bool next(int i, Unit& u) const {
        const long L = (long)i * G + c; if (L >= nwg) return false;
        int wgid = (int)L; { const int q = nwg / NXCD, r = nwg % NXCD, xcd = wgid % NXCD, off = wgid / NXCD; wgid = (xcd < r ? xcd * (q + 1) : r * (q + 1) + (xcd - r) * q) + off; }
        const int nig = WGM * nN, gid = wgid / nig, fm = gid * WGM, gsz = (nM - fm) < WGM ? (nM - fm) : WGM;
        u.pm = fm + ((wgid % nig) % gsz); u.pn = (wgid % nig) / gsz; return true;
    }
    __device__ __forceinline__ void a_ready(const Unit&) const {}
    __device__ __forceinline__ void done(const Unit&) const {}
};
__device__ __forceinline__ unsigned cvt_pk_bf16(float lo, float hi) { unsigned r; asm volatile("v_cvt_pk_bf16_f32 %0, %1, %2" : "=v"(r) : "v"(lo), "v"(hi)); return r; }
typedef float f32x2 __attribute__((ext_vector_type(2)));

template <class Epi, class Sched, bool STAMP = false>
__device__ __forceinline__ void gemm_phase(PG8_LAS unsigned char* lds, const Gemm g, const Sched& S, const Epi& E, unsigned long long* stamps) {
    int tid_l_ = threadIdx.x; asm volatile("" : "+v"(tid_l_)); const int tid = tid_l_, wid = __builtin_amdgcn_readfirstlane(tid >> 6), lane = tid & 63, wr = wid >> 2, wc = wid & 3, fr = lane & 15, fq = lane >> 4;
    const int K = g.K, nt = K / BK;
    int ts_lo = 0, ts_hi = 0, nts = 0; const unsigned long long rt_entry = STAMP ? (unsigned long long)wall_clock64() : 0ull;
#define PG8_STAMP() do { if (STAMP && wid == 0 && nts < 64) { const unsigned long long _c = (unsigned long long)clock64(); \
        ts_lo = (lane == nts) ? (int)(unsigned)_c : ts_lo; ts_hi = (lane == nts) ? (int)(unsigned)(_c >> 32) : ts_hi; ++nts; } } while (0)
    PG8_STAMP();
    unsigned voffA[2], voffB[2];
#pragma unroll
    for (int i = 0; i < 2; ++i) { int R, C; stage_rc(tid * 16 + i * 8192, R, C); const int Rb = Epi::PERM ? ((R & ~31) + perm32(R & 31)) : R;
        voffA[i] = (unsigned)(R * K + C) * 2u; voffB[i] = (unsigned)(Rb * K + C) * 2u; }
    const size_t kstep = (size_t)(BK * 2);
    const size_t hstep = (size_t)HALF * K * 2;
    const size_t tstep = 2 * hstep;
    const unsigned ldsw = (unsigned)wid * 1024u;
    const int aoff = lds_byte(wr * 64 + fr, fq * 8), boff = lds_byte(wc * 32 + fr, fq * 8);
#define PG8_SA(b, h) (((b) * 2 + (h)) * HTB)
#define PG8_SB(b, h) ((4 + (b) * 2 + (h)) * HTB)
#define PG8_STAGE(bufoff, gbase, voff) do { _Pragma("unroll") for (int _i = 0; _i < 2; ++_i) \
        __builtin_amdgcn_global_load_lds((const unsigned*)((const char*)(gbase) + (voff)[_i]), (PG8_LAS unsigned*)(lds + (bufoff) + ldsw + _i * 8192), 16, 0, 0); } while (0)
#define PG8_LDA(dst, b, h) do { _Pragma("unroll") for (int m = 0; m < 4; ++m) _Pragma("unroll") for (int k = 0; k < 2; ++k) dst[m][k] = *(const PG8_LAS bf16x8*)(lds + PG8_SA(b, h) + aoff + m * 2048 + k * 1024); } while (0)
#define PG8_LDB(dst, b, h) do { _Pragma("unroll") for (int n = 0; n < 2; ++n) _Pragma("unroll") for (int k = 0; k < 2; ++k) dst[n][k] = *(const PG8_LAS bf16x8*)(lds + PG8_SB(b, h) + boff + n * 2048 + k * 1024); } while (0)
#define PG8_MMA(ai, bj, At, Bt) do { __builtin_amdgcn_s_setprio(1); _Pragma("unroll") for (int m = 0; m < 4; ++m) _Pragma("unroll") for (int n = 0; n < 2; ++n) _Pragma("unroll") for (int k = 0; k < 2; ++k) \
        acc[ai][bj][m][n] = __builtin_amdgcn_mfma_f32_16x16x32_bf16(Bt[n][k], At[m][k], acc[ai][bj][m][n], 0, 0, 0); __builtin_amdgcn_s_setprio(0); } while (0)
#define PG8_WAIT_V(n) asm volatile("s_waitcnt vmcnt(" #n ")" ::: "memory")
#define PG8_WAIT_L(n) asm volatile("s_waitcnt lgkmcnt(" #n ")" ::: "memory")
#define PG8_BAR __builtin_amdgcn_s_barrier()
#define PG8_SCHED __builtin_amdgcn_sched_barrier(0)
    Unit cur, nxt; int ui = 0;
    if (!S.next(0, cur)) return;
    f32x4 acc[2][2][4][2];
#pragma unroll
    for (int a = 0; a < 2; ++a)
#pragma unroll
        for (int b = 0; b < 2; ++b)
#pragma unroll
            for (int m = 0; m < 4; ++m)
#pragma unroll
                for (int n = 0; n < 2; ++n) acc[a][b][m][n] = (f32x4){0.f, 0.f, 0.f, 0.f};
    bf16x8 At[4][2], B0[2][2], B1[2][2];
    const char* cA = (const char*)g.A + (size_t)cur.pm * tstep; const char* cB = (const char*)g.Bt + (size_t)cur.pn * tstep;
    S.a_ready(cur);
    PG8_STAGE(PG8_SB(0, 0), cB, voffB); PG8_STAGE(PG8_SA(0, 0), cA, voffA); PG8_STAGE(PG8_SB(0, 1), cB + hstep, voffB); PG8_STAGE(PG8_SA(0, 1), cA + hstep, voffA);
    if (wr == 1) PG8_BAR;
    PG8_WAIT_V(4); PG8_BAR;
    PG8_STAGE(PG8_SB(1, 0), cB + kstep, voffB); PG8_STAGE(PG8_SA(1, 0), cA + kstep, voffA); PG8_STAGE(PG8_SB(1, 1), cB + hstep + kstep, voffB);
    PG8_WAIT_V(6); PG8_BAR;
    PG8_STAMP();
    for (;;) {
        const bool has_next = S.next(ui + 1, nxt);
        const char* nA = has_next ? (const char*)g.A + (size_t)nxt.pm * tstep : cA; const char* nB = has_next ? (const char*)g.Bt + (size_t)nxt.pn * tstep : cB;
        for (int t = 0; t < nt; t += 2) {
            const bool last = (t == nt - 2);
            const char* a1 = cA + (size_t)(t + 1) * kstep;
            const char* a2 = last ? nA : cA + (size_t)(t + 2) * kstep; const char* b2 = last ? nB : cB + (size_t)(t + 2) * kstep;
            const char* a3 = a2 + kstep; const char* b3 = b2 + kstep;
            if (last && has_next) S.a_ready(nxt);
            PG8_LDB(B0, 0, 0); PG8_SCHED; PG8_LDA(At, 0, 0); PG8_STAGE(PG8_SA(1, 1), a1 + hstep, voffA);
            PG8_WAIT_L(8); PG8_BAR; PG8_WAIT_L(0); PG8_MMA(0, 0, At, B0); PG8_BAR; PG8_SCHED;
            PG8_LDB(B1, 0, 1); PG8_STAGE(PG8_SB(0, 0), b2, voffB);
            PG8_BAR; PG8_WAIT_L(0); PG8_MMA(0, 1, At, B1); PG8_BAR;
            PG8_LDA(At, 0, 1); PG8_STAGE(PG8_SA(0, 0), a2, voffA);
            PG8_BAR; PG8_WAIT_L(0); PG8_MMA(1, 0, At, B0); PG8_BAR; PG8_SCHED;
            PG8_STAGE(PG8_SB(0, 1), b2 + hstep, voffB);
            PG8_WAIT_V(6); PG8_BAR; PG8_MMA(1, 1, At, B1); PG8_BAR;
            PG8_LDB(B0, 1, 0); PG8_SCHED; PG8_LDA(At, 1, 0); PG8_STAGE(PG8_SA(0, 1), a2 + hstep, voffA);
            PG8_WAIT_L(8); PG8_BAR; PG8_WAIT_L(0); PG8_MMA(0, 0, At, B0); PG8_BAR; PG8_SCHED;
            PG8_LDB(B1, 1, 1); PG8_STAGE(PG8_SB(1, 0), b3, voffB);
            PG8_BAR; PG8_WAIT_L(0); PG8_MMA(0, 1, At, B1); PG8_BAR;
            PG8_LDA(At, 1, 1); PG8_STAGE(PG8_SA(1, 0), a3, voffA);
            PG8_BAR; PG8_WAIT_L(0); PG8_MMA(1, 0, At, B0); PG8_BAR; PG8_SCHED;
            PG8_STAGE(PG8_SB(1, 1), b3 + hstep, voffB);
            PG8_WAIT_V(6); PG8_BAR; PG8_MMA(1, 1, At, B1); PG8_BAR;
        }
        PG8_STAMP();
        if constexpr (!Epi::AFTER_DRAIN) { E(acc, cur, wr, wc, fr, fq); S.done(cur); }
        PG8_STAMP();
        if (!has_next) break;
#pragma unroll
        for (int a = 0; a < 2; ++a)
#pragma unroll
            for (int b = 0; b < 2; ++b)
#pragma unroll
                for (int m = 0; m < 4; ++m)
#pragma unroll
                    for (int n = 0; n < 2; ++n) acc[a][b][m][n] = (f32x4){0.f, 0.f, 0.f, 0.f};
        cur = nxt; cA = nA; cB = nB; ++ui;
    }
    PG8_WAIT_V(0);
    if (wr == 0) PG8_BAR;
    PG8_BAR;
    if constexpr (Epi::AFTER_DRAIN) { E.fused(acc, cur, wr, wc, fr, fq, lds, wid, lane); S.done(cur); }
    PG8_STAMP();
    if (STAMP && wid == 0) { stamps[lane] = lane < nts ? (((unsigned long long)(unsigned)ts_hi << 32) | (unsigned)ts_lo) : 0ull;
        if (lane == 62) stamps[62] = rt_entry; if (lane == 63) stamps[63] = (unsigned long long)wall_clock64(); }
#undef PG8_STAMP
#undef PG8_SA
#undef PG8_SB
#undef PG8_STAGE
#undef PG8_LDA
#undef PG8_LDB
#undef PG8_MMA
#undef PG8_WAIT_V
#undef PG8_WAIT_L
#undef PG8_BAR
#undef PG8_SCHED
}
}
#define XB_TMO      128
#define XB_XCNT(j)  (256  + 64 * (j))
#define XB_XSUB(j)  (1280 + 64 * (j))
#define XB_XGEN(j)  (2304 + 64 * (j))
#define XB_TOP      3328
#define XB_TOPGEN   3392
#define XCD_BAR_WORDS 3456
#define XB_SPIN_CAP (1u << 18)
#define XB_LAS __attribute__((address_space(3)))

__device__ __forceinline__ unsigned xb_ld(unsigned* p)              { return __hip_atomic_load(p, __ATOMIC_RELAXED, __HIP_MEMORY_SCOPE_AGENT); }
__device__ __forceinline__ unsigned xb_add(unsigned* p, unsigned v) { return __hip_atomic_fetch_add(p, v, __ATOMIC_RELAXED, __HIP_MEMORY_SCOPE_AGENT); }
__device__ __forceinline__ unsigned xb_xcc_id() { return (unsigned)__builtin_amdgcn_s_getreg((3 << 11) | 20) & 0xFu; }
#define XB_SPIN(cond, bar) do { unsigned _sp = 0; while (cond) { __builtin_amdgcn_s_sleep(1); \
    if ((++_sp & 255u) == 0u) { if (xb_ld(&(bar)[XB_TMO])) break; if (_sp > XB_SPIN_CAP) { atomicAdd(&(bar)[XB_TMO], 1u); break; } } } } while (0)

struct XcdBarrier {
    unsigned* bar; unsigned x;
    volatile XB_LAS unsigned* st;
};

__device__ __forceinline__ XcdBarrier xcd_barrier_post(unsigned* bar, volatile XB_LAS unsigned* st) {
    XcdBarrier b; b.bar = bar; b.x = xb_xcc_id(); b.st = st;
    if (threadIdx.x == 0) (void)xb_add(&bar[XB_XCNT(b.x)], 1u);
    return b;
}
__device__ __forceinline__ void xcd_barrier_complete(unsigned* bar, unsigned x, unsigned& nloc, unsigned& nx) {
    const unsigned G = gridDim.x * gridDim.y * gridDim.z;
    unsigned sum, cnt, mine, sp = 0u;
    for (;;) {
        sum = 0u; cnt = 0u; mine = 0u;
#pragma unroll
        for (unsigned j = 0; j < 16; ++j) { const unsigned c = xb_ld(&bar[XB_XCNT(j)]); sum += c; cnt += (c > 0u) ? 1u : 0u; mine = (j == x) ? c : mine; }
        if (sum == G) break;
        __builtin_amdgcn_s_sleep(1);
        if ((++sp & 255u) == 0u) { if (xb_ld(&bar[XB_TMO])) break; if (sp > XB_SPIN_CAP) { atomicAdd(&bar[XB_TMO], 1u); break; } }
    }
    nloc = mine > 0u ? mine : 1u; nx = cnt > 0u ? cnt : 1u;
}

__device__ __forceinline__ void xcd_barrier(const XcdBarrier& b) {
    asm volatile("s_waitcnt vmcnt(0)" ::: "memory");
    __syncthreads();
    if (threadIdx.x == 0) {
        unsigned* bar = b.bar;
        __builtin_amdgcn_s_waitcnt(0);
        unsigned nloc = b.st[0], nx = b.st[1];
        if (nloc == 0u) { xcd_barrier_complete(bar, b.x, nloc, nx); b.st[0] = nloc; b.st[1] = nx; }
        const unsigned old = xb_add(&bar[XB_XSUB(b.x)], 1u);
        const unsigned gen = old / nloc;
        if (old + 1u == (gen + 1u) * nloc) {
            __builtin_amdgcn_fence(__ATOMIC_RELEASE, "agent");
            asm volatile("s_waitcnt vmcnt(0)" ::: "memory");
            const unsigned og = xb_add(&bar[XB_TOP], 1u);
            const unsigned tg = og / nx;
            if (og + 1u == (tg + 1u) * nx) xb_add(&bar[XB_TOPGEN], 1u);
            else XB_SPIN(xb_ld(&bar[XB_TOPGEN]) == tg, bar);
            __builtin_amdgcn_fence(__ATOMIC_ACQUIRE, "agent");
            xb_add(&bar[XB_XGEN(b.x)], 1u);
            asm volatile("s_waitcnt vmcnt(0)" ::: "memory");
        } else {
            XB_SPIN(xb_ld(&bar[XB_XGEN(b.x)]) == gen, bar);
            __builtin_amdgcn_fence(__ATOMIC_ACQUIRE, "agent");
            asm volatile("s_waitcnt vmcnt(0)" ::: "memory");
        }
    }
    __syncthreads();
}

namespace cg = cooperative_groups;
typedef unsigned short bf16_t;
using pg8::bf16x8; using pg8::f32x4;
#define LAS __attribute__((address_space(3)))

constexpr int D = 1024, NB = 16, TL = 2048, TCX = 256, FF = 2816;
constexpr int MLAT = NB * TL, MCTX = NB * TCX, MTOT = MLAT + MCTX;
constexpr float DN_ALPHA = 1.681792830507429f;
constexpr int NTHR = 512;
constexpr int LDS_BYTES = 155648;

constexpr size_t al256(size_t x) { return (x + 255) & ~(size_t)255; }
constexpr size_t WS_MOD = 16384;
constexpr size_t WS_FT = al256(WS_MOD + (size_t)4 * 17 * 9216 * 4);
constexpr size_t FT_LAT = (size_t)2 * 512 * 4096, FT_CTX = (size_t)2 * 512 * 512, FT_E = FT_LAT + FT_CTX;
constexpr size_t WS_WUP = al256(WS_FT + 2 * FT_E * 2);
constexpr size_t WS_WDN = WS_WUP + (size_t)2 * 5632 * 1024 * 2;
constexpr size_t WS_WIN = WS_WDN + (size_t)2 * 1024 * 2816 * 2;
constexpr size_t WS_WOUT = WS_WIN + (size_t)3584 * 1024 * 2;
constexpr size_t WS_H = WS_WOUT + (size_t)1024 * 1024 * 2;
constexpr size_t WS_A = WS_H + (size_t)MTOT * 1024 * 4;
constexpr size_t WS_BON = WS_A + (size_t)MTOT * 1024 * 2;
constexpr size_t WS_STATS = al256(WS_BON + (size_t)2 * MTOT * 8 * 4);
constexpr size_t WS_BIG = al256(WS_STATS + (size_t)MTOT * 2 * 4);
constexpr size_t BIG_ZR = (size_t)1536 * MTOT * 2;
constexpr size_t BIG_ORW = BIG_ZR + (size_t)MTOT * 1920 * 2;
constexpr size_t BIG_EVEN_END = BIG_ORW + (size_t)2 * MTOT * 512 * 2;
constexpr size_t BIG_OGL = al256((size_t)MTOT * 3104 * 2);
constexpr size_t WS_END = WS_BIG + BIG_EVEN_END;

struct Params { const float* in[41]; };
#define PH_PRO int tid_ = threadIdx.x; asm volatile("" : "+v"(tid_)); int bid_ = blockIdx.x; asm volatile("" : "+s"(bid_)); int gdim_ = gridDim.x; asm volatile("" : "+s"(gdim_));
extern __shared__ __attribute__((aligned(16))) unsigned char smem_g[];
constexpr int TBL_OFF = LDS_BYTES - 512;
typedef const float __attribute__((address_space(1)))* gfptr_;
#define IN(i) ((const float*)(((const gfptr_*)(smem_g + TBL_OFF))[i]))
#define OUT_ ((float*)IN(39))
#define WS_ ((unsigned char*)IN(40))

__device__ __forceinline__ float bf2f(bf16_t b) { return __uint_as_float(((unsigned)b) << 16); }
typedef __bf16 bf16x2_t_ __attribute__((ext_vector_type(2)));
typedef float f32x2_t_ __attribute__((ext_vector_type(2)));
__device__ __forceinline__ unsigned pk2(float lo, float hi) { f32x2_t_ v = {lo, hi}; bf16x2_t_ b = __builtin_convertvector(v, bf16x2_t_); return __builtin_bit_cast(unsigned, b); }
__device__ __forceinline__ bf16_t f2bf(float f) { return (bf16_t)(pk2(f, 0.f) & 0xffffu); }
__device__ __forceinline__ bf16x8 ld8(const bf16_t* p) { const uint2 a = *(const uint2*)p, b = *(const uint2*)(p + 4); uint4 v; v.x = a.x; v.y = a.y; v.z = b.x; v.w = b.y; return __builtin_bit_cast(bf16x8, v); }
#define DPPF(v, ctrl) __builtin_bit_cast(float, __builtin_amdgcn_update_dpp(0, __builtin_bit_cast(int, (v)), (ctrl), 0xF, 0xF, true))
__device__ __forceinline__ float wsum(float v) {
    v += DPPF(v, 0xB1); v += DPPF(v, 0x4E); v += DPPF(v, 0x141); v += DPPF(v, 0x140);
    const int iv = __builtin_bit_cast(int, v);
    return __builtin_bit_cast(float, __builtin_amdgcn_readlane(iv, 0)) + __builtin_bit_cast(float, __builtin_amdgcn_readlane(iv, 16)) +
           __builtin_bit_cast(float, __builtin_amdgcn_readlane(iv, 32)) + __builtin_bit_cast(float, __builtin_amdgcn_readlane(iv, 48));
}
__device__ __forceinline__ float sigm(float x) { return __builtin_amdgcn_rcpf(1.f + __expf(-x)); }
__device__ __forceinline__ float silu_(float x) { return x * __builtin_amdgcn_rcpf(1.f + __expf(-x)); }
__device__ __forceinline__ float softplus_(float y) { return fmaxf(y, 0.f) + __logf(1.f + __expf(-fabsf(y))); }
__device__ __forceinline__ float tanh_(float x) { return 1.f - 2.f * __builtin_amdgcn_rcpf(1.f + __expf(2.f * x)); }

struct EpiStore {
    static constexpr bool PERM = true, AFTER_DRAIN = false;
    bf16_t* O; int ldc; int nvalid;
    __device__ __forceinline__ void operator()(const f32x4 (&acc)[2][2][4][2], const pg8::Unit& u, int wr, int wc, int fr, int fq) const {
        const int row0 = u.pm * 256 + wr * 64 + fr, col0 = u.pn * 256 + wc * 32 + 8 * fq;
#pragma unroll
        for (int ai = 0; ai < 2; ++ai)
#pragma unroll
            for (int m = 0; m < 4; ++m) {
                bf16_t* rowp = O + (size_t)(row0 + ai * 128 + m * 16) * ldc;
#pragma unroll
                for (int bj = 0; bj < 2; ++bj) {
                    const int col = col0 + bj * 128;
                    if (col < nvalid) {
                        const f32x4 v0 = acc[ai][bj][m][0], v1 = acc[ai][bj][m][1];
                        uint4 o; o.x = pk2(v0[0], v0[1]); o.y = pk2(v0[2], v0[3]); o.z = pk2(v1[0], v1[1]); o.w = pk2(v1[2], v1[3]);
                        *(uint4*)(rowp + col) = o;
                    }
                }
            }
    }
};
struct EpiSwiglu {
    static constexpr bool PERM = true, AFTER_DRAIN = false;
    bf16_t* G; int pm_off;
    __device__ __forceinline__ void operator()(const f32x4 (&acc)[2][2][4][2], const pg8::Unit& u, int wr, int wc, int fr, int fq) const {
        const int row0 = (u.pm + pm_off) * 256 + wr * 64 + fr, col0 = u.pn * 128 + wc * 32 + 8 * fq;
#pragma unroll
        for (int ai = 0; ai < 2; ++ai)
#pragma unroll
            for (int m = 0; m < 4; ++m) {
                bf16_t* rowp = G + (size_t)(row0 + ai * 128 + m * 16) * FF + col0;
                float o[8];
#pragma unroll
                for (int n = 0; n < 2; ++n)
#pragma unroll
                    for (int e = 0; e < 4; ++e) o[n * 4 + e] = silu_(acc[ai][0][m][n][e]) * acc[ai][1][m][n][e];
                uint4 q; q.x = pk2(o[0], o[1]); q.y = pk2(o[2], o[3]); q.z = pk2(o[4], o[5]); q.w = pk2(o[6], o[7]);
                *(uint4*)rowp = q;
            }
    }
};
struct EpiResid {
    static constexpr bool PERM = false, AFTER_DRAIN = false;
    int gate_off; float wgt; int ln_idx; int pm_off;
    __device__ __forceinline__ void operator()(const f32x4 (&acc)[2][2][4][2], const pg8::Unit& u, int wr, int wc, int fr, int fq) const {
        float* H = (float*)(WS_ + WS_H); const float* gate = (const float*)(WS_ + WS_MOD) + gate_off;
        const float* stats = ln_idx >= 0 ? (const float*)(WS_ + WS_STATS) : nullptr;
        const float* Hin = ln_idx >= 0 ? H : ((u.pm + pm_off) < 128 ? IN(0) : IN(2) - (size_t)MLAT * D);
        const float* lg = IN(6) + (ln_idx < 0 ? 0 : ln_idx) * 1024; const float* lb = IN(7) + (ln_idx < 0 ? 0 : ln_idx) * 1024;
        const int gpm = u.pm + pm_off;
        const int row0 = gpm * 256 + wr * 64 + fr, col0 = u.pn * 256 + wc * 32 + 4 * fq;
        const int midx = gpm < 128 ? (gpm >> 3) : 16;
        const float* gp = gate + (size_t)midx * 9216 + col0;
        float mu[2][4], rs[2][4];
#pragma unroll
        for (int ai = 0; ai < 2; ++ai)
#pragma unroll
            for (int m = 0; m < 4; ++m) {
                if (stats) { const float2 st = *(const float2*)(stats + 2 * (size_t)(row0 + ai * 128 + m * 16)); mu[ai][m] = st.x; rs[ai][m] = st.y; }
                else { mu[ai][m] = 0.f; rs[ai][m] = 1.f; }
            }
#pragma unroll
        for (int bj = 0; bj < 2; ++bj)
#pragma unroll
            for (int n = 0; n < 2; ++n) {
                const int co = bj * 128 + n * 16;
                const f32x4 gvv = *(const f32x4*)(gp + co) * wgt;
                f32x4 g4 = (f32x4){1.f, 1.f, 1.f, 1.f}, b4 = (f32x4){0.f, 0.f, 0.f, 0.f};
                if (stats) { g4 = *(const f32x4*)(lg + col0 + co); b4 = *(const f32x4*)(lb + col0 + co); }
#pragma unroll
                for (int ai = 0; ai < 2; ++ai)
#pragma unroll
                    for (int m = 0; m < 4; ++m) {
                        float* rowp = H + (size_t)(row0 + ai * 128 + m * 16) * D + col0 + co;
                        f32x4 h = *(const f32x4*)(Hin + (size_t)(row0 + ai * 128 + m * 16) * D + col0 + co);
                        h = (h - mu[ai][m]) * rs[ai][m] * g4 + b4;
                        h = h * DN_ALPHA + gvv * acc[ai][bj][m][n];
                        *(f32x4*)rowp = h;
                    }
            }
    }
};

template <class Epi>
__device__ __forceinline__ void run_gemm(unsigned char* smem, const bf16_t* A, const bf16_t* Bt, int M, int N, int K, const Epi& E, int bid_, int gdim_) {
    pg8::Gemm g; g.A = A; g.Bt = Bt; g.M = M; g.N = N; g.K = K;
    pg8::StaticOrder S; S.init(M, N, gdim_, bid_);
    pg8::gemm_phase<Epi, pg8::StaticOrder, false>((PG8_LAS unsigned char*)smem, g, S, E, nullptr);
}

__device__ __forceinline__ void phase_mod(const Params& p, unsigned char* smem) {
    PH_PRO
    float* s = (float*)smem;
    float* part = s + 17 * 1024;
    const int tid = tid_;
    const float* c = IN(1); const float* cc = IN(3);
    float* MOD = (float*)(WS_ + WS_MOD);
    if (bid_ >= 288) return;
    for (int idx = tid; idx < 17 * 1024; idx += NTHR) { const int i = idx >> 10, k = idx & 1023; const float v = i < 16 ? c[i * 1024 + k] : cc[k]; s[idx] = silu_(v); }
    __syncthreads();
    for (int item = bid_; item < 288; item += gdim_) {
        const int l = item / 72, j0 = (item % 72) * 128;
        const int col = tid & 127, kq = tid >> 7;
        const float* w = IN(4) + ((size_t)l * 1024 + kq * 256) * 9216 + j0 + col;
        float acc[17];
#pragma unroll
        for (int i = 0; i < 17; ++i) acc[i] = 0.f;
        for (int k = 0; k < 256; ++k) {
            const float wv = w[(size_t)k * 9216];
#pragma unroll
            for (int i = 0; i < 17; ++i) acc[i] += s[i * 1024 + kq * 256 + k] * wv;
        }
#pragma unroll
        for (int i = 0; i < 17; ++i) part[(kq * 17 + i) * 128 + col] = acc[i];
        __syncthreads();
        for (int idx = tid; idx < 17 * 128; idx += NTHR) {
            const int i = idx >> 7, cl = idx & 127;
            const float v = part[(0 * 17 + i) * 128 + cl] + part[(1 * 17 + i) * 128 + cl] + part[(2 * 17 + i) * 128 + cl] + part[(3 * 17 + i) * 128 + cl] + IN(5)[l * 9216 + j0 + cl];
            MOD[((size_t)l * 17 + i) * 9216 + j0 + cl] = v;
        }
        __syncthreads();
    }
}

__device__ __forceinline__ void conv_tile(const float* src, int ld, int nvalid, bf16_t* dst, int ldd, float* tile) {
    PH_PRO
    const int tid = tid_;
#pragma unroll
    for (int i = 0; i < 2; ++i) {
        const int k = (tid >> 4) + 32 * i, c4 = (tid & 15) * 4;
        float4 v = make_float4(0.f, 0.f, 0.f, 0.f);
        if (c4 < nvalid) v = *(const float4*)(src + (size_t)k * ld + c4);
        tile[k * 65 + c4] = v.x; tile[k * 65 + c4 + 1] = v.y; tile[k * 65 + c4 + 2] = v.z; tile[k * 65 + c4 + 3] = v.w;
    }
    __syncthreads();
    const int n = tid >> 3, ks = (tid & 7) * 8;
    uint4 o;
    o.x = pk2(tile[(ks + 0) * 65 + n], tile[(ks + 1) * 65 + n]); o.y = pk2(tile[(ks + 2) * 65 + n], tile[(ks + 3) * 65 + n]);
    o.z = pk2(tile[(ks + 4) * 65 + n], tile[(ks + 5) * 65 + n]); o.w = pk2(tile[(ks + 6) * 65 + n], tile[(ks + 7) * 65 + n]);
    *(uint4*)(dst + (size_t)n * ldd + ks) = o;
    __syncthreads();
}
__device__ __forceinline__ void conv_weights(const Params& p, int l, unsigned char* smem) {
    PH_PRO
    float* tile = (float*)smem;
    const bool even = !(l & 1); const int eo = l >> 1;
    const int NIN = even ? 3456 : 3104, nint = (even ? 3584 : 3328) / 64;
    const int total = 2816 + 1408 + nint * 16 + 256;
    bf16_t* WUP = (bf16_t*)(WS_ + WS_WUP); bf16_t* WDN = (bf16_t*)(WS_ + WS_WDN); bf16_t* WIN = (bf16_t*)(WS_ + WS_WIN); bf16_t* WOUT = (bf16_t*)(WS_ + WS_WOUT);
    for (int idx = bid_; idx < total; idx += gdim_) {
        if (idx < 2816) {
            const int f = idx / 1408, r = idx % 1408, nt = r / 16, kt = r % 16, n0 = nt * 64;
            const int pn = n0 >> 8, bj = (n0 & 255) >> 7, j = n0 & 127, col = pn * 128 + j;
            const float* src = (bj ? IN(9) : IN(8)) + ((size_t)(l * 2 + f) * 1024 + kt * 64) * FF + col;
            conv_tile(src, FF, 64, WUP + ((size_t)f * 5632 + n0) * 1024 + kt * 64, 1024, tile);
        } else if (idx < 4224) {
            int r = idx - 2816; const int f = r / 704; r %= 704; const int kt = r / 16, nt = r % 16;
            const float* src = IN(10) + ((size_t)(l * 2 + f) * FF + kt * 64) * 1024 + nt * 64;
            conv_tile(src, 1024, 64, WDN + ((size_t)f * 1024 + nt * 64) * FF + kt * 64, FF, tile);
        } else if (idx < 4224 + nint * 16) {
            const int r = idx - 4224, nt = r / 16, kt = r % 16, n0 = nt * 64;
            int nv = NIN - n0; nv = nv < 0 ? 0 : (nv > 64 ? 64 : nv);
            const float* src = (even ? IN(11) : IN(34)) + ((size_t)eo * 1024 + kt * 64) * NIN + n0;
            conv_tile(src, NIN, nv, WIN + (size_t)n0 * 1024 + kt * 64, 1024, tile);
        } else {
            const int r = idx - 4224 - nint * 16, nt = r / 16, kt = r % 16;
            const float* src = (even ? IN(12) : IN(35)) + ((size_t)eo * 1024 + kt * 64) * 1024 + nt * 64;
            conv_tile(src, 1024, 64, WOUT + (size_t)nt * 64 * 1024 + kt * 64, 1024, tile);
        }
    }
}

__device__ __forceinline__ void filt_gen(const Params& p, unsigned char* smem) {
    PH_PRO
    float* z = (float*)smem;
    float* h1 = z + 64 * 33;
    float* h2 = h1 + 64 * 65;
    const int tid = tid_, lane = tid & 63, wid = __builtin_amdgcn_readfirstlane(tid >> 6);
    bf16_t* FT = (bf16_t*)(WS_ + WS_FT);
    for (int item = (bid_ + gdim_ / 2) % gdim_; item < 2 * 36 * 4; item += gdim_) {
        const int e = item / 144; int r = item % 144; const int cg = r & 3; r >>= 2;
        const int seg = r >= 32; const int jb = seg ? r - 32 : r;
        const int L = seg ? 256 : 2048;
        const float* w1 = IN(15) + e * 33 * 64; const float* b1 = IN(16) + e * 64; const float* f1 = IN(17) + e * 64;
        const float* w2 = IN(18) + e * 64 * 64; const float* b2 = IN(19) + e * 64; const float* f2 = IN(20) + e * 64;
        const float* w3 = IN(21) + (size_t)e * 64 * 2048; const float* skip = IN(22) + e * 1024;
        __syncthreads();
        for (int idx = tid; idx < 64 * 33; idx += NTHR) {
            const int jj = idx / 33, i = idx % 33; const int j = jb * 64 + jj;
            float v;
            if (i == 0) v = (float)j / (float)(L - 1);
            else { const int bi = (i - 1) & 15; const float f = 1e-4f + (float)bi * ((15.f - 1e-4f) / 15.f); const float w = 6.283185307179586f * (float)j / (float)L; v = (i <= 16) ? cosf(f * w) : -sinf(f * w); }
            z[idx] = v;
        }
        __syncthreads();
        for (int idx = tid; idx < 4096; idx += NTHR) {
            const int jj = idx >> 6, o = idx & 63; float a = b1[o];
            for (int i = 0; i < 33; ++i) a += z[jj * 33 + i] * w1[i * 64 + o];
            h1[jj * 65 + o] = sinf(f1[o] * a);
        }
        __syncthreads();
        for (int idx = tid; idx < 4096; idx += NTHR) {
            const int jj = idx >> 6, o = idx & 63; float a = b2[o];
            for (int k = 0; k < 64; ++k) a += h1[jj * 65 + k] * w2[k * 64 + o];
            h2[jj * 65 + o] = sinf(f2[o] * a);
        }
        __syncthreads();
        bf16_t* base = FT + (size_t)e * FT_E + (seg ? FT_LAT : 0);
#pragma unroll 1
        for (int ps = 0; ps < 2; ++ps) {
            const int col0 = cg * 512 + ps * 256 + 4 * lane;
            float acc[8][4];
#pragma unroll
            for (int i = 0; i < 8; ++i)
#pragma unroll
                for (int c = 0; c < 4; ++c) acc[i][c] = 0.f;
#pragma unroll 4
            for (int k = 0; k < 64; ++k) {
                const float4 wv = *(const float4*)(w3 + (size_t)k * 2048 + col0);
#pragma unroll
                for (int i = 0; i < 8; ++i) { const float hv = h2[(8 * wid + i) * 65 + k]; acc[i][0] += hv * wv.x; acc[i][1] += hv * wv.y; acc[i][2] += hv * wv.z; acc[i][3] += hv * wv.w; }
            }
            const int ord = col0 >> 10, dir = (col0 >> 9) & 1;
            const float lo = -4.605170185988091f / 1.5f, hi = -4.605170185988091f / 0.3f;
#pragma unroll
            for (int c = 0; c < 4; ++c) {
                const int ch = (col0 + c) & 511;
                const float adl = fabsf(lo + (hi - lo) * (float)ch / 511.f);
                bf16_t* fp = base + ((size_t)ord * 512 + ch) * (2 * L);
#pragma unroll
                for (int i = 0; i < 8; ++i) {
                    const int j = jb * 64 + 8 * wid + i; const float tj = (float)j / (float)(L - 1);
                    float v = acc[i][c] * __expf(-tj * adl);
                    if (dir == 0 && j == 0) v += skip[ord * 512 + ch];
                    if (!(dir == 1 && j == 0)) fp[dir == 0 ? (L - 1 - j) : (L - 1 + j)] = f2bf(v);
                }
            }
        }
    }
    __syncthreads();
}

__device__ __forceinline__ void row_phase(const Params& p, int mode, int l_ln, int which, int l_mod, int sidx, bool fin, int nrows_in = MTOT, int row_begin = 0, int blk_off = 0, int nblk_in = 0) {
    PH_PRO
    const int lane = tid_ & 63, wid = tid_ >> 6;
    float* H = (float*)(WS_ + WS_H); bf16_t* A = (bf16_t*)(WS_ + WS_A);
    const float* MOD = (const float*)(WS_ + WS_MOD);
    const float* lg = IN(6) + (l_ln * 3 + which) * 1024; const float* lb = IN(7) + (l_ln * 3 + which) * 1024;
    const int nrows = fin ? MLAT : nrows_in;
    constexpr int RU = 1;
    const int nblk = nblk_in ? nblk_in : gdim_;
    for (int rowb = row_begin + (bid_ - blk_off) * 8 + wid; rowb < nrows; rowb += nblk * 8 * RU) {
        float4 v[RU][4]; int rows[RU]; bool okr[RU];
#pragma unroll
        for (int u = 0; u < RU; ++u) {
            const int row = rowb + u * nblk * 8; okr[u] = row < nrows; rows[u] = okr[u] ? row : rowb;
            const float* src = mode ? H + (size_t)rows[u] * D : (rows[u] < MLAT ? IN(0) + (size_t)rows[u] * D : IN(2) + (size_t)(rows[u] - MLAT) * D);
#pragma unroll
            for (int i = 0; i < 4; ++i) v[u][i] = *(const float4*)(src + 4 * lane + 256 * i);
        }
#pragma unroll
        for (int u = 0; u < RU; ++u) {
            const int row = rows[u];
            if (mode) {
                float s = 0.f;
#pragma unroll
                for (int i = 0; i < 4; ++i) s += v[u][i].x + v[u][i].y + v[u][i].z + v[u][i].w;
                const float mu = wsum(s) * (1.f / 1024.f);
                float q = 0.f;
#pragma unroll
                for (int i = 0; i < 4; ++i) { v[u][i].x -= mu; v[u][i].y -= mu; v[u][i].z -= mu; v[u][i].w -= mu; q += v[u][i].x * v[u][i].x + v[u][i].y * v[u][i].y + v[u][i].z * v[u][i].z + v[u][i].w * v[u][i].w; }
                const float rstd = rsqrtf(wsum(q) * (1.f / 1024.f) + 1e-6f);
                if (lane == 0 && !fin && okr[u]) *(float2*)((float*)(WS_ + WS_STATS) + 2 * (size_t)row) = make_float2(mu, rstd);
#pragma unroll
                for (int i = 0; i < 4; ++i) {
                    const float4 g = *(const float4*)(lg + 4 * lane + 256 * i), b = *(const float4*)(lb + 4 * lane + 256 * i);
                    v[u][i].x = v[u][i].x * rstd * g.x + b.x; v[u][i].y = v[u][i].y * rstd * g.y + b.y; v[u][i].z = v[u][i].z * rstd * g.z + b.z; v[u][i].w = v[u][i].w * rstd * g.w + b.w;
                }
            }
            if (!okr[u]) continue;
            if (fin) {
#pragma unroll
                for (int i = 0; i < 4; ++i) *(float4*)(OUT_ + (size_t)row * D + 4 * lane + 256 * i) = v[u][i];
            } else {
                const int midx = row < MLAT ? (row >> 11) : 16;
                const float* mp = MOD + ((size_t)l_mod * 17 + midx) * 9216 + sidx * 1024;
#pragma unroll
                for (int i = 0; i < 4; ++i) {
                    const float4 sh = *(const float4*)(mp + 4 * lane + 256 * i), sc = *(const float4*)(mp + 1024 + 4 * lane + 256 * i);
                    uint2 o; o.x = pk2(v[u][i].x * (1.f + sc.x) + sh.x, v[u][i].y * (1.f + sc.y) + sh.y); o.y = pk2(v[u][i].z * (1.f + sc.z) + sh.z, v[u][i].w * (1.f + sc.w) + sh.w);
                    *(uint2*)(A + (size_t)row * D + 4 * lane + 256 * i) = o;
                }
            }
        }
    }
}
template <int L>
__device__ __forceinline__ void hyena_item(const Params& p, int e, int c, int segbase, const bf16_t* ft, unsigned char* smem) {
    PH_PRO
    constexpr int CPS = 2 * L + 16, UTS = L + 8, TPW = (L / 16) / 8;
    bf16_t* COP = (bf16_t*)smem;
    bf16_t* UT = COP + 8 * CPS;
    const int tid = tid_, lane = tid & 63, wid = tid >> 6;
    bf16_t* ZHT = (bf16_t*)(WS_ + WS_BIG);
    bf16_t* zv = ZHT + (size_t)c * MTOT + segbase;
    const bf16_t* zx1 = ZHT + (size_t)(512 + c) * MTOT + segbase;
    const bf16_t* zx2 = ZHT + (size_t)(1024 + c) * MTOT + segbase;
    const float* cw = IN(13) + e * 3 * 1536; const float* cbp = IN(14) + e * 1536;
    const float vw0 = cw[c], vw1 = cw[1536 + c], vw2 = cw[3072 + c], vb = cbp[c];
    const float aw0 = cw[512 + c], aw1 = cw[1536 + 512 + c], aw2 = cw[3072 + 512 + c], ab = cbp[512 + c];
    const float bw0 = cw[1024 + c], bw1 = cw[1536 + 1024 + c], bw2 = cw[3072 + 1024 + c], bb = cbp[1024 + c];
    auto conv4 = [&](const bf16_t* q, int t0, float w0, float w1, float w2, float bias, float (&y)[4]) {
        const uint2 mid = *(const uint2*)(q + t0);
        float zm = bf2f(q[t0 > 0 ? t0 - 1 : 0]); zm = t0 > 0 ? zm : 0.f;
        float zq = bf2f(q[t0 + 4 < L ? t0 + 4 : L - 1]); zq = t0 + 4 < L ? zq : 0.f;
        const float z0 = __uint_as_float(mid.x << 16), z1 = __uint_as_float(mid.x & 0xffff0000u), z2 = __uint_as_float(mid.y << 16), z3 = __uint_as_float(mid.y & 0xffff0000u);
        y[0] = zm * w0 + z0 * w1 + z1 * w2 + bias; y[1] = z0 * w0 + z1 * w1 + z2 * w2 + bias;
        y[2] = z1 * w0 + z2 * w1 + z3 * w2 + bias; y[3] = z2 * w0 + z3 * w1 + zq * w2 + bias;
    };
#pragma unroll 4
    for (int idx = tid; idx < 4 * L; idx += NTHR) {
        const int b = idx / (L / 4), s4 = (idx % (L / 4)) * 4;
        float y[4]; conv4(zv + b * L, s4, vw0, vw1, vw2, vb, y);
        uint2 o; o.x = pk2(y[0], y[1]); o.y = pk2(y[2], y[3]);
        *(uint2*)(UT + b * UTS + s4) = o;
    }
    const int r = lane & 15, g = lane >> 4, a = 7 - (r & 7);
    const bf16_t* cop_a = COP + a * CPS;
    f32x4 acc[TPW];
#pragma unroll 1
    for (int ord = 0; ord < 2; ++ord) {
        const bf16_t* fo = ft + ((size_t)ord * 512 + c) * (2 * L);
        for (int cidx = tid; cidx < (2 * L) / 8; cidx += NTHR) {
            const uint4 raw = *(const uint4*)(fo + 8 * cidx);
            unsigned short v[8] = {(unsigned short)(raw.x & 0xffffu), (unsigned short)(raw.x >> 16), (unsigned short)(raw.y & 0xffffu), (unsigned short)(raw.y >> 16),
                                   (unsigned short)(raw.z & 0xffffu), (unsigned short)(raw.z >> 16), (unsigned short)(raw.w & 0xffffu), (unsigned short)(raw.w >> 16)};
            if (cidx == (2 * L) / 8 - 1) v[7] = 0;
#pragma unroll
            for (int ca = 0; ca < 8; ++ca)
#pragma unroll
                for (int j = 0; j < 8; ++j) { const int x = 8 * cidx - ca + j; COP[ca * CPS + (x < 0 ? 0 : x)] = v[j]; }
        }
        __syncthreads();
#pragma unroll
        for (int i = 0; i < TPW; ++i) acc[i] = (f32x4){0.f, 0.f, 0.f, 0.f};
        if constexpr (TPW == 16) {
            const bf16_t* fbase = cop_a + (8 * g - r + L - 1 - a) - wid * 256;
            bf16x8 F[16];
#pragma unroll
            for (int dd = -15; dd <= 0; ++dd) F[dd & 15] = *(const bf16x8*)(fbase + 16 * dd);
#pragma unroll 1
            for (int S0 = 0; S0 < L / 32; S0 += 8) {
#pragma unroll
                for (int u = 0; u < 8; ++u) {
                    const int S = S0 + u;
                    if (S > 0) { F[(2 * u) & 15] = *(const bf16x8*)(fbase + 32 * S); F[(2 * u - 1) & 15] = *(const bf16x8*)(fbase + 32 * S - 16); }
                    const bf16x8 bfr = *(const bf16x8*)(UT + r * UTS + 32 * S + 8 * g);
#pragma unroll
                    for (int i = 0; i < 16; ++i) acc[i] = __builtin_amdgcn_mfma_f32_16x16x32_bf16(F[(2 * u - i) & 15], bfr, acc[i], 0, 0, 0);
                }
            }
        } else {
        for (int s0 = 0; s0 < L; s0 += 32) {
            const bf16x8 bfr = *(const bf16x8*)(UT + r * UTS + s0 + 8 * g);
#pragma unroll
            for (int i = 0; i < TPW; ++i) {
                const int t0 = (wid * TPW + i) * 16;
                const int n8 = s0 - t0 + 8 * g - r + L - 1 - a;
                const bf16x8 afr = *(const bf16x8*)(cop_a + n8);
                acc[i] = __builtin_amdgcn_mfma_f32_16x16x32_bf16(afr, bfr, acc[i], 0, 0, 0);
            }
        }
        }
        __syncthreads();
        int rl = r * L, tb0 = wid * TPW * 16 + 4 * g; asm volatile("" : "+v"(rl), "+v"(tb0));
        if (ord == 0) {
#pragma unroll
            for (int i = 0; i < TPW; ++i) {
                const int t0 = tb0 + i * 16;
                float y[4]; conv4(zx1 + rl, t0, aw0, aw1, aw2, ab, y);
                uint2 o; o.x = pk2(y[0] * acc[i][0], y[1] * acc[i][1]); o.y = pk2(y[2] * acc[i][2], y[3] * acc[i][3]);
                *(uint2*)(UT + r * UTS + t0) = o;
                if ((i & 3) == 3) __builtin_amdgcn_sched_barrier(0);
            }
        } else {
#pragma unroll
            for (int i = 0; i < TPW; ++i) {
                const int t0 = tb0 + i * 16;
                float y[4]; conv4(zx2 + rl, t0, bw0, bw1, bw2, bb, y);
                uint2 o; o.x = pk2(y[0] * acc[i][0], y[1] * acc[i][1]); o.y = pk2(y[2] * acc[i][2], y[3] * acc[i][3]);
                *(uint2*)(zv + rl + t0) = o;
                if ((i & 3) == 3) __builtin_amdgcn_sched_barrier(0);
            }
        }
    }
    __syncthreads();
}
__device__ __forceinline__ void hyena_phase(const Params& p, int e, unsigned char* smem) {
    PH_PRO
    const bf16_t* FT = (const bf16_t*)(WS_ + WS_FT) + (size_t)e * FT_E;
    for (int item = bid_; item < 1024; item += gdim_) {
        if (item < 512) hyena_item<2048>(p, e, item, 0, FT, smem);
        else hyena_item<256>(p, e, item - 512, MLAT, FT + FT_LAT, smem);
    }
}

__device__ __forceinline__ void rwkv_scan_phase(const Params& p, int e, unsigned char* smem) {
    PH_PRO
    const int chain = bid_; if (chain >= 256) return;
    const int xcd_ = chain & 7, jx_ = chain >> 3;
    const int b = 2 * xcd_ + (jx_ >> 4), d = (jx_ >> 3) & 1, h = jx_ & 7;
    const int tid = tid_, lane = tid & 63, wid = tid >> 6;
    bf16_t* WUPT = (bf16_t*)smem;
    bf16_t* AUPT = WUPT + 4096;
    float* sBONp = (float*)(AUPT + 4096);
    constexpr int SOPS = 336;
    float* sOP = (float*)smem + 8192;
    float* sR = sOP;
    float* sKK = sR + 4096;
    float* sW = sKK + 4096;
    float* sKD = sW + 4096;
    float* sKKA = sKD + 4096;
    float* sV = sOP + 64 * SOPS;
    float* sO = sV + 4096;
    bf16_t* TWb = (bf16_t*)sO;
    bf16_t* ADb = TWb + 4096;
    const bf16_t* ZR = (const bf16_t*)(WS_ + WS_BIG + BIG_ZR);
    bf16_t* ORW = (bf16_t*)(WS_ + WS_BIG + BIG_ORW) + (size_t)d * MTOT * 512;
    float* BON = (float*)(WS_ + WS_BON) + (size_t)d * MTOT * 8;
    const float* mu = IN(23) + e * 1920;
    const float* w0 = IN(24) + (e * 2 + d) * 512 + 64 * h;
    const float* a0 = IN(26) + (e * 2 + d) * 512 + 64 * h;
    const float* wup_g = IN(25) + (size_t)(e * 2 + d) * 64 * 512 + 64 * h;
    const float* aup_g = IN(27) + (size_t)(e * 2 + d) * 64 * 512 + 64 * h;
    const float kk_c = IN(29)[e * 512 + 64 * h + lane];
    const float mu_r = mu[64 * h + lane], mu_k = mu[512 + 64 * h + lane], mu_v = mu[1024 + 64 * h + lane], mu_w = mu[1536 + 64 * d + lane], mu_a = mu[1664 + 64 * d + lane];
    for (int idx = tid; idx < 4096; idx += NTHR) { const int j = idx >> 6, k = idx & 63; WUPT[k * 64 + j] = f2bf(wup_g[(size_t)j * 512 + k]); AUPT[k * 64 + j] = f2bf(aup_g[(size_t)j * 512 + k]); }
    const int r16 = lane & 15, g4 = lane >> 4, tr = wid & 3, tcb = 2 * (wid >> 2);
    float c_w0[2], c_a0[2], c_ka[2], c_rk[2];
#pragma unroll
    for (int jt = 0; jt < 2; ++jt) { const int kc = 16 * (tcb + jt) + r16; c_w0[jt] = w0[kc]; c_a0[jt] = a0[kc]; c_ka[jt] = IN(30)[e * 512 + 64 * h + kc]; c_rk[jt] = IN(31)[e * 512 + 64 * h + kc]; }
    typedef float f32x2 __attribute__((ext_vector_type(2)));
    f32x2 S2[4];
#pragma unroll
    for (int k = 0; k < 4; ++k) S2[k] = (f32x2){0.f, 0.f};
    __syncthreads();
    bf16_t pr_[10], pk_[10], pv_[10], pw_[10], pa_[10];
    auto issue = [&](int cidx) {
        const int seg = cidx >= 4; const int L = seg ? TL : TCX; const int rowbase = seg ? b * TL : MLAT + b * TCX; const int ch = seg ? cidx - 4 : cidx;
        const int tlo = d ? (L - 1 - (ch * 64 + 8 * wid + 7)) : (ch * 64 + 8 * wid);
#pragma unroll
        for (int q = 0; q < 10; ++q) {
            const int t = tlo - 1 + q; const int tc = t < 0 ? 0 : (t > L - 1 ? L - 1 : t);
            const bf16_t* zr = ZR + (size_t)(rowbase + tc) * 1920;
            pr_[q] = zr[64 * h + lane]; pk_[q] = zr[512 + 64 * h + lane]; pv_[q] = zr[1024 + 64 * h + lane]; pw_[q] = zr[1536 + 64 * d + lane]; pa_[q] = zr[1664 + 64 * d + lane];
        }
    };
    issue(0);
#pragma unroll 1
    for (int cidx = 0; cidx < 36; ++cidx) {
        {
            const int seg = cidx >= 4; const int L = seg ? TL : TCX; const int rowbase = seg ? b * TL : MLAT + b * TCX; const int ch = seg ? cidx - 4 : cidx;
            const int tlo = d ? (L - 1 - (ch * 64 + 8 * wid + 7)) : (ch * 64 + 8 * wid);
            {
                float zr_[10], zk_[10], zv_[10], zw_[10], za_[10];
#pragma unroll
                for (int q = 0; q < 10; ++q) {
                    const int t = tlo - 1 + q; const bool ok = (t >= 0) && (t < L);
                    const float a0 = bf2f(pr_[q]), a1 = bf2f(pk_[q]), a2 = bf2f(pv_[q]), a3 = bf2f(pw_[q]), a4 = bf2f(pa_[q]);
                    zr_[q] = ok ? a0 : 0.f; zk_[q] = ok ? a1 : 0.f; zv_[q] = ok ? a2 : 0.f; zw_[q] = ok ? a3 : 0.f; za_[q] = ok ? a4 : 0.f;
                }
#pragma unroll
                for (int sl = 0; sl < 8; ++sl) {
                    const int tau = 8 * wid + (d ? 7 - sl : sl);
#define ZS(arr, muv) (arr[sl + 1] + (muv) * (0.5f * (arr[sl] + arr[sl + 2]) - arr[sl + 1]))
                    const float rr = ZS(zr_, mu_r), kr = ZS(zk_, mu_k), vv = ZS(zv_, mu_v), wd = ZS(zw_, mu_w), ad = ZS(za_, mu_a);
#undef ZS
                    const float kkv = kr * kk_c; const float n2 = wsum(kkv * kkv);
                    const float kk = kkv * __builtin_amdgcn_rcpf(fmaxf(__builtin_amdgcn_sqrtf(n2), 1e-12f));
                    sOP[tau * SOPS + 0 + lane] = rr; sOP[tau * SOPS + 64 + lane] = kk; sV[tau * 64 + lane] = vv; sOP[tau * SOPS + 192 + lane] = kr;
                    TWb[tau * 64 + lane] = f2bf(tanh_(wd)); ADb[tau * 64 + lane] = f2bf(ad);
                }
            }
            __syncthreads();
            {
                const bf16x8 aw0 = *(const bf16x8*)(TWb + (16 * tr + r16) * 64 + 8 * g4), aw1 = *(const bf16x8*)(TWb + (16 * tr + r16) * 64 + 32 + 8 * g4);
                const bf16x8 aa0 = *(const bf16x8*)(ADb + (16 * tr + r16) * 64 + 8 * g4), aa1 = *(const bf16x8*)(ADb + (16 * tr + r16) * 64 + 32 + 8 * g4);
                float bonp[4] = {0.f, 0.f, 0.f, 0.f};
#pragma unroll
                for (int jt = 0; jt < 2; ++jt) {
                    const int kc = 16 * (tcb + jt) + r16;
                    const bf16x8 bw0 = *(const bf16x8*)(WUPT + kc * 64 + 8 * g4), bw1 = *(const bf16x8*)(WUPT + kc * 64 + 32 + 8 * g4);
                    const bf16x8 ba0 = *(const bf16x8*)(AUPT + kc * 64 + 8 * g4), ba1 = *(const bf16x8*)(AUPT + kc * 64 + 32 + 8 * g4);
                    f32x4 cw = (f32x4){0.f, 0.f, 0.f, 0.f}, ca = (f32x4){0.f, 0.f, 0.f, 0.f};
                    cw = __builtin_amdgcn_mfma_f32_16x16x32_bf16(aw0, bw0, cw, 0, 0, 0); cw = __builtin_amdgcn_mfma_f32_16x16x32_bf16(aw1, bw1, cw, 0, 0, 0);
                    ca = __builtin_amdgcn_mfma_f32_16x16x32_bf16(aa0, ba0, ca, 0, 0, 0); ca = __builtin_amdgcn_mfma_f32_16x16x32_bf16(aa1, ba1, ca, 0, 0, 0);
#pragma unroll
                    for (int q = 0; q < 4; ++q) {
                        const int tau = 16 * tr + 4 * g4 + q;
                        const float wlog = -softplus_(-(c_w0[jt] + cw[q])) - 0.5f;
                        const float dec = __expf(-__expf(wlog));
                        const float av = sigm(c_a0[jt] + ca[q]);
                        const float kd = sOP[tau * SOPS + 192 + kc] * (1.f + (av - 1.f) * c_ka[jt]);
                        bonp[q] += sOP[tau * SOPS + 0 + kc] * kd * c_rk[jt];
                        sOP[tau * SOPS + 128 + kc] = dec; sOP[tau * SOPS + 192 + kc] = kd; sOP[tau * SOPS + 256 + kc] = sOP[tau * SOPS + 64 + kc] * av;
                    }
                }
#pragma unroll
                for (int q = 0; q < 4; ++q) {
                    float v = bonp[q];
                    v += DPPF(v, 0xB1); v += DPPF(v, 0x4E); v += DPPF(v, 0x141); v += DPPF(v, 0x140);
                    if (r16 == 0) sBONp[(16 * tr + 4 * g4 + q) * 2 + (wid >> 2)] = v;
                }
            }
            __syncthreads();
            if (tid < 64) { const int pp = ch * 64 + tid; const int t = d ? (L - 1 - pp) : pp; BON[(size_t)(rowbase + t) * 8 + h] = sBONp[2 * tid] + sBONp[2 * tid + 1]; }
            if (cidx + 1 < 36) issue(cidx + 1);
            {
                const int vrow = 8 * wid + (lane >> 3), kq = lane & 7;
                const float* pb = sOP + 8 * kq;
                constexpr int O_R = 0, O_KK = 64, O_W = 128, O_KD = 192, O_KA = 256;
                struct Ops { float4 kk0, kk1, w0, w1, ka0, ka1, kd0, kd1, r0, r1; float vv; };
                auto ldops = [&](Ops& o, int tau) {
                    const float* q = pb + tau * SOPS;
                    o.kk0 = *(const float4*)(q + O_KK); o.kk1 = *(const float4*)(q + O_KK + 4); o.w0 = *(const float4*)(q + O_W); o.w1 = *(const float4*)(q + O_W + 4);
                    o.ka0 = *(const float4*)(q + O_KA); o.ka1 = *(const float4*)(q + O_KA + 4); o.kd0 = *(const float4*)(q + O_KD); o.kd1 = *(const float4*)(q + O_KD + 4);
                    o.r0 = *(const float4*)(q + O_R); o.r1 = *(const float4*)(q + O_R + 4); o.vv = sV[tau * 64 + vrow];
                };
                auto step = [&](const Ops& o, int tau) -> float {
                    const f32x2 kk[4] = {{o.kk0.x, o.kk0.y}, {o.kk0.z, o.kk0.w}, {o.kk1.x, o.kk1.y}, {o.kk1.z, o.kk1.w}};
                    const f32x2 w[4] = {{o.w0.x, o.w0.y}, {o.w0.z, o.w0.w}, {o.w1.x, o.w1.y}, {o.w1.z, o.w1.w}};
                    const f32x2 ka[4] = {{o.ka0.x, o.ka0.y}, {o.ka0.z, o.ka0.w}, {o.ka1.x, o.ka1.y}, {o.ka1.z, o.ka1.w}};
                    const f32x2 kd[4] = {{o.kd0.x, o.kd0.y}, {o.kd0.z, o.kd0.w}, {o.kd1.x, o.kd1.y}, {o.kd1.z, o.kd1.w}};
                    const f32x2 rr[4] = {{o.r0.x, o.r0.y}, {o.r0.z, o.r0.w}, {o.r1.x, o.r1.y}, {o.r1.z, o.r1.w}};
                    f32x2 da = S2[0] * kk[0] + S2[1] * kk[1]; f32x2 db = S2[2] * kk[2] + S2[3] * kk[3]; da = da + db;
                    float dt = da.x + da.y;
                    dt += DPPF(dt, 0xB1); dt += DPPF(dt, 0x4E); dt += DPPF(dt, 0x141);
                    const f32x2 sa2 = {-dt, -dt}; const f32x2 vv2 = {o.vv, o.vv};
#pragma unroll
                    for (int q = 0; q < 4; ++q) S2[q] = S2[q] * w[q] + (sa2 * ka[q] + vv2 * kd[q]);
                    f32x2 oa = S2[0] * rr[0] + S2[1] * rr[1]; f32x2 ob = S2[2] * rr[2] + S2[3] * rr[3]; oa = oa + ob;
                    return oa.x + oa.y;
                };
                Ops oa_, ob_;
                ldops(oa_, 0);
                const bool b1_ = (kq & 2) != 0, b0_ = (kq & 1) != 0;
#pragma unroll 1
                for (int t4 = 0; t4 < 64; t4 += 4) {
                    float po[4];
#pragma unroll
                    for (int u = 0; u < 4; u += 2) {
                        ldops(ob_, t4 + u + 1);
                        po[u] = step(oa_, t4 + u);
                        ldops(oa_, t4 + u + 2 < 64 ? t4 + u + 2 : 63);
                        po[u + 1] = step(ob_, t4 + u + 1);
                    }
                    float a2[2];
#pragma unroll
                    for (int j = 0; j < 2; ++j) { const float send = b1_ ? po[j] : po[j + 2], keep = b1_ ? po[j + 2] : po[j]; a2[j] = keep + DPPF(send, 0x4E); }
                    const float send = b0_ ? a2[0] : a2[1], keep = b0_ ? a2[1] : a2[0];
                    float r_ = keep + DPPF(send, 0xB1);
                    r_ += __builtin_bit_cast(float, __builtin_amdgcn_ds_swizzle(__builtin_bit_cast(int, r_), 0x101F));
                    sO[(t4 + (kq & 3)) * 64 + vrow] = r_;
                }
            }
            __syncthreads();
#pragma unroll
            for (int i = 0; i < 8; ++i) {
                const int tau = wid + 8 * i; const int pp = ch * 64 + tau; const int t = d ? (L - 1 - pp) : pp;
                ORW[(size_t)(rowbase + t) * 512 + 64 * h + lane] = f2bf(sO[tau * 64 + lane]);
            }
            __syncthreads();
        }
    }
}

__device__ __forceinline__ void even_readout_phase(const Params& p, int e, unsigned char* smem) {
    PH_PRO
    const int tid = tid_, lane = tid & 63, wid = __builtin_amdgcn_readfirstlane(tid >> 6);
    bf16_t* SGb = (bf16_t*)smem;
    float* GG = (float*)(SGb + 64 * 128);
    bf16_t* GUT = (bf16_t*)(GG + 64 * 64);
    bf16_t* TT = GUT + 64 * 128;
    const int r16 = lane & 15, g4 = lane >> 4, tr = wid & 3, tcb = 2 * (wid >> 2);
    const bf16_t* ZR = (const bf16_t*)(WS_ + WS_BIG + BIG_ZR);
    const bf16_t* ORW = (const bf16_t*)(WS_ + WS_BIG + BIG_ORW);
    const bf16_t* YT = (const bf16_t*)(WS_ + WS_BIG);
    const float* BON = (const float*)(WS_ + WS_BON);
    bf16_t* YM = (bf16_t*)(WS_ + WS_A);
    const float* mu = IN(23) + e * 1920;
    const int h = bid_ & 7;
    {
        const float* gup = IN(28) + (size_t)e * 128 * 512 + 64 * h;
        for (int idx = tid; idx < 128 * 64; idx += NTHR) { const int j = idx >> 6, k = idx & 63; GUT[k * 128 + j] = f2bf(gup[(size_t)j * 512 + k]); }
    }
    const float gng = IN(32)[e * 512 + 64 * h + lane], gnb = IN(33)[e * 512 + 64 * h + lane], muv = mu[1024 + 64 * h + lane];
    for (int item = bid_; item < 4608; item += gdim_) {
        const int tb = item >> 3; const int row0 = tb * 64;
        const int hh = item & 7;
        const int L = row0 < MLAT ? TL : TCX; const int t0 = row0 < MLAT ? (row0 & (TL - 1)) : ((row0 - MLAT) & (TCX - 1));
        __syncthreads();
        if (hh != h) {
            const float* gup = IN(28) + (size_t)e * 128 * 512 + 64 * hh;
            for (int idx = tid; idx < 128 * 64; idx += NTHR) { const int j = idx >> 6, k = idx & 63; GUT[k * 128 + j] = f2bf(gup[(size_t)j * 512 + k]); }
        }
        {
            const int j = tid & 127, tq = wid >> 1; const float muj = mu[1792 + j];
            float zz[18];
#pragma unroll
            for (int q = 0; q < 18; ++q) {
                const int t = t0 + 16 * tq - 1 + q; const bool ok = (t >= 0) && (t < L); const int tc = t < 0 ? 0 : (t > L - 1 ? L - 1 : t);
                const float a = bf2f(ZR[(size_t)(row0 - t0 + tc) * 1920 + 1792 + j]); zz[q] = ok ? a : 0.f;
            }
#pragma unroll
            for (int i = 0; i < 16; ++i) SGb[(16 * tq + i) * 128 + j] = f2bf(sigm(zz[i + 1] + muj * (0.5f * (zz[i] + zz[i + 2]) - zz[i + 1])));
        }
        float ov[8], vv[8], bon[8];
        const float gngh = hh == h ? gng : IN(32)[e * 512 + 64 * hh + lane], gnbh = hh == h ? gnb : IN(33)[e * 512 + 64 * hh + lane], muvh = hh == h ? muv : mu[1024 + 64 * hh + lane];
        {
            float zv[10];
#pragma unroll
            for (int q = 0; q < 10; ++q) {
                const int t = t0 + 8 * wid - 1 + q; const bool ok = (t >= 0) && (t < L); const int tc = t < 0 ? 0 : (t > L - 1 ? L - 1 : t);
                const float a = bf2f(ZR[(size_t)(row0 - t0 + tc) * 1920 + 1024 + 64 * hh + lane]); zv[q] = ok ? a : 0.f;
            }
#pragma unroll
            for (int i = 0; i < 8; ++i) {
                const int row = row0 + 8 * wid + i;
                ov[i] = bf2f(ORW[(size_t)row * 512 + 64 * hh + lane]) + bf2f(ORW[(size_t)(MTOT + row) * 512 + 64 * hh + lane]);
                vv[i] = zv[i + 1] + muvh * (0.5f * (zv[i] + zv[i + 2]) - zv[i + 1]);
                bon[i] = BON[(size_t)row * 8 + hh] + BON[(size_t)(MTOT + row) * 8 + hh];
            }
        }
        __syncthreads();
        {
            f32x4 c0 = (f32x4){0.f, 0.f, 0.f, 0.f}, c1 = (f32x4){0.f, 0.f, 0.f, 0.f};
#pragma unroll
            for (int ks = 0; ks < 4; ++ks) {
                const bf16x8 af = *(const bf16x8*)(SGb + (16 * tr + r16) * 128 + 32 * ks + 8 * g4);
                const bf16x8 b0 = *(const bf16x8*)(GUT + (16 * tcb + r16) * 128 + 32 * ks + 8 * g4), b1 = *(const bf16x8*)(GUT + (16 * (tcb + 1) + r16) * 128 + 32 * ks + 8 * g4);
                c0 = __builtin_amdgcn_mfma_f32_16x16x32_bf16(af, b0, c0, 0, 0, 0); c1 = __builtin_amdgcn_mfma_f32_16x16x32_bf16(af, b1, c1, 0, 0, 0);
            }
#pragma unroll
            for (int q = 0; q < 4; ++q) { GG[(16 * tr + 4 * g4 + q) * 64 + 16 * tcb + r16] = c0[q]; GG[(16 * tr + 4 * g4 + q) * 64 + 16 * (tcb + 1) + r16] = c1[q]; }
        }
        __syncthreads();
        float gg[8];
#pragma unroll
        for (int i = 0; i < 8; ++i) gg[i] = GG[(8 * wid + i) * 64 + lane];
#pragma unroll
        for (int i = 0; i < 8; ++i) {
            const int row = row0 + 8 * wid + i;
            const float mean = wsum(ov[i]) * (1.f / 64.f); const float dd = ov[i] - mean; const float var = wsum(dd * dd) * (1.f / 64.f);
            const float y = dd * rsqrtf(var + 64e-5f) * gngh + gnbh;
            YM[(size_t)row * D + 512 + 64 * hh + lane] = f2bf((y + bon[i] * vv[i]) * gg[i]);
        }
    }
    __syncthreads();
    for (int it = bid_; it < 4608; it += gdim_) {
        const int tb = it >> 3, cb = it & 7; const int row0 = tb * 64;
#pragma unroll
        for (int i = 0; i < 8; ++i) { const int cc = wid + 8 * i; TT[cc * 72 + lane] = YT[(size_t)(cb * 64 + cc) * MTOT + row0 + lane]; }
        __syncthreads();
#pragma unroll
        for (int i = 0; i < 8; ++i) { const int tau = wid + 8 * i; YM[(size_t)(row0 + tau) * D + cb * 64 + lane] = TT[lane * 72 + tau]; }
        __syncthreads();
    }
}
__device__ __forceinline__ void gla_phase(const Params& p, int o_idx, unsigned char* smem) {
    PH_PRO
    const int item = bid_; if (item >= 256) return;
    const int xcd_ = item & 7, jx_ = item >> 3;
    const int b = 2 * xcd_ + (jx_ >> 4), h = (jx_ >> 2) & 3, d = (jx_ >> 1) & 1, dvh = jx_ & 1;
    const int tid = tid_, lane = tid & 63, wid = __builtin_amdgcn_readfirstlane(tid >> 6), r = lane & 15, g = lane >> 4;
    constexpr int QST = 136, SST = 68;
    bf16_t* QS = (bf16_t*)smem;
    bf16_t* KS = QS + 64 * QST;
    bf16_t* ST = KS + 64 * QST;
    bf16_t* KST = ST + 128 * QST;
    bf16_t* VT = KST + 128 * SST;
    bf16_t* PP = VT + 128 * SST;
    float* GD = (float*)(PP + 64 * SST);
    float* DL = GD + 64 * 16;
    float* E1 = DL + 128;
    float* E2 = E1 + 128;
    float* TOT = E2 + 128;
    float* BR = TOT + 512;
    int* ROWS = (int*)(BR + 128);
    const bf16_t* Z = (const bf16_t*)(WS_ + WS_BIG);
    bf16_t* OG = d ? (bf16_t*)OUT_ : (bf16_t*)(WS_ + WS_BIG + BIG_OGL);
    const float qscale = 0.08838834764831845f;
    const int k = tid & 127, tq = wid >> 1, tr = wid >> 1, tcb = 4 * (wid & 1);
    auto rowof = [&](int c, int tau) -> int {
        const int seg = c >= 4; const int L = seg ? TL : TCX; const int pf = (seg ? c - 4 : c) * 64 + tau; const int pp = d ? (L - 1 - pf) : pf;
        return seg ? (b * TL + (pp & 31) * 64 + (pp >> 5)) : (MLAT + b * TCX + pp);
    };
    bf16_t nq[16], nk[16], nv[16], ngd[2];
    auto prefetch = [&](int c) {
        const long r0 = rowof(c, 16 * tq); const long st = (long)(c >= 4 ? 64 : 1) * (d ? -1 : 1) * 3104;
        const bf16_t* zb = Z + r0 * 3104 + 128 * h + k;
#pragma unroll
        for (int i = 0; i < 16; ++i) { const bf16_t* zr = zb + i * st; nq[i] = zr[0]; nk[i] = zr[512]; nv[i] = zr[1024 + 128 * h + 128 * dvh]; }
#pragma unroll
        for (int i = 0; i < 2; ++i) { const int idx = tid + NTHR * i; ngd[i] = Z[(size_t)rowof(c, idx >> 4) * 3104 + 2048 + 16 * d + (idx & 15)]; }
    };
    f32x4 Sacc[8];
#pragma unroll
    for (int j = 0; j < 8; ++j) Sacc[j] = (f32x4){0.f, 0.f, 0.f, 0.f};
    float gu[16];
    {
        const float* gup_g = IN(36) + (size_t)(o_idx * 2 + d) * 16 * 512 + 128 * h + k;
#pragma unroll
        for (int j = 0; j < 16; ++j) gu[j] = gup_g[(size_t)j * 512];
    }
    const float gbv = IN(37)[(o_idx * 2 + d) * 512 + 128 * h + k];
    prefetch(0);
#pragma unroll 1
    for (int c = 0; c < 36; ++c) {
        __syncthreads();
        if (tid < 64) ROWS[tid] = rowof(c, tid);
#pragma unroll
        for (int i = 0; i < 2; ++i) GD[tid + NTHR * i] = bf2f(ngd[i]);
#pragma unroll
        for (int i = 0; i < 16; ++i) VT[k * SST + 16 * tq + i] = nv[i];
        bf16_t cq[16], ck[16];
#pragma unroll
        for (int i = 0; i < 16; ++i) { cq[i] = nq[i]; ck[i] = nk[i]; }
        __syncthreads();
        if (c + 1 < 36) prefetch(c + 1);
        float bl[16]; float run = 0.f;
#pragma unroll
        for (int i = 0; i < 16; ++i) {
            const float4* gd4 = (const float4*)(GD + (16 * tq + i) * 16);
            const float4 g0 = gd4[0], g1 = gd4[1], g2 = gd4[2], g3 = gd4[3];
            float a = gbv + g0.x * gu[0] + g0.y * gu[1] + g0.z * gu[2] + g0.w * gu[3] + g1.x * gu[4] + g1.y * gu[5] + g1.z * gu[6] + g1.w * gu[7]
                    + g2.x * gu[8] + g2.y * gu[9] + g2.z * gu[10] + g2.w * gu[11] + g3.x * gu[12] + g3.y * gu[13] + g3.z * gu[14] + g3.w * gu[15];
            run -= __logf(1.f + __expf(-a)) * (1.f / 16.f);
            bl[i] = run;
        }
        TOT[tq * 128 + k] = run; if (tq == 2) BR[k] = bl[0];
        __syncthreads();
        {
            const float t0 = TOT[k], t1 = TOT[128 + k], t2 = TOT[256 + k], t3 = TOT[384 + k];
            const float off = tq == 0 ? 0.f : (tq == 1 ? t0 : (tq == 2 ? t0 + t1 : t0 + t1 + t2));
            const float bref = BR[k] + t0 + t1, blast = t0 + t1 + t2 + t3;
            if (tq == 0) { DL[k] = __expf(blast); E1[k] = __expf(bref); E2[k] = __expf(blast - bref); }
#pragma unroll
            for (int i = 0; i < 16; ++i) {
                const int tau = 16 * tq + i;
                const float bb = bl[i] + off; const float ef = __expf(bb - bref);
                const bf16_t ksv = f2bf(bf2f(ck[i]) * __builtin_amdgcn_rcpf(ef));
                QS[tau * QST + k] = f2bf(bf2f(cq[i]) * qscale * ef); KS[tau * QST + k] = ksv; KST[k * SST + tau] = ksv;
            }
        }
        __syncthreads();
        {
            float e1v[4];
#pragma unroll
            for (int q = 0; q < 4; ++q) e1v[q] = E1[16 * wid + 4 * g + q];
#pragma unroll
            for (int j = 0; j < 8; ++j) {
                uint2 o; o.x = pk2(Sacc[j][0] * e1v[0], Sacc[j][1] * e1v[1]); o.y = pk2(Sacc[j][2] * e1v[2], Sacc[j][3] * e1v[3]);
                *(uint2*)(ST + (16 * j + r) * QST + 16 * wid + 4 * g) = o;
            }
        }
        f32x4 sc[2];
#pragma unroll
        for (int j = 0; j < 2; ++j) sc[j] = (f32x4){0.f, 0.f, 0.f, 0.f};
#pragma unroll
        for (int ks = 0; ks < 4; ++ks) {
            const bf16x8 af = *(const bf16x8*)(QS + (16 * tr + r) * QST + 32 * ks + 8 * g);
#pragma unroll
            for (int j = 0; j < 2; ++j) {
                const bf16x8 bfr = *(const bf16x8*)(KS + (16 * (2 * (wid & 1) + j) + r) * QST + 32 * ks + 8 * g);
                sc[j] = __builtin_amdgcn_mfma_f32_16x16x32_bf16(af, bfr, sc[j], 0, 0, 0);
            }
        }
#pragma unroll
        for (int j = 0; j < 2; ++j) {
            const int sidx = 16 * (2 * (wid & 1) + j) + r;
#pragma unroll
            for (int q = 0; q < 4; ++q) { const int ci = 16 * tr + 4 * g + q; PP[ci * SST + sidx] = f2bf(sidx <= ci ? sc[j][q] : 0.f); }
        }
        __syncthreads();
        f32x4 oc[4];
#pragma unroll
        for (int j = 0; j < 4; ++j) oc[j] = (f32x4){0.f, 0.f, 0.f, 0.f};
#pragma unroll
        for (int ks = 0; ks < 2; ++ks) {
            const bf16x8 af = ld8(PP + (16 * tr + r) * SST + 32 * ks + 8 * g);
#pragma unroll
            for (int j = 0; j < 4; ++j) {
                const bf16x8 bfr = ld8(VT + (16 * (tcb + j) + r) * SST + 32 * ks + 8 * g);
                oc[j] = __builtin_amdgcn_mfma_f32_16x16x32_bf16(af, bfr, oc[j], 0, 0, 0);
            }
        }
#pragma unroll
        for (int ks = 0; ks < 4; ++ks) {
            const bf16x8 af = *(const bf16x8*)(QS + (16 * tr + r) * QST + 32 * ks + 8 * g);
#pragma unroll
            for (int j = 0; j < 4; ++j) {
                const bf16x8 bfr = *(const bf16x8*)(ST + (16 * (tcb + j) + r) * QST + 32 * ks + 8 * g);
                oc[j] = __builtin_amdgcn_mfma_f32_16x16x32_bf16(af, bfr, oc[j], 0, 0, 0);
            }
        }
#pragma unroll
        for (int j = 0; j < 4; ++j) {
            const int dv = 16 * (tcb + j) + r;
#pragma unroll
            for (int q = 0; q < 4; ++q) OG[(size_t)ROWS[16 * tr + 4 * g + q] * D + 256 * h + 128 * dvh + dv] = f2bf(oc[j][q]);
        }
        {
            f32x4 kv[8];
#pragma unroll
            for (int j = 0; j < 8; ++j) kv[j] = (f32x4){0.f, 0.f, 0.f, 0.f};
#pragma unroll
            for (int ks = 0; ks < 2; ++ks) {
                const bf16x8 af = ld8(KST + (16 * wid + r) * SST + 32 * ks + 8 * g);
#pragma unroll
                for (int j = 0; j < 8; ++j) {
                    const bf16x8 bfr = ld8(VT + (16 * j + r) * SST + 32 * ks + 8 * g);
                    kv[j] = __builtin_amdgcn_mfma_f32_16x16x32_bf16(af, bfr, kv[j], 0, 0, 0);
                }
            }
            float dl[4], e2[4];
#pragma unroll
            for (int q = 0; q < 4; ++q) { dl[q] = DL[16 * wid + 4 * g + q]; e2[q] = E2[16 * wid + 4 * g + q]; }
#pragma unroll
            for (int j = 0; j < 8; ++j)
#pragma unroll
                for (int q = 0; q < 4; ++q) Sacc[j][q] = Sacc[j][q] * dl[q] + e2[q] * kv[j][q];
        }
    }
    __syncthreads();
}

__device__ __forceinline__ void odd_readout_phase(const Params& p, int o_idx) {
    PH_PRO
    const int lane = tid_ & 63, wid = tid_ >> 6;
    const bf16_t* Z = (const bf16_t*)(WS_ + WS_BIG);
    const bf16_t* OGL = (const bf16_t*)(WS_ + WS_BIG + BIG_OGL);
    const bf16_t* OGB = (const bf16_t*)OUT_;
    bf16_t* YM = (bf16_t*)(WS_ + WS_A);
    const float4 ng = *(const float4*)(IN(38) + o_idx * 256 + 4 * lane);
    for (int row = bid_ * 8 + wid; row < MTOT; row += gdim_ * 8) {
        uint2 ovs[4], ows[4], gvs[4];
#pragma unroll
        for (int hh = 0; hh < 4; ++hh) {
            ovs[hh] = *(const uint2*)(OGL + (size_t)row * D + 256 * hh + 4 * lane);
            ows[hh] = *(const uint2*)(OGB + (size_t)row * D + 256 * hh + 4 * lane);
            gvs[hh] = *(const uint2*)(Z + (size_t)row * 3104 + 2080 + 256 * hh + 4 * lane);
        }
#pragma unroll
        for (int hh = 0; hh < 4; ++hh) {
            const uint2 ov = ovs[hh], ow = ows[hh], gv = gvs[hh];
            const float o0 = __uint_as_float(ov.x << 16) + __uint_as_float(ow.x << 16), o1 = __uint_as_float(ov.x & 0xffff0000u) + __uint_as_float(ow.x & 0xffff0000u), o2 = __uint_as_float(ov.y << 16) + __uint_as_float(ow.y << 16), o3 = __uint_as_float(ov.y & 0xffff0000u) + __uint_as_float(ow.y & 0xffff0000u);
            const float g0 = __uint_as_float(gv.x << 16), g1 = __uint_as_float(gv.x & 0xffff0000u), g2 = __uint_as_float(gv.y << 16), g3 = __uint_as_float(gv.y & 0xffff0000u);
            const float ms = wsum(o0 * o0 + o1 * o1 + o2 * o2 + o3 * o3) * (1.f / 256.f);
            const float rs = rsqrtf(ms + 1e-5f);
            uint2 y; y.x = pk2(o0 * rs * ng.x * silu_(g0), o1 * rs * ng.y * silu_(g1)); y.y = pk2(o2 * rs * ng.z * silu_(g2), o3 * rs * ng.w * silu_(g3));
            *(uint2*)(YM + (size_t)row * D + 256 * hh + 4 * lane) = y;
        }
    }
}

#ifndef REP_UP
#define REP_UP 1
#endif
#ifndef REP_SCAN
#define REP_SCAN 1
#endif
#ifndef REP_GLA
#define REP_GLA 1
#endif
#ifndef REP_HY
#define REP_HY 1
#endif
#define REPEAT(n) for (int rep_ = 0, nrep_ = ({ int t_ = (n); asm volatile("" : "+s"(t_)); t_; }); rep_ < nrep_; ++rep_)
#ifndef REP_LN
#define REP_LN 1
#endif
#ifndef REP_MISC
#define REP_MISC 1
#endif
#ifndef REP_SYNC
#define REP_SYNC 1
#endif
#define GSYNC() do { for (int s_ = 0; s_ < REP_SYNC; ++s_) { XcdBarrier xb_; xb_.bar = (unsigned*)IN(40); xb_.x = xb_xcc_id(); xb_.st = (volatile XB_LAS unsigned*)(smem_g + TBL_OFF + 448); xcd_barrier(xb_); } } while (0)
#define LAUNDER() do { bid_ = blockIdx.x; asm volatile("" : "+s"(bid_)); gdim_ = gridDim.x; asm volatile("" : "+s"(gdim_)); } while (0)
__global__ void __launch_bounds__(NTHR, 2) mega(Params p) {
    unsigned char* smem = smem_g;
    cg::grid_group grid = cg::this_grid();
    int bid_, gdim_; LAUNDER();
    if (threadIdx.x == 0) {
        const float** tb = (const float**)(smem_g + TBL_OFF);
#pragma unroll
        for (int i = 0; i < 41; ++i) tb[i] = p.in[i];
        *(uint4*)(smem_g + TBL_OFF + 448) = make_uint4(0u, 0u, 0u, 0u);
    }
    unsigned* bar_ = (unsigned*)p.in[40];
    if (blockIdx.x == 0) for (int i = threadIdx.x; i < XCD_BAR_WORDS; i += NTHR) bar_[i] = 0u;
    __syncthreads();
    grid.sync();
    (void)xcd_barrier_post(bar_, (volatile XB_LAS unsigned*)(smem_g + TBL_OFF + 448));
    REPEAT(REP_MISC) {
    phase_mod(p, smem);
    __syncthreads();
    conv_weights(p, 0, smem);
    filt_gen(p, smem);
    GSYNC();
    }
    row_phase(p, 0, 0, 0, 0, 0, false);
    GSYNC();
#pragma unroll 1
    for (int l = 0; l < 4; ++l) {
#pragma unroll 1
        for (int f = 0; f < 2; ++f) {
            if (f == 1) {
                if (!(l & 1)) {
                    const int e = l >> 1;
                    REPEAT(REP_HY) {
                    LAUNDER();
                    { EpiStore E; E.O = (bf16_t*)(WS_ + WS_BIG); E.ldc = MTOT; E.nvalid = MTOT; run_gemm(smem, (const bf16_t*)(WS_ + WS_WIN), (const bf16_t*)(WS_ + WS_A), 1536, MTOT, 1024, E, bid_, gdim_); }
                    LAUNDER();
                    { EpiStore E; E.O = (bf16_t*)(WS_ + WS_BIG + BIG_ZR); E.ldc = 1920; E.nvalid = 1920; run_gemm(smem, (const bf16_t*)(WS_ + WS_A), (const bf16_t*)(WS_ + WS_WIN) + (size_t)1536 * 1024, MTOT, 2048, 1024, E, gdim_ - 1 - bid_, gdim_); }
                    GSYNC();
                    hyena_phase(p, e, smem);
                    if (rep_ + 1 < nrep_) GSYNC();
                    }
                    REPEAT(REP_SCAN) rwkv_scan_phase(p, e, smem);
                    GSYNC();
                    REPEAT(REP_MISC) even_readout_phase(p, e, smem);
                    GSYNC();
                } else {
                    const int o = l >> 1;
                    LAUNDER();
                    { EpiStore E; E.O = (bf16_t*)(WS_ + WS_BIG); E.ldc = 3104; E.nvalid = 3104; run_gemm(smem, (const bf16_t*)(WS_ + WS_A), (const bf16_t*)(WS_ + WS_WIN), MTOT, 3328, 1024, E, bid_, gdim_); }
                    GSYNC();
                    REPEAT(REP_GLA) gla_phase(p, o, smem);
                    GSYNC();
                    REPEAT(REP_MISC) odd_readout_phase(p, o);
                    GSYNC();
                }
                LAUNDER();
                { EpiResid E; E.gate_off = l * 17 * 9216 + 5 * 1024; E.wgt = 1.0f; E.ln_idx = l * 3 + 0; E.pm_off = 0; run_gemm(smem, (const bf16_t*)(WS_ + WS_A), (const bf16_t*)(WS_ + WS_WOUT), l == 3 ? MLAT : MTOT, 1024, 1024, E, bid_, gdim_); }
                GSYNC();
                REPEAT(REP_LN) row_phase(p, 1, l, 1, l, 6, false, l == 3 ? MLAT : MTOT);
                GSYNC();
            }
            const bool latonly = (l == 3 && f == 1);
#pragma unroll 1
            for (int s = 0; s < 4; ++s) {
                if (s == 3 && latonly) break;
                LAUNDER();
                if ((s == 1) || (s == 2 && !latonly && bid_ < 64)) {
                    const int part = s - 1;
                    EpiResid E; E.gate_off = l * 17 * 9216 + (f ? 8 : 2) * 1024; E.wgt = 0.5f; E.ln_idx = f ? (l * 3 + 1) : (l * 3 - 1); E.pm_off = part ? 128 : 0;
                    run_gemm(smem, (const bf16_t*)(WS_ + WS_BIG) + (size_t)part * MLAT * FF, (const bf16_t*)(WS_ + WS_WDN) + (size_t)f * 1024 * FF, part ? MCTX : MLAT, 1024, FF, E, bid_, part ? 64 : gdim_);
                }
                if (s == 0 || (s == 1 && !latonly)) {
                    LAUNDER();
                    EpiSwiglu E; E.G = (bf16_t*)(WS_ + WS_BIG); E.pm_off = s ? 128 : 0;
                    run_gemm(smem, (const bf16_t*)(WS_ + WS_A) + (size_t)s * MLAT * 1024, (const bf16_t*)(WS_ + WS_WUP) + (size_t)f * 5632 * 1024, s ? MCTX : MLAT, 5632, 1024, E, bid_, gdim_);
                }
                if (s == 2) {
                    if (latonly) row_phase(p, 1, l, 2, 0, 0, true);
                    else if (bid_ >= 64) { if (f == 0) row_phase(p, 1, l, 0, l, 3, false, MLAT, 0, 64, gdim_ - 64); else row_phase(p, 1, l, 2, l + 1, 0, false, MLAT, 0, 64, gdim_ - 64); }
                }
                if (s == 3) {
                    if (f == 0) row_phase(p, 1, l, 0, l, 3, false, MTOT, MLAT);
                    else { if (l < 3) { row_phase(p, 1, l, 2, l + 1, 0, false, MTOT, MLAT); conv_weights(p, l + 1, smem); } else row_phase(p, 1, l, 2, 0, 0, false, MTOT, MLAT); }
                }
                GSYNC();
            }
        }
    }
}

extern "C" void kernel_launch(void* const* d_in, const int* in_sizes, int n_in, void* d_out, int out_size, void* d_ws, size_t ws_size, hipStream_t stream) {
    static int grid = 0;
    if (grid == 0) {
        if (n_in != 39 || ws_size < WS_END) { fprintf(stderr, "kernel_launch: need 39 inputs and %zu bytes of workspace; got %d, %zu\n", (size_t)WS_END, n_in, ws_size); grid = -1; return; }
        int dev = 0, cus = 0, per_cu = 0;
        (void)hipGetDevice(&dev);
        (void)hipDeviceGetAttribute(&cus, hipDeviceAttributeMultiprocessorCount, dev);
        if (hipFuncSetAttribute((const void*)mega, hipFuncAttributeMaxDynamicSharedMemorySize, LDS_BYTES) != hipSuccess) { fprintf(stderr, "kernel_launch: hipFuncSetAttribute failed\n"); grid = -1; return; }
        (void)hipOccupancyMaxActiveBlocksPerMultiprocessor(&per_cu, (const void*)mega, NTHR, LDS_BYTES);
        if (per_cu < 1) fprintf(stderr, "kernel_launch: occupancy query says %d blocks/CU\n", per_cu);
        (void)hipGetLastError();
        grid = cus;
        if (grid > 256) grid = 256;
    }
    if (grid < 0) return;
    Params p{};
    for (int i = 0; i < 39; ++i) p.in[i] = (const float*)d_in[i];
    p.in[39] = (const float*)d_out; p.in[40] = (const float*)d_ws;
    void* args[] = {&p};
    hipError_t e = hipLaunchCooperativeKernel((const void*)mega, dim3(grid), dim3(NTHR), args, LDS_BYTES, stream);
    if (e != hipSuccess) fprintf(stderr, "cooperative launch failed: %s (grid %d)\n", hipGetErrorString(e), grid);
}
```

```cpp
#include <hip/hip_runtime.h>
#include <hip/hip_cooperative_groups.h>
#include <cstdio>
namespace pg8 {
#define PG8_LAS __attribute__((address_space(3)))
typedef unsigned short bf16_t;
typedef short bf16x8 __attribute__((ext_vector_type(8)));
typedef float f32x4 __attribute__((ext_vector_type(4)));
typedef unsigned u32x4 __attribute__((ext_vector_type(4)));
constexpr int BM = 256, BK = 64, HALF = 128, HTB = HALF * BK * 2  , STAGE_BYTES = 8 * HTB, NXCD = 8, WGM = 4;

__host__ __device__ __forceinline__ int lds_byte(int r, int c) { const int st = (r >> 4) * 2 + (c >> 5), rr = r & 15, cc = c & 31, ob = rr * 64 + cc * 2; return st * 1024 + (ob ^ (((ob >> 9) & 1) << 5)); }
__host__ __device__ __forceinline__ void stage_rc(int b, int& R, int& C) { const int st = b / 1024, sb = b % 1024, swz = sb ^ (((sb >> 9) & 1) << 5); R = (st >> 1) * 16 + swz / 64; C = (st & 1) * 32 + (swz % 64) / 2; }
__host__ __device__ __forceinline__ int perm32(int rho) { const int n = rho >> 4, i = rho & 15; return 8 * (i >> 2) + 4 * n + (i & 3); }

struct Unit { int pm, pn; };
struct Gemm { const bf16_t* A; const bf16_t* Bt; int M, N, K; };

struct StaticOrder {
    int nM, nN, nwg, G, c;
    __host__ __device__ void init(int M, int N, int G_, int c_) { nM = M / BM; nN = N / BM; nwg = nM * nN; G = G_; c = c_; }
    __host__ __device__ bool next(int i, Unit& u) const {
        const long L = (long)i * G + c; if (L >= nwg) return false;
        int wgid = (int)L; { const int q = nwg / NXCD, r = nwg % NXCD, xcd = wgid % NXCD, off = wgid / NXCD; wgid = (xcd < r ? xcd * (q + 1) : r * (q + 1) + (xcd - r) * q) + off; }
        const int nig = WGM * nN, gid = wgid / nig, fm = gid * WGM, gsz = (nM - fm) < WGM ? (nM - fm) : WGM;
        u.pm = fm + ((wgid % nig) % gsz); u.pn = (wgid % nig) / gsz; return true;
    }
    __device__ __forceinline__ void a_ready(const Unit&) const {}
    __device__ __forceinline__ void done(const Unit&) const {}
};
__device__ __forceinline__ unsigned cvt_pk_bf16(float lo, float hi) { unsigned r; asm volatile("v_cvt_pk_bf16_f32 %0, %1, %2" : "=v"(r) : "v"(lo), "v"(hi)); return r; }
typedef float f32x2 __attribute__((ext_vector_type(2)));

template <class Epi, class Sched, bool STAMP = false>
__device__ __forceinline__ void gemm_phase(PG8_LAS unsigned char* lds, const Gemm g, const Sched& S, const Epi& E, unsigned long long* stamps) {
    int tid_l_ = threadIdx.x; asm volatile("" : "+v"(tid_l_)); const int tid = tid_l_, wid = __builtin_amdgcn_readfirstlane(tid >> 6), lane = tid & 63, wr = wid >> 2, wc = wid & 3, fr = lane & 15, fq = lane >> 4;
    const int K = g.K, nt = K / BK;
    int ts_lo = 0, ts_hi = 0, nts = 0; const unsigned long long rt_entry = STAMP ? (unsigned long long)wall_clock64() : 0ull;
#define PG8_STAMP() do { if (STAMP && wid == 0 && nts < 64) { const unsigned long long _c = (unsigned long long)clock64(); \
        ts_lo = (lane == nts) ? (int)(unsigned)_c : ts_lo; ts_hi = (lane == nts) ? (int)(unsigned)(_c >> 32) : ts_hi; ++nts; } } while (0)
    PG8_STAMP();
    unsigned voffA[2], voffB[2];
#pragma unroll
    for (int i = 0; i < 2; ++i) { int R, C; stage_rc(tid * 16 + i * 8192, R, C); const int Rb = Epi::PERM ? ((R & ~31) + perm32(R & 31)) : R;
        voffA[i] = (unsigned)(R * K + C) * 2u; voffB[i] = (unsigned)(Rb * K + C) * 2u; }
    const size_t kstep = (size_t)(BK * 2);
    const size_t hstep = (size_t)HALF * K * 2;
    const size_t tstep = 2 * hstep;
    const unsigned ldsw = (unsigned)wid * 1024u;
    const int aoff = lds_byte(wr * 64 + fr, fq * 8), boff = lds_byte(wc * 32 + fr, fq * 8);
#define PG8_SA(b, h) (((b) * 2 + (h)) * HTB)
#define PG8_SB(b, h) ((4 + (b) * 2 + (h)) * HTB)
#define PG8_STAGE(bufoff, gbase, voff) do { _Pragma("unroll") for (int _i = 0; _i < 2; ++_i) \
        __builtin_amdgcn_global_load_lds((const unsigned*)((const char*)(gbase) + (voff)[_i]), (PG8_LAS unsigned*)(lds + (bufoff) + ldsw + _i * 8192), 16, 0, 0); } while (0)
#define PG8_LDA(dst, b, h) do { _Pragma("unroll") for (int m = 0; m < 4; ++m) _Pragma("unroll") for (int k = 0; k < 2; ++k) dst[m][k] = *(const PG8_LAS bf16x8*)(lds + PG8_SA(b, h) + aoff + m * 2048 + k * 1024); } while (0)
#define PG8_LDB(dst, b, h) do { _Pragma("unroll") for (int n = 0; n < 2; ++n) _Pragma("unroll") for (int k = 0; k < 2; ++k) dst[n][k] = *(const PG8_LAS bf16x8*)(lds + PG8_SB(b, h) + boff + n * 2048 + k * 1024); } while (0)
#define PG8_MMA(ai, bj, At, Bt) do { __builtin_amdgcn_s_setprio(1); _Pragma("unroll") for (int m = 0; m < 4; ++m) _Pragma("unroll") for (int n = 0; n < 2; ++n) _Pragma("unroll") for (int k = 0; k < 2; ++k) \
        acc[ai][bj][m][n] = __builtin_amdgcn_mfma_f32_16x16x32_bf16(Bt[n][k], At[m][k], acc[ai][bj][m][n], 0, 0, 0); __builtin_amdgcn_s_setprio(0); } while (0)
#define PG8_WAIT_V(n) asm volatile("s_waitcnt vmcnt(" #n ")" ::: "memory")
#define PG8_WAIT_L(n) asm volatile("s_waitcnt lgkmcnt(" #n ")" ::: "memory")
#define PG8_BAR __builtin_amdgcn_s_barrier()
#define PG8_SCHED __builtin_amdgcn_sched_barrier(0)
    Unit cur, nxt; int ui = 0;
    if (!S.next(0, cur)) return;
    f32x4 acc[2][2][4][2];
#pragma unroll
    for (int a = 0; a < 2; ++a)
#pragma unroll
        for (int b = 0; b < 2; ++b)
#pragma unroll
            for (int m = 0; m < 4; ++m)
#pragma unroll
                for (int n = 0; n < 2; ++n) acc[a][b][m][n] = (f32x4){0.f, 0.f, 0.f, 0.f};
    bf16x8 At[4][2], B0[2][2], B1[2][2];
    const char* cA = (const char*)g.A + (size_t)cur.pm * tstep; const char* cB = (const char*)g.Bt + (size_t)cur.pn * tstep;
    S.a_ready(cur);
    PG8_STAGE(PG8_SB(0, 0), cB, voffB); PG8_STAGE(PG8_SA(0, 0), cA, voffA); PG8_STAGE(PG8_SB(0, 1), cB + hstep, voffB); PG8_STAGE(PG8_SA(0, 1), cA + hstep, voffA);
    if (wr == 1) PG8_BAR;
    PG8_WAIT_V(4); PG8_BAR;
    PG8_STAGE(PG8_SB(1, 0), cB + kstep, voffB); PG8_STAGE(PG8_SA(1, 0), cA + kstep, voffA); PG8_STAGE(PG8_SB(1, 1), cB + hstep + kstep, voffB);
    PG8_WAIT_V(6); PG8_BAR;
    PG8_STAMP();
    for (;;) {
        const bool has_next = S.next(ui + 1, nxt);
        const char* nA = has_next ? (const char*)g.A + (size_t)nxt.pm * tstep : cA; const char* nB = has_next ? (const char*)g.Bt + (size_t)nxt.pn * tstep : cB;
        for (int t = 0; t < nt; t += 2) {
            const bool last = (t == nt - 2);
            const char* a1 = cA + (size_t)(t + 1) * kstep;
            const char* a2 = last ? nA : cA + (size_t)(t + 2) * kstep; const char* b2 = last ? nB : cB + (size_t)(t + 2) * kstep;
            const char* a3 = a2 + kstep; const char* b3 = b2 + kstep;
            if (last && has_next) S.a_ready(nxt);
            PG8_LDB(B0, 0, 0); PG8_SCHED; PG8_LDA(At, 0, 0); PG8_STAGE(PG8_SA(1, 1), a1 + hstep, voffA);
            PG8_WAIT_L(8); PG8_BAR; PG8_WAIT_L(0); PG8_MMA(0, 0, At, B0); PG8_BAR; PG8_SCHED;
            PG8_LDB(B1, 0, 1); PG8_STAGE(PG8_SB(0, 0), b2, voffB);
            PG8_BAR; PG8_WAIT_L(0); PG8_MMA(0, 1, At, B1); PG8_BAR;
            PG8_LDA(At, 0, 1); PG8_STAGE(PG8_SA(0, 0), a2, voffA);
            PG8_BAR; PG8_WAIT_L(0); PG8_MMA(1, 0, At, B0); PG8_BAR; PG8_SCHED;
            PG8_STAGE(PG8_SB(0, 1), b2 + hstep, voffB);
            PG8_WAIT_V(6); PG8_BAR; PG8_MMA(1, 1, At, B1); PG8_BAR;
            PG8_LDB(B0, 1, 0); PG8_SCHED; PG8_LDA(At, 1, 0); PG8_STAGE(PG8_SA(0, 1), a2 + hstep, voffA);
            PG8_WAIT_L(8); PG8_BAR; PG8_WAIT_L(0); PG8_MMA(0, 0, At, B0); PG8_BAR; PG8_SCHED;
            PG8_LDB(B1, 1, 1); PG8_STAGE(PG8_SB(1, 0), b3, voffB);
            PG8_BAR; PG8_WAIT_L(0); PG8_MMA(0, 1, At, B1); PG8_BAR;
            PG8_LDA(At, 1, 1); PG8_STAGE(PG8_SA(1, 0), a3, voffA);
            PG8_BAR; PG8_WAIT_L(0); PG8_MMA(1, 0, At, B0); PG8_BAR; PG8_SCHED;
            PG8_STAGE(PG8_SB(1, 1), b3 + hstep, voffB);
            PG8_WAIT_V(6); PG8_BAR; PG8_MMA(1, 1, At, B1); PG8_BAR;
        }
        PG8_STAMP();
        if constexpr (!Epi::AFTER_DRAIN) { E(acc, cur, wr, wc, fr, fq); S.done(cur); }
        PG8_STAMP();
        if (!has_next) break;
#pragma unroll
        for (int a = 0; a < 2; ++a)
#pragma unroll
            for (int b = 0; b < 2; ++b)
#pragma unroll
                for (int m = 0; m < 4; ++m)
#pragma unroll
                    for (int n = 0; n < 2; ++n) acc[a][b][m][n] = (f32x4){0.f, 0.f, 0.f, 0.f};
        cur = nxt; cA = nA; cB = nB; ++ui;
    }
    PG8_WAIT_V(0);
    if (wr == 0) PG8_BAR;
    PG8_BAR;
    if constexpr (Epi::AFTER_DRAIN) { E.fused(acc, cur, wr, wc, fr, fq, lds, wid, lane); S.done(cur); }
    PG8_STAMP();
    if (STAMP && wid == 0) { stamps[lane] = lane < nts ? (((unsigned long long)(unsigned)ts_hi << 32) | (unsigned)ts_lo) : 0ull;
        if (lane == 62) stamps[62] = rt_entry; if (lane == 63) stamps[63] = (unsigned long long)wall_clock64(); }
#undef PG8_STAMP
#undef PG8_SA
#undef PG8_SB
#undef PG8_STAGE
#undef PG8_LDA
#undef PG8_LDB
#undef PG8_MMA
#undef PG8_WAIT_V
#undef PG8_WAIT_L
#undef PG8_BAR
#undef PG8_SCHED
}
}
#define XB_TMO      128
#define XB_XCNT(j)  (256  + 64 * (j))
#define XB_XSUB(j)  (1280 + 64 * (j))
#define XB_XGEN(j)  (2304 + 64 * (j))
#define XB_TOP      3328
#define XB_TOPGEN   3392
#define XCD_BAR_WORDS 3456
#define XB_SPIN_CAP (1u << 18)
#define XB_LAS __attribute__((address_space(3)))

__device__ __forceinline__ unsigned xb_ld(unsigned* p)              { return __hip_atomic_load(p, __ATOMIC_RELAXED, __HIP_MEMORY_SCOPE_AGENT); }
__device__ __forceinline__ unsigned xb_add(unsigned* p, unsigned v) { return __hip_atomic_fetch_add(p, v, __ATOMIC_RELAXED, __HIP_MEMORY_SCOPE_AGENT); }
__device__ __forceinline__ unsigned xb_xcc_id() { return (unsigned)__builtin_amdgcn_s_getreg((3 << 11) | 20) & 0xFu; }
#define XB_SPIN(cond, bar) do { unsigned _sp = 0; while (cond) { __builtin_amdgcn_s_sleep(1); \
    if ((++_sp & 255u) == 0u) { if (xb_ld(&(bar)[XB_TMO])) break; if (_sp > XB_SPIN_CAP) { atomicAdd(&(bar)[XB_TMO], 1u); break; } } } } while (0)

struct XcdBarrier {
    unsigned* bar; unsigned x;
    volatile XB_LAS unsigned* st;
};

__device__ __forceinline__ XcdBarrier xcd_barrier_post(unsigned* bar, volatile XB_LAS unsigned* st) {
    XcdBarrier b; b.bar = bar; b.x = xb_xcc_id(); b.st = st;
    if (threadIdx.x == 0) (void)xb_add(&bar[XB_XCNT(b.x)], 1u);
    return b;
}
__device__ __forceinline__ void xcd_barrier_complete(unsigned* bar, unsigned x, unsigned& nloc, unsigned& nx) {
    const unsigned G = gridDim.x * gridDim.y * gridDim.z;
    unsigned sum, cnt, mine, sp = 0u;
    for (;;) {
        sum = 0u; cnt = 0u; mine = 0u;
#pragma unroll
        for (unsigned j = 0; j < 16; ++j) { const unsigned c = xb_ld(&bar[XB_XCNT(j)]); sum += c; cnt += (c > 0u) ? 1u : 0u; mine = (j == x) ? c : mine; }
        if (sum == G) break;
        __builtin_amdgcn_s_sleep(1);
        if ((++sp & 255u) == 0u) { if (xb_ld(&bar[XB_TMO])) break; if (sp > XB_SPIN_CAP) { atomicAdd(&bar[XB_TMO], 1u); break; } }
    }
    nloc = mine > 0u ? mine : 1u; nx = cnt > 0u ? cnt : 1u;
}

__device__ __forceinline__ void xcd_barrier(const XcdBarrier& b) {
    asm volatile("s_waitcnt vmcnt(0)" ::: "memory");
    __syncthreads();
    if (threadIdx.x == 0) {
        unsigned* bar = b.bar;
        __builtin_amdgcn_s_waitcnt(0);
        unsigned nloc = b.st[0], nx = b.st[1];
        if (nloc == 0u) { xcd_barrier_complete(bar, b.x, nloc, nx); b.st[0] = nloc; b.st[1] = nx; }
        const unsigned old = xb_add(&bar[XB_XSUB(b.x)], 1u);
        const unsigned gen = old / nloc;
        if (old + 1u == (gen + 1u) * nloc) {
            __builtin_amdgcn_fence(__ATOMIC_RELEASE, "agent");
            asm volatile("s_waitcnt vmcnt(0)" ::: "memory");
            const unsigned og = xb_add(&bar[XB_TOP], 1u);
            const unsigned tg = og / nx;
            if (og + 1u == (tg + 1u) * nx) xb_add(&bar[XB_TOPGEN], 1u);
            else XB_SPIN(xb_ld(&bar[XB_TOPGEN]) == tg, bar);
            __builtin_amdgcn_fence(__ATOMIC_ACQUIRE, "agent");
            xb_add(&bar[XB_XGEN(b.x)], 1u);
            asm volatile("s_waitcnt vmcnt(0)" ::: "memory");
        } else {
            XB_SPIN(xb_ld(&bar[XB_XGEN(b.x)]) == gen, bar);
            __builtin_amdgcn_fence(__ATOMIC_ACQUIRE, "agent");
            asm volatile("s_waitcnt vmcnt(0)" ::: "memory");
        }
    }
    __syncthreads();
}

namespace cg = cooperative_groups;
typedef unsigned short bf16_t;
using pg8::bf16x8; using pg8::f32x4;
#define LAS __attribute__((address_space(3)))

constexpr int D = 1024, NB = 16, TL = 2048, TCX = 256, FF = 2816;
constexpr int MLAT = NB * TL, MCTX = NB * TCX, MTOT = MLAT + MCTX;
constexpr float DN_ALPHA = 1.681792830507429f;
constexpr int NTHR = 512;
constexpr int LDS_BYTES = 155648;

constexpr size_t al256(size_t x) { return (x + 255) & ~(size_t)255; }
constexpr size_t WS_MOD = 16384;
constexpr size_t WS_FT = al256(WS_MOD + (size_t)4 * 17 * 9216 * 4);
constexpr size_t FT_LAT = (size_t)2 * 512 * 4096, FT_CTX = (size_t)2 * 512 * 512, FT_E = FT_LAT + FT_CTX;
constexpr size_t WS_WUP = al256(WS_FT + 2 * FT_E * 2);
constexpr size_t WS_WDN = WS_WUP + (size_t)2 * 5632 * 1024 * 2;
constexpr size_t WS_WIN = WS_WDN + (size_t)2 * 1024 * 2816 * 2;
constexpr size_t WS_WOUT = WS_WIN + (size_t)3584 * 1024 * 2;
constexpr size_t WS_H = WS_WOUT + (size_t)1024 * 1024 * 2;
constexpr size_t WS_A = WS_H + (size_t)MTOT * 1024 * 4;
constexpr size_t WS_BON = WS_A + (size_t)MTOT * 1024 * 2;
constexpr size_t WS_STATS = al256(WS_BON + (size_t)2 * MTOT * 8 * 4);
constexpr size_t WS_BIG = al256(WS_STATS + (size_t)MTOT * 2 * 4);
constexpr size_t BIG_ZR = (size_t)1536 * MTOT * 2;
constexpr size_t BIG_ORW = BIG_ZR + (size_t)MTOT * 1920 * 2;
constexpr size_t BIG_EVEN_END = BIG_ORW + (size_t)2 * MTOT * 512 * 2;
constexpr size_t BIG_OGL = al256((size_t)MTOT * 3104 * 2);
constexpr size_t WS_END = WS_BIG + BIG_EVEN_END;

struct Params { const float* in[41]; };
#define PH_PRO int tid_ = threadIdx.x; asm volatile("" : "+v"(tid_)); int bid_ = blockIdx.x; asm volatile("" : "+s"(bid_)); int gdim_ = gridDim.x; asm volatile("" : "+s"(gdim_));
extern __shared__ __attribute__((aligned(16))) unsigned char smem_g[];
constexpr int TBL_OFF = LDS_BYTES - 512;
typedef const float __attribute__((address_space(1)))* gfptr_;
#define IN(i) ((const float*)(((const gfptr_*)(smem_g + TBL_OFF))[i]))
#define OUT_ ((float*)IN(39))
#define WS_ ((unsigned char*)IN(40))

__device__ __forceinline__ float bf2f(bf16_t b) { return __uint_as_float(((unsigned)b) << 16); }
typedef __bf16 bf16x2_t_ __attribute__((ext_vector_type(2)));
typedef float f32x2_t_ __attribute__((ext_vector_type(2)));
__device__ __forceinline__ unsigned pk2(float lo, float hi) { f32x2_t_ v = {lo, hi}; bf16x2_t_ b = __builtin_convertvector(v, bf16x2_t_); return __builtin_bit_cast(unsigned, b); }
__device__ __forceinline__ bf16_t f2bf(float f) { return (bf16_t)(pk2(f, 0.f) & 0xffffu); }
__device__ __forceinline__ bf16x8 ld8(const bf16_t* p) { const uint2 a = *(const uint2*)p, b = *(const uint2*)(p + 4); uint4 v; v.x = a.x; v.y = a.y; v.z = b.x; v.w = b.y; return __builtin_bit_cast(bf16x8, v); }
#define DPPF(v, ctrl) __builtin_bit_cast(float, __builtin_amdgcn_update_dpp(0, __builtin_bit_cast(int, (v)), (ctrl), 0xF, 0xF, true))
__device__ __forceinline__ float wsum(float v) {
    v += DPPF(v, 0xB1); v += DPPF(v, 0x4E); v += DPPF(v, 0x141); v += DPPF(v, 0x140);
    const int iv = __builtin_bit_cast(int, v);
    return __builtin_bit_cast(float, __builtin_amdgcn_readlane(iv, 0)) + __builtin_bit_cast(float, __builtin_amdgcn_readlane(iv, 16)) +
           __builtin_bit_cast(float, __builtin_amdgcn_readlane(iv, 32)) + __builtin_bit_cast(float, __builtin_amdgcn_readlane(iv, 48));
}
__device__ __forceinline__ float sigm(float x) { return __builtin_amdgcn_rcpf(1.f + __expf(-x)); }
__device__ __forceinline__ float silu_(float x) { return x * __builtin_amdgcn_rcpf(1.f + __expf(-x)); }
__device__ __forceinline__ float softplus_(float y) { return fmaxf(y, 0.f) + __logf(1.f + __expf(-fabsf(y))); }
__device__ __forceinline__ float tanh_(float x) { return 1.f - 2.f * __builtin_amdgcn_rcpf(1.f + __expf(2.f * x)); }

struct EpiStore {
    static constexpr bool PERM = true, AFTER_DRAIN = false;
    bf16_t* O; int ldc; int nvalid;
    __device__ __forceinline__ void operator()(const f32x4 (&acc)[2][2][4][2], const pg8::Unit& u, int wr, int wc, int fr, int fq) const {
        const int row0 = u.pm * 256 + wr * 64 + fr, col0 = u.pn * 256 + wc * 32 + 8 * fq;
#pragma unroll
        for (int ai = 0; ai < 2; ++ai)
#pragma unroll
            for (int m = 0; m < 4; ++m) {
                bf16_t* rowp = O + (size_t)(row0 + ai * 128 + m * 16) * ldc;
#pragma unroll
                for (int bj = 0; bj < 2; ++bj) {
                    const int col = col0 + bj * 128;
                    if (col < nvalid) {
                        const f32x4 v0 = acc[ai][bj][m][0], v1 = acc[ai][bj][m][1];
                        uint4 o; o.x = pk2(v0[0], v0[1]); o.y = pk2(v0[2], v0[3]); o.z = pk2(v1[0], v1[1]); o.w = pk2(v1[2], v1[3]);
                        *(uint4*)(rowp + col) = o;
                    }
                }
            }
    }
};
struct EpiSwiglu {
    static constexpr bool PERM = true, AFTER_DRAIN = false;
    bf16_t* G; int pm_off;
    __device__ __forceinline__ void operator()(const f32x4 (&acc)[2][2][4][2], const pg8::Unit& u, int wr, int wc, int fr, int fq) const {
        const int row0 = (u.pm + pm_off) * 256 + wr * 64 + fr, col0 = u.pn * 128 + wc * 32 + 8 * fq;
#pragma unroll
        for (int ai = 0; ai < 2; ++ai)
#pragma unroll
            for (int m = 0; m < 4; ++m) {
                bf16_t* rowp = G + (size_t)(row0 + ai * 128 + m * 16) * FF + col0;
                float o[8];
#pragma unroll
                for (int n = 0; n < 2; ++n)
#pragma unroll
                    for (int e = 0; e < 4; ++e) o[n * 4 + e] = silu_(acc[ai][0][m][n][e]) * acc[ai][1][m][n][e];
                uint4 q; q.x = pk2(o[0], o[1]); q.y = pk2(o[2], o[3]); q.z = pk2(o[4], o[5]); q.w = pk2(o[6], o[7]);
                *(uint4*)rowp = q;
            }
    }
};
struct EpiResid {
    static constexpr bool PERM = false, AFTER_DRAIN = false;
    int gate_off; float wgt; int ln_idx; int pm_off;
    __device__ __forceinline__ void operator()(const f32x4 (&acc)[2][2][4][2], const pg8::Unit& u, int wr, int wc, int fr, int fq) const {
        float* H = (float*)(WS_ + WS_H); const float* gate = (const float*)(WS_ + WS_MOD) + gate_off;
        const float* stats = ln_idx >= 0 ? (const float*)(WS_ + WS_STATS) : nullptr;
        const float* Hin = ln_idx >= 0 ? H : ((u.pm + pm_off) < 128 ? IN(0) : IN(2) - (size_t)MLAT * D);
        const float* lg = IN(6) + (ln_idx < 0 ? 0 : ln_idx) * 1024; const float* lb = IN(7) + (ln_idx < 0 ? 0 : ln_idx) * 1024;
        const int gpm = u.pm + pm_off;
        const int row0 = gpm * 256 + wr * 64 + fr, col0 = u.pn * 256 + wc * 32 + 4 * fq;
        const int midx = gpm < 128 ? (gpm >> 3) : 16;
        const float* gp = gate + (size_t)midx * 9216 + col0;
        float mu[2][4], rs[2][4];
#pragma unroll
        for (int ai = 0; ai < 2; ++ai)
#pragma unroll
            for (int m = 0; m < 4; ++m) {
                if (stats) { const float2 st = *(const float2*)(stats + 2 * (size_t)(row0 + ai * 128 + m * 16)); mu[ai][m] = st.x; rs[ai][m] = st.y; }
                else { mu[ai][m] = 0.f; rs[ai][m] = 1.f; }
            }
#pragma unroll
        for (int bj = 0; bj < 2; ++bj)
#pragma unroll
            for (int n = 0; n < 2; ++n) {
                const int co = bj * 128 + n * 16;
                const f32x4 gvv = *(const f32x4*)(gp + co) * wgt;
                f32x4 g4 = (f32x4){1.f, 1.f, 1.f, 1.f}, b4 = (f32x4){0.f, 0.f, 0.f, 0.f};
                if (stats) { g4 = *(const f32x4*)(lg + col0 + co); b4 = *(const f32x4*)(lb + col0 + co); }
#pragma unroll
                for (int ai = 0; ai < 2; ++ai)
#pragma unroll
                    for (int m = 0; m < 4; ++m) {
                        float* rowp = H + (size_t)(row0 + ai * 128 + m * 16) * D + col0 + co;
                        f32x4 h = *(const f32x4*)(Hin + (size_t)(row0 + ai * 128 + m * 16) * D + col0 + co);
                        h = (h - mu[ai][m]) * rs[ai][m] * g4 + b4;
                        h = h * DN_ALPHA + gvv * acc[ai][bj][m][n];
                        *(f32x4*)rowp = h;
                    }
            }
    }
};

template <class Epi>
__device__ __forceinline__ void run_gemm(unsigned char* smem, const bf16_t* A, const bf16_t* Bt, int M, int N, int K, const Epi& E, int bid_, int gdim_) {
    pg8::Gemm g; g.A = A; g.Bt = Bt; g.M = M; g.N = N; g.K = K;
    pg8::StaticOrder S; S.init(M, N, gdim_, bid_);
    pg8::gemm_phase<Epi, pg8::StaticOrder, false>((PG8_LAS unsigned char*)smem, g, S, E, nullptr);
}

__device__ __forceinline__ void phase_mod(const Params& p, unsigned char* smem) {
    PH_PRO
    float* s = (float*)smem;
    float* part = s + 17 * 1024;
    const int tid = tid_;
    const float* c = IN(1); const float* cc = IN(3);
    float* MOD = (float*)(WS_ + WS_MOD);
    if (bid_ >= 288) return;
    for (int idx = tid; idx < 17 * 1024; idx += NTHR) { const int i = idx >> 10, k = idx & 1023; const float v = i < 16 ? c[i * 1024 + k] : cc[k]; s[idx] = silu_(v); }
    __syncthreads();
    for (int item = bid_; item < 288; item += gdim_) {
        const int l = item / 72, j0 = (item % 72) * 128;
        const int col = tid & 127, kq = tid >> 7;
        const float* w = IN(4) + ((size_t)l * 1024 + kq * 256) * 9216 + j0 + col;
        float acc[17];
#pragma unroll
        for (int i = 0; i < 17; ++i) acc[i] = 0.f;
        for (int k = 0; k < 256; ++k) {
            const float wv = w[(size_t)k * 9216];
#pragma unroll
            for (int i = 0; i < 17; ++i) acc[i] += s[i * 1024 + kq * 256 + k] * wv;
        }
#pragma unroll
        for (int i = 0; i < 17; ++i) part[(kq * 17 + i) * 128 + col] = acc[i];
        __syncthreads();
        for (int idx = tid; idx < 17 * 128; idx += NTHR) {
            const int i = idx >> 7, cl = idx & 127;
            const float v = part[(0 * 17 + i) * 128 + cl] + part[(1 * 17 + i) * 128 + cl] + part[(2 * 17 + i) * 128 + cl] + part[(3 * 17 + i) * 128 + cl] + IN(5)[l * 9216 + j0 + cl];
            MOD[((size_t)l * 17 + i) * 9216 + j0 + cl] = v;
        }
        __syncthreads();
    }
}

__device__ __forceinline__ void conv_tile(const float* src, int ld, int nvalid, bf16_t* dst, int ldd, float* tile) {
    PH_PRO
    const int tid = tid_;
#pragma unroll
    for (int i = 0; i < 2; ++i) {
        const int k = (tid >> 4) + 32 * i, c4 = (tid & 15) * 4;
        float4 v = make_float4(0.f, 0.f, 0.f, 0.f);
        if (c4 < nvalid) v = *(const float4*)(src + (size_t)k * ld + c4);
        tile[k * 65 + c4] = v.x; tile[k * 65 + c4 + 1] = v.y; tile[k * 65 + c4 + 2] = v.z; tile[k * 65 + c4 + 3] = v.w;
    }
    __syncthreads();
    const int n = tid >> 3, ks = (tid & 7) * 8;
    uint4 o;
    o.x = pk2(tile[(ks + 0) * 65 + n], tile[(ks + 1) * 65 + n]); o.y = pk2(tile[(ks + 2) * 65 + n], tile[(ks + 3) * 65 + n]);
    o.z = pk2(tile[(ks + 4) * 65 + n], tile[(ks + 5) * 65 + n]); o.w = pk2(tile[(ks + 6) * 65 + n], tile[(ks + 7) * 65 + n]);
    *(uint4*)(dst + (size_t)n * ldd + ks) = o;
    __syncthreads();
}
__device__ __forceinline__ void conv_weights(const Params& p, int l, unsigned char* smem) {
    PH_PRO
    float* tile = (float*)smem;
    const bool even = !(l & 1); const int eo = l >> 1;
    const int NIN = even ? 3456 : 3104, nint = (even ? 3584 : 3328) / 64;
    const int total = 2816 + 1408 + nint * 16 + 256;
    bf16_t* WUP = (bf16_t*)(WS_ + WS_WUP); bf16_t* WDN = (bf16_t*)(WS_ + WS_WDN); bf16_t* WIN = (bf16_t*)(WS_ + WS_WIN); bf16_t* WOUT = (bf16_t*)(WS_ + WS_WOUT);
    for (int idx = bid_; idx < total; idx += gdim_) {
        if (idx < 2816) {
            const int f = idx / 1408, r = idx % 1408, nt = r / 16, kt = r % 16, n0 = nt * 64;
            const int pn = n0 >> 8, bj = (n0 & 255) >> 7, j = n0 & 127, col = pn * 128 + j;
            const float* src = (bj ? IN(9) : IN(8)) + ((size_t)(l * 2 + f) * 1024 + kt * 64) * FF + col;
            conv_tile(src, FF, 64, WUP + ((size_t)f * 5632 + n0) * 1024 + kt * 64, 1024, tile);
        } else if (idx < 4224) {
            int r = idx - 2816; const int f = r / 704; r %= 704; const int kt = r / 16, nt = r % 16;
            const float* src = IN(10) + ((size_t)(l * 2 + f) * FF + kt * 64) * 1024 + nt * 64;
            conv_tile(src, 1024, 64, WDN + ((size_t)f * 1024 + nt * 64) * FF + kt * 64, FF, tile);
        } else if (idx < 4224 + nint * 16) {
            const int r = idx - 4224, nt = r / 16, kt = r % 16, n0 = nt * 64;
            int nv = NIN - n0; nv = nv < 0 ? 0 : (nv > 64 ? 64 : nv);
            const float* src = (even ? IN(11) : IN(34)) + ((size_t)eo * 1024 + kt * 64) * NIN + n0;
            conv_tile(src, NIN, nv, WIN + (size_t)n0 * 1024 + kt * 64, 1024, tile);
        } else {
            const int r = idx - 4224 - nint * 16, nt = r / 16, kt = r % 16;
            const float* src = (even ? IN(12) : IN(35)) + ((size_t)eo * 1024 + kt * 64) * 1024 + nt * 64;
            conv_tile(src, 1024, 64, WOUT + (size_t)nt * 64 * 1024 + kt * 64, 1024, tile);
        }
    }
}

__device__ __forceinline__ void filt_gen(const Params& p, unsigned char* smem) {
    PH_PRO
    float* z = (float*)smem;
    float* h1 = z + 64 * 33;
    float* h2 = h1 + 64 * 65;
    const int tid = tid_, lane = tid & 63, wid = __builtin_amdgcn_readfirstlane(tid >> 6);
    bf16_t* FT = (bf16_t*)(WS_ + WS_FT);
    for (int item = (bid_ + gdim_ / 2) % gdim_; item < 2 * 36 * 4; item += gdim_) {
        const int e = item / 144; int r = item % 144; const int cg = r & 3; r >>= 2;
        const int seg = r >= 32; const int jb = seg ? r - 32 : r;
        const int L = seg ? 256 : 2048;
        const float* w1 = IN(15) + e * 33 * 64; const float* b1 = IN(16) + e * 64; const float* f1 = IN(17) + e * 64;
        const float* w2 = IN(18) + e * 64 * 64; const float* b2 = IN(19) + e * 64; const float* f2 = IN(20) + e * 64;
        const float* w3 = IN(21) + (size_t)e * 64 * 2048; const float* skip = IN(22) + e * 1024;
        __syncthreads();
        for (int idx = tid; idx < 64 * 33; idx += NTHR) {
            const int jj = idx / 33, i = idx % 33; const int j = jb * 64 + jj;
            float v;
            if (i == 0) v = (float)j / (float)(L - 1);
            else { const int bi = (i - 1) & 15; const float f = 1e-4f + (float)bi * ((15.f - 1e-4f) / 15.f); const float w = 6.283185307179586f * (float)j / (float)L; v = (i <= 16) ? cosf(f * w) : -sinf(f * w); }
            z[idx] = v;
        }
        __syncthreads();
        for (int idx = tid; idx < 4096; idx += NTHR) {
            const int jj = idx >> 6, o = idx & 63; float a = b1[o];
            for (int i = 0; i < 33; ++i) a += z[jj * 33 + i] * w1[i * 64 + o];
            h1[jj * 65 + o] = sinf(f1[o] * a);
        }
        __syncthreads();
        for (int idx = tid; idx < 4096; idx += NTHR) {
            const int jj = idx >> 6, o = idx & 63; float a = b2[o];
            for (int k = 0; k < 64; ++k) a += h1[jj * 65 + k] * w2[k * 64 + o];
            h2[jj * 65 + o] = sinf(f2[o] * a);
        }
        __syncthreads();
        bf16_t* base = FT + (size_t)e * FT_E + (seg ? FT_LAT : 0);
#pragma unroll 1
        for (int ps = 0; ps < 2; ++ps) {
            const int col0 = cg * 512 + ps * 256 + 4 * lane;
            float acc[8][4];
#pragma unroll
            for (int i = 0; i < 8; ++i)
#pragma unroll
                for (int c = 0; c < 4; ++c) acc[i][c] = 0.f;
#pragma unroll 4
            for (int k = 0; k < 64; ++k) {
                const float4 wv = *(const float4*)(w3 + (size_t)k * 2048 + col0);
#pragma unroll
                for (int i = 0; i < 8; ++i) { const float hv = h2[(8 * wid + i) * 65 + k]; acc[i][0] += hv * wv.x; acc[i][1] += hv * wv.y; acc[i][2] += hv * wv.z; acc[i][3] += hv * wv.w; }
            }
            const int ord = col0 >> 10, dir = (col0 >> 9) & 1;
            const float lo = -4.605170185988091f / 1.5f, hi = -4.605170185988091f / 0.3f;
#pragma unroll
            for (int c = 0; c < 4; ++c) {
                const int ch = (col0 + c) & 511;
                const float adl = fabsf(lo + (hi - lo) * (float)ch / 511.f);
                bf16_t* fp = base + ((size_t)ord * 512 + ch) * (2 * L);
#pragma unroll
                for (int i = 0; i < 8; ++i) {
                    const int j = jb * 64 + 8 * wid + i; const float tj = (float)j / (float)(L - 1);
                    float v = acc[i][c] * __expf(-tj * adl);
                    if (dir == 0 && j == 0) v += skip[ord * 512 + ch];
                    if (!(dir == 1 && j == 0)) fp[dir == 0 ? (L - 1 - j) : (L - 1 + j)] = f2bf(v);
                }
            }
        }
    }
    __syncthreads();
}

__device__ __forceinline__ void row_phase(const Params& p, int mode, int l_ln, int which, int l_mod, int sidx, bool fin, int nrows_in = MTOT, int row_begin = 0, int blk_off = 0, int nblk_in = 0) {
    PH_PRO
    const int lane = tid_ & 63, wid = tid_ >> 6;
    float* H = (float*)(WS_ + WS_H); bf16_t* A = (bf16_t*)(WS_ + WS_A);
    const float* MOD = (const float*)(WS_ + WS_MOD);
    const float* lg = IN(6) + (l_ln * 3 + which) * 1024; const float* lb = IN(7) + (l_ln * 3 + which) * 1024;
    const int nrows = fin ? MLAT : nrows_in;
    constexpr int RU = 1;
    const int nblk = nblk_in ? nblk_in : gdim_;
    for (int rowb = row_begin + (bid_ - blk_off) * 8 + wid; rowb < nrows; rowb += nblk * 8 * RU) {
        float4 v[RU][4]; int rows[RU]; bool okr[RU];
#pragma unroll
        for (int u = 0; u < RU; ++u) {
            const int row = rowb + u * nblk * 8; okr[u] = row < nrows; rows[u] = okr[u] ? row : rowb;
            const float* src = mode ? H + (size_t)rows[u] * D : (rows[u] < MLAT ? IN(0) + (size_t)rows[u] * D : IN(2) + (size_t)(rows[u] - MLAT) * D);
#pragma unroll
            for (int i = 0; i < 4; ++i) v[u][i] = *(const float4*)(src + 4 * lane + 256 * i);
        }
#pragma unroll
        for (int u = 0; u < RU; ++u) {
            const int row = rows[u];
            if (mode) {
                float s = 0.f;
#pragma unroll
                for (int i = 0; i < 4; ++i) s += v[u][i].x + v[u][i].y + v[u][i].z + v[u][i].w;
                const float mu = wsum(s) * (1.f / 1024.f);
                float q = 0.f;
#pragma unroll
                for (int i = 0; i < 4; ++i) { v[u][i].x -= mu; v[u][i].y -= mu; v[u][i].z -= mu; v[u][i].w -= mu; q += v[u][i].x * v[u][i].x + v[u][i].y * v[u][i].y + v[u][i].z * v[u][i].z + v[u][i].w * v[u][i].w; }
                const float rstd = rsqrtf(wsum(q) * (1.f / 1024.f) + 1e-6f);
                if (lane == 0 && !fin && okr[u]) *(float2*)((float*)(WS_ + WS_STATS) + 2 * (size_t)row) = make_float2(mu, rstd);
#pragma unroll
                for (int i = 0; i < 4; ++i) {
                    const float4 g = *(const float4*)(lg + 4 * lane + 256 * i), b = *(const float4*)(lb + 4 * lane + 256 * i);
                    v[u][i].x = v[u][i].x * rstd * g.x + b.x; v[u][i].y = v[u][i].y * rstd * g.y + b.y; v[u][i].z = v[u][i].z * rstd * g.z + b.z; v[u][i].w = v[u][i].w * rstd * g.w + b.w;
                }
            }
            if (!okr[u]) continue;
            if (fin) {
#pragma unroll
                for (int i = 0; i < 4; ++i) *(float4*)(OUT_ + (size_t)row * D + 4 * lane + 256 * i) = v[u][i];
            } else {
                const int midx = row < MLAT ? (row >> 11) : 16;
                const float* mp = MOD + ((size_t)l_mod * 17 + midx) * 9216 + sidx * 1024;
#pragma unroll
                for (int i = 0; i < 4; ++i) {
                    const float4 sh = *(const float4*)(mp + 4 * lane + 256 * i), sc = *(const float4*)(mp + 1024 + 4 * lane + 256 * i);
                    uint2 o; o.x = pk2(v[u][i].x * (1.f + sc.x) + sh.x, v[u][i].y * (1.f + sc.y) + sh.y); o.y = pk2(v[u][i].z * (1.f + sc.z) + sh.z, v[u][i].w * (1.f + sc.w) + sh.w);
                    *(uint2*)(A + (size_t)row * D + 4 * lane + 256 * i) = o;
                }
            }
        }
    }
}
template <int L>
__device__ __forceinline__ void hyena_item(const Params& p, int e, int c, int segbase, const bf16_t* ft, unsigned char* smem) {
    PH_PRO
    constexpr int CPS = 2 * L + 16, UTS = L + 8, TPW = (L / 16) / 8;
    bf16_t* COP = (bf16_t*)smem;
    bf16_t* UT = COP + 8 * CPS;
    const int tid = tid_, lane = tid & 63, wid = tid >> 6;
    bf16_t* ZHT = (bf16_t*)(WS_ + WS_BIG);
    bf16_t* zv = ZHT + (size_t)c * MTOT + segbase;
    const bf16_t* zx1 = ZHT + (size_t)(512 + c) * MTOT + segbase;
    const bf16_t* zx2 = ZHT + (size_t)(1024 + c) * MTOT + segbase;
    const float* cw = IN(13) + e * 3 * 1536; const float* cbp = IN(14) + e * 1536;
    const float vw0 = cw[c], vw1 = cw[1536 + c], vw2 = cw[3072 + c], vb = cbp[c];
    const float aw0 = cw[512 + c], aw1 = cw[1536 + 512 + c], aw2 = cw[3072 + 512 + c], ab = cbp[512 + c];
    const float bw0 = cw[1024 + c], bw1 = cw[1536 + 1024 + c], bw2 = cw[3072 + 1024 + c], bb = cbp[1024 + c];
    auto conv4 = [&](const bf16_t* q, int t0, float w0, float w1, float w2, float bias, float (&y)[4]) {
        const uint2 mid = *(const uint2*)(q + t0);
        float zm = bf2f(q[t0 > 0 ? t0 - 1 : 0]); zm = t0 > 0 ? zm : 0.f;
        float zq = bf2f(q[t0 + 4 < L ? t0 + 4 : L - 1]); zq = t0 + 4 < L ? zq : 0.f;
        const float z0 = __uint_as_float(mid.x << 16), z1 = __uint_as_float(mid.x & 0xffff0000u), z2 = __uint_as_float(mid.y << 16), z3 = __uint_as_float(mid.y & 0xffff0000u);
        y[0] = zm * w0 + z0 * w1 + z1 * w2 + bias; y[1] = z0 * w0 + z1 * w1 + z2 * w2 + bias;
        y[2] = z1 * w0 + z2 * w1 + z3 * w2 + bias; y[3] = z2 * w0 + z3 * w1 + zq * w2 + bias;
    };
#pragma unroll 4
    for (int idx = tid; idx < 4 * L; idx += NTHR) {
        const int b = idx / (L / 4), s4 = (idx % (L / 4)) * 4;
        float y[4]; conv4(zv + b * L, s4, vw0, vw1, vw2, vb, y);
        uint2 o; o.x = pk2(y[0], y[1]); o.y = pk2(y[2], y[3]);
        *(uint2*)(UT + b * UTS + s4) = o;
    }
    const int r = lane & 15, g = lane >> 4, a = 7 - (r & 7);
    const bf16_t* cop_a = COP + a * CPS;
    f32x4 acc[TPW];
#pragma unroll 1
    for (int ord = 0; ord < 2; ++ord) {
        const bf16_t* fo = ft + ((size_t)ord * 512 + c) * (2 * L);
        for (int cidx = tid; cidx < (2 * L) / 8; cidx += NTHR) {
            const uint4 raw = *(const uint4*)(fo + 8 * cidx);
            unsigned short v[8] = {(unsigned short)(raw.x & 0xffffu), (unsigned short)(raw.x >> 16), (unsigned short)(raw.y & 0xffffu), (unsigned short)(raw.y >> 16),
                                   (unsigned short)(raw.z & 0xffffu), (unsigned short)(raw.z >> 16), (unsigned short)(raw.w & 0xffffu), (unsigned short)(raw.w >> 16)};
            if (cidx == (2 * L) / 8 - 1) v[7] = 0;
#pragma unroll
            for (int ca = 0; ca < 8; ++ca)
#pragma unroll
                for (int j = 0; j < 8; ++j) { const int x = 8 * cidx - ca + j; COP[ca * CPS + (x < 0 ? 0 : x)] = v[j]; }
        }
        __syncthreads();
#pragma unroll
        for (int i = 0; i < TPW; ++i) acc[i] = (f32x4){0.f, 0.f, 0.f, 0.f};
        if constexpr (TPW == 16) {
            const bf16_t* fbase = cop_a + (8 * g - r + L - 1 - a) - wid * 256;
            bf16x8 F[16];
#pragma unroll
            for (int dd = -15; dd <= 0; ++dd) F[dd & 15] = *(const bf16x8*)(fbase + 16 * dd);
#pragma unroll 1
            for (int S0 = 0; S0 < L / 32; S0 += 8) {
#pragma unroll
                for (int u = 0; u < 8; ++u) {
                    const int S = S0 + u;
                    if (S > 0) { F[(2 * u) & 15] = *(const bf16x8*)(fbase + 32 * S); F[(2 * u - 1) & 15] = *(const bf16x8*)(fbase + 32 * S - 16); }
                    const bf16x8 bfr = *(const bf16x8*)(UT + r * UTS + 32 * S + 8 * g);
#pragma unroll
                    for (int i = 0; i < 16; ++i) acc[i] = __builtin_amdgcn_mfma_f32_16x16x32_bf16(F[(2 * u - i) & 15], bfr, acc[i], 0, 0, 0);
                }
            }
        } else {
        for (int s0 = 0; s0 < L; s0 += 32) {
            const bf16x8 bfr = *(const bf16x8*)(UT + r * UTS + s0 + 8 * g);
#pragma unroll
            for (int i = 0; i < TPW; ++i) {
                const int t0 = (wid * TPW + i) * 16;
                const int n8 = s0 - t0 + 8 * g - r + L - 1 - a;
                const bf16x8 afr = *(const bf16x8*)(cop_a + n8);
                acc[i] = __builtin_amdgcn_mfma_f32_16x16x32_bf16(afr, bfr, acc[i], 0, 0, 0);
            }
        }
        }
        __syncthreads();
        int rl = r * L, tb0 = wid * TPW * 16 + 4 * g; asm volatile("" : "+v"(rl), "+v"(tb0));
        if (ord == 0) {
#pragma unroll
            for (int i = 0; i < TPW; ++i) {
                const int t0 = tb0 + i * 16;
                float y[4]; conv4(zx1 + rl, t0, aw0, aw1, aw2, ab, y);
                uint2 o; o.x = pk2(y[0] * acc[i][0], y[1] * acc[i][1]); o.y = pk2(y[2] * acc[i][2], y[3] * acc[i][3]);
                *(uint2*)(UT + r * UTS + t0) = o;
                if ((i & 3) == 3) __builtin_amdgcn_sched_barrier(0);
            }
        } else {
#pragma unroll
            for (int i = 0; i < TPW; ++i) {
                const int t0 = tb0 + i * 16;
                float y[4]; conv4(zx2 + rl, t0, bw0, bw1, bw2, bb, y);
                uint2 o; o.x = pk2(y[0] * acc[i][0], y[1] * acc[i][1]); o.y = pk2(y[2] * acc[i][2], y[3] * acc[i][3]);
                *(uint2*)(zv + rl + t0) = o;
                if ((i & 3) == 3) __builtin_amdgcn_sched_barrier(0);
            }
        }
    }
    __syncthreads();
}
__device__ __forceinline__ void hyena_phase(const Params& p, int e, unsigned char* smem) {
    PH_PRO
    const bf16_t* FT = (const bf16_t*)(WS_ + WS_FT) + (size_t)e * FT_E;
    for (int item = bid_; item < 1024; item += gdim_) {
        if (item < 512) hyena_item<2048>(p, e, item, 0, FT, smem);
        else hyena_item<256>(p, e, item - 512, MLAT, FT + FT_LAT, smem);
    }
}

__device__ __forceinline__ void rwkv_scan_phase(const Params& p, int e, unsigned char* smem) {
    PH_PRO
    const int chain = bid_; if (chain >= 256) return;
    const int xcd_ = chain & 7, jx_ = chain >> 3;
    const int b = 2 * xcd_ + (jx_ >> 4), d = (jx_ >> 3) & 1, h = jx_ & 7;
    const int tid = tid_, lane = tid & 63, wid = tid >> 6;
    bf16_t* WUPT = (bf16_t*)smem;
    bf16_t* AUPT = WUPT + 4096;
    float* sBONp = (float*)(AUPT + 4096);
    constexpr int SOPS = 336;
    float* sOP = (float*)smem + 8192;
    float* sR = sOP;
    float* sKK = sR + 4096;
    float* sW = sKK + 4096;
    float* sKD = sW + 4096;
    float* sKKA = sKD + 4096;
    float* sV = sOP + 64 * SOPS;
    float* sO = sV + 4096;
    bf16_t* TWb = (bf16_t*)sO;
    bf16_t* ADb = TWb + 4096;
    const bf16_t* ZR = (const bf16_t*)(WS_ + WS_BIG + BIG_ZR);
    bf16_t* ORW = (bf16_t*)(WS_ + WS_BIG + BIG_ORW) + (size_t)d * MTOT * 512;
    float* BON = (float*)(WS_ + WS_BON) + (size_t)d * MTOT * 8;
    const float* mu = IN(23) + e * 1920;
    const float* w0 = IN(24) + (e * 2 + d) * 512 + 64 * h;
    const float* a0 = IN(26) + (e * 2 + d) * 512 + 64 * h;
    const float* wup_g = IN(25) + (size_t)(e * 2 + d) * 64 * 512 + 64 * h;
    const float* aup_g = IN(27) + (size_t)(e * 2 + d) * 64 * 512 + 64 * h;
    const float kk_c = IN(29)[e * 512 + 64 * h + lane];
    const float mu_r = mu[64 * h + lane], mu_k = mu[512 + 64 * h + lane], mu_v = mu[1024 + 64 * h + lane], mu_w = mu[1536 + 64 * d + lane], mu_a = mu[1664 + 64 * d + lane];
    for (int idx = tid; idx < 4096; idx += NTHR) { const int j = idx >> 6, k = idx & 63; WUPT[k * 64 + j] = f2bf(wup_g[(size_t)j * 512 + k]); AUPT[k * 64 + j] = f2bf(aup_g[(size_t)j * 512 + k]); }
    const int r16 = lane & 15, g4 = lane >> 4, tr = wid & 3, tcb = 2 * (wid >> 2);
    float c_w0[2], c_a0[2], c_ka[2], c_rk[2];
#pragma unroll
    for (int jt = 0; jt < 2; ++jt) { const int kc = 16 * (tcb + jt) + r16; c_w0[jt] = w0[kc]; c_a0[jt] = a0[kc]; c_ka[jt] = IN(30)[e * 512 + 64 * h + kc]; c_rk[jt] = IN(31)[e * 512 + 64 * h + kc]; }
    typedef float f32x2 __attribute__((ext_vector_type(2)));
    f32x2 S2[4];
#pragma unroll
    for (int k = 0; k < 4; ++k) S2[k] = (f32x2){0.f, 0.f};
    __syncthreads();
    bf16_t pr_[10], pk_[10], pv_[10], pw_[10], pa_[10];
    auto issue = [&](int cidx) {
        const int seg = cidx >= 4; const int L = seg ? TL : TCX; const int rowbase = seg ? b * TL : MLAT + b * TCX; const int ch = seg ? cidx - 4 : cidx;
        const int tlo = d ? (L - 1 - (ch * 64 + 8 * wid + 7)) : (ch * 64 + 8 * wid);
#pragma unroll
        for (int q = 0; q < 10; ++q) {
            const int t = tlo - 1 + q; const int tc = t < 0 ? 0 : (t > L - 1 ? L - 1 : t);
            const bf16_t* zr = ZR + (size_t)(rowbase + tc) * 1920;
            pr_[q] = zr[64 * h + lane]; pk_[q] = zr[512 + 64 * h + lane]; pv_[q] = zr[1024 + 64 * h + lane]; pw_[q] = zr[1536 + 64 * d + lane]; pa_[q] = zr[1664 + 64 * d + lane];
        }
    };
    issue(0);
#pragma unroll 1
    for (int cidx = 0; cidx < 36; ++cidx) {
        {
            const int seg = cidx >= 4; const int L = seg ? TL : TCX; const int rowbase = seg ? b * TL : MLAT + b * TCX; const int ch = seg ? cidx - 4 : cidx;
            const int tlo = d ? (L - 1 - (ch * 64 + 8 * wid + 7)) : (ch * 64 + 8 * wid);
            {
                float zr_[10], zk_[10], zv_[10], zw_[10], za_[10];
#pragma unroll
                for (int q = 0; q < 10; ++q) {
                    const int t = tlo - 1 + q; const bool ok = (t >= 0) && (t < L);
                    const float a0 = bf2f(pr_[q]), a1 = bf2f(pk_[q]), a2 = bf2f(pv_[q]), a3 = bf2f(pw_[q]), a4 = bf2f(pa_[q]);
                    zr_[q] = ok ? a0 : 0.f; zk_[q] = ok ? a1 : 0.f; zv_[q] = ok ? a2 : 0.f; zw_[q] = ok ? a3 : 0.f; za_[q] = ok ? a4 : 0.f;
                }
#pragma unroll
                for (int sl = 0; sl < 8; ++sl) {
                    const int tau = 8 * wid + (d ? 7 - sl : sl);
#define ZS(arr, muv) (arr[sl + 1] + (muv) * (0.5f * (arr[sl] + arr[sl + 2]) - arr[sl + 1]))
                    const float rr = ZS(zr_, mu_r), kr = ZS(zk_, mu_k), vv = ZS(zv_, mu_v), wd = ZS(zw_, mu_w), ad = ZS(za_, mu_a);
#undef ZS
                    const float kkv = kr * kk_c; const float n2 = wsum(kkv * kkv);
                    const float kk = kkv * __builtin_amdgcn_rcpf(fmaxf(__builtin_amdgcn_sqrtf(n2), 1e-12f));
                    sOP[tau * SOPS + 0 + lane] = rr; sOP[tau * SOPS + 64 + lane] = kk; sV[tau * 64 + lane] = vv; sOP[tau * SOPS + 192 + lane] = kr;
                    TWb[tau * 64 + lane] = f2bf(tanh_(wd)); ADb[tau * 64 + lane] = f2bf(ad);
                }
            }
            __syncthreads();
            {
                const bf16x8 aw0 = *(const bf16x8*)(TWb + (16 * tr + r16) * 64 + 8 * g4), aw1 = *(const bf16x8*)(TWb + (16 * tr + r16) * 64 + 32 + 8 * g4);
                const bf16x8 aa0 = *(const bf16x8*)(ADb + (16 * tr + r16) * 64 + 8 * g4), aa1 = *(const bf16x8*)(ADb + (16 * tr + r16) * 64 + 32 + 8 * g4);
                float bonp[4] = {0.f, 0.f, 0.f, 0.f};
#pragma unroll
                for (int jt = 0; jt < 2; ++jt) {
                    const int kc = 16 * (tcb + jt) + r16;
                    const bf16x8 bw0 = *(const bf16x8*)(WUPT + kc * 64 + 8 * g4), bw1 = *(const bf16x8*)(WUPT + kc * 64 + 32 + 8 * g4);
                    const bf16x8 ba0 = *(const bf16x8*)(AUPT + kc * 64 + 8 * g4), ba1 = *(const bf16x8*)(AUPT + kc * 64 + 32 + 8 * g4);
                    f32x4 cw = (f32x4){0.f, 0.f, 0.f, 0.f}, ca = (f32x4){0.f, 0.f, 0.f, 0.f};
                    cw = __builtin_amdgcn_mfma_f32_16x16x32_bf16(aw0, bw0, cw, 0, 0, 0); cw = __builtin_amdgcn_mfma_f32_16x16x32_bf16(aw1, bw1, cw, 0, 0, 0);
                    ca = __builtin_amdgcn_mfma_f32_16x16x32_bf16(aa0, ba0, ca, 0, 0, 0); ca = __builtin_amdgcn_mfma_f32_16x16x32_bf16(aa1, ba1, ca, 0, 0, 0);
#pragma unroll
                    for (int q = 0; q < 4; ++q) {
                        const int tau = 16 * tr + 4 * g4 + q;
                        const float wlog = -softplus_(-(c_w0[jt] + cw[q])) - 0.5f;
                        const float dec = __expf(-__expf(wlog));
                        const float av = sigm(c_a0[jt] + ca[q]);
                        const float kd = sOP[tau * SOPS + 192 + kc] * (1.f + (av - 1.f) * c_ka[jt]);
                        bonp[q] += sOP[tau * SOPS + 0 + kc] * kd * c_rk[jt];
                        sOP[tau * SOPS + 128 + kc] = dec; sOP[tau * SOPS + 192 + kc] = kd; sOP[tau * SOPS + 256 + kc] = sOP[tau * SOPS + 64 + kc] * av;
                    }
                }
#pragma unroll
                for (int q = 0; q < 4; ++q) {
                    float v = bonp[q];
                    v += DPPF(v, 0xB1); v += DPPF(v, 0x4E); v += DPPF(v, 0x141); v += DPPF(v, 0x140);
                    if (r16 == 0) sBONp[(16 * tr + 4 * g4 + q) * 2 + (wid >> 2)] = v;
                }
            }
            __syncthreads();
            if (tid < 64) { const int pp = ch * 64 + tid; const int t = d ? (L - 1 - pp) : pp; BON[(size_t)(rowbase + t) * 8 + h] = sBONp[2 * tid] + sBONp[2 * tid + 1]; }
            if (cidx + 1 < 36) issue(cidx + 1);
            {
                const int vrow = 8 * wid + (lane >> 3), kq = lane & 7;
                const float* pb = sOP + 8 * kq;
                constexpr int O_R = 0, O_KK = 64, O_W = 128, O_KD = 192, O_KA = 256;
                struct Ops { float4 kk0, kk1, w0, w1, ka0, ka1, kd0, kd1, r0, r1; float vv; };
                auto ldops = [&](Ops& o, int tau) {
                    const float* q = pb + tau * SOPS;
                    o.kk0 = *(const float4*)(q + O_KK); o.kk1 = *(const float4*)(q + O_KK + 4); o.w0 = *(const float4*)(q + O_W); o.w1 = *(const float4*)(q + O_W + 4);
                    o.ka0 = *(const float4*)(q + O_KA); o.ka1 = *(const float4*)(q + O_KA + 4); o.kd0 = *(const float4*)(q + O_KD); o.kd1 = *(const float4*)(q + O_KD + 4);
                    o.r0 = *(const float4*)(q + O_R); o.r1 = *(const float4*)(q + O_R + 4); o.vv = sV[tau * 64 + vrow];
                };
                auto step = [&](const Ops& o, int tau) -> float {
                    const f32x2 kk[4] = {{o.kk0.x, o.kk0.y}, {o.kk0.z, o.kk0.w}, {o.kk1.x, o.kk1.y}, {o.kk1.z, o.kk1.w}};
                    const f32x2 w[4] = {{o.w0.x, o.w0.y}, {o.w0.z, o.w0.w}, {o.w1.x, o.w1.y}, {o.w1.z, o.w1.w}};
                    const f32x2 ka[4] = {{o.ka0.x, o.ka0.y}, {o.ka0.z, o.ka0.w}, {o.ka1.x, o.ka1.y}, {o.ka1.z, o.ka1.w}};
                    const f32x2 kd[4] = {{o.kd0.x, o.kd0.y}, {o.kd0.z, o.kd0.w}, {o.kd1.x, o.kd1.y}, {o.kd1.z, o.kd1.w}};
                    const f32x2 rr[4] = {{o.r0.x, o.r0.y}, {o.r0.z, o.r0.w}, {o.r1.x, o.r1.y}, {o.r1.z, o.r1.w}};
                    f32x2 da = S2[0] * kk[0] + S2[1] * kk[1]; f32x2 db = S2[2] * kk[2] + S2[3] * kk[3]; da = da + db;
                    float dt = da.x + da.y;
                    dt += DPPF(dt, 0xB1); dt += DPPF(dt, 0x4E); dt += DPPF(dt, 0x141);
                    const f32x2 sa2 = {-dt, -dt}; const f32x2 vv2 = {o.vv, o.vv};
#pragma unroll
                    for (int q = 0; q < 4; ++q) S2[q] = S2[q] * w[q] + (sa2 * ka[q] + vv2 * kd[q]);
                    f32x2 oa = S2[0] * rr[0] + S2[1] * rr[1]; f32x2 ob = S2[2] * rr[2] + S2[3] * rr[3]; oa = oa + ob;
                    return oa.x + oa.y;
                };
                Ops oa_, ob_;
                ldops(oa_, 0);
                const bool b1_ = (kq & 2) != 0, b0_ = (kq & 1) != 0;
#pragma unroll 1
                for (int t4 = 0; t4 < 64; t4 += 4) {
                    float po[4];
#pragma unroll
                    for (int u = 0; u < 4; u += 2) {
                        ldops(ob_, t4 + u + 1);
                        po[u] = step(oa_, t4 + u);
                        ldops(oa_, t4 + u + 2 < 64 ? t4 + u + 2 : 63);
                        po[u + 1] = step(ob_, t4 + u + 1);
                    }
                    float a2[2];
#pragma unroll
                    for (int j = 0; j < 2; ++j) { const float send = b1_ ? po[j] : po[j + 2], keep = b1_ ? po[j + 2] : po[j]; a2[j] = keep + DPPF(send, 0x4E); }
                    const float send = b0_ ? a2[0] : a2[1], keep = b0_ ? a2[1] : a2[0];
                    float r_ = keep + DPPF(send, 0xB1);
                    r_ += __builtin_bit_cast(float, __builtin_amdgcn_ds_swizzle(__builtin_bit_cast(int, r_), 0x101F));
                    sO[(t4 + (kq & 3)) * 64 + vrow] = r_;
                }
            }
            __syncthreads();
#pragma unroll
            for (int i = 0; i < 8; ++i) {
                const int tau = wid + 8 * i; const int pp = ch * 64 + tau; const int t = d ? (L - 1 - pp) : pp;
                ORW[(size_t)(rowbase + t) * 512 + 64 * h + lane] = f2bf(sO[tau * 64 + lane]);
            }
            __syncthreads();
        }
    }
}

__device__ __forceinline__ void even_readout_phase(const Params& p, int e, unsigned char* smem) {
    PH_PRO
    const int tid = tid_, lane = tid & 63, wid = __builtin_amdgcn_readfirstlane(tid >> 6);
    bf16_t* SGb = (bf16_t*)smem;
    float* GG = (float*)(SGb + 64 * 128);
    bf16_t* GUT = (bf16_t*)(GG + 64 * 64);
    bf16_t* TT = GUT + 64 * 128;
    const int r16 = lane & 15, g4 = lane >> 4, tr = wid & 3, tcb = 2 * (wid >> 2);
    const bf16_t* ZR = (const bf16_t*)(WS_ + WS_BIG + BIG_ZR);
    const bf16_t* ORW = (const bf16_t*)(WS_ + WS_BIG + BIG_ORW);
    const bf16_t* YT = (const bf16_t*)(WS_ + WS_BIG);
    const float* BON = (const float*)(WS_ + WS_BON);
    bf16_t* YM = (bf16_t*)(WS_ + WS_A);
    const float* mu = IN(23) + e * 1920;
    const int h = bid_ & 7;
    {
        const float* gup = IN(28) + (size_t)e * 128 * 512 + 64 * h;
        for (int idx = tid; idx < 128 * 64; idx += NTHR) { const int j = idx >> 6, k = idx & 63; GUT[k * 128 + j] = f2bf(gup[(size_t)j * 512 + k]); }
    }
    const float gng = IN(32)[e * 512 + 64 * h + lane], gnb = IN(33)[e * 512 + 64 * h + lane], muv = mu[1024 + 64 * h + lane];
    bf16_t rz_[18], rv_[10], rof_[8], rob_[8]; float rbf_[8], rbb_[8];
    auto issue = [&](int item) {
        const int tb = item >> 3, hh = item & 7; const int row0 = tb * 64;
        const int L = row0 < MLAT ? TL : TCX; const int t0 = row0 < MLAT ? (row0 & (TL - 1)) : ((row0 - MLAT) & (TCX - 1));
        const int j = tid & 127, tq = wid >> 1;
#pragma unroll
        for (int q = 0; q < 18; ++q) { const int t = t0 + 16 * tq - 1 + q; const int tc = t < 0 ? 0 : (t > L - 1 ? L - 1 : t); rz_[q] = ZR[(size_t)(row0 - t0 + tc) * 1920 + 1792 + j]; }
#pragma unroll
        for (int q = 0; q < 10; ++q) { const int t = t0 + 8 * wid - 1 + q; const int tc = t < 0 ? 0 : (t > L - 1 ? L - 1 : t); rv_[q] = ZR[(size_t)(row0 - t0 + tc) * 1920 + 1024 + 64 * hh + lane]; }
#pragma unroll
        for (int i = 0; i < 8; ++i) {
            const int row = row0 + 8 * wid + i;
            rof_[i] = ORW[(size_t)row * 512 + 64 * hh + lane]; rob_[i] = ORW[(size_t)(MTOT + row) * 512 + 64 * hh + lane];
            rbf_[i] = BON[(size_t)row * 8 + hh]; rbb_[i] = BON[(size_t)(MTOT + row) * 8 + hh];
        }
    };
    if (bid_ < 4608) issue(bid_);
    for (int item = bid_; item < 4608; item += gdim_) {
        const int tb = item >> 3; const int row0 = tb * 64;
        const int hh = item & 7;
        const int L = row0 < MLAT ? TL : TCX; const int t0 = row0 < MLAT ? (row0 & (TL - 1)) : ((row0 - MLAT) & (TCX - 1));
        __syncthreads();
        if (hh != h) {
            const float* gup = IN(28) + (size_t)e * 128 * 512 + 64 * hh;
            for (int idx = tid; idx < 128 * 64; idx += NTHR) { const int j = idx >> 6, k = idx & 63; GUT[k * 128 + j] = f2bf(gup[(size_t)j * 512 + k]); }
        }
        {
            const int j = tid & 127, tq = wid >> 1; const float muj = mu[1792 + j];
            float zz[18];
#pragma unroll
            for (int q = 0; q < 18; ++q) { const int t = t0 + 16 * tq - 1 + q; const bool ok = (t >= 0) && (t < L); zz[q] = ok ? bf2f(rz_[q]) : 0.f; }
#pragma unroll
            for (int i = 0; i < 16; ++i) SGb[(16 * tq + i) * 128 + j] = f2bf(sigm(zz[i + 1] + muj * (0.5f * (zz[i] + zz[i + 2]) - zz[i + 1])));
        }
        float ov[8], vv[8], bon[8];
        const float gngh = hh == h ? gng : IN(32)[e * 512 + 64 * hh + lane], gnbh = hh == h ? gnb : IN(33)[e * 512 + 64 * hh + lane], muvh = hh == h ? muv : mu[1024 + 64 * hh + lane];
        {
            float zv[10];
#pragma unroll
            for (int q = 0; q < 10; ++q) { const int t = t0 + 8 * wid - 1 + q; const bool ok = (t >= 0) && (t < L); zv[q] = ok ? bf2f(rv_[q]) : 0.f; }
#pragma unroll
            for (int i = 0; i < 8; ++i) {
                ov[i] = bf2f(rof_[i]) + bf2f(rob_[i]);
                vv[i] = zv[i + 1] + muvh * (0.5f * (zv[i] + zv[i + 2]) - zv[i + 1]);
                bon[i] = rbf_[i] + rbb_[i];
            }
        }
        __syncthreads();
        if (item + gdim_ < 4608) issue(item + gdim_);
        {
            f32x4 c0 = (f32x4){0.f, 0.f, 0.f, 0.f}, c1 = (f32x4){0.f, 0.f, 0.f, 0.f};
#pragma unroll
            for (int ks = 0; ks < 4; ++ks) {
                const bf16x8 af = *(const bf16x8*)(SGb + (16 * tr + r16) * 128 + 32 * ks + 8 * g4);
                const bf16x8 b0 = *(const bf16x8*)(GUT + (16 * tcb + r16) * 128 + 32 * ks + 8 * g4), b1 = *(const bf16x8*)(GUT + (16 * (tcb + 1) + r16) * 128 + 32 * ks + 8 * g4);
                c0 = __builtin_amdgcn_mfma_f32_16x16x32_bf16(af, b0, c0, 0, 0, 0); c1 = __builtin_amdgcn_mfma_f32_16x16x32_bf16(af, b1, c1, 0, 0, 0);
            }
#pragma unroll
            for (int q = 0; q < 4; ++q) { GG[(16 * tr + 4 * g4 + q) * 64 + 16 * tcb + r16] = c0[q]; GG[(16 * tr + 4 * g4 + q) * 64 + 16 * (tcb + 1) + r16] = c1[q]; }
        }
        __syncthreads();
        float gg[8];
#pragma unroll
        for (int i = 0; i < 8; ++i) gg[i] = GG[(8 * wid + i) * 64 + lane];
#pragma unroll
        for (int i = 0; i < 8; ++i) {
            const int row = row0 + 8 * wid + i;
            const float mean = wsum(ov[i]) * (1.f / 64.f); const float dd = ov[i] - mean; const float var = wsum(dd * dd) * (1.f / 64.f);
            const float y = dd * rsqrtf(var + 64e-5f) * gngh + gnbh;
            YM[(size_t)row * D + 512 + 64 * hh + lane] = f2bf((y + bon[i] * vv[i]) * gg[i]);
        }
    }
    __syncthreads();
    for (int it = bid_; it < 4608; it += gdim_) {
        const int tb = it >> 3, cb = it & 7; const int row0 = tb * 64;
#pragma unroll
        for (int i = 0; i < 8; ++i) { const int cc = wid + 8 * i; TT[cc * 72 + lane] = YT[(size_t)(cb * 64 + cc) * MTOT + row0 + lane]; }
        __syncthreads();
#pragma unroll
        for (int i = 0; i < 8; ++i) { const int tau = wid + 8 * i; YM[(size_t)(row0 + tau) * D + cb * 64 + lane] = TT[lane * 72 + tau]; }
        __syncthreads();
    }
}
__device__ __forceinline__ void gla_phase(const Params& p, int o_idx, unsigned char* smem) {
    PH_PRO
    const int item = bid_; if (item >= 256) return;
    const int xcd_ = item & 7, jx_ = item >> 3;
    const int b = 2 * xcd_ + (jx_ >> 4), h = (jx_ >> 2) & 3, d = (jx_ >> 1) & 1, dvh = jx_ & 1;
    const int tid = tid_, lane = tid & 63, wid = __builtin_amdgcn_readfirstlane(tid >> 6), r = lane & 15, g = lane >> 4;
    constexpr int QST = 136, SST = 68;
    bf16_t* QS = (bf16_t*)smem;
    bf16_t* KS = QS + 64 * QST;
    bf16_t* ST = KS + 64 * QST;
    bf16_t* KST = ST + 128 * QST;
    bf16_t* VT = KST + 128 * SST;
    bf16_t* PP = VT + 128 * SST;
    float* GD = (float*)(PP + 64 * SST);
    float* DL = GD + 64 * 16;
    float* E1 = DL + 128;
    float* E2 = E1 + 128;
    float* TOT = E2 + 128;
    float* BR = TOT + 512;
    int* ROWS = (int*)(BR + 128);
    const bf16_t* Z = (const bf16_t*)(WS_ + WS_BIG);
    bf16_t* OG = d ? (bf16_t*)OUT_ : (bf16_t*)(WS_ + WS_BIG + BIG_OGL);
    const float qscale = 0.08838834764831845f;
    const int k = tid & 127, tq = wid >> 1, tr = wid >> 1, tcb = 4 * (wid & 1);
    auto rowof = [&](int c, int tau) -> int {
        const int seg = c >= 4; const int L = seg ? TL : TCX; const int pf = (seg ? c - 4 : c) * 64 + tau; const int pp = d ? (L - 1 - pf) : pf;
        return seg ? (b * TL + (pp & 31) * 64 + (pp >> 5)) : (MLAT + b * TCX + pp);
    };
    bf16_t nq[16], nk[16], nv[16], ngd[2];
    auto prefetch = [&](int c) {
        const long r0 = rowof(c, 16 * tq); const long st = (long)(c >= 4 ? 64 : 1) * (d ? -1 : 1) * 3104;
        const bf16_t* zb = Z + r0 * 3104 + 128 * h + k;
#pragma unroll
        for (int i = 0; i < 16; ++i) { const bf16_t* zr = zb + i * st; nq[i] = zr[0]; nk[i] = zr[512]; nv[i] = zr[1024 + 128 * h + 128 * dvh]; }
#pragma unroll
        for (int i = 0; i < 2; ++i) { const int idx = tid + NTHR * i; ngd[i] = Z[(size_t)rowof(c, idx >> 4) * 3104 + 2048 + 16 * d + (idx & 15)]; }
    };
    f32x4 Sacc[8];
#pragma unroll
    for (int j = 0; j < 8; ++j) Sacc[j] = (f32x4){0.f, 0.f, 0.f, 0.f};
    float gu[16];
    {
        const float* gup_g = IN(36) + (size_t)(o_idx * 2 + d) * 16 * 512 + 128 * h + k;
#pragma unroll
        for (int j = 0; j < 16; ++j) gu[j] = gup_g[(size_t)j * 512];
    }
    const float gbv = IN(37)[(o_idx * 2 + d) * 512 + 128 * h + k];
    prefetch(0);
#pragma unroll 1
    for (int c = 0; c < 36; ++c) {
        __syncthreads();
        if (tid < 64) ROWS[tid] = rowof(c, tid);
#pragma unroll
        for (int i = 0; i < 2; ++i) GD[tid + NTHR * i] = bf2f(ngd[i]);
#pragma unroll
        for (int i = 0; i < 16; ++i) VT[k * SST + 16 * tq + i] = nv[i];
        bf16_t cq[16], ck[16];
#pragma unroll
        for (int i = 0; i < 16; ++i) { cq[i] = nq[i]; ck[i] = nk[i]; }
        __syncthreads();
        if (c + 1 < 36) prefetch(c + 1);
        float bl[16]; float run = 0.f;
#pragma unroll
        for (int i = 0; i < 16; ++i) {
            const float4* gd4 = (const float4*)(GD + (16 * tq + i) * 16);
            const float4 g0 = gd4[0], g1 = gd4[1], g2 = gd4[2], g3 = gd4[3];
            float a = gbv + g0.x * gu[0] + g0.y * gu[1] + g0.z * gu[2] + g0.w * gu[3] + g1.x * gu[4] + g1.y * gu[5] + g1.z * gu[6] + g1.w * gu[7]
                    + g2.x * gu[8] + g2.y * gu[9] + g2.z * gu[10] + g2.w * gu[11] + g3.x * gu[12] + g3.y * gu[13] + g3.z * gu[14] + g3.w * gu[15];
            run -= __logf(1.f + __expf(-a)) * (1.f / 16.f);
            bl[i] = run;
        }
        TOT[tq * 128 + k] = run; if (tq == 2) BR[k] = bl[0];
        __syncthreads();
        {
            const float t0 = TOT[k], t1 = TOT[128 + k], t2 = TOT[256 + k], t3 = TOT[384 + k];
            const float off = tq == 0 ? 0.f : (tq == 1 ? t0 : (tq == 2 ? t0 + t1 : t0 + t1 + t2));
            const float bref = BR[k] + t0 + t1, blast = t0 + t1 + t2 + t3;
            if (tq == 0) { DL[k] = __expf(blast); E1[k] = __expf(bref); E2[k] = __expf(blast - bref); }
#pragma unroll
            for (int i = 0; i < 16; ++i) {
                const int tau = 16 * tq + i;
                const float bb = bl[i] + off; const float ef = __expf(bb - bref);
                const bf16_t ksv = f2bf(bf2f(ck[i]) * __builtin_amdgcn_rcpf(ef));
                QS[tau * QST + k] = f2bf(bf2f(cq[i]) * qscale * ef); KS[tau * QST + k] = ksv; KST[k * SST + tau] = ksv;
            }
        }
        __syncthreads();
        {
            float e1v[4];
#pragma unroll
            for (int q = 0; q < 4; ++q) e1v[q] = E1[16 * wid + 4 * g + q];
#pragma unroll
            for (int j = 0; j < 8; ++j) {
                uint2 o; o.x = pk2(Sacc[j][0] * e1v[0], Sacc[j][1] * e1v[1]); o.y = pk2(Sacc[j][2] * e1v[2], Sacc[j][3] * e1v[3]);
                *(uint2*)(ST + (16 * j + r) * QST + 16 * wid + 4 * g) = o;
            }
        }
        f32x4 sc[2];
#pragma unroll
        for (int j = 0; j < 2; ++j) sc[j] = (f32x4){0.f, 0.f, 0.f, 0.f};
#pragma unroll
        for (int ks = 0; ks < 4; ++ks) {
            const bf16x8 af = *(const bf16x8*)(QS + (16 * tr + r) * QST + 32 * ks + 8 * g);
#pragma unroll
            for (int j = 0; j < 2; ++j) {
                const bf16x8 bfr = *(const bf16x8*)(KS + (16 * (2 * (wid & 1) + j) + r) * QST + 32 * ks + 8 * g);
                sc[j] = __builtin_amdgcn_mfma_f32_16x16x32_bf16(af, bfr, sc[j], 0, 0, 0);
            }
        }
#pragma unroll
        for (int j = 0; j < 2; ++j) {
            const int sidx = 16 * (2 * (wid & 1) + j) + r;
#pragma unroll
            for (int q = 0; q < 4; ++q) { const int ci = 16 * tr + 4 * g + q; PP[ci * SST + sidx] = f2bf(sidx <= ci ? sc[j][q] : 0.f); }
        }
        __syncthreads();
        f32x4 oc[4];
#pragma unroll
        for (int j = 0; j < 4; ++j) oc[j] = (f32x4){0.f, 0.f, 0.f, 0.f};
#pragma unroll
        for (int ks = 0; ks < 2; ++ks) {
            const bf16x8 af = ld8(PP + (16 * tr + r) * SST + 32 * ks + 8 * g);
#pragma unroll
            for (int j = 0; j < 4; ++j) {
                const bf16x8 bfr = ld8(VT + (16 * (tcb + j) + r) * SST + 32 * ks + 8 * g);
                oc[j] = __builtin_amdgcn_mfma_f32_16x16x32_bf16(af, bfr, oc[j], 0, 0, 0);
            }
        }
#pragma unroll
        for (int ks = 0; ks < 4; ++ks) {
            const bf16x8 af = *(const bf16x8*)(QS + (16 * tr + r) * QST + 32 * ks + 8 * g);
#pragma unroll
            for (int j = 0; j < 4; ++j) {
                const bf16x8 bfr = *(const bf16x8*)(ST + (16 * (tcb + j) + r) * QST + 32 * ks + 8 * g);
                oc[j] = __builtin_amdgcn_mfma_f32_16x16x32_bf16(af, bfr, oc[j], 0, 0, 0);
            }
        }
#pragma unroll
        for (int j = 0; j < 4; ++j) {
            const int dv = 16 * (tcb + j) + r;
#pragma unroll
            for (int q = 0; q < 4; ++q) OG[(size_t)ROWS[16 * tr + 4 * g + q] * D + 256 * h + 128 * dvh + dv] = f2bf(oc[j][q]);
        }
        {
            f32x4 kv[8];
#pragma unroll
            for (int j = 0; j < 8; ++j) kv[j] = (f32x4){0.f, 0.f, 0.f, 0.f};
#pragma unroll
            for (int ks = 0; ks < 2; ++ks) {
                const bf16x8 af = ld8(KST + (16 * wid + r) * SST + 32 * ks + 8 * g);
#pragma unroll
                for (int j = 0; j < 8; ++j) {
                    const bf16x8 bfr = ld8(VT + (16 * j + r) * SST + 32 * ks + 8 * g);
                    kv[j] = __builtin_amdgcn_mfma_f32_16x16x32_bf16(af, bfr, kv[j], 0, 0, 0);
                }
            }
            float dl[4], e2[4];
#pragma unroll
            for (int q = 0; q < 4; ++q) { dl[q] = DL[16 * wid + 4 * g + q]; e2[q] = E2[16 * wid + 4 * g + q]; }
#pragma unroll
            for (int j = 0; j < 8; ++j)
#pragma unroll
                for (int q = 0; q < 4; ++q) Sacc[j][q] = Sacc[j][q] * dl[q] + e2[q] * kv[j][q];
        }
    }
    __syncthreads();
}

__device__ __forceinline__ void odd_readout_phase(const Params& p, int o_idx) {
    PH_PRO
    const int lane = tid_ & 63, wid = tid_ >> 6;
    const bf16_t* Z = (const bf16_t*)(WS_ + WS_BIG);
    const bf16_t* OGL = (const bf16_t*)(WS_ + WS_BIG + BIG_OGL);
    const bf16_t* OGB = (const bf16_t*)OUT_;
    bf16_t* YM = (bf16_t*)(WS_ + WS_A);
    const float4 ng = *(const float4*)(IN(38) + o_idx * 256 + 4 * lane);
    for (int row = bid_ * 8 + wid; row < MTOT; row += gdim_ * 8) {
        uint2 ovs[4], ows[4], gvs[4];
#pragma unroll
        for (int hh = 0; hh < 4; ++hh) {
            ovs[hh] = *(const uint2*)(OGL + (size_t)row * D + 256 * hh + 4 * lane);
            ows[hh] = *(const uint2*)(OGB + (size_t)row * D + 256 * hh + 4 * lane);
            gvs[hh] = *(const uint2*)(Z + (size_t)row * 3104 + 2080 + 256 * hh + 4 * lane);
        }
#pragma unroll
        for (int hh = 0; hh < 4; ++hh) {
            const uint2 ov = ovs[hh], ow = ows[hh], gv = gvs[hh];
            const float o0 = __uint_as_float(ov.x << 16) + __uint_as_float(ow.x << 16), o1 = __uint_as_float(ov.x & 0xffff0000u) + __uint_as_float(ow.x & 0xffff0000u), o2 = __uint_as_float(ov.y << 16) + __uint_as_float(ow.y << 16), o3 = __uint_as_float(ov.y & 0xffff0000u) + __uint_as_float(ow.y & 0xffff0000u);
            const float g0 = __uint_as_float(gv.x << 16), g1 = __uint_as_float(gv.x & 0xffff0000u), g2 = __uint_as_float(gv.y << 16), g3 = __uint_as_float(gv.y & 0xffff0000u);
            const float ms = wsum(o0 * o0 + o1 * o1 + o2 * o2 + o3 * o3) * (1.f / 256.f);
            const float rs = rsqrtf(ms + 1e-5f);
            uint2 y; y.x = pk2(o0 * rs * ng.x * silu_(g0), o1 * rs * ng.y * silu_(g1)); y.y = pk2(o2 * rs * ng.z * silu_(g2), o3 * rs * ng.w * silu_(g3));
            *(uint2*)(YM + (size_t)row * D + 256 * hh + 4 * lane) = y;
        }
    }
}

#ifndef REP_UP
#define REP_UP 1
#endif
#ifndef REP_SCAN
#define REP_SCAN 1
#endif
#ifndef REP_GLA
#define REP_GLA 1
#endif
#ifndef REP_HY
#define REP_HY 1
#endif
#define REPEAT(n) for (int rep_ = 0, nrep_ = ({ int t_ = (n); asm volatile("" : "+s"(t_)); t_; }); rep_ < nrep_; ++rep_)
#ifndef REP_LN
#define REP_LN 1
#endif
#ifndef REP_MISC
#define REP_MISC 1
#endif
#ifndef REP_SYNC
#define REP_SYNC 1
#endif
#define GSYNC() do { for (int s_ = 0; s_ < REP_SYNC; ++s_) { XcdBarrier xb_; xb_.bar = (unsigned*)IN(40); xb_.x = xb_xcc_id(); xb_.st = (volatile XB_LAS unsigned*)(smem_g + TBL_OFF + 448); xcd_barrier(xb_); } } while (0)
#define LAUNDER() do { bid_ = blockIdx.x; asm volatile("" : "+s"(bid_)); gdim_ = gridDim.x; asm volatile("" : "+s"(gdim_)); } while (0)
__global__ void __launch_bounds__(NTHR, 2) mega(Params p) {
    unsigned char* smem = smem_g;
    cg::grid_group grid = cg::this_grid();
    int bid_, gdim_; LAUNDER();
    if (threadIdx.x == 0) {
        const float** tb = (const float**)(smem_g + TBL_OFF);
#pragma unroll
        for (int i = 0; i < 41; ++i) tb[i] = p.in[i];
        *(uint4*)(smem_g + TBL_OFF + 448) = make_uint4(0u, 0u, 0u, 0u);
    }
    unsigned* bar_ = (unsigned*)p.in[40];
    if (blockIdx.x == 0) for (int i = threadIdx.x; i < XCD_BAR_WORDS; i += NTHR) bar_[i] = 0u;
    __syncthreads();
    grid.sync();
    (void)xcd_barrier_post(bar_, (volatile XB_LAS unsigned*)(smem_g + TBL_OFF + 448));
    REPEAT(REP_MISC) {
    phase_mod(p, smem);
    __syncthreads();
    conv_weights(p, 0, smem);
    filt_gen(p, smem);
    GSYNC();
    }
    row_phase(p, 0, 0, 0, 0, 0, false);
    GSYNC();
#pragma unroll 1
    for (int l = 0; l < 4; ++l) {
#pragma unroll 1
        for (int f = 0; f < 2; ++f) {
            if (f == 1) {
                if (!(l & 1)) {
                    const int e = l >> 1;
                    REPEAT(REP_HY) {
                    LAUNDER();
                    { EpiStore E; E.O = (bf16_t*)(WS_ + WS_BIG); E.ldc = MTOT; E.nvalid = MTOT; run_gemm(smem, (const bf16_t*)(WS_ + WS_WIN), (const bf16_t*)(WS_ + WS_A), 1536, MTOT, 1024, E, bid_, gdim_); }
                    LAUNDER();
                    { EpiStore E; E.O = (bf16_t*)(WS_ + WS_BIG + BIG_ZR); E.ldc = 1920; E.nvalid = 1920; run_gemm(smem, (const bf16_t*)(WS_ + WS_A), (const bf16_t*)(WS_ + WS_WIN) + (size_t)1536 * 1024, MTOT, 2048, 1024, E, gdim_ - 1 - bid_, gdim_); }
                    GSYNC();
                    hyena_phase(p, e, smem);
                    if (rep_ + 1 < nrep_) GSYNC();
                    }
                    REPEAT(REP_SCAN) rwkv_scan_phase(p, e, smem);
                    GSYNC();
                    REPEAT(REP_MISC) even_readout_phase(p, e, smem);
                    GSYNC();
                } else {
                    const int o = l >> 1;
                    LAUNDER();
                    { EpiStore E; E.O = (bf16_t*)(WS_ + WS_BIG); E.ldc = 3104; E.nvalid = 3104; run_gemm(smem, (const bf16_t*)(WS_ + WS_A), (const bf16_t*)(WS_ + WS_WIN), MTOT, 3328, 1024, E, bid_, gdim_); }
                    GSYNC();
                    REPEAT(REP_GLA) gla_phase(p, o, smem);
                    GSYNC();
                    REPEAT(REP_MISC) odd_readout_phase(p, o);
                    GSYNC();
                }
                LAUNDER();
                { EpiResid E; E.gate_off = l * 17 * 9216 + 5 * 1024; E.wgt = 1.0f; E.ln_idx = l * 3 + 0; E.pm_off = 0; run_gemm(smem, (const bf16_t*)(WS_ + WS_A), (const bf16_t*)(WS_ + WS_WOUT), l == 3 ? MLAT : MTOT, 1024, 1024, E, bid_, gdim_); }
                GSYNC();
                REPEAT(REP_LN) row_phase(p, 1, l, 1, l, 6, false, l == 3 ? MLAT : MTOT);
                GSYNC();
            }
            const bool latonly = (l == 3 && f == 1);
#pragma unroll 1
            for (int s = 0; s < 4; ++s) {
                if (s == 3 && latonly) break;
                LAUNDER();
                if ((s == 1) || (s == 2 && !latonly && bid_ < 64)) {
                    const int part = s - 1;
                    EpiResid E; E.gate_off = l * 17 * 9216 + (f ? 8 : 2) * 1024; E.wgt = 0.5f; E.ln_idx = f ? (l * 3 + 1) : (l * 3 - 1); E.pm_off = part ? 128 : 0;
                    run_gemm(smem, (const bf16_t*)(WS_ + WS_BIG) + (size_t)part * MLAT * FF, (const bf16_t*)(WS_ + WS_WDN) + (size_t)f * 1024 * FF, part ? MCTX : MLAT, 1024, FF, E, bid_, part ? 64 : gdim_);
                }
                if (s == 0 || (s == 1 && !latonly)) {
                    LAUNDER();
                    EpiSwiglu E; E.G = (bf16_t*)(WS_ + WS_BIG); E.pm_off = s ? 128 : 0;
                    run_gemm(smem, (const bf16_t*)(WS_ + WS_A) + (size_t)s * MLAT * 1024, (const bf16_t*)(WS_ + WS_WUP) + (size_t)f * 5632 * 1024, s ? MCTX : MLAT, 5632, 1024, E, bid_, gdim_);
                }
                if (s == 2) {
                    if (latonly) row_phase(p, 1, l, 2, 0, 0, true);
                    else if (bid_ >= 64) { if (f == 0) row_phase(p, 1, l, 0, l, 3, false, MLAT, 0, 64, gdim_ - 64); else row_phase(p, 1, l, 2, l + 1, 0, false, MLAT, 0, 64, gdim_ - 64); }
                }
                if (s == 3) {
                    if (f == 0) row_phase(p, 1, l, 0, l, 3, false, MTOT, MLAT);
                    else { if (l < 3) { row_phase(p, 1, l, 2, l + 1, 0, false, MTOT, MLAT); conv_weights(p, l + 1, smem); } else row_phase(p, 1, l, 2, 0, 0, false, MTOT, MLAT); }
                }
                GSYNC();
            }
        }
    }
}

extern "C" void kernel_launch(void* const* d_in, const int* in_sizes, int n_in, void* d_out, int out_size, void* d_ws, size_t ws_size, hipStream_t stream) {
    static int grid = 0;
    if (grid == 0) {
        if (n_in != 39 || ws_size < WS_END) { fprintf(stderr, "kernel_launch: need 39 inputs and %zu bytes of workspace; got %d, %zu\n", (size_t)WS_END, n_in, ws_size); grid = -1; return; }
        int dev = 0, cus = 0, per_cu = 0;
        (void)hipGetDevice(&dev);
        (void)hipDeviceGetAttribute(&cus, hipDeviceAttributeMultiprocessorCount, dev);
        if (hipFuncSetAttribute((const void*)mega, hipFuncAttributeMaxDynamicSharedMemorySize, LDS_BYTES) != hipSuccess) { fprintf(stderr, "kernel_launch: hipFuncSetAttribute failed\n"); grid = -1; return; }
        (void)hipOccupancyMaxActiveBlocksPerMultiprocessor(&per_cu, (const void*)mega, NTHR, LDS_BYTES);
        if (per_cu < 1) fprintf(stderr, "kernel_launch: occupancy query says %d blocks/CU\n", per_cu);
        (void)hipGetLastError();
        grid = cus;
        if (grid > 256) grid = 256;
    }
    if (grid < 0) return;
    Params p{};
    for (int i = 0; i < 39; ++i) p.in[i] = (const float*)d_in[i];
    p.in[39] = (const float*)d_out; p.in[40] = (const float*)d_ws;
    void* args[] = {&p};
    hipError_t e = hipLaunchCooperativeKernel((const void*)mega, dim3(grid), dim3(NTHR), args, LDS_BYTES, stream);
    if (e != hipSuccess) fprintf(stderr, "cooperative launch failed: %s (grid %d)\n", hipGetErrorString(e), grid);
}
```

```cpp
#include <hip/hip_runtime.h>
#include <hip/hip_cooperative_groups.h>
#include <cstdio>
namespace pg8 {
#define PG8_LAS __attribute__((address_space(3)))
typedef unsigned short bf16_t;
typedef short bf16x8 __attribute__((ext_vector_type(8)));
typedef float f32x4 __attribute__((ext_vector_type(4)));
typedef unsigned u32x4 __attribute__((ext_vector_type(4)));
constexpr int BM = 256, BK = 64, HALF = 128, HTB = HALF * BK * 2  , STAGE_BYTES = 8 * HTB, NXCD = 8, WGM = 4;

__host__ __device__ __forceinline__ int lds_byte(int r, int c) { const int st = (r >> 4) * 2 + (c >> 5), rr = r & 15, cc = c & 31, ob = rr * 64 + cc * 2; return st * 1024 + (ob ^ (((ob >> 9) & 1) << 5)); }
__host__ __device__ __forceinline__ void stage_rc(int b, int& R, int& C) { const int st = b / 1024, sb = b % 1024, swz = sb ^ (((sb >> 9) & 1) << 5); R = (st >> 1) * 16 + swz / 64; C = (st & 1) * 32 + (swz % 64) / 2; }
__host__ __device__ __forceinline__ int perm32(int rho) { const int n = rho >> 4, i = rho & 15; return 8 * (i >> 2) + 4 * n + (i & 3); }

struct Unit { int pm, pn; };
struct Gemm { const bf16_t* A; const bf16_t* Bt; int M, N, K; };

struct StaticOrder {
    int nM, nN, nwg, G, c;
    __host__ __device__ void init(int M, int N, int G_, int c_) { nM = M / BM; nN = N / BM; nwg = nM * nN; G = G_; c = c_; }
    __host__ __device__ bool next(int i, Unit& u) const {
        const long L = (long)i * G + c; if (L >= nwg) return false;
        int wgid = (int)L; { const int q = nwg / NXCD, r = nwg % NXCD, xcd = wgid % NXCD, off = wgid / NXCD; wgid = (xcd < r ? xcd * (q + 1) : r * (q + 1) + (xcd - r) * q) + off; }
        const int nig = WGM * nN, gid = wgid / nig, fm = gid * WGM, gsz = (nM - fm) < WGM ? (nM - fm) : WGM;
        u.pm = fm + ((wgid % nig) % gsz); u.pn = (wgid % nig) / gsz; return true;
    }
    __device__ __forceinline__ void a_ready(const Unit&) const {}
    __device__ __forceinline__ void done(const Unit&) const {}
};
__device__ __forceinline__ unsigned cvt_pk_bf16(float lo, float hi) { unsigned r; asm volatile("v_cvt_pk_bf16_f32 %0, %1, %2" : "=v"(r) : "v"(lo), "v"(hi)); return r; }
typedef float f32x2 __attribute__((ext_vector_type(2)));

template <class Epi, class Sched, bool STAMP = false>
__device__ __forceinline__ void gemm_phase(PG8_LAS unsigned char* lds, const Gemm g, const Sched& S, const Epi& E, unsigned long long* stamps) {
    int tid_l_ = threadIdx.x; asm volatile("" : "+v"(tid_l_)); const int tid = tid_l_, wid = __builtin_amdgcn_readfirstlane(tid >> 6), lane = tid & 63, wr = wid >> 2, wc = wid & 3, fr = lane & 15, fq = lane >> 4;
    const int K = g.K, nt = K / BK;
    int ts_lo = 0, ts_hi = 0, nts = 0; const unsigned long long rt_entry = STAMP ? (unsigned long long)wall_clock64() : 0ull;
#define PG8_STAMP() do { if (STAMP && wid == 0 && nts < 64) { const unsigned long long _c = (unsigned long long)clock64(); \
        ts_lo = (lane == nts) ? (int)(unsigned)_c : ts_lo; ts_hi = (lane == nts) ? (int)(unsigned)(_c >> 32) : ts_hi; ++nts; } } while (0)
    PG8_STAMP();
    unsigned voffA[2], voffB[2];
#pragma unroll
    for (int i = 0; i < 2; ++i) { int R, C; stage_rc(tid * 16 + i * 8192, R, C); const int Rb = Epi::PERM ? ((R & ~31) + perm32(R & 31)) : R;
        voffA[i] = (unsigned)(R * K + C) * 2u; voffB[i] = (unsigned)(Rb * K + C) * 2u; }
    const size_t kstep = (size_t)(BK * 2);
    const size_t hstep = (size_t)HALF * K * 2;
    const size_t tstep = 2 * hstep;
    const unsigned ldsw = (unsigned)wid * 1024u;
    const int aoff = lds_byte(wr * 64 + fr, fq * 8), boff = lds_byte(wc * 32 + fr, fq * 8);
#define PG8_SA(b, h) (((b) * 2 + (h)) * HTB)
#define PG8_SB(b, h) ((4 + (b) * 2 + (h)) * HTB)
#define PG8_STAGE(bufoff, gbase, voff) do { _Pragma("unroll") for (int _i = 0; _i < 2; ++_i) \
        __builtin_amdgcn_global_load_lds((const unsigned*)((const char*)(gbase) + (voff)[_i]), (PG8_LAS unsigned*)(lds + (bufoff) + ldsw + _i * 8192), 16, 0, 0); } while (0)
#define PG8_LDA(dst, b, h) do { _Pragma("unroll") for (int m = 0; m < 4; ++m) _Pragma("unroll") for (int k = 0; k < 2; ++k) dst[m][k] = *(const PG8_LAS bf16x8*)(lds + PG8_SA(b, h) + aoff + m * 2048 + k * 1024); } while (0)
#define PG8_LDB(dst, b, h) do { _Pragma("unroll") for (int n = 0; n < 2; ++n) _Pragma("unroll") for (int k = 0; k < 2; ++k) dst[n][k] = *(const PG8_LAS bf16x8*)(lds + PG8_SB(b, h) + boff + n * 2048 + k * 1024); } while (0)
#define PG8_MMA(ai, bj, At, Bt) do { __builtin_amdgcn_s_setprio(1); _Pragma("unroll") for (int m = 0; m < 4; ++m) _Pragma("unroll") for (int n = 0; n < 2; ++n) _Pragma("unroll") for (int k = 0; k < 2; ++k) \
        acc[ai][bj][m][n] = __builtin_amdgcn_mfma_f32_16x16x32_bf16(Bt[n][k], At[m][k], acc[ai][bj][m][n], 0, 0, 0); __builtin_amdgcn_s_setprio(0); } while (0)
#define PG8_WAIT_V(n) asm volatile("s_waitcnt vmcnt(" #n ")" ::: "memory")
#define PG8_WAIT_L(n) asm volatile("s_waitcnt lgkmcnt(" #n ")" ::: "memory")
#define PG8_BAR __builtin_amdgcn_s_barrier()
#define PG8_SCHED __builtin_amdgcn_sched_barrier(0)
    Unit cur, nxt; int ui = 0;
    if (!S.next(0, cur)) return;
    f32x4 acc[2][2][4][2];
#pragma unroll
    for (int a = 0; a < 2; ++a)
#pragma unroll
        for (int b = 0; b < 2; ++b)
#pragma unroll
            for (int m = 0; m < 4; ++m)
#pragma unroll
                for (int n = 0; n < 2; ++n) acc[a][b][m][n] = (f32x4){0.f, 0.f, 0.f, 0.f};
    bf16x8 At[4][2], B0[2][2], B1[2][2];
    const char* cA = (const char*)g.A + (size_t)cur.pm * tstep; const char* cB = (const char*)g.Bt + (size_t)cur.pn * tstep;
    S.a_ready(cur);
    PG8_STAGE(PG8_SB(0, 0), cB, voffB); PG8_STAGE(PG8_SA(0, 0), cA, voffA); PG8_STAGE(PG8_SB(0, 1), cB + hstep, voffB); PG8_STAGE(PG8_SA(0, 1), cA + hstep, voffA);
    if (wr == 1) PG8_BAR;
    PG8_WAIT_V(4); PG8_BAR;
    PG8_STAGE(PG8_SB(1, 0), cB + kstep, voffB); PG8_STAGE(PG8_SA(1, 0), cA + kstep, voffA); PG8_STAGE(PG8_SB(1, 1), cB + hstep + kstep, voffB);
    PG8_WAIT_V(6); PG8_BAR;
    PG8_STAMP();
    for (;;) {
        const bool has_next = S.next(ui + 1, nxt);
        const char* nA = has_next ? (const char*)g.A + (size_t)nxt.pm * tstep : cA; const char* nB = has_next ? (const char*)g.Bt + (size_t)nxt.pn * tstep : cB;
        for (int t = 0; t < nt; t += 2) {
            const bool last = (t == nt - 2);
            const char* a1 = cA + (size_t)(t + 1) * kstep;
            const char* a2 = last ? nA : cA + (size_t)(t + 2) * kstep; const char* b2 = last ? nB : cB + (size_t)(t + 2) * kstep;
            const char* a3 = a2 + kstep; const char* b3 = b2 + kstep;
            if (last && has_next) S.a_ready(nxt);
            PG8_LDB(B0, 0, 0); PG8_SCHED; PG8_LDA(At, 0, 0); PG8_STAGE(PG8_SA(1, 1), a1 + hstep, voffA);
            PG8_WAIT_L(8); PG8_BAR; PG8_WAIT_L(0); PG8_MMA(0, 0, At, B0); PG8_BAR; PG8_SCHED;
            PG8_LDB(B1, 0, 1); PG8_STAGE(PG8_SB(0, 0), b2, voffB);
            PG8_BAR; PG8_WAIT_L(0); PG8_MMA(0, 1, At, B1); PG8_BAR;
            PG8_LDA(At, 0, 1); PG8_STAGE(PG8_SA(0, 0), a2, voffA);
            PG8_BAR; PG8_WAIT_L(0); PG8_MMA(1, 0, At, B0); PG8_BAR; PG8_SCHED;
            PG8_STAGE(PG8_SB(0, 1), b2 + hstep, voffB);
            PG8_WAIT_V(6); PG8_BAR; PG8_MMA(1, 1, At, B1); PG8_BAR;
            PG8_LDB(B0, 1, 0); PG8_SCHED; PG8_LDA(At, 1, 0); PG8_STAGE(PG8_SA(0, 1), a2 + hstep, voffA);
            PG8_WAIT_L(8); PG8_BAR; PG8_WAIT_L(0); PG8_MMA(0, 0, At, B0); PG8_BAR; PG8_SCHED;
            PG8_LDB(B1, 1, 1); PG8_STAGE(PG8_SB(1, 0), b3, voffB);
            PG8_BAR; PG8_WAIT_L(0); PG8_MMA(0, 1, At, B1); PG8_BAR;
            PG8_LDA(At, 1, 1); PG8_STAGE(PG8_SA(1, 0), a3, voffA);
            PG8_BAR; PG8_WAIT_L(0); PG8_MMA(1, 0, At, B0); PG8_BAR; PG8_SCHED;
            PG8_STAGE(PG8_SB(1, 1), b3 + hstep, voffB);
            PG8_WAIT_V(6); PG8_BAR; PG8_MMA(1, 1, At, B1); PG8_BAR;
        }
        PG8_STAMP();
        if constexpr (!Epi::AFTER_DRAIN) { E(acc, cur, wr, wc, fr, fq); S.done(cur); }
        PG8_STAMP();
        if (!has_next) break;
#pragma unroll
        for (int a = 0; a < 2; ++a)
#pragma unroll
            for (int b = 0; b < 2; ++b)
#pragma unroll
                for (int m = 0; m < 4; ++m)
#pragma unroll
                    for (int n = 0; n < 2; ++n) acc[a][b][m][n] = (f32x4){0.f, 0.f, 0.f, 0.f};
        cur = nxt; cA = nA; cB = nB; ++ui;
    }
    PG8_WAIT_V(0);
    if (wr == 0) PG8_BAR;
    PG8_BAR;
    if constexpr (Epi::AFTER_DRAIN) { E.fused(acc, cur, wr, wc, fr, fq, lds, wid, lane); S.done(cur); }
    PG8_STAMP();
    if (STAMP && wid == 0) { stamps[lane] = lane < nts ? (((unsigned long long)(unsigned)ts_hi << 32) | (unsigned)ts_lo) : 0ull;
        if (lane == 62) stamps[62] = rt_entry; if (lane == 63) stamps[63] = (unsigned long long)wall_clock64(); }
#undef PG8_STAMP
#undef PG8_SA
#undef PG8_SB
#undef PG8_STAGE
#undef PG8_LDA
#undef PG8_LDB
#undef PG8_MMA
#undef PG8_WAIT_V
#undef PG8_WAIT_L
#undef PG8_BAR
#undef PG8_SCHED
}
}
#define XB_TMO      128
#define XB_XCNT(j)  (256  + 64 * (j))
#define XB_XSUB(j)  (1280 + 64 * (j))
#define XB_XGEN(j)  (2304 + 64 * (j))
#define XB_TOP      3328
#define XB_TOPGEN   3392
#define XCD_BAR_WORDS 3456
#define XB_SPIN_CAP (1u << 18)
#define XB_LAS __attribute__((address_space(3)))

__device__ __forceinline__ unsigned xb_ld(unsigned* p)              { return __hip_atomic_load(p, __ATOMIC_RELAXED, __HIP_MEMORY_SCOPE_AGENT); }
__device__ __forceinline__ unsigned xb_add(unsigned* p, unsigned v) { return __hip_atomic_fetch_add(p, v, __ATOMIC_RELAXED, __HIP_MEMORY_SCOPE_AGENT); }
__device__ __forceinline__ unsigned xb_xcc_id() { return (unsigned)__builtin_amdgcn_s_getreg((3 << 11) | 20) & 0xFu; }
#define XB_SPIN(cond, bar) do { unsigned _sp = 0; while (cond) { __builtin_amdgcn_s_sleep(1); \
    if ((++_sp & 255u) == 0u) { if (xb_ld(&(bar)[XB_TMO])) break; if (_sp > XB_SPIN_CAP) { atomicAdd(&(bar)[XB_TMO], 1u); break; } } } } while (0)

struct XcdBarrier {
    unsigned* bar; unsigned x;
    volatile XB_LAS unsigned* st;
};

__device__ __forceinline__ XcdBarrier xcd_barrier_post(unsigned* bar, volatile XB_LAS unsigned* st) {
    XcdBarrier b; b.bar = bar; b.x = xb_xcc_id(); b.st = st;
    if (threadIdx.x == 0) (void)xb_add(&bar[XB_XCNT(b.x)], 1u);
    return b;
}
__device__ __forceinline__ void xcd_barrier_complete(unsigned* bar, unsigned x, unsigned& nloc, unsigned& nx) {
    const unsigned G = gridDim.x * gridDim.y * gridDim.z;
    unsigned sum, cnt, mine, sp = 0u;
    for (;;) {
        sum = 0u; cnt = 0u; mine = 0u;
#pragma unroll
        for (unsigned j = 0; j < 16; ++j) { const unsigned c = xb_ld(&bar[XB_XCNT(j)]); sum += c; cnt += (c > 0u) ? 1u : 0u; mine = (j == x) ? c : mine; }
        if (sum == G) break;
        __builtin_amdgcn_s_sleep(1);
        if ((++sp & 255u) == 0u) { if (xb_ld(&bar[XB_TMO])) break; if (sp > XB_SPIN_CAP) { atomicAdd(&bar[XB_TMO], 1u); break; } }
    }
    nloc = mine > 0u ? mine : 1u; nx = cnt > 0u ? cnt : 1u;
}

__device__ __forceinline__ void xcd_barrier(const XcdBarrier& b) {
    asm volatile("s_waitcnt vmcnt(0)" ::: "memory");
    __syncthreads();
    if (threadIdx.x == 0) {
        unsigned* bar = b.bar;
        __builtin_amdgcn_s_waitcnt(0);
        unsigned nloc = b.st[0], nx = b.st[1];
        if (nloc == 0u) { xcd_barrier_complete(bar, b.x, nloc, nx); b.st[0] = nloc; b.st[1] = nx; }
        const unsigned old = xb_add(&bar[XB_XSUB(b.x)], 1u);
        const unsigned gen = old / nloc;
        if (old + 1u == (gen + 1u) * nloc) {
            __builtin_amdgcn_fence(__ATOMIC_RELEASE, "agent");
            asm volatile("s_waitcnt vmcnt(0)" ::: "memory");
            const unsigned og = xb_add(&bar[XB_TOP], 1u);
            const unsigned tg = og / nx;
            if (og + 1u == (tg + 1u) * nx) xb_add(&bar[XB_TOPGEN], 1u);
            else XB_SPIN(xb_ld(&bar[XB_TOPGEN]) == tg, bar);
            __builtin_amdgcn_fence(__ATOMIC_ACQUIRE, "agent");
            xb_add(&bar[XB_XGEN(b.x)], 1u);
            asm volatile("s_waitcnt vmcnt(0)" ::: "memory");
        } else {
            XB_SPIN(xb_ld(&bar[XB_XGEN(b.x)]) == gen, bar);
            __builtin_amdgcn_fence(__ATOMIC_ACQUIRE, "agent");
            asm volatile("s_waitcnt vmcnt(0)" ::: "memory");
        }
    }
    __syncthreads();
}

namespace cg = cooperative_groups;
typedef unsigned short bf16_t;
using pg8::bf16x8; using pg8::f32x4;
#define LAS __attribute__((address_space(3)))

constexpr int D = 1024, NB = 16, TL = 2048, TCX = 256, FF = 2816;
constexpr int MLAT = NB * TL, MCTX = NB * TCX, MTOT = MLAT + MCTX;
constexpr float DN_ALPHA = 1.681792830507429f;
constexpr int NTHR = 512;
constexpr int LDS_BYTES = 155648;

constexpr size_t al256(size_t x) { return (x + 255) & ~(size_t)255; }
constexpr size_t WS_MOD = 16384;
constexpr size_t WS_FT = al256(WS_MOD + (size_t)4 * 17 * 9216 * 4);
constexpr size_t FT_LAT = (size_t)2 * 512 * 4096, FT_CTX = (size_t)2 * 512 * 512, FT_E = FT_LAT + FT_CTX;
constexpr size_t WS_WUP = al256(WS_FT + 2 * FT_E * 2);
constexpr size_t WS_WDN = WS_WUP + (size_t)2 * 5632 * 1024 * 2;
constexpr size_t WS_WIN = WS_WDN + (size_t)2 * 1024 * 2816 * 2;
constexpr size_t WS_WOUT = WS_WIN + (size_t)3584 * 1024 * 2;
constexpr size_t WS_H = WS_WOUT + (size_t)1024 * 1024 * 2;
constexpr size_t WS_A = WS_H + (size_t)MTOT * 1024 * 4;
constexpr size_t WS_BON = WS_A + (size_t)MTOT * 1024 * 2;
constexpr size_t WS_STATS = al256(WS_BON + (size_t)2 * MTOT * 8 * 4);
constexpr size_t WS_BIG = al256(WS_STATS + (size_t)MTOT * 2 * 4);
constexpr size_t BIG_ZR = (size_t)1536 * MTOT * 2;
constexpr size_t BIG_ORW = BIG_ZR + (size_t)MTOT * 1920 * 2;
constexpr size_t BIG_EVEN_END = BIG_ORW + (size_t)2 * MTOT * 512 * 2;
constexpr size_t BIG_OGL = al256((size_t)MTOT * 3104 * 2);
constexpr size_t WS_END = WS_BIG + BIG_EVEN_END;

struct Params { const float* in[41]; };
#define PH_PRO int tid_ = threadIdx.x; asm volatile("" : "+v"(tid_)); int bid_ = blockIdx.x; asm volatile("" : "+s"(bid_)); int gdim_ = gridDim.x; asm volatile("" : "+s"(gdim_));
extern __shared__ __attribute__((aligned(16))) unsigned char smem_g[];
constexpr int TBL_OFF = LDS_BYTES - 512;
typedef const float __attribute__((address_space(1)))* gfptr_;
#define IN(i) ((const float*)(((const gfptr_*)(smem_g + TBL_OFF))[i]))
#define OUT_ ((float*)IN(39))
#define WS_ ((unsigned char*)IN(40))

__device__ __forceinline__ float bf2f(bf16_t b) { return __uint_as_float(((unsigned)b) << 16); }
typedef __bf16 bf16x2_t_ __attribute__((ext_vector_type(2)));
typedef float f32x2_t_ __attribute__((ext_vector_type(2)));
__device__ __forceinline__ unsigned pk2(float lo, float hi) { f32x2_t_ v = {lo, hi}; bf16x2_t_ b = __builtin_convertvector(v, bf16x2_t_); return __builtin_bit_cast(unsigned, b); }
__device__ __forceinline__ bf16_t f2bf(float f) { return (bf16_t)(pk2(f, 0.f) & 0xffffu); }
__device__ __forceinline__ bf16x8 ld8(const bf16_t* p) { const uint2 a = *(const uint2*)p, b = *(const uint2*)(p + 4); uint4 v; v.x = a.x; v.y = a.y; v.z = b.x; v.w = b.y; return __builtin_bit_cast(bf16x8, v); }
#define DPPF(v, ctrl) __builtin_bit_cast(float, __builtin_amdgcn_update_dpp(0, __builtin_bit_cast(int, (v)), (ctrl), 0xF, 0xF, true))
__device__ __forceinline__ float wsum(float v) {
    v += DPPF(v, 0xB1); v += DPPF(v, 0x4E); v += DPPF(v, 0x141); v += DPPF(v, 0x140);
    const int iv = __builtin_bit_cast(int, v);
    return __builtin_bit_cast(float, __builtin_amdgcn_readlane(iv, 0)) + __builtin_bit_cast(float, __builtin_amdgcn_readlane(iv, 16)) +
           __builtin_bit_cast(float, __builtin_amdgcn_readlane(iv, 32)) + __builtin_bit_cast(float, __builtin_amdgcn_readlane(iv, 48));
}
__device__ __forceinline__ float sigm(float x) { return __builtin_amdgcn_rcpf(1.f + __expf(-x)); }
__device__ __forceinline__ float silu_(float x) { return x * __builtin_amdgcn_rcpf(1.f + __expf(-x)); }
__device__ __forceinline__ float softplus_(float y) { return fmaxf(y, 0.f) + __logf(1.f + __expf(-fabsf(y))); }
__device__ __forceinline__ float tanh_(float x) { return 1.f - 2.f * __builtin_amdgcn_rcpf(1.f + __expf(2.f * x)); }

struct EpiStore {
    static constexpr bool PERM = true, AFTER_DRAIN = false;
    bf16_t* O; int ldc; int nvalid;
    __device__ __forceinline__ void operator()(const f32x4 (&acc)[2][2][4][2], const pg8::Unit& u, int wr, int wc, int fr, int fq) const {
        const int row0 = u.pm * 256 + wr * 64 + fr, col0 = u.pn * 256 + wc * 32 + 8 * fq;
#pragma unroll
        for (int ai = 0; ai < 2; ++ai)
#pragma unroll
            for (int m = 0; m < 4; ++m) {
                bf16_t* rowp = O + (size_t)(row0 + ai * 128 + m * 16) * ldc;
#pragma unroll
                for (int bj = 0; bj < 2; ++bj) {
                    const int col = col0 + bj * 128;
                    if (col < nvalid) {
                        const f32x4 v0 = acc[ai][bj][m][0], v1 = acc[ai][bj][m][1];
                        uint4 o; o.x = pk2(v0[0], v0[1]); o.y = pk2(v0[2], v0[3]); o.z = pk2(v1[0], v1[1]); o.w = pk2(v1[2], v1[3]);
                        *(uint4*)(rowp + col) = o;
                    }
                }
            }
    }
};
struct EpiSwiglu {
    static constexpr bool PERM = true, AFTER_DRAIN = false;
    bf16_t* G; int pm_off;
    __device__ __forceinline__ void operator()(const f32x4 (&acc)[2][2][4][2], const pg8::Unit& u, int wr, int wc, int fr, int fq) const {
        const int row0 = (u.pm + pm_off) * 256 + wr * 64 + fr, col0 = u.pn * 128 + wc * 32 + 8 * fq;
#pragma unroll
        for (int ai = 0; ai < 2; ++ai)
#pragma unroll
            for (int m = 0; m < 4; ++m) {
                bf16_t* rowp = G + (size_t)(row0 + ai * 128 + m * 16) * FF + col0;
                float o[8];
#pragma unroll
                for (int n = 0; n < 2; ++n)
#pragma unroll
                    for (int e = 0; e < 4; ++e) o[n * 4 + e] = silu_(acc[ai][0][m][n][e]) * acc[ai][1][m][n][e];
                uint4 q; q.x = pk2(o[0], o[1]); q.y = pk2(o[2], o[3]); q.z = pk2(o[4], o[5]); q.w = pk2(o[6], o[7]);
                *(uint4*)rowp = q;
            }
    }
};
struct EpiResid {
    static constexpr bool PERM = false, AFTER_DRAIN = false;
    int gate_off; float wgt; int ln_idx; int pm_off;
    __device__ __forceinline__ void operator()(const f32x4 (&acc)[2][2][4][2], const pg8::Unit& u, int wr, int wc, int fr, int fq) const {
        float* H = (float*)(WS_ + WS_H); const float* gate = (const float*)(WS_ + WS_MOD) + gate_off;
        const float* stats = ln_idx >= 0 ? (const float*)(WS_ + WS_STATS) : nullptr;
        const float* Hin = ln_idx >= 0 ? H : ((u.pm + pm_off) < 128 ? IN(0) : IN(2) - (size_t)MLAT * D);
        const float* lg = IN(6) + (ln_idx < 0 ? 0 : ln_idx) * 1024; const float* lb = IN(7) + (ln_idx < 0 ? 0 : ln_idx) * 1024;
        const int gpm = u.pm + pm_off;
        const int row0 = gpm * 256 + wr * 64 + fr, col0 = u.pn * 256 + wc * 32 + 4 * fq;
        const int midx = gpm < 128 ? (gpm >> 3) : 16;
        const float* gp = gate + (size_t)midx * 9216 + col0;
        float mu[2][4], rs[2][4];
#pragma unroll
        for (int ai = 0; ai < 2; ++ai)
#pragma unroll
            for (int m = 0; m < 4; ++m) {
                if (stats) { const float2 st = *(const float2*)(stats + 2 * (size_t)(row0 + ai * 128 + m * 16)); mu[ai][m] = st.x; rs[ai][m] = st.y; }
                else { mu[ai][m] = 0.f; rs[ai][m] = 1.f; }
            }
#pragma unroll
        for (int bj = 0; bj < 2; ++bj)
#pragma unroll
            for (int n = 0; n < 2; ++n) {
                const int co = bj * 128 + n * 16;
                const f32x4 gvv = *(const f32x4*)(gp + co) * wgt;
                f32x4 g4 = (f32x4){1.f, 1.f, 1.f, 1.f}, b4 = (f32x4){0.f, 0.f, 0.f, 0.f};
                if (stats) { g4 = *(const f32x4*)(lg + col0 + co); b4 = *(const f32x4*)(lb + col0 + co); }
#pragma unroll
                for (int ai = 0; ai < 2; ++ai)
#pragma unroll
                    for (int m = 0; m < 4; ++m) {
                        float* rowp = H + (size_t)(row0 + ai * 128 + m * 16) * D + col0 + co;
                        f32x4 h = *(const f32x4*)(Hin + (size_t)(row0 + ai * 128 + m * 16) * D + col0 + co);
                        h = (h - mu[ai][m]) * rs[ai][m] * g4 + b4;
                        h = h * DN_ALPHA + gvv * acc[ai][bj][m][n];
                        *(f32x4*)rowp = h;
                    }
            }
    }
};

template <class Epi>
__device__ __forceinline__ void run_gemm(unsigned char* smem, const bf16_t* A, const bf16_t* Bt, int M, int N, int K, const Epi& E, int bid_, int gdim_) {
    pg8::Gemm g; g.A = A; g.Bt = Bt; g.M = M; g.N = N; g.K = K;
    pg8::StaticOrder S; S.init(M, N, gdim_, bid_);
    pg8::gemm_phase<Epi, pg8::StaticOrder, false>((PG8_LAS unsigned char*)smem, g, S, E, nullptr);
}

__device__ __forceinline__ void phase_mod(const Params& p, unsigned char* smem) {
    PH_PRO
    float* s = (float*)smem;
    float* part = s + 17 * 1024;
    const int tid = tid_;
    const float* c = IN(1); const float* cc = IN(3);
    float* MOD = (float*)(WS_ + WS_MOD);
    if (bid_ >= 288) return;
    for (int idx = tid; idx < 17 * 1024; idx += NTHR) { const int i = idx >> 10, k = idx & 1023; const float v = i < 16 ? c[i * 1024 + k] : cc[k]; s[idx] = silu_(v); }
    __syncthreads();
    for (int item = bid_; item < 288; item += gdim_) {
        const int l = item / 72, j0 = (item % 72) * 128;
        const int col = tid & 127, kq = tid >> 7;
        const float* w = IN(4) + ((size_t)l * 1024 + kq * 256) * 9216 + j0 + col;
        float acc[17];
#pragma unroll
        for (int i = 0; i < 17; ++i) acc[i] = 0.f;
        for (int k = 0; k < 256; ++k) {
            const float wv = w[(size_t)k * 9216];
#pragma unroll
            for (int i = 0; i < 17; ++i) acc[i] += s[i * 1024 + kq * 256 + k] * wv;
        }
#pragma unroll
        for (int i = 0; i < 17; ++i) part[(kq * 17 + i) * 128 + col] = acc[i];
        __syncthreads();
        for (int idx = tid; idx < 17 * 128; idx += NTHR) {
            const int i = idx >> 7, cl = idx & 127;
            const float v = part[(0 * 17 + i) * 128 + cl] + part[(1 * 17 + i) * 128 + cl] + part[(2 * 17 + i) * 128 + cl] + part[(3 * 17 + i) * 128 + cl] + IN(5)[l * 9216 + j0 + cl];
            MOD[((size_t)l * 17 + i) * 9216 + j0 + cl] = v;
        }
        __syncthreads();
    }
}

__device__ __forceinline__ void conv_tile(const float* src, int ld, int nvalid, bf16_t* dst, int ldd, float* tile) {
    PH_PRO
    const int tid = tid_;
#pragma unroll
    for (int i = 0; i < 2; ++i) {
        const int k = (tid >> 4) + 32 * i, c4 = (tid & 15) * 4;
        float4 v = make_float4(0.f, 0.f, 0.f, 0.f);
        if (c4 < nvalid) v = *(const float4*)(src + (size_t)k * ld + c4);
        tile[k * 65 + c4] = v.x; tile[k * 65 + c4 + 1] = v.y; tile[k * 65 + c4 + 2] = v.z; tile[k * 65 + c4 + 3] = v.w;
    }
    __syncthreads();
    const int n = tid >> 3, ks = (tid & 7) * 8;
    uint4 o;
    o.x = pk2(tile[(ks + 0) * 65 + n], tile[(ks + 1) * 65 + n]); o.y = pk2(tile[(ks + 2) * 65 + n], tile[(ks + 3) * 65 + n]);
    o.z = pk2(tile[(ks + 4) * 65 + n], tile[(ks + 5) * 65 + n]); o.w = pk2(tile[(ks + 6) * 65 + n], tile[(ks + 7) * 65 + n]);
    *(uint4*)(dst + (size_t)n * ldd + ks) = o;
    __syncthreads();
}
__device__ __forceinline__ void conv_weights(const Params& p, int l, unsigned char* smem) {
    PH_PRO
    float* tile = (float*)smem;
    const int tid = tid_;
    const bool even = !(l & 1); const int eo = l >> 1;
    const int NIN = even ? 3456 : 3104, nint = (even ? 3584 : 3328) / 64;
    const int total = 2816 + 1408 + nint * 16 + 256;
    bf16_t* WUP = (bf16_t*)(WS_ + WS_WUP); bf16_t* WDN = (bf16_t*)(WS_ + WS_WDN); bf16_t* WIN = (bf16_t*)(WS_ + WS_WIN); bf16_t* WOUT = (bf16_t*)(WS_ + WS_WOUT);
    auto desc = [&](int idx, const float*& src, int& ld, int& nv, bf16_t*& dst, int& ldd) {
        if (idx < 2816) {
            const int f = idx / 1408, r = idx % 1408, nt = r / 16, kt = r % 16, n0 = nt * 64;
            const int pn = n0 >> 8, bj = (n0 & 255) >> 7, j = n0 & 127, col = pn * 128 + j;
            src = (bj ? IN(9) : IN(8)) + ((size_t)(l * 2 + f) * 1024 + kt * 64) * FF + col; ld = FF; nv = 64;
            dst = WUP + ((size_t)f * 5632 + n0) * 1024 + kt * 64; ldd = 1024;
        } else if (idx < 4224) {
            int r = idx - 2816; const int f = r / 704; r %= 704; const int kt = r / 16, nt = r % 16;
            src = IN(10) + ((size_t)(l * 2 + f) * FF + kt * 64) * 1024 + nt * 64; ld = 1024; nv = 64;
            dst = WDN + ((size_t)f * 1024 + nt * 64) * FF + kt * 64; ldd = FF;
        } else if (idx < 4224 + nint * 16) {
            const int r = idx - 4224, nt = r / 16, kt = r % 16, n0 = nt * 64;
            int v = NIN - n0; v = v < 0 ? 0 : (v > 64 ? 64 : v);
            src = (even ? IN(11) : IN(34)) + ((size_t)eo * 1024 + kt * 64) * NIN + n0; ld = NIN; nv = v;
            dst = WIN + (size_t)n0 * 1024 + kt * 64; ldd = 1024;
        } else {
            const int r = idx - 4224 - nint * 16, nt = r / 16, kt = r % 16;
            src = (even ? IN(12) : IN(35)) + ((size_t)eo * 1024 + kt * 64) * 1024 + nt * 64; ld = 1024; nv = 64;
            dst = WOUT + (size_t)nt * 64 * 1024 + kt * 64; ldd = 1024;
        }
    };
    float4 nx[2]; bf16_t* ndst = nullptr; int nldd = 0;
    auto issue = [&](int idx) {
        const float* src; int ld, nv; desc(idx, src, ld, nv, ndst, nldd);
#pragma unroll
        for (int i = 0; i < 2; ++i) { const int k = (tid >> 4) + 32 * i, c4 = (tid & 15) * 4; nx[i] = make_float4(0.f, 0.f, 0.f, 0.f); if (c4 < nv) nx[i] = *(const float4*)(src + (size_t)k * ld + c4); }
    };
    if (bid_ < total) issue(bid_);
    for (int idx = bid_; idx < total; idx += gdim_) {
        const float4 c0 = nx[0], c1 = nx[1]; bf16_t* dst = ndst; const int ldd = nldd;
        if (idx + gdim_ < total) issue(idx + gdim_);
        { const int k = (tid >> 4), c4 = (tid & 15) * 4;
          tile[k * 65 + c4] = c0.x; tile[k * 65 + c4 + 1] = c0.y; tile[k * 65 + c4 + 2] = c0.z; tile[k * 65 + c4 + 3] = c0.w;
          tile[(k + 32) * 65 + c4] = c1.x; tile[(k + 32) * 65 + c4 + 1] = c1.y; tile[(k + 32) * 65 + c4 + 2] = c1.z; tile[(k + 32) * 65 + c4 + 3] = c1.w; }
        __syncthreads();
        const int n = tid >> 3, ks = (tid & 7) * 8;
        uint4 o;
        o.x = pk2(tile[(ks + 0) * 65 + n], tile[(ks + 1) * 65 + n]); o.y = pk2(tile[(ks + 2) * 65 + n], tile[(ks + 3) * 65 + n]);
        o.z = pk2(tile[(ks + 4) * 65 + n], tile[(ks + 5) * 65 + n]); o.w = pk2(tile[(ks + 6) * 65 + n], tile[(ks + 7) * 65 + n]);
        *(uint4*)(dst + (size_t)n * ldd + ks) = o;
        __syncthreads();
    }
}

__device__ __forceinline__ void filt_gen(const Params& p, unsigned char* smem) {
    PH_PRO
    float* z = (float*)smem;
    float* h1 = z + 64 * 33;
    float* h2 = h1 + 64 * 65;
    const int tid = tid_, lane = tid & 63, wid = __builtin_amdgcn_readfirstlane(tid >> 6);
    bf16_t* FT = (bf16_t*)(WS_ + WS_FT);
    for (int item = (bid_ + gdim_ / 2) % gdim_; item < 2 * 36 * 4; item += gdim_) {
        const int e = item / 144; int r = item % 144; const int cg = r & 3; r >>= 2;
        const int seg = r >= 32; const int jb = seg ? r - 32 : r;
        const int L = seg ? 256 : 2048;
        const float* w1 = IN(15) + e * 33 * 64; const float* b1 = IN(16) + e * 64; const float* f1 = IN(17) + e * 64;
        const float* w2 = IN(18) + e * 64 * 64; const float* b2 = IN(19) + e * 64; const float* f2 = IN(20) + e * 64;
        const float* w3 = IN(21) + (size_t)e * 64 * 2048; const float* skip = IN(22) + e * 1024;
        __syncthreads();
        for (int idx = tid; idx < 64 * 33; idx += NTHR) {
            const int jj = idx / 33, i = idx % 33; const int j = jb * 64 + jj;
            float v;
            if (i == 0) v = (float)j / (float)(L - 1);
            else { const int bi = (i - 1) & 15; const float f = 1e-4f + (float)bi * ((15.f - 1e-4f) / 15.f); const float w = 6.283185307179586f * (float)j / (float)L; v = (i <= 16) ? cosf(f * w) : -sinf(f * w); }
            z[idx] = v;
        }
        __syncthreads();
        for (int idx = tid; idx < 4096; idx += NTHR) {
            const int jj = idx >> 6, o = idx & 63; float a = b1[o];
            for (int i = 0; i < 33; ++i) a += z[jj * 33 + i] * w1[i * 64 + o];
            h1[jj * 65 + o] = sinf(f1[o] * a);
        }
        __syncthreads();
        for (int idx = tid; idx < 4096; idx += NTHR) {
            const int jj = idx >> 6, o = idx & 63; float a = b2[o];
            for (int k = 0; k < 64; ++k) a += h1[jj * 65 + k] * w2[k * 64 + o];
            h2[jj * 65 + o] = sinf(f2[o] * a);
        }
        __syncthreads();
        bf16_t* base = FT + (size_t)e * FT_E + (seg ? FT_LAT : 0);
#pragma unroll 1
        for (int ps = 0; ps < 2; ++ps) {
            const int col0 = cg * 512 + ps * 256 + 4 * lane;
            float acc[8][4];
#pragma unroll
            for (int i = 0; i < 8; ++i)
#pragma unroll
                for (int c = 0; c < 4; ++c) acc[i][c] = 0.f;
#pragma unroll 4
            for (int k = 0; k < 64; ++k) {
                const float4 wv = *(const float4*)(w3 + (size_t)k * 2048 + col0);
#pragma unroll
                for (int i = 0; i < 8; ++i) { const float hv = h2[(8 * wid + i) * 65 + k]; acc[i][0] += hv * wv.x; acc[i][1] += hv * wv.y; acc[i][2] += hv * wv.z; acc[i][3] += hv * wv.w; }
            }
            const int ord = col0 >> 10, dir = (col0 >> 9) & 1;
            const float lo = -4.605170185988091f / 1.5f, hi = -4.605170185988091f / 0.3f;
#pragma unroll
            for (int c = 0; c < 4; ++c) {
                const int ch = (col0 + c) & 511;
                const float adl = fabsf(lo + (hi - lo) * (float)ch / 511.f);
                bf16_t* fp = base + ((size_t)ord * 512 + ch) * (2 * L);
#pragma unroll
                for (int i = 0; i < 8; ++i) {
                    const int j = jb * 64 + 8 * wid + i; const float tj = (float)j / (float)(L - 1);
                    float v = acc[i][c] * __expf(-tj * adl);
                    if (dir == 0 && j == 0) v += skip[ord * 512 + ch];
                    if (!(dir == 1 && j == 0)) fp[dir == 0 ? (L - 1 - j) : (L - 1 + j)] = f2bf(v);
                }
            }
        }
    }
    __syncthreads();
}

__device__ __forceinline__ void row_phase(const Params& p, int mode, int l_ln, int which, int l_mod, int sidx, bool fin, int nrows_in = MTOT, int row_begin = 0, int blk_off = 0, int nblk_in = 0) {
    PH_PRO
    const int lane = tid_ & 63, wid = tid_ >> 6;
    float* H = (float*)(WS_ + WS_H); bf16_t* A = (bf16_t*)(WS_ + WS_A);
    const float* MOD = (const float*)(WS_ + WS_MOD);
    const float* lg = IN(6) + (l_ln * 3 + which) * 1024; const float* lb = IN(7) + (l_ln * 3 + which) * 1024;
    const int nrows = fin ? MLAT : nrows_in;
    constexpr int RU = 1;
    const int nblk = nblk_in ? nblk_in : gdim_;
    for (int rowb = row_begin + (bid_ - blk_off) * 8 + wid; rowb < nrows; rowb += nblk * 8 * RU) {
        float4 v[RU][4]; int rows[RU]; bool okr[RU];
#pragma unroll
        for (int u = 0; u < RU; ++u) {
            const int row = rowb + u * nblk * 8; okr[u] = row < nrows; rows[u] = okr[u] ? row : rowb;
            const float* src = mode ? H + (size_t)rows[u] * D : (rows[u] < MLAT ? IN(0) + (size_t)rows[u] * D : IN(2) + (size_t)(rows[u] - MLAT) * D);
#pragma unroll
            for (int i = 0; i < 4; ++i) v[u][i] = *(const float4*)(src + 4 * lane + 256 * i);
        }
#pragma unroll
        for (int u = 0; u < RU; ++u) {
            const int row = rows[u];
            if (mode) {
                float s = 0.f;
#pragma unroll
                for (int i = 0; i < 4; ++i) s += v[u][i].x + v[u][i].y + v[u][i].z + v[u][i].w;
                const float mu = wsum(s) * (1.f / 1024.f);
                float q = 0.f;
#pragma unroll
                for (int i = 0; i < 4; ++i) { v[u][i].x -= mu; v[u][i].y -= mu; v[u][i].z -= mu; v[u][i].w -= mu; q += v[u][i].x * v[u][i].x + v[u][i].y * v[u][i].y + v[u][i].z * v[u][i].z + v[u][i].w * v[u][i].w; }
                const float rstd = rsqrtf(wsum(q) * (1.f / 1024.f) + 1e-6f);
                if (lane == 0 && !fin && okr[u]) *(float2*)((float*)(WS_ + WS_STATS) + 2 * (size_t)row) = make_float2(mu, rstd);
#pragma unroll
                for (int i = 0; i < 4; ++i) {
                    const float4 g = *(const float4*)(lg + 4 * lane + 256 * i), b = *(const float4*)(lb + 4 * lane + 256 * i);
                    v[u][i].x = v[u][i].x * rstd * g.x + b.x; v[u][i].y = v[u][i].y * rstd * g.y + b.y; v[u][i].z = v[u][i].z * rstd * g.z + b.z; v[u][i].w = v[u][i].w * rstd * g.w + b.w;
                }
            }
            if (!okr[u]) continue;
            if (fin) {
#pragma unroll
                for (int i = 0; i < 4; ++i) *(float4*)(OUT_ + (size_t)row * D + 4 * lane + 256 * i) = v[u][i];
            } else {
                const int midx = row < MLAT ? (row >> 11) : 16;
                const float* mp = MOD + ((size_t)l_mod * 17 + midx) * 9216 + sidx * 1024;
#pragma unroll
                for (int i = 0; i < 4; ++i) {
                    const float4 sh = *(const float4*)(mp + 4 * lane + 256 * i), sc = *(const float4*)(mp + 1024 + 4 * lane + 256 * i);
                    uint2 o; o.x = pk2(v[u][i].x * (1.f + sc.x) + sh.x, v[u][i].y * (1.f + sc.y) + sh.y); o.y = pk2(v[u][i].z * (1.f + sc.z) + sh.z, v[u][i].w * (1.f + sc.w) + sh.w);
                    *(uint2*)(A + (size_t)row * D + 4 * lane + 256 * i) = o;
                }
            }
        }
    }
}
template <int L>
__device__ __forceinline__ void hyena_item(const Params& p, int e, int c, int segbase, const bf16_t* ft, unsigned char* smem) {
    PH_PRO
    constexpr int CPS = 2 * L + 16, UTS = L + 8, TPW = (L / 16) / 8;
    bf16_t* COP = (bf16_t*)smem;
    bf16_t* UT = COP + 8 * CPS;
    const int tid = tid_, lane = tid & 63, wid = tid >> 6;
    bf16_t* ZHT = (bf16_t*)(WS_ + WS_BIG);
    bf16_t* zv = ZHT + (size_t)c * MTOT + segbase;
    const bf16_t* zx1 = ZHT + (size_t)(512 + c) * MTOT + segbase;
    const bf16_t* zx2 = ZHT + (size_t)(1024 + c) * MTOT + segbase;
    const float* cw = IN(13) + e * 3 * 1536; const float* cbp = IN(14) + e * 1536;
    const float vw0 = cw[c], vw1 = cw[1536 + c], vw2 = cw[3072 + c], vb = cbp[c];
    const float aw0 = cw[512 + c], aw1 = cw[1536 + 512 + c], aw2 = cw[3072 + 512 + c], ab = cbp[512 + c];
    const float bw0 = cw[1024 + c], bw1 = cw[1536 + 1024 + c], bw2 = cw[3072 + 1024 + c], bb = cbp[1024 + c];
    auto conv4 = [&](const bf16_t* q, int t0, float w0, float w1, float w2, float bias, float (&y)[4]) {
        const uint2 mid = *(const uint2*)(q + t0);
        float zm = bf2f(q[t0 > 0 ? t0 - 1 : 0]); zm = t0 > 0 ? zm : 0.f;
        float zq = bf2f(q[t0 + 4 < L ? t0 + 4 : L - 1]); zq = t0 + 4 < L ? zq : 0.f;
        const float z0 = __uint_as_float(mid.x << 16), z1 = __uint_as_float(mid.x & 0xffff0000u), z2 = __uint_as_float(mid.y << 16), z3 = __uint_as_float(mid.y & 0xffff0000u);
        y[0] = zm * w0 + z0 * w1 + z1 * w2 + bias; y[1] = z0 * w0 + z1 * w1 + z2 * w2 + bias;
        y[2] = z1 * w0 + z2 * w1 + z3 * w2 + bias; y[3] = z2 * w0 + z3 * w1 + zq * w2 + bias;
    };
#pragma unroll 4
    for (int idx = tid; idx < 4 * L; idx += NTHR) {
        const int b = idx / (L / 4), s4 = (idx % (L / 4)) * 4;
        float y[4]; conv4(zv + b * L, s4, vw0, vw1, vw2, vb, y);
        uint2 o; o.x = pk2(y[0], y[1]); o.y = pk2(y[2], y[3]);
        *(uint2*)(UT + b * UTS + s4) = o;
    }
    const int r = lane & 15, g = lane >> 4, a = 7 - (r & 7);
    const bf16_t* cop_a = COP + a * CPS;
    f32x4 acc[TPW];
#pragma unroll 1
    for (int ord = 0; ord < 2; ++ord) {
        const bf16_t* fo = ft + ((size_t)ord * 512 + c) * (2 * L);
        for (int cidx = tid; cidx < (2 * L) / 8; cidx += NTHR) {
            const uint4 raw = *(const uint4*)(fo + 8 * cidx);
            unsigned short v[8] = {(unsigned short)(raw.x & 0xffffu), (unsigned short)(raw.x >> 16), (unsigned short)(raw.y & 0xffffu), (unsigned short)(raw.y >> 16),
                                   (unsigned short)(raw.z & 0xffffu), (unsigned short)(raw.z >> 16), (unsigned short)(raw.w & 0xffffu), (unsigned short)(raw.w >> 16)};
            if (cidx == (2 * L) / 8 - 1) v[7] = 0;
#pragma unroll
            for (int ca = 0; ca < 8; ++ca)
#pragma unroll
                for (int j = 0; j < 8; ++j) { const int x = 8 * cidx - ca + j; COP[ca * CPS + (x < 0 ? 0 : x)] = v[j]; }
        }
        __syncthreads();
#pragma unroll
        for (int i = 0; i < TPW; ++i) acc[i] = (f32x4){0.f, 0.f, 0.f, 0.f};
        if constexpr (TPW == 16) {
            const bf16_t* fbase = cop_a + (8 * g - r + L - 1 - a) - wid * 256;
            bf16x8 F[16];
#pragma unroll
            for (int dd = -15; dd <= 0; ++dd) F[dd & 15] = *(const bf16x8*)(fbase + 16 * dd);
#pragma unroll 1
            for (int S0 = 0; S0 < L / 32; S0 += 8) {
#pragma unroll
                for (int u = 0; u < 8; ++u) {
                    const int S = S0 + u;
                    if (S > 0) { F[(2 * u) & 15] = *(const bf16x8*)(fbase + 32 * S); F[(2 * u - 1) & 15] = *(const bf16x8*)(fbase + 32 * S - 16); }
                    const bf16x8 bfr = *(const bf16x8*)(UT + r * UTS + 32 * S + 8 * g);
#pragma unroll
                    for (int i = 0; i < 16; ++i) acc[i] = __builtin_amdgcn_mfma_f32_16x16x32_bf16(F[(2 * u - i) & 15], bfr, acc[i], 0, 0, 0);
                }
            }
        } else {
        for (int s0 = 0; s0 < L; s0 += 32) {
            const bf16x8 bfr = *(const bf16x8*)(UT + r * UTS + s0 + 8 * g);
#pragma unroll
            for (int i = 0; i < TPW; ++i) {
                const int t0 = (wid * TPW + i) * 16;
                const int n8 = s0 - t0 + 8 * g - r + L - 1 - a;
                const bf16x8 afr = *(const bf16x8*)(cop_a + n8);
                acc[i] = __builtin_amdgcn_mfma_f32_16x16x32_bf16(afr, bfr, acc[i], 0, 0, 0);
            }
        }
        }
        __syncthreads();
        int rl = r * L, tb0 = wid * TPW * 16 + 4 * g; asm volatile("" : "+v"(rl), "+v"(tb0));
        if (ord == 0) {
#pragma unroll
            for (int i = 0; i < TPW; ++i) {
                const int t0 = tb0 + i * 16;
                float y[4]; conv4(zx1 + rl, t0, aw0, aw1, aw2, ab, y);
                uint2 o; o.x = pk2(y[0] * acc[i][0], y[1] * acc[i][1]); o.y = pk2(y[2] * acc[i][2], y[3] * acc[i][3]);
                *(uint2*)(UT + r * UTS + t0) = o;
                if ((i & 3) == 3) __builtin_amdgcn_sched_barrier(0);
            }
        } else {
#pragma unroll
            for (int i = 0; i < TPW; ++i) {
                const int t0 = tb0 + i * 16;
                float y[4]; conv4(zx2 + rl, t0, bw0, bw1, bw2, bb, y);
                uint2 o; o.x = pk2(y[0] * acc[i][0], y[1] * acc[i][1]); o.y = pk2(y[2] * acc[i][2], y[3] * acc[i][3]);
                *(uint2*)(zv + rl + t0) = o;
                if ((i & 3) == 3) __builtin_amdgcn_sched_barrier(0);
            }
        }
    }
    __syncthreads();
}
__device__ __forceinline__ void hyena_phase(const Params& p, int e, unsigned char* smem) {
    PH_PRO
    const bf16_t* FT = (const bf16_t*)(WS_ + WS_FT) + (size_t)e * FT_E;
    for (int item = bid_; item < 1024; item += gdim_) {
        if (item < 512) hyena_item<2048>(p, e, item, 0, FT, smem);
        else hyena_item<256>(p, e, item - 512, MLAT, FT + FT_LAT, smem);
    }
}

__device__ __forceinline__ void rwkv_scan_phase(const Params& p, int e, unsigned char* smem) {
    PH_PRO
    const int chain = bid_; if (chain >= 256) return;
    const int xcd_ = chain & 7, jx_ = chain >> 3;
    const int b = 2 * xcd_ + (jx_ >> 4), d = (jx_ >> 3) & 1, h = jx_ & 7;
    const int tid = tid_, lane = tid & 63, wid = tid >> 6;
    bf16_t* WUPT = (bf16_t*)smem;
    bf16_t* AUPT = WUPT + 4096;
    float* sBONp = (float*)(AUPT + 4096);
    constexpr int SOPS = 336;
    float* sOP = (float*)smem + 8192;
    float* sR = sOP;
    float* sKK = sR + 4096;
    float* sW = sKK + 4096;
    float* sKD = sW + 4096;
    float* sKKA = sKD + 4096;
    float* sV = sOP + 64 * SOPS;
    float* sO = sV + 4096;
    bf16_t* TWb = (bf16_t*)sO;
    bf16_t* ADb = TWb + 4096;
    const bf16_t* ZR = (const bf16_t*)(WS_ + WS_BIG + BIG_ZR);
    bf16_t* ORW = (bf16_t*)(WS_ + WS_BIG + BIG_ORW) + (size_t)d * MTOT * 512;
    float* BON = (float*)(WS_ + WS_BON) + (size_t)d * MTOT * 8;
    const float* mu = IN(23) + e * 1920;
    const float* w0 = IN(24) + (e * 2 + d) * 512 + 64 * h;
    const float* a0 = IN(26) + (e * 2 + d) * 512 + 64 * h;
    const float* wup_g = IN(25) + (size_t)(e * 2 + d) * 64 * 512 + 64 * h;
    const float* aup_g = IN(27) + (size_t)(e * 2 + d) * 64 * 512 + 64 * h;
    const float kk_c = IN(29)[e * 512 + 64 * h + lane];
    const float mu_r = mu[64 * h + lane], mu_k = mu[512 + 64 * h + lane], mu_v = mu[1024 + 64 * h + lane], mu_w = mu[1536 + 64 * d + lane], mu_a = mu[1664 + 64 * d + lane];
    for (int idx = tid; idx < 4096; idx += NTHR) { const int j = idx >> 6, k = idx & 63; WUPT[k * 64 + j] = f2bf(wup_g[(size_t)j * 512 + k]); AUPT[k * 64 + j] = f2bf(aup_g[(size_t)j * 512 + k]); }
    const int r16 = lane & 15, g4 = lane >> 4, tr = wid & 3, tcb = 2 * (wid >> 2);
    float c_w0[2], c_a0[2], c_ka[2], c_rk[2];
#pragma unroll
    for (int jt = 0; jt < 2; ++jt) { const int kc = 16 * (tcb + jt) + r16; c_w0[jt] = w0[kc]; c_a0[jt] = a0[kc]; c_ka[jt] = IN(30)[e * 512 + 64 * h + kc]; c_rk[jt] = IN(31)[e * 512 + 64 * h + kc]; }
    typedef float f32x2 __attribute__((ext_vector_type(2)));
    f32x2 S2[4];
#pragma unroll
    for (int k = 0; k < 4; ++k) S2[k] = (f32x2){0.f, 0.f};
    __syncthreads();
    bf16_t pr_[10], pk_[10], pv_[10], pw_[10], pa_[10];
    auto issue = [&](int cidx) {
        const int seg = cidx >= 4; const int L = seg ? TL : TCX; const int rowbase = seg ? b * TL : MLAT + b * TCX; const int ch = seg ? cidx - 4 : cidx;
        const int tlo = d ? (L - 1 - (ch * 64 + 8 * wid + 7)) : (ch * 64 + 8 * wid);
#pragma unroll
        for (int q = 0; q < 10; ++q) {
            const int t = tlo - 1 + q; const int tc = t < 0 ? 0 : (t > L - 1 ? L - 1 : t);
            const bf16_t* zr = ZR + (size_t)(rowbase + tc) * 1920;
            pr_[q] = zr[64 * h + lane]; pk_[q] = zr[512 + 64 * h + lane]; pv_[q] = zr[1024 + 64 * h + lane]; pw_[q] = zr[1536 + 64 * d + lane]; pa_[q] = zr[1664 + 64 * d + lane];
        }
    };
    issue(0);
#pragma unroll 1
    for (int cidx = 0; cidx < 36; ++cidx) {
        {
            const int seg = cidx >= 4; const int L = seg ? TL : TCX; const int rowbase = seg ? b * TL : MLAT + b * TCX; const int ch = seg ? cidx - 4 : cidx;
            const int tlo = d ? (L - 1 - (ch * 64 + 8 * wid + 7)) : (ch * 64 + 8 * wid);
            {
                float zr_[10], zk_[10], zv_[10], zw_[10], za_[10];
#pragma unroll
                for (int q = 0; q < 10; ++q) {
                    const int t = tlo - 1 + q; const bool ok = (t >= 0) && (t < L);
                    const float a0 = bf2f(pr_[q]), a1 = bf2f(pk_[q]), a2 = bf2f(pv_[q]), a3 = bf2f(pw_[q]), a4 = bf2f(pa_[q]);
                    zr_[q] = ok ? a0 : 0.f; zk_[q] = ok ? a1 : 0.f; zv_[q] = ok ? a2 : 0.f; zw_[q] = ok ? a3 : 0.f; za_[q] = ok ? a4 : 0.f;
                }
#pragma unroll
                for (int sl = 0; sl < 8; ++sl) {
                    const int tau = 8 * wid + (d ? 7 - sl : sl);
#define ZS(arr, muv) (arr[sl + 1] + (muv) * (0.5f * (arr[sl] + arr[sl + 2]) - arr[sl + 1]))
                    const float rr = ZS(zr_, mu_r), kr = ZS(zk_, mu_k), vv = ZS(zv_, mu_v), wd = ZS(zw_, mu_w), ad = ZS(za_, mu_a);
#undef ZS
                    const float kkv = kr * kk_c; const float n2 = wsum(kkv * kkv);
                    const float kk = kkv * __builtin_amdgcn_rcpf(fmaxf(__builtin_amdgcn_sqrtf(n2), 1e-12f));
                    sOP[tau * SOPS + 0 + lane] = rr; sOP[tau * SOPS + 64 + lane] = kk; sV[tau * 64 + lane] = vv; sOP[tau * SOPS + 192 + lane] = kr;
                    TWb[tau * 64 + lane] = f2bf(tanh_(wd)); ADb[tau * 64 + lane] = f2bf(ad);
                }
            }
            __syncthreads();
            {
                const bf16x8 aw0 = *(const bf16x8*)(TWb + (16 * tr + r16) * 64 + 8 * g4), aw1 = *(const bf16x8*)(TWb + (16 * tr + r16) * 64 + 32 + 8 * g4);
                const bf16x8 aa0 = *(const bf16x8*)(ADb + (16 * tr + r16) * 64 + 8 * g4), aa1 = *(const bf16x8*)(ADb + (16 * tr + r16) * 64 + 32 + 8 * g4);
                float bonp[4] = {0.f, 0.f, 0.f, 0.f};
#pragma unroll
                for (int jt = 0; jt < 2; ++jt) {
                    const int kc = 16 * (tcb + jt) + r16;
                    const bf16x8 bw0 = *(const bf16x8*)(WUPT + kc * 64 + 8 * g4), bw1 = *(const bf16x8*)(WUPT + kc * 64 + 32 + 8 * g4);
                    const bf16x8 ba0 = *(const bf16x8*)(AUPT + kc * 64 + 8 * g4), ba1 = *(const bf16x8*)(AUPT + kc * 64 + 32 + 8 * g4);
                    f32x4 cw = (f32x4){0.f, 0.f, 0.f, 0.f}, ca = (f32x4){0.f, 0.f, 0.f, 0.f};
                    cw = __builtin_amdgcn_mfma_f32_16x16x32_bf16(aw0, bw0, cw, 0, 0, 0); cw = __builtin_amdgcn_mfma_f32_16x16x32_bf16(aw1, bw1, cw, 0, 0, 0);
                    ca = __builtin_amdgcn_mfma_f32_16x16x32_bf16(aa0, ba0, ca, 0, 0, 0); ca = __builtin_amdgcn_mfma_f32_16x16x32_bf16(aa1, ba1, ca, 0, 0, 0);
#pragma unroll
                    for (int q = 0; q < 4; ++q) {
                        const int tau = 16 * tr + 4 * g4 + q;
                        const float wlog = -softplus_(-(c_w0[jt] + cw[q])) - 0.5f;
                        const float dec = __expf(-__expf(wlog));
                        const float av = sigm(c_a0[jt] + ca[q]);
                        const float kd = sOP[tau * SOPS + 192 + kc] * (1.f + (av - 1.f) * c_ka[jt]);
                        bonp[q] += sOP[tau * SOPS + 0 + kc] * kd * c_rk[jt];
                        sOP[tau * SOPS + 128 + kc] = dec; sOP[tau * SOPS + 192 + kc] = kd; sOP[tau * SOPS + 256 + kc] = sOP[tau * SOPS + 64 + kc] * av;
                    }
                }
#pragma unroll
                for (int q = 0; q < 4; ++q) {
                    float v = bonp[q];
                    v += DPPF(v, 0xB1); v += DPPF(v, 0x4E); v += DPPF(v, 0x141); v += DPPF(v, 0x140);
                    if (r16 == 0) sBONp[(16 * tr + 4 * g4 + q) * 2 + (wid >> 2)] = v;
                }
            }
            __syncthreads();
            if (tid < 64) { const int pp = ch * 64 + tid; const int t = d ? (L - 1 - pp) : pp; BON[(size_t)(rowbase + t) * 8 + h] = sBONp[2 * tid] + sBONp[2 * tid + 1]; }
            if (cidx + 1 < 36) issue(cidx + 1);
            {
                const int vrow = 8 * wid + (lane >> 3), kq = lane & 7;
                const float* pb = sOP + 8 * kq;
                constexpr int O_R = 0, O_KK = 64, O_W = 128, O_KD = 192, O_KA = 256;
                struct Ops { float4 kk0, kk1, w0, w1, ka0, ka1, kd0, kd1, r0, r1; float vv; };
                auto ldops = [&](Ops& o, int tau) {
                    const float* q = pb + tau * SOPS;
                    o.kk0 = *(const float4*)(q + O_KK); o.kk1 = *(const float4*)(q + O_KK + 4); o.w0 = *(const float4*)(q + O_W); o.w1 = *(const float4*)(q + O_W + 4);
                    o.ka0 = *(const float4*)(q + O_KA); o.ka1 = *(const float4*)(q + O_KA + 4); o.kd0 = *(const float4*)(q + O_KD); o.kd1 = *(const float4*)(q + O_KD + 4);
                    o.r0 = *(const float4*)(q + O_R); o.r1 = *(const float4*)(q + O_R + 4); o.vv = sV[tau * 64 + vrow];
                };
                auto step = [&](const Ops& o, int tau) -> float {
                    const f32x2 kk[4] = {{o.kk0.x, o.kk0.y}, {o.kk0.z, o.kk0.w}, {o.kk1.x, o.kk1.y}, {o.kk1.z, o.kk1.w}};
                    const f32x2 w[4] = {{o.w0.x, o.w0.y}, {o.w0.z, o.w0.w}, {o.w1.x, o.w1.y}, {o.w1.z, o.w1.w}};
                    const f32x2 ka[4] = {{o.ka0.x, o.ka0.y}, {o.ka0.z, o.ka0.w}, {o.ka1.x, o.ka1.y}, {o.ka1.z, o.ka1.w}};
                    const f32x2 kd[4] = {{o.kd0.x, o.kd0.y}, {o.kd0.z, o.kd0.w}, {o.kd1.x, o.kd1.y}, {o.kd1.z, o.kd1.w}};
                    const f32x2 rr[4] = {{o.r0.x, o.r0.y}, {o.r0.z, o.r0.w}, {o.r1.x, o.r1.y}, {o.r1.z, o.r1.w}};
                    f32x2 da = S2[0] * kk[0] + S2[1] * kk[1]; f32x2 db = S2[2] * kk[2] + S2[3] * kk[3]; da = da + db;
                    float dt = da.x + da.y;
                    dt += DPPF(dt, 0xB1); dt += DPPF(dt, 0x4E); dt += DPPF(dt, 0x141);
                    const f32x2 sa2 = {-dt, -dt}; const f32x2 vv2 = {o.vv, o.vv};
#pragma unroll
                    for (int q = 0; q < 4; ++q) S2[q] = S2[q] * w[q] + (sa2 * ka[q] + vv2 * kd[q]);
                    f32x2 oa = S2[0] * rr[0] + S2[1] * rr[1]; f32x2 ob = S2[2] * rr[2] + S2[3] * rr[3]; oa = oa + ob;
                    return oa.x + oa.y;
                };
                Ops oa_, ob_;
                ldops(oa_, 0);
                const bool b1_ = (kq & 2) != 0, b0_ = (kq & 1) != 0;
#pragma unroll 1
                for (int t4 = 0; t4 < 64; t4 += 4) {
                    float po[4];
#pragma unroll
                    for (int u = 0; u < 4; u += 2) {
                        ldops(ob_, t4 + u + 1);
                        po[u] = step(oa_, t4 + u);
                        ldops(oa_, t4 + u + 2 < 64 ? t4 + u + 2 : 63);
                        po[u + 1] = step(ob_, t4 + u + 1);
                    }
                    float a2[2];
#pragma unroll
                    for (int j = 0; j < 2; ++j) { const float send = b1_ ? po[j] : po[j + 2], keep = b1_ ? po[j + 2] : po[j]; a2[j] = keep + DPPF(send, 0x4E); }
                    const float send = b0_ ? a2[0] : a2[1], keep = b0_ ? a2[1] : a2[0];
                    float r_ = keep + DPPF(send, 0xB1);
                    r_ += __builtin_bit_cast(float, __builtin_amdgcn_ds_swizzle(__builtin_bit_cast(int, r_), 0x101F));
                    sO[(t4 + (kq & 3)) * 64 + vrow] = r_;
                }
            }
            __syncthreads();
#pragma unroll
            for (int i = 0; i < 8; ++i) {
                const int tau = wid + 8 * i; const int pp = ch * 64 + tau; const int t = d ? (L - 1 - pp) : pp;
                ORW[(size_t)(rowbase + t) * 512 + 64 * h + lane] = f2bf(sO[tau * 64 + lane]);
            }
            __syncthreads();
        }
    }
}

__device__ __forceinline__ void even_readout_phase(const Params& p, int e, unsigned char* smem) {
    PH_PRO
    const int tid = tid_, lane = tid & 63, wid = __builtin_amdgcn_readfirstlane(tid >> 6);
    bf16_t* SGb = (bf16_t*)smem;
    float* GG = (float*)(SGb + 64 * 128);
    bf16_t* GUT = (bf16_t*)(GG + 64 * 64);
    bf16_t* TT = GUT + 64 * 128;
    const int r16 = lane & 15, g4 = lane >> 4, tr = wid & 3, tcb = 2 * (wid >> 2);
    const bf16_t* ZR = (const bf16_t*)(WS_ + WS_BIG + BIG_ZR);
    const bf16_t* ORW = (const bf16_t*)(WS_ + WS_BIG + BIG_ORW);
    const bf16_t* YT = (const bf16_t*)(WS_ + WS_BIG);
    const float* BON = (const float*)(WS_ + WS_BON);
    bf16_t* YM = (bf16_t*)(WS_ + WS_A);
    const float* mu = IN(23) + e * 1920;
    const int h = bid_ & 7;
    {
        const float* gup = IN(28) + (size_t)e * 128 * 512 + 64 * h;
        for (int idx = tid; idx < 128 * 64; idx += NTHR) { const int j = idx >> 6, k = idx & 63; GUT[k * 128 + j] = f2bf(gup[(size_t)j * 512 + k]); }
    }
    const float gng = IN(32)[e * 512 + 64 * h + lane], gnb = IN(33)[e * 512 + 64 * h + lane], muv = mu[1024 + 64 * h + lane];
    bf16_t rz_[18], rv_[10], rof_[8], rob_[8]; float rbf_[8], rbb_[8];
    auto issue = [&](int item) {
        const int tb = item >> 3, hh = item & 7; const int row0 = tb * 64;
        const int L = row0 < MLAT ? TL : TCX; const int t0 = row0 < MLAT ? (row0 & (TL - 1)) : ((row0 - MLAT) & (TCX - 1));
        const int j = tid & 127, tq = wid >> 1;
#pragma unroll
        for (int q = 0; q < 18; ++q) { const int t = t0 + 16 * tq - 1 + q; const int tc = t < 0 ? 0 : (t > L - 1 ? L - 1 : t); rz_[q] = ZR[(size_t)(row0 - t0 + tc) * 1920 + 1792 + j]; }
#pragma unroll
        for (int q = 0; q < 10; ++q) { const int t = t0 + 8 * wid - 1 + q; const int tc = t < 0 ? 0 : (t > L - 1 ? L - 1 : t); rv_[q] = ZR[(size_t)(row0 - t0 + tc) * 1920 + 1024 + 64 * hh + lane]; }
#pragma unroll
        for (int i = 0; i < 8; ++i) {
            const int row = row0 + 8 * wid + i;
            rof_[i] = ORW[(size_t)row * 512 + 64 * hh + lane]; rob_[i] = ORW[(size_t)(MTOT + row) * 512 + 64 * hh + lane];
            rbf_[i] = BON[(size_t)row * 8 + hh]; rbb_[i] = BON[(size_t)(MTOT + row) * 8 + hh];
        }
    };
    if (bid_ < 4608) issue(bid_);
    for (int item = bid_; item < 4608; item += gdim_) {
        const int tb = item >> 3; const int row0 = tb * 64;
        const int hh = item & 7;
        const int L = row0 < MLAT ? TL : TCX; const int t0 = row0 < MLAT ? (row0 & (TL - 1)) : ((row0 - MLAT) & (TCX - 1));
        __syncthreads();
        if (hh != h) {
            const float* gup = IN(28) + (size_t)e * 128 * 512 + 64 * hh;
            for (int idx = tid; idx < 128 * 64; idx += NTHR) { const int j = idx >> 6, k = idx & 63; GUT[k * 128 + j] = f2bf(gup[(size_t)j * 512 + k]); }
        }
        {
            const int j = tid & 127, tq = wid >> 1; const float muj = mu[1792 + j];
            float zz[18];
#pragma unroll
            for (int q = 0; q < 18; ++q) { const int t = t0 + 16 * tq - 1 + q; const bool ok = (t >= 0) && (t < L); zz[q] = ok ? bf2f(rz_[q]) : 0.f; }
#pragma unroll
            for (int i = 0; i < 16; ++i) SGb[(16 * tq + i) * 128 + j] = f2bf(sigm(zz[i + 1] + muj * (0.5f * (zz[i] + zz[i + 2]) - zz[i + 1])));
        }
        float ov[8], vv[8], bon[8];
        const float gngh = hh == h ? gng : IN(32)[e * 512 + 64 * hh + lane], gnbh = hh == h ? gnb : IN(33)[e * 512 + 64 * hh + lane], muvh = hh == h ? muv : mu[1024 + 64 * hh + lane];
        {
            float zv[10];
#pragma unroll
            for (int q = 0; q < 10; ++q) { const int t = t0 + 8 * wid - 1 + q; const bool ok = (t >= 0) && (t < L); zv[q] = ok ? bf2f(rv_[q]) : 0.f; }
#pragma unroll
            for (int i = 0; i < 8; ++i) {
                ov[i] = bf2f(rof_[i]) + bf2f(rob_[i]);
                vv[i] = zv[i + 1] + muvh * (0.5f * (zv[i] + zv[i + 2]) - zv[i + 1]);
                bon[i] = rbf_[i] + rbb_[i];
            }
        }
        __syncthreads();
        if (item + gdim_ < 4608) issue(item + gdim_);
        {
            f32x4 c0 = (f32x4){0.f, 0.f, 0.f, 0.f}, c1 = (f32x4){0.f, 0.f, 0.f, 0.f};
#pragma unroll
            for (int ks = 0; ks < 4; ++ks) {
                const bf16x8 af = *(const bf16x8*)(SGb + (16 * tr + r16) * 128 + 32 * ks + 8 * g4);
                const bf16x8 b0 = *(const bf16x8*)(GUT + (16 * tcb + r16) * 128 + 32 * ks + 8 * g4), b1 = *(const bf16x8*)(GUT + (16 * (tcb + 1) + r16) * 128 + 32 * ks + 8 * g4);
                c0 = __builtin_amdgcn_mfma_f32_16x16x32_bf16(af, b0, c0, 0, 0, 0); c1 = __builtin_amdgcn_mfma_f32_16x16x32_bf16(af, b1, c1, 0, 0, 0);
            }
#pragma unroll
            for (int q = 0; q < 4; ++q) { GG[(16 * tr + 4 * g4 + q) * 64 + 16 * tcb + r16] = c0[q]; GG[(16 * tr + 4 * g4 + q) * 64 + 16 * (tcb + 1) + r16] = c1[q]; }
        }
        __syncthreads();
        float gg[8];
#pragma unroll
        for (int i = 0; i < 8; ++i) gg[i] = GG[(8 * wid + i) * 64 + lane];
#pragma unroll
        for (int i = 0; i < 8; ++i) {
            const int row = row0 + 8 * wid + i;
            const float mean = wsum(ov[i]) * (1.f / 64.f); const float dd = ov[i] - mean; const float var = wsum(dd * dd) * (1.f / 64.f);
            const float y = dd * rsqrtf(var + 64e-5f) * gngh + gnbh;
            YM[(size_t)row * D + 512 + 64 * hh + lane] = f2bf((y + bon[i] * vv[i]) * gg[i]);
        }
    }
    __syncthreads();
    bf16_t tr_[8];
    auto issueT = [&](int it) {
        const int tb = it >> 3, cb = it & 7; const int row0 = tb * 64;
#pragma unroll
        for (int i = 0; i < 8; ++i) tr_[i] = YT[(size_t)(cb * 64 + wid + 8 * i) * MTOT + row0 + lane];
    };
    if (bid_ < 4608) issueT(bid_);
    for (int it = bid_; it < 4608; it += gdim_) {
        const int tb = it >> 3, cb = it & 7; const int row0 = tb * 64;
#pragma unroll
        for (int i = 0; i < 8; ++i) TT[(wid + 8 * i) * 72 + lane] = tr_[i];
        __syncthreads();
        if (it + gdim_ < 4608) issueT(it + gdim_);
#pragma unroll
        for (int i = 0; i < 8; ++i) { const int tau = wid + 8 * i; YM[(size_t)(row0 + tau) * D + cb * 64 + lane] = TT[lane * 72 + tau]; }
        __syncthreads();
    }
}
__device__ __forceinline__ void gla_phase(const Params& p, int o_idx, unsigned char* smem) {
    PH_PRO
    const int item = bid_; if (item >= 256) return;
    const int xcd_ = item & 7, jx_ = item >> 3;
    const int b = 2 * xcd_ + (jx_ >> 4), h = (jx_ >> 2) & 3, d = (jx_ >> 1) & 1, dvh = jx_ & 1;
    const int tid = tid_, lane = tid & 63, wid = __builtin_amdgcn_readfirstlane(tid >> 6), r = lane & 15, g = lane >> 4;
    constexpr int QST = 136, SST = 68;
    bf16_t* QS = (bf16_t*)smem;
    bf16_t* KS = QS + 64 * QST;
    bf16_t* ST = KS + 64 * QST;
    bf16_t* KST = ST + 128 * QST;
    bf16_t* VT = KST + 128 * SST;
    bf16_t* PP = VT + 128 * SST;
    float* GD = (float*)(PP + 64 * SST);
    float* DL = GD + 64 * 16;
    float* E1 = DL + 128;
    float* E2 = E1 + 128;
    float* TOT = E2 + 128;
    float* BR = TOT + 512;
    int* ROWS = (int*)(BR + 128);
    const bf16_t* Z = (const bf16_t*)(WS_ + WS_BIG);
    bf16_t* OG = d ? (bf16_t*)OUT_ : (bf16_t*)(WS_ + WS_BIG + BIG_OGL);
    const float qscale = 0.08838834764831845f;
    const int k = tid & 127, tq = wid >> 1, tr = wid >> 1, tcb = 4 * (wid & 1);
    auto rowof = [&](int c, int tau) -> int {
        const int seg = c >= 4; const int L = seg ? TL : TCX; const int pf = (seg ? c - 4 : c) * 64 + tau; const int pp = d ? (L - 1 - pf) : pf;
        return seg ? (b * TL + (pp & 31) * 64 + (pp >> 5)) : (MLAT + b * TCX + pp);
    };
    bf16_t nq[16], nk[16], nv[16], ngd[2];
    auto prefetch = [&](int c) {
        const long r0 = rowof(c, 16 * tq); const long st = (long)(c >= 4 ? 64 : 1) * (d ? -1 : 1) * 3104;
        const bf16_t* zb = Z + r0 * 3104 + 128 * h + k;
#pragma unroll
        for (int i = 0; i < 16; ++i) { const bf16_t* zr = zb + i * st; nq[i] = zr[0]; nk[i] = zr[512]; nv[i] = zr[1024 + 128 * h + 128 * dvh]; }
#pragma unroll
        for (int i = 0; i < 2; ++i) { const int idx = tid + NTHR * i; ngd[i] = Z[(size_t)rowof(c, idx >> 4) * 3104 + 2048 + 16 * d + (idx & 15)]; }
    };
    f32x4 Sacc[8];
#pragma unroll
    for (int j = 0; j < 8; ++j) Sacc[j] = (f32x4){0.f, 0.f, 0.f, 0.f};
    float gu[16];
    {
        const float* gup_g = IN(36) + (size_t)(o_idx * 2 + d) * 16 * 512 + 128 * h + k;
#pragma unroll
        for (int j = 0; j < 16; ++j) gu[j] = gup_g[(size_t)j * 512];
    }
    const float gbv = IN(37)[(o_idx * 2 + d) * 512 + 128 * h + k];
    prefetch(0);
#pragma unroll 1
    for (int c = 0; c < 36; ++c) {
        __syncthreads();
        if (tid < 64) ROWS[tid] = rowof(c, tid);
#pragma unroll
        for (int i = 0; i < 2; ++i) GD[tid + NTHR * i] = bf2f(ngd[i]);
#pragma unroll
        for (int i = 0; i < 16; ++i) VT[k * SST + 16 * tq + i] = nv[i];
        bf16_t cq[16], ck[16];
#pragma unroll
        for (int i = 0; i < 16; ++i) { cq[i] = nq[i]; ck[i] = nk[i]; }
        __syncthreads();
        if (c + 1 < 36) prefetch(c + 1);
        float bl[16]; float run = 0.f;
#pragma unroll
        for (int i = 0; i < 16; ++i) {
            const float4* gd4 = (const float4*)(GD + (16 * tq + i) * 16);
            const float4 g0 = gd4[0], g1 = gd4[1], g2 = gd4[2], g3 = gd4[3];
            float a = gbv + g0.x * gu[0] + g0.y * gu[1] + g0.z * gu[2] + g0.w * gu[3] + g1.x * gu[4] + g1.y * gu[5] + g1.z * gu[6] + g1.w * gu[7]
                    + g2.x * gu[8] + g2.y * gu[9] + g2.z * gu[10] + g2.w * gu[11] + g3.x * gu[12] + g3.y * gu[13] + g3.z * gu[14] + g3.w * gu[15];
            run -= __logf(1.f + __expf(-a)) * (1.f / 16.f);
            bl[i] = run;
        }
        TOT[tq * 128 + k] = run; if (tq == 2) BR[k] = bl[0];
        __syncthreads();
        {
            const float t0 = TOT[k], t1 = TOT[128 + k], t2 = TOT[256 + k], t3 = TOT[384 + k];
            const float off = tq == 0 ? 0.f : (tq == 1 ? t0 : (tq == 2 ? t0 + t1 : t0 + t1 + t2));
            const float bref = BR[k] + t0 + t1, blast = t0 + t1 + t2 + t3;
            if (tq == 0) { DL[k] = __expf(blast); E1[k] = __expf(bref); E2[k] = __expf(blast - bref); }
#pragma unroll
            for (int i = 0; i < 16; ++i) {
                const int tau = 16 * tq + i;
                const float bb = bl[i] + off; const float ef = __expf(bb - bref);
                const bf16_t ksv = f2bf(bf2f(ck[i]) * __builtin_amdgcn_rcpf(ef));
                QS[tau * QST + k] = f2bf(bf2f(cq[i]) * qscale * ef); KS[tau * QST + k] = ksv; KST[k * SST + tau] = ksv;
            }
        }
        __syncthreads();
        {
            float e1v[4];
#pragma unroll
            for (int q = 0; q < 4; ++q) e1v[q] = E1[16 * wid + 4 * g + q];
#pragma unroll
            for (int j = 0; j < 8; ++j) {
                uint2 o; o.x = pk2(Sacc[j][0] * e1v[0], Sacc[j][1] * e1v[1]); o.y = pk2(Sacc[j][2] * e1v[2], Sacc[j][3] * e1v[3]);
                *(uint2*)(ST + (16 * j + r) * QST + 16 * wid + 4 * g) = o;
            }
        }
        f32x4 sc[2];
#pragma unroll
        for (int j = 0; j < 2; ++j) sc[j] = (f32x4){0.f, 0.f, 0.f, 0.f};
#pragma unroll
        for (int ks = 0; ks < 4; ++ks) {
            const bf16x8 af = *(const bf16x8*)(QS + (16 * tr + r) * QST + 32 * ks + 8 * g);
#pragma unroll
            for (int j = 0; j < 2; ++j) {
                const bf16x8 bfr = *(const bf16x8*)(KS + (16 * (2 * (wid & 1) + j) + r) * QST + 32 * ks + 8 * g);
                sc[j] = __builtin_amdgcn_mfma_f32_16x16x32_bf16(af, bfr, sc[j], 0, 0, 0);
            }
        }
#pragma unroll
        for (int j = 0; j < 2; ++j) {
            const int sidx = 16 * (2 * (wid & 1) + j) + r;
#pragma unroll
            for (int q = 0; q < 4; ++q) { const int ci = 16 * tr + 4 * g + q; PP[ci * SST + sidx] = f2bf(sidx <= ci ? sc[j][q] : 0.f); }
        }
        __syncthreads();
        f32x4 oc[4];
#pragma unroll
        for (int j = 0; j < 4; ++j) oc[j] = (f32x4){0.f, 0.f, 0.f, 0.f};
#pragma unroll
        for (int ks = 0; ks < 2; ++ks) {
            const bf16x8 af = ld8(PP + (16 * tr + r) * SST + 32 * ks + 8 * g);
#pragma unroll
            for (int j = 0; j < 4; ++j) {
                const bf16x8 bfr = ld8(VT + (16 * (tcb + j) + r) * SST + 32 * ks + 8 * g);
                oc[j] = __builtin_amdgcn_mfma_f32_16x16x32_bf16(af, bfr, oc[j], 0, 0, 0);
            }
        }
#pragma unroll
        for (int ks = 0; ks < 4; ++ks) {
            const bf16x8 af = *(const bf16x8*)(QS + (16 * tr + r) * QST + 32 * ks + 8 * g);
#pragma unroll
            for (int j = 0; j < 4; ++j) {
                const bf16x8 bfr = *(const bf16x8*)(ST + (16 * (tcb + j) + r) * QST + 32 * ks + 8 * g);
                oc[j] = __builtin_amdgcn_mfma_f32_16x16x32_bf16(af, bfr, oc[j], 0, 0, 0);
            }
        }
#pragma unroll
        for (int j = 0; j < 4; ++j) {
            const int dv = 16 * (tcb + j) + r;
#pragma unroll
            for (int q = 0; q < 4; ++q) OG[(size_t)ROWS[16 * tr + 4 * g + q] * D + 256 * h + 128 * dvh + dv] = f2bf(oc[j][q]);
        }
        {
            f32x4 kv[8];
#pragma unroll
            for (int j = 0; j < 8; ++j) kv[j] = (f32x4){0.f, 0.f, 0.f, 0.f};
#pragma unroll
            for (int ks = 0; ks < 2; ++ks) {
                const bf16x8 af = ld8(KST + (16 * wid + r) * SST + 32 * ks + 8 * g);
#pragma unroll
                for (int j = 0; j < 8; ++j) {
                    const bf16x8 bfr = ld8(VT + (16 * j + r) * SST + 32 * ks + 8 * g);
                    kv[j] = __builtin_amdgcn_mfma_f32_16x16x32_bf16(af, bfr, kv[j], 0, 0, 0);
                }
            }
            float dl[4], e2[4];
#pragma unroll
            for (int q = 0; q < 4; ++q) { dl[q] = DL[16 * wid + 4 * g + q]; e2[q] = E2[16 * wid + 4 * g + q]; }
#pragma unroll
            for (int j = 0; j < 8; ++j)
#pragma unroll
                for (int q = 0; q < 4; ++q) Sacc[j][q] = Sacc[j][q] * dl[q] + e2[q] * kv[j][q];
        }
    }
    __syncthreads();
}

__device__ __forceinline__ void odd_readout_phase(const Params& p, int o_idx) {
    PH_PRO
    const int lane = tid_ & 63, wid = tid_ >> 6;
    const bf16_t* Z = (const bf16_t*)(WS_ + WS_BIG);
    const bf16_t* OGL = (const bf16_t*)(WS_ + WS_BIG + BIG_OGL);
    const bf16_t* OGB = (const bf16_t*)OUT_;
    bf16_t* YM = (bf16_t*)(WS_ + WS_A);
    const float4 ng = *(const float4*)(IN(38) + o_idx * 256 + 4 * lane);
    uint2 novs[4], nows[4], ngvs[4];
    auto issueR = [&](int row) {
#pragma unroll
        for (int hh = 0; hh < 4; ++hh) {
            novs[hh] = *(const uint2*)(OGL + (size_t)row * D + 256 * hh + 4 * lane);
            nows[hh] = *(const uint2*)(OGB + (size_t)row * D + 256 * hh + 4 * lane);
            ngvs[hh] = *(const uint2*)(Z + (size_t)row * 3104 + 2080 + 256 * hh + 4 * lane);
        }
    };
    if (bid_ * 8 + wid < MTOT) issueR(bid_ * 8 + wid);
    for (int row = bid_ * 8 + wid; row < MTOT; row += gdim_ * 8) {
        uint2 ovs[4], ows[4], gvs[4];
#pragma unroll
        for (int hh = 0; hh < 4; ++hh) { ovs[hh] = novs[hh]; ows[hh] = nows[hh]; gvs[hh] = ngvs[hh]; }
        if (row + gdim_ * 8 < MTOT) issueR(row + gdim_ * 8);
#pragma unroll
        for (int hh = 0; hh < 4; ++hh) {
            const uint2 ov = ovs[hh], ow = ows[hh], gv = gvs[hh];
            const float o0 = __uint_as_float(ov.x << 16) + __uint_as_float(ow.x << 16), o1 = __uint_as_float(ov.x & 0xffff0000u) + __uint_as_float(ow.x & 0xffff0000u), o2 = __uint_as_float(ov.y << 16) + __uint_as_float(ow.y << 16), o3 = __uint_as_float(ov.y & 0xffff0000u) + __uint_as_float(ow.y & 0xffff0000u);
            const float g0 = __uint_as_float(gv.x << 16), g1 = __uint_as_float(gv.x & 0xffff0000u), g2 = __uint_as_float(gv.y << 16), g3 = __uint_as_float(gv.y & 0xffff0000u);
            const float ms = wsum(o0 * o0 + o1 * o1 + o2 * o2 + o3 * o3) * (1.f / 256.f);
            const float rs = rsqrtf(ms + 1e-5f);
            uint2 y; y.x = pk2(o0 * rs * ng.x * silu_(g0), o1 * rs * ng.y * silu_(g1)); y.y = pk2(o2 * rs * ng.z * silu_(g2), o3 * rs * ng.w * silu_(g3));
            *(uint2*)(YM + (size_t)row * D + 256 * hh + 4 * lane) = y;
        }
    }
}

#ifndef REP_UP
#define REP_UP 1
#endif
#ifndef REP_SCAN
#define REP_SCAN 1
#endif
#ifndef REP_GLA
#define REP_GLA 1
#endif
#ifndef REP_HY
#define REP_HY 1
#endif
#define REPEAT(n) for (int rep_ = 0, nrep_ = ({ int t_ = (n); asm volatile("" : "+s"(t_)); t_; }); rep_ < nrep_; ++rep_)
#ifndef REP_LN
#define REP_LN 1
#endif
#ifndef REP_MISC
#define REP_MISC 1
#endif
#ifndef REP_SYNC
#define REP_SYNC 1
#endif
#define GSYNC() do { for (int s_ = 0; s_ < REP_SYNC; ++s_) { XcdBarrier xb_; xb_.bar = (unsigned*)IN(40); xb_.x = xb_xcc_id(); xb_.st = (volatile XB_LAS unsigned*)(smem_g + TBL_OFF + 448); xcd_barrier(xb_); } } while (0)
#define LAUNDER() do { bid_ = blockIdx.x; asm volatile("" : "+s"(bid_)); gdim_ = gridDim.x; asm volatile("" : "+s"(gdim_)); } while (0)
__global__ void __launch_bounds__(NTHR, 2) mega(Params p) {
    unsigned char* smem = smem_g;
    cg::grid_group grid = cg::this_grid();
    int bid_, gdim_; LAUNDER();
    if (threadIdx.x == 0) {
        const float** tb = (const float**)(smem_g + TBL_OFF);
#pragma unroll
        for (int i = 0; i < 41; ++i) tb[i] = p.in[i];
        *(uint4*)(smem_g + TBL_OFF + 448) = make_uint4(0u, 0u, 0u, 0u);
    }
    unsigned* bar_ = (unsigned*)p.in[40];
    if (blockIdx.x == 0) for (int i = threadIdx.x; i < XCD_BAR_WORDS; i += NTHR) bar_[i] = 0u;
    __syncthreads();
    grid.sync();
    (void)xcd_barrier_post(bar_, (volatile XB_LAS unsigned*)(smem_g + TBL_OFF + 448));
    REPEAT(REP_MISC) {
    phase_mod(p, smem);
    __syncthreads();
    conv_weights(p, 0, smem);
    filt_gen(p, smem);
    GSYNC();
    }
    row_phase(p, 0, 0, 0, 0, 0, false);
    GSYNC();
#pragma unroll 1
    for (int l = 0; l < 4; ++l) {
#pragma unroll 1
        for (int f = 0; f < 2; ++f) {
            if (f == 1) {
                if (!(l & 1)) {
                    const int e = l >> 1;
                    REPEAT(REP_HY) {
                    LAUNDER();
                    { EpiStore E; E.O = (bf16_t*)(WS_ + WS_BIG); E.ldc = MTOT; E.nvalid = MTOT; run_gemm(smem, (const bf16_t*)(WS_ + WS_WIN), (const bf16_t*)(WS_ + WS_A), 1536, MTOT, 1024, E, bid_, gdim_); }
                    LAUNDER();
                    { EpiStore E; E.O = (bf16_t*)(WS_ + WS_BIG + BIG_ZR); E.ldc = 1920; E.nvalid = 1920; run_gemm(smem, (const bf16_t*)(WS_ + WS_A), (const bf16_t*)(WS_ + WS_WIN) + (size_t)1536 * 1024, MTOT, 2048, 1024, E, gdim_ - 1 - bid_, gdim_); }
                    GSYNC();
                    hyena_phase(p, e, smem);
                    if (rep_ + 1 < nrep_) GSYNC();
                    }
                    REPEAT(REP_SCAN) rwkv_scan_phase(p, e, smem);
                    GSYNC();
                    REPEAT(REP_MISC) even_readout_phase(p, e, smem);
                    GSYNC();
                } else {
                    const int o = l >> 1;
                    LAUNDER();
                    { EpiStore E; E.O = (bf16_t*)(WS_ + WS_BIG); E.ldc = 3104; E.nvalid = 3104; run_gemm(smem, (const bf16_t*)(WS_ + WS_A), (const bf16_t*)(WS_ + WS_WIN), MTOT, 3328, 1024, E, bid_, gdim_); }
                    GSYNC();
                    REPEAT(REP_GLA) gla_phase(p, o, smem);
                    GSYNC();
                    REPEAT(REP_MISC) odd_readout_phase(p, o);
                    GSYNC();
                }
                LAUNDER();
                { EpiResid E; E.gate_off = l * 17 * 9216 + 5 * 1024; E.wgt = 1.0f; E.ln_idx = l * 3 + 0; E.pm_off = 0; run_gemm(smem, (const bf16_t*)(WS_ + WS_A), (const bf16_t*)(WS_ + WS_WOUT), l == 3 ? MLAT : MTOT, 1024, 1024, E, bid_, gdim_); }
                GSYNC();
                REPEAT(REP_LN) row_phase(p, 1, l, 1, l, 6, false, l == 3 ? MLAT : MTOT);
                GSYNC();
            }
            const bool latonly = (l == 3 && f == 1);
#pragma unroll 1
            for (int s = 0; s < 4; ++s) {
                if (s == 3 && latonly) break;
                LAUNDER();
                if ((s == 1) || (s == 2 && !latonly && bid_ < 64)) {
                    const int part = s - 1;
                    EpiResid E; E.gate_off = l * 17 * 9216 + (f ? 8 : 2) * 1024; E.wgt = 0.5f; E.ln_idx = f ? (l * 3 + 1) : (l * 3 - 1); E.pm_off = part ? 128 : 0;
                    run_gemm(smem, (const bf16_t*)(WS_ + WS_BIG) + (size_t)part * MLAT * FF, (const bf16_t*)(WS_ + WS_WDN) + (size_t)f * 1024 * FF, part ? MCTX : MLAT, 1024, FF, E, bid_, part ? 64 : gdim_);
                }
                if (s == 0 || (s == 1 && !latonly)) {
                    LAUNDER();
                    EpiSwiglu E; E.G = (bf16_t*)(WS_ + WS_BIG); E.pm_off = s ? 128 : 0;
                    run_gemm(smem, (const bf16_t*)(WS_ + WS_A) + (size_t)s * MLAT * 1024, (const bf16_t*)(WS_ + WS_WUP) + (size_t)f * 5632 * 1024, s ? MCTX : MLAT, 5632, 1024, E, bid_, gdim_);
                }
                if (s == 2) {
                    if (latonly) row_phase(p, 1, l, 2, 0, 0, true);
                    else if (bid_ >= 64) { if (f == 0) row_phase(p, 1, l, 0, l, 3, false, MLAT, 0, 64, gdim_ - 64); else row_phase(p, 1, l, 2, l + 1, 0, false, MLAT, 0, 64, gdim_ - 64); }
                }
                if (s == 3) {
                    if (f == 0) row_phase(p, 1, l, 0, l, 3, false, MTOT, MLAT);
                    else { if (l < 3) { row_phase(p, 1, l, 2, l + 1, 0, false, MTOT, MLAT); conv_weights(p, l + 1, smem); } else row_phase(p, 1, l, 2, 0, 0, false, MTOT, MLAT); }
                }
                GSYNC();
            }
        }
    }
}

extern "C" void kernel_launch(void* const* d_in, const int* in_sizes, int n_in, void* d_out, int out_size, void* d_ws, size_t ws_size, hipStream_t stream) {
    static int grid = 0;
    if (grid == 0) {
        if (n_in != 39 || ws_size < WS_END) { fprintf(stderr, "kernel_launch: need 39 inputs and %zu bytes of workspace; got %d, %zu\n", (size_t)WS_END, n_in, ws_size); grid = -1; return; }
        int dev = 0, cus = 0, per_cu = 0;
        (void)hipGetDevice(&dev);
        (void)hipDeviceGetAttribute(&cus, hipDeviceAttributeMultiprocessorCount, dev);
        if (hipFuncSetAttribute((const void*)mega, hipFuncAttributeMaxDynamicSharedMemorySize, LDS_BYTES) != hipSuccess) { fprintf(stderr, "kernel_launch: hipFuncSetAttribute failed\n"); grid = -1; return; }
        (void)hipOccupancyMaxActiveBlocksPerMultiprocessor(&per_cu, (const void*)mega, NTHR, LDS_BYTES);
        if (per_cu < 1) fprintf(stderr, "kernel_launch: occupancy query says %d blocks/CU\n", per_cu);
        (void)hipGetLastError();
        grid = cus;
        if (grid > 256) grid = 256;
    }
    if (grid < 0) return;
    Params p{};
    for (int i = 0; i < 39; ++i) p.in[i] = (const float*)d_in[i];
    p.in[39] = (const float*)d_out; p.in[40] = (const float*)d_ws;
    void* args[] = {&p};
    hipError_t e = hipLaunchCooperativeKernel((const void*)mega, dim3(grid), dim3(NTHR), args, LDS_BYTES, stream);
    if (e != hipSuccess) fprintf(stderr, "cooperative launch failed: %s (grid %d)\n", hipGetErrorString(e), grid);
}
```

```cpp
#include <hip/hip_runtime.h>
#include <hip/hip_cooperative_groups.h>
#include <cstdio>
namespace pg8 {
#define PG8_LAS __attribute__((address_space(3)))
typedef unsigned short bf16_t;
typedef short bf16x8 __attribute__((ext_vector_type(8)));
typedef float f32x4 __attribute__((ext_vector_type(4)));
typedef unsigned u32x4 __attribute__((ext_vector_type(4)));
constexpr int BM = 256, BK = 64, HALF = 128, HTB = HALF * BK * 2  , STAGE_BYTES = 8 * HTB, NXCD = 8, WGM = 4;

__host__ __device__ __forceinline__ int lds_byte(int r, int c) { const int st = (r >> 4) * 2 + (c >> 5), rr = r & 15, cc = c & 31, ob = rr * 64 + cc * 2; return st * 1024 + (ob ^ (((ob >> 9) & 1) << 5)); }
__host__ __device__ __forceinline__ void stage_rc(int b, int& R, int& C) { const int st = b / 1024, sb = b % 1024, swz = sb ^ (((sb >> 9) & 1) << 5); R = (st >> 1) * 16 + swz / 64; C = (st & 1) * 32 + (swz % 64) / 2; }
__host__ __device__ __forceinline__ int perm32(int rho) { const int n = rho >> 4, i = rho & 15; return 8 * (i >> 2) + 4 * n + (i & 3); }

struct Unit { int pm, pn; };
struct Gemm { const bf16_t* A; const bf16_t* Bt; int M, N, K; };

struct StaticOrder {
    int nM, nN, nwg, G, c;
    __host__ __device__ void init(int M, int N, int G_, int c_) { nM = M / BM; nN = N / BM; nwg = nM * nN; G = G_; c = c_; }
    __host__ __device__ bool next(int i, Unit& u) const {
        const long L = (long)i * G + c; if (L >= nwg) return false;
        int wgid = (int)L; { const int q = nwg / NXCD, r = nwg % NXCD, xcd = wgid % NXCD, off = wgid / NXCD; wgid = (xcd < r ? xcd * (q + 1) : r * (q + 1) + (xcd - r) * q) + off; }
        const int nig = WGM * nN, gid = wgid / nig, fm = gid * WGM, gsz = (nM - fm) < WGM ? (nM - fm) : WGM;
        u.pm = fm + ((wgid % nig) % gsz); u.pn = (wgid % nig) / gsz; return true;
    }
    __device__ __forceinline__ void a_ready(const Unit&) const {}
    __device__ __forceinline__ void done(const Unit&) const {}
};
__device__ __forceinline__ unsigned cvt_pk_bf16(float lo, float hi) { unsigned r; asm volatile("v_cvt_pk_bf16_f32 %0, %1, %2" : "=v"(r) : "v"(lo), "v"(hi)); return r; }
typedef float f32x2 __attribute__((ext_vector_type(2)));

template <class Epi, class Sched, bool STAMP = false>
__device__ __forceinline__ void gemm_phase(PG8_LAS unsigned char* lds, const Gemm g, const Sched& S, const Epi& E, unsigned long long* stamps) {
    int tid_l_ = threadIdx.x; asm volatile("" : "+v"(tid_l_)); const int tid = tid_l_, wid = __builtin_amdgcn_readfirstlane(tid >> 6), lane = tid & 63, wr = wid >> 2, wc = wid & 3, fr = lane & 15, fq = lane >> 4;
    const int K = g.K, nt = K / BK;
    int ts_lo = 0, ts_hi = 0, nts = 0; const unsigned long long rt_entry = STAMP ? (unsigned long long)wall_clock64() : 0ull;
#define PG8_STAMP() do { if (STAMP && wid == 0 && nts < 64) { const unsigned long long _c = (unsigned long long)clock64(); \
        ts_lo = (lane == nts) ? (int)(unsigned)_c : ts_lo; ts_hi = (lane == nts) ? (int)(unsigned)(_c >> 32) : ts_hi; ++nts; } } while (0)
    PG8_STAMP();
    unsigned voffA[2], voffB[2];
#pragma unroll
    for (int i = 0; i < 2; ++i) { int R, C; stage_rc(tid * 16 + i * 8192, R, C); const int Rb = Epi::PERM ? ((R & ~31) + perm32(R & 31)) : R;
        voffA[i] = (unsigned)(R * K + C) * 2u; voffB[i] = (unsigned)(Rb * K + C) * 2u; }
    const size_t kstep = (size_t)(BK * 2);
    const size_t hstep = (size_t)HALF * K * 2;
    const size_t tstep = 2 * hstep;
    const unsigned ldsw = (unsigned)wid * 1024u;
    const int aoff = lds_byte(wr * 64 + fr, fq * 8), boff = lds_byte(wc * 32 + fr, fq * 8);
#define PG8_SA(b, h) (((b) * 2 + (h)) * HTB)
#define PG8_SB(b, h) ((4 + (b) * 2 + (h)) * HTB)
#define PG8_STAGE(bufoff, gbase, voff) do { _Pragma("unroll") for (int _i = 0; _i < 2; ++_i) \
        __builtin_amdgcn_global_load_lds((const unsigned*)((const char*)(gbase) + (voff)[_i]), (PG8_LAS unsigned*)(lds + (bufoff) + ldsw + _i * 8192), 16, 0, 0); } while (0)
#define PG8_LDA(dst, b, h) do { _Pragma("unroll") for (int m = 0; m < 4; ++m) _Pragma("unroll") for (int k = 0; k < 2; ++k) dst[m][k] = *(const PG8_LAS bf16x8*)(lds + PG8_SA(b, h) + aoff + m * 2048 + k * 1024); } while (0)
#define PG8_LDB(dst, b, h) do { _Pragma("unroll") for (int n = 0; n < 2; ++n) _Pragma("unroll") for (int k = 0; k < 2; ++k) dst[n][k] = *(const PG8_LAS bf16x8*)(lds + PG8_SB(b, h) + boff + n * 2048 + k * 1024); } while (0)
#define PG8_MMA(ai, bj, At, Bt) do { __builtin_amdgcn_s_setprio(1); _Pragma("unroll") for (int m = 0; m < 4; ++m) _Pragma("unroll") for (int n = 0; n < 2; ++n) _Pragma("unroll") for (int k = 0; k < 2; ++k) \
        acc[ai][bj][m][n] = __builtin_amdgcn_mfma_f32_16x16x32_bf16(Bt[n][k], At[m][k], acc[ai][bj][m][n], 0, 0, 0); __builtin_amdgcn_s_setprio(0); } while (0)
#define PG8_WAIT_V(n) asm volatile("s_waitcnt vmcnt(" #n ")" ::: "memory")
#define PG8_WAIT_L(n) asm volatile("s_waitcnt lgkmcnt(" #n ")" ::: "memory")
#define PG8_BAR __builtin_amdgcn_s_barrier()
#define PG8_SCHED __builtin_amdgcn_sched_barrier(0)
    Unit cur, nxt; int ui = 0;
    if (!S.next(0, cur)) return;
    f32x4 acc[2][2][4][2];
#pragma unroll
    for (int a = 0; a < 2; ++a)
#pragma unroll
        for (int b = 0; b < 2; ++b)
#pragma unroll
            for (int m = 0; m < 4; ++m)
#pragma unroll
                for (int n = 0; n < 2; ++n) acc[a][b][m][n] = (f32x4){0.f, 0.f, 0.f, 0.f};
    bf16x8 At[4][2], B0[2][2], B1[2][2];
    const char* cA = (const char*)g.A + (size_t)cur.pm * tstep; const char* cB = (const char*)g.Bt + (size_t)cur.pn * tstep;
    S.a_ready(cur);
    PG8_STAGE(PG8_SB(0, 0), cB, voffB); PG8_STAGE(PG8_SA(0, 0), cA, voffA); PG8_STAGE(PG8_SB(0, 1), cB + hstep, voffB); PG8_STAGE(PG8_SA(0, 1), cA + hstep, voffA);
    if (wr == 1) PG8_BAR;
    PG8_WAIT_V(4); PG8_BAR;
    PG8_STAGE(PG8_SB(1, 0), cB + kstep, voffB); PG8_STAGE(PG8_SA(1, 0), cA + kstep, voffA); PG8_STAGE(PG8_SB(1, 1), cB + hstep + kstep, voffB);
    PG8_WAIT_V(6); PG8_BAR;
    PG8_STAMP();
    for (;;) {
        const bool has_next = S.next(ui + 1, nxt);
        const char* nA = has_next ? (const char*)g.A + (size_t)nxt.pm * tstep : cA; const char* nB = has_next ? (const char*)g.Bt + (size_t)nxt.pn * tstep : cB;
        for (int t = 0; t < nt; t += 2) {
            const bool last = (t == nt - 2);
            const char* a1 = cA + (size_t)(t + 1) * kstep;
            const char* a2 = last ? nA : cA + (size_t)(t + 2) * kstep; const char* b2 = last ? nB : cB + (size_t)(t + 2) * kstep;
            const char* a3 = a2 + kstep; const char* b3 = b2 + kstep;
            if (last && has_next) S.a_ready(nxt);
            PG8_LDB(B0, 0, 0); PG8_SCHED; PG8_LDA(At, 0, 0); PG8_STAGE(PG8_SA(1, 1), a1 + hstep, voffA);
            PG8_WAIT_L(8); PG8_BAR; PG8_WAIT_L(0); PG8_MMA(0, 0, At, B0); PG8_BAR; PG8_SCHED;
            PG8_LDB(B1, 0, 1); PG8_STAGE(PG8_SB(0, 0), b2, voffB);
            PG8_BAR; PG8_WAIT_L(0); PG8_MMA(0, 1, At, B1); PG8_BAR;
            PG8_LDA(At, 0, 1); PG8_STAGE(PG8_SA(0, 0), a2, voffA);
            PG8_BAR; PG8_WAIT_L(0); PG8_MMA(1, 0, At, B0); PG8_BAR; PG8_SCHED;
            PG8_STAGE(PG8_SB(0, 1), b2 + hstep, voffB);
            PG8_WAIT_V(6); PG8_BAR; PG8_MMA(1, 1, At, B1); PG8_BAR;
            PG8_LDB(B0, 1, 0); PG8_SCHED; PG8_LDA(At, 1, 0); PG8_STAGE(PG8_SA(0, 1), a2 + hstep, voffA);
            PG8_WAIT_L(8); PG8_BAR; PG8_WAIT_L(0); PG8_MMA(0, 0, At, B0); PG8_BAR; PG8_SCHED;
            PG8_LDB(B1, 1, 1); PG8_STAGE(PG8_SB(1, 0), b3, voffB);
            PG8_BAR; PG8_WAIT_L(0); PG8_MMA(0, 1, At, B1); PG8_BAR;
            PG8_LDA(At, 1, 1); PG8_STAGE(PG8_SA(1, 0), a3, voffA);
            PG8_BAR; PG8_WAIT_L(0); PG8_MMA(1, 0, At, B0); PG8_BAR; PG8_SCHED;
            PG8_STAGE(PG8_SB(1, 1), b3 + hstep, voffB);
            PG8_WAIT_V(6); PG8_BAR; PG8_MMA(1, 1, At, B1); PG8_BAR;
        }
        PG8_STAMP();
        if constexpr (!Epi::AFTER_DRAIN) { E(acc, cur, wr, wc, fr, fq); S.done(cur); }
        PG8_STAMP();
        if (!has_next) break;
#pragma unroll
        for (int a = 0; a < 2; ++a)
#pragma unroll
            for (int b = 0; b < 2; ++b)
#pragma unroll
                for (int m = 0; m < 4; ++m)
#pragma unroll
                    for (int n = 0; n < 2; ++n) acc[a][b][m][n] = (f32x4){0.f, 0.f, 0.f, 0.f};
        cur = nxt; cA = nA; cB = nB; ++ui;
    }
    PG8_WAIT_V(0);
    if (wr == 0) PG8_BAR;
    PG8_BAR;
    if constexpr (Epi::AFTER_DRAIN) { E.fused(acc, cur, wr, wc, fr, fq, lds, wid, lane); S.done(cur); }
    PG8_STAMP();
    if (STAMP && wid == 0) { stamps[lane] = lane < nts ? (((unsigned long long)(unsigned)ts_hi << 32) | (unsigned)ts_lo) : 0ull;
        if (lane == 62) stamps[62] = rt_entry; if (lane == 63) stamps[63] = (unsigned long long)wall_clock64(); }
#undef PG8_STAMP
#undef PG8_SA
#undef PG8_SB
#undef PG8_STAGE
#undef PG8_LDA
#undef PG8_LDB
#undef PG8_MMA
#undef PG8_WAIT_V
#undef PG8_WAIT_L
#undef PG8_BAR
#undef PG8_SCHED
}
}
#define XB_TMO      128
#define XB_XCNT(j)  (256  + 64 * (j))
#define XB_XSUB(j)  (1280 + 64 * (j))
#define XB_XGEN(j)  (2304 + 64 * (j))
#define XB_TOP      3328
#define XB_TOPGEN   3392
#define XCD_BAR_WORDS 3456
#define XB_SPIN_CAP (1u << 18)
#define XB_LAS __attribute__((address_space(3)))

__device__ __forceinline__ unsigned xb_ld(unsigned* p)              { return __hip_atomic_load(p, __ATOMIC_RELAXED, __HIP_MEMORY_SCOPE_AGENT); }
__device__ __forceinline__ unsigned xb_add(unsigned* p, unsigned v) { return __hip_atomic_fetch_add(p, v, __ATOMIC_RELAXED, __HIP_MEMORY_SCOPE_AGENT); }
__device__ __forceinline__ unsigned xb_xcc_id() { return (unsigned)__builtin_amdgcn_s_getreg((3 << 11) | 20) & 0xFu; }
#define XB_SPIN(cond, bar) do { unsigned _sp = 0; while (cond) { __builtin_amdgcn_s_sleep(1); \
    if ((++_sp & 255u) == 0u) { if (xb_ld(&(bar)[XB_TMO])) break; if (_sp > XB_SPIN_CAP) { atomicAdd(&(bar)[XB_TMO], 1u); break; } } } } while (0)

struct XcdBarrier {
    unsigned* bar; unsigned x;
    volatile XB_LAS unsigned* st;
};

__device__ __forceinline__ XcdBarrier xcd_barrier_post(unsigned* bar, volatile XB_LAS unsigned* st) {
    XcdBarrier b; b.bar = bar; b.x = xb_xcc_id(); b.st = st;
    if (threadIdx.x == 0) (void)xb_add(&bar[XB_XCNT(b.x)], 1u);
    return b;
}
__device__ __forceinline__ void xcd_barrier_complete(unsigned* bar, unsigned x, unsigned& nloc, unsigned& nx) {
    const unsigned G = gridDim.x * gridDim.y * gridDim.z;
    unsigned sum, cnt, mine, sp = 0u;
    for (;;) {
        sum = 0u; cnt = 0u; mine = 0u;
#pragma unroll
        for (unsigned j = 0; j < 16; ++j) { const unsigned c = xb_ld(&bar[XB_XCNT(j)]); sum += c; cnt += (c > 0u) ? 1u : 0u; mine = (j == x) ? c : mine; }
        if (sum == G) break;
        __builtin_amdgcn_s_sleep(1);
        if ((++sp & 255u) == 0u) { if (xb_ld(&bar[XB_TMO])) break; if (sp > XB_SPIN_CAP) { atomicAdd(&bar[XB_TMO], 1u); break; } }
    }
    nloc = mine > 0u ? mine : 1u; nx = cnt > 0u ? cnt : 1u;
}

__device__ __forceinline__ void xcd_barrier(const XcdBarrier& b) {
    asm volatile("s_waitcnt vmcnt(0)" ::: "memory");
    __syncthreads();
    if (threadIdx.x == 0) {
        unsigned* bar = b.bar;
        __builtin_amdgcn_s_waitcnt(0);
        unsigned nloc = b.st[0], nx = b.st[1];
        if (nloc == 0u) { xcd_barrier_complete(bar, b.x, nloc, nx); b.st[0] = nloc; b.st[1] = nx; }
        const unsigned old = xb_add(&bar[XB_XSUB(b.x)], 1u);
        const unsigned gen = old / nloc;
        if (old + 1u == (gen + 1u) * nloc) {
            __builtin_amdgcn_fence(__ATOMIC_RELEASE, "agent");
            asm volatile("s_waitcnt vmcnt(0)" ::: "memory");
            const unsigned og = xb_add(&bar[XB_TOP], 1u);
            const unsigned tg = og / nx;
            if (og + 1u == (tg + 1u) * nx) xb_add(&bar[XB_TOPGEN], 1u);
            else XB_SPIN(xb_ld(&bar[XB_TOPGEN]) == tg, bar);
            __builtin_amdgcn_fence(__ATOMIC_ACQUIRE, "agent");
            xb_add(&bar[XB_XGEN(b.x)], 1u);
            asm volatile("s_waitcnt vmcnt(0)" ::: "memory");
        } else {
            XB_SPIN(xb_ld(&bar[XB_XGEN(b.x)]) == gen, bar);
            __builtin_amdgcn_fence(__ATOMIC_ACQUIRE, "agent");
            asm volatile("s_waitcnt vmcnt(0)" ::: "memory");
        }
    }
    __syncthreads();
}

namespace cg = cooperative_groups;
typedef unsigned short bf16_t;
using pg8::bf16x8; using pg8::f32x4;
#define LAS __attribute__((address_space(3)))

constexpr int D = 1024, NB = 16, TL = 2048, TCX = 256, FF = 2816;
constexpr int MLAT = NB * TL, MCTX = NB * TCX, MTOT = MLAT + MCTX;
constexpr float DN_ALPHA = 1.681792830507429f;
constexpr int NTHR = 512;
constexpr int LDS_BYTES = 155648;

constexpr size_t al256(size_t x) { return (x + 255) & ~(size_t)255; }
constexpr size_t WS_MOD = 16384;
constexpr size_t WS_FT = al256(WS_MOD + (size_t)4 * 17 * 9216 * 4);
constexpr size_t FT_LAT = (size_t)2 * 512 * 4096, FT_CTX = (size_t)2 * 512 * 512, FT_E = FT_LAT + FT_CTX;
constexpr size_t WS_WUP = al256(WS_FT + 2 * FT_E * 2);
constexpr size_t WS_WDN = WS_WUP + (size_t)2 * 5632 * 1024 * 2;
constexpr size_t WS_WIN = WS_WDN + (size_t)2 * 1024 * 2816 * 2;
constexpr size_t WS_WOUT = WS_WIN + (size_t)3584 * 1024 * 2;
constexpr size_t WS_H = WS_WOUT + (size_t)1024 * 1024 * 2;
constexpr size_t WS_A = WS_H + (size_t)MTOT * 1024 * 4;
constexpr size_t WS_BON = WS_A + (size_t)MTOT * 1024 * 2;
constexpr size_t WS_STATS = al256(WS_BON + (size_t)2 * MTOT * 8 * 4);
constexpr size_t WS_BIG = al256(WS_STATS + (size_t)MTOT * 2 * 4);
constexpr size_t BIG_ZR = (size_t)1536 * MTOT * 2;
constexpr size_t BIG_ORW = BIG_ZR + (size_t)MTOT * 1920 * 2;
constexpr size_t BIG_EVEN_END = BIG_ORW + (size_t)2 * MTOT * 512 * 2;
constexpr size_t BIG_OGL = al256((size_t)MTOT * 3104 * 2);
constexpr size_t WS_END = WS_BIG + BIG_EVEN_END;

struct Params { const float* in[41]; };
#define PH_PRO int tid_ = threadIdx.x; asm volatile("" : "+v"(tid_)); int bid_ = blockIdx.x; asm volatile("" : "+s"(bid_)); int gdim_ = gridDim.x; asm volatile("" : "+s"(gdim_));
extern __shared__ __attribute__((aligned(16))) unsigned char smem_g[];
constexpr int TBL_OFF = LDS_BYTES - 512;
typedef const float __attribute__((address_space(1)))* gfptr_;
#define IN(i) ((const float*)(((const gfptr_*)(smem_g + TBL_OFF))[i]))
#define OUT_ ((float*)IN(39))
#define WS_ ((unsigned char*)IN(40))

__device__ __forceinline__ float bf2f(bf16_t b) { return __uint_as_float(((unsigned)b) << 16); }
typedef __bf16 bf16x2_t_ __attribute__((ext_vector_type(2)));
typedef float f32x2_t_ __attribute__((ext_vector_type(2)));
__device__ __forceinline__ unsigned pk2(float lo, float hi) { f32x2_t_ v = {lo, hi}; bf16x2_t_ b = __builtin_convertvector(v, bf16x2_t_); return __builtin_bit_cast(unsigned, b); }
__device__ __forceinline__ bf16_t f2bf(float f) { return (bf16_t)(pk2(f, 0.f) & 0xffffu); }
__device__ __forceinline__ bf16x8 ld8(const bf16_t* p) { const uint2 a = *(const uint2*)p, b = *(const uint2*)(p + 4); uint4 v; v.x = a.x; v.y = a.y; v.z = b.x; v.w = b.y; return __builtin_bit_cast(bf16x8, v); }
#define DPPF(v, ctrl) __builtin_bit_cast(float, __builtin_amdgcn_update_dpp(0, __builtin_bit_cast(int, (v)), (ctrl), 0xF, 0xF, true))
__device__ __forceinline__ float wsum(float v) {
    v += DPPF(v, 0xB1); v += DPPF(v, 0x4E); v += DPPF(v, 0x141); v += DPPF(v, 0x140);
    const int iv = __builtin_bit_cast(int, v);
    return __builtin_bit_cast(float, __builtin_amdgcn_readlane(iv, 0)) + __builtin_bit_cast(float, __builtin_amdgcn_readlane(iv, 16)) +
           __builtin_bit_cast(float, __builtin_amdgcn_readlane(iv, 32)) + __builtin_bit_cast(float, __builtin_amdgcn_readlane(iv, 48));
}
__device__ __forceinline__ float sigm(float x) { return __builtin_amdgcn_rcpf(1.f + __expf(-x)); }
__device__ __forceinline__ float silu_(float x) { return x * __builtin_amdgcn_rcpf(1.f + __expf(-x)); }
__device__ __forceinline__ float softplus_(float y) { return fmaxf(y, 0.f) + __logf(1.f + __expf(-fabsf(y))); }
__device__ __forceinline__ float tanh_(float x) { return 1.f - 2.f * __builtin_amdgcn_rcpf(1.f + __expf(2.f * x)); }

struct EpiStore {
    static constexpr bool PERM = true, AFTER_DRAIN = false;
    bf16_t* O; int ldc; int nvalid;
    __device__ __forceinline__ void operator()(const f32x4 (&acc)[2][2][4][2], const pg8::Unit& u, int wr, int wc, int fr, int fq) const {
        const int row0 = u.pm * 256 + wr * 64 + fr, col0 = u.pn * 256 + wc * 32 + 8 * fq;
#pragma unroll
        for (int ai = 0; ai < 2; ++ai)
#pragma unroll
            for (int m = 0; m < 4; ++m) {
                bf16_t* rowp = O + (size_t)(row0 + ai * 128 + m * 16) * ldc;
#pragma unroll
                for (int bj = 0; bj < 2; ++bj) {
                    const int col = col0 + bj * 128;
                    if (col < nvalid) {
                        const f32x4 v0 = acc[ai][bj][m][0], v1 = acc[ai][bj][m][1];
                        uint4 o; o.x = pk2(v0[0], v0[1]); o.y = pk2(v0[2], v0[3]); o.z = pk2(v1[0], v1[1]); o.w = pk2(v1[2], v1[3]);
                        *(uint4*)(rowp + col) = o;
                    }
                }
            }
    }
};
struct EpiSwiglu {
    static constexpr bool PERM = true, AFTER_DRAIN = false;
    bf16_t* G; int pm_off;
    __device__ __forceinline__ void operator()(const f32x4 (&acc)[2][2][4][2], const pg8::Unit& u, int wr, int wc, int fr, int fq) const {
        const int row0 = (u.pm + pm_off) * 256 + wr * 64 + fr, col0 = u.pn * 128 + wc * 32 + 8 * fq;
#pragma unroll
        for (int ai = 0; ai < 2; ++ai)
#pragma unroll
            for (int m = 0; m < 4; ++m) {
                bf16_t* rowp = G + (size_t)(row0 + ai * 128 + m * 16) * FF + col0;
                float o[8];
#pragma unroll
                for (int n = 0; n < 2; ++n)
#pragma unroll
                    for (int e = 0; e < 4; ++e) o[n * 4 + e] = silu_(acc[ai][0][m][n][e]) * acc[ai][1][m][n][e];
                uint4 q; q.x = pk2(o[0], o[1]); q.y = pk2(o[2], o[3]); q.z = pk2(o[4], o[5]); q.w = pk2(o[6], o[7]);
                *(uint4*)rowp = q;
            }
    }
};
struct EpiResid {
    static constexpr bool PERM = false, AFTER_DRAIN = false;
    int gate_off; float wgt; int ln_idx; int pm_off;
    __device__ __forceinline__ void operator()(const f32x4 (&acc)[2][2][4][2], const pg8::Unit& u, int wr, int wc, int fr, int fq) const {
        float* H = (float*)(WS_ + WS_H); const float* gate = (const float*)(WS_ + WS_MOD) + gate_off;
        const float* stats = ln_idx >= 0 ? (const float*)(WS_ + WS_STATS) : nullptr;
        const float* Hin = ln_idx >= 0 ? H : ((u.pm + pm_off) < 128 ? IN(0) : IN(2) - (size_t)MLAT * D);
        const float* lg = IN(6) + (ln_idx < 0 ? 0 : ln_idx) * 1024; const float* lb = IN(7) + (ln_idx < 0 ? 0 : ln_idx) * 1024;
        const int gpm = u.pm + pm_off;
        const int row0 = gpm * 256 + wr * 64 + fr, col0 = u.pn * 256 + wc * 32 + 4 * fq;
        const int midx = gpm < 128 ? (gpm >> 3) : 16;
        const float* gp = gate + (size_t)midx * 9216 + col0;
        float mu[2][4], rs[2][4];
#pragma unroll
        for (int ai = 0; ai < 2; ++ai)
#pragma unroll
            for (int m = 0; m < 4; ++m) {
                if (stats) { const float2 st = *(const float2*)(stats + 2 * (size_t)(row0 + ai * 128 + m * 16)); mu[ai][m] = st.x; rs[ai][m] = st.y; }
                else { mu[ai][m] = 0.f; rs[ai][m] = 1.f; }
            }
#pragma unroll
        for (int bj = 0; bj < 2; ++bj)
#pragma unroll
            for (int n = 0; n < 2; ++n) {
                const int co = bj * 128 + n * 16;
                const f32x4 gvv = *(const f32x4*)(gp + co) * wgt;
                f32x4 g4 = (f32x4){1.f, 1.f, 1.f, 1.f}, b4 = (f32x4){0.f, 0.f, 0.f, 0.f};
                if (stats) { g4 = *(const f32x4*)(lg + col0 + co); b4 = *(const f32x4*)(lb + col0 + co); }
#pragma unroll
                for (int ai = 0; ai < 2; ++ai)
#pragma unroll
                    for (int m = 0; m < 4; ++m) {
                        float* rowp = H + (size_t)(row0 + ai * 128 + m * 16) * D + col0 + co;
                        f32x4 h = *(const f32x4*)(Hin + (size_t)(row0 + ai * 128 + m * 16) * D + col0 + co);
                        h = (h - mu[ai][m]) * rs[ai][m] * g4 + b4;
                        h = h * DN_ALPHA + gvv * acc[ai][bj][m][n];
                        *(f32x4*)rowp = h;
                    }
            }
    }
};

template <class Epi>
__device__ __forceinline__ void run_gemm(unsigned char* smem, const bf16_t* A, const bf16_t* Bt, int M, int N, int K, const Epi& E, int bid_, int gdim_) {
    pg8::Gemm g; g.A = A; g.Bt = Bt; g.M = M; g.N = N; g.K = K;
    pg8::StaticOrder S; S.init(M, N, gdim_, bid_);
    pg8::gemm_phase<Epi, pg8::StaticOrder, false>((PG8_LAS unsigned char*)smem, g, S, E, nullptr);
}

__device__ __forceinline__ void phase_mod(const Params& p, unsigned char* smem) {
    PH_PRO
    float* s = (float*)smem;
    float* part = s + 17 * 1024;
    const int tid = tid_;
    const float* c = IN(1); const float* cc = IN(3);
    float* MOD = (float*)(WS_ + WS_MOD);
    if (bid_ >= 288) return;
    for (int idx = tid; idx < 17 * 1024; idx += NTHR) { const int i = idx >> 10, k = idx & 1023; const float v = i < 16 ? c[i * 1024 + k] : cc[k]; s[idx] = silu_(v); }
    __syncthreads();
    for (int item = bid_; item < 288; item += gdim_) {
        const int l = item / 72, j0 = (item % 72) * 128;
        const int col = tid & 127, kq = tid >> 7;
        const float* w = IN(4) + ((size_t)l * 1024 + kq * 256) * 9216 + j0 + col;
        float acc[17];
#pragma unroll
        for (int i = 0; i < 17; ++i) acc[i] = 0.f;
        for (int k = 0; k < 256; ++k) {
            const float wv = w[(size_t)k * 9216];
#pragma unroll
            for (int i = 0; i < 17; ++i) acc[i] += s[i * 1024 + kq * 256 + k] * wv;
        }
#pragma unroll
        for (int i = 0; i < 17; ++i) part[(kq * 17 + i) * 128 + col] = acc[i];
        __syncthreads();
        for (int idx = tid; idx < 17 * 128; idx += NTHR) {
            const int i = idx >> 7, cl = idx & 127;
            const float v = part[(0 * 17 + i) * 128 + cl] + part[(1 * 17 + i) * 128 + cl] + part[(2 * 17 + i) * 128 + cl] + part[(3 * 17 + i) * 128 + cl] + IN(5)[l * 9216 + j0 + cl];
            MOD[((size_t)l * 17 + i) * 9216 + j0 + cl] = v;
        }
        __syncthreads();
    }
}

__device__ __forceinline__ void conv_tile(const float* src, int ld, int nvalid, bf16_t* dst, int ldd, float* tile) {
    PH_PRO
    const int tid = tid_;
#pragma unroll
    for (int i = 0; i < 2; ++i) {
        const int k = (tid >> 4) + 32 * i, c4 = (tid & 15) * 4;
        float4 v = make_float4(0.f, 0.f, 0.f, 0.f);
        if (c4 < nvalid) v = *(const float4*)(src + (size_t)k * ld + c4);
        tile[k * 65 + c4] = v.x; tile[k * 65 + c4 + 1] = v.y; tile[k * 65 + c4 + 2] = v.z; tile[k * 65 + c4 + 3] = v.w;
    }
    __syncthreads();
    const int n = tid >> 3, ks = (tid & 7) * 8;
    uint4 o;
    o.x = pk2(tile[(ks + 0) * 65 + n], tile[(ks + 1) * 65 + n]); o.y = pk2(tile[(ks + 2) * 65 + n], tile[(ks + 3) * 65 + n]);
    o.z = pk2(tile[(ks + 4) * 65 + n], tile[(ks + 5) * 65 + n]); o.w = pk2(tile[(ks + 6) * 65 + n], tile[(ks + 7) * 65 + n]);
    *(uint4*)(dst + (size_t)n * ldd + ks) = o;
    __syncthreads();
}
__device__ __forceinline__ void conv_weights(const Params& p, int l, unsigned char* smem, int mode = 0, int blk_off = 0, int nblk_in = 0) {
    PH_PRO
    float* tile = (float*)smem;
    const int tid = tid_;
    const bool even = !(l & 1); const int eo = l >> 1;
    const int NIN = even ? 3456 : 3104, nint = (even ? 3584 : 3328) / 64;
    const int total = 2816 + 1408 + nint * 16 + 256;
    bf16_t* WUP = (bf16_t*)(WS_ + WS_WUP); bf16_t* WDN = (bf16_t*)(WS_ + WS_WDN); bf16_t* WIN = (bf16_t*)(WS_ + WS_WIN); bf16_t* WOUT = (bf16_t*)(WS_ + WS_WOUT);
    auto desc = [&](int idx, const float*& src, int& ld, int& nv, bf16_t*& dst, int& ldd) {
        if (idx < 2816) {
            const int f = idx / 1408, r = idx % 1408, nt = r / 16, kt = r % 16, n0 = nt * 64;
            const int pn = n0 >> 8, bj = (n0 & 255) >> 7, j = n0 & 127, col = pn * 128 + j;
            src = (bj ? IN(9) : IN(8)) + ((size_t)(l * 2 + f) * 1024 + kt * 64) * FF + col; ld = FF; nv = 64;
            dst = WUP + ((size_t)f * 5632 + n0) * 1024 + kt * 64; ldd = 1024;
        } else if (idx < 4224) {
            int r = idx - 2816; const int f = r / 704; r %= 704; const int kt = r / 16, nt = r % 16;
            src = IN(10) + ((size_t)(l * 2 + f) * FF + kt * 64) * 1024 + nt * 64; ld = 1024; nv = 64;
            dst = WDN + ((size_t)f * 1024 + nt * 64) * FF + kt * 64; ldd = FF;
        } else if (idx < 4224 + nint * 16) {
            const int r = idx - 4224, nt = r / 16, kt = r % 16, n0 = nt * 64;
            int v = NIN - n0; v = v < 0 ? 0 : (v > 64 ? 64 : v);
            src = (even ? IN(11) : IN(34)) + ((size_t)eo * 1024 + kt * 64) * NIN + n0; ld = NIN; nv = v;
            dst = WIN + (size_t)n0 * 1024 + kt * 64; ldd = 1024;
        } else {
            const int r = idx - 4224 - nint * 16, nt = r / 16, kt = r % 16;
            src = (even ? IN(12) : IN(35)) + ((size_t)eo * 1024 + kt * 64) * 1024 + nt * 64; ld = 1024; nv = 64;
            dst = WOUT + (size_t)nt * 64 * 1024 + kt * 64; ldd = 1024;
        }
    };
    float4 nx[2]; bf16_t* ndst = nullptr; int nldd = 0;
    auto issue = [&](int idx) {
        const float* src; int ld, nv; desc(idx, src, ld, nv, ndst, nldd);
#pragma unroll
        for (int i = 0; i < 2; ++i) { const int k = (tid >> 4) + 32 * i, c4 = (tid & 15) * 4; nx[i] = make_float4(0.f, 0.f, 0.f, 0.f); if (c4 < nv) nx[i] = *(const float4*)(src + (size_t)k * ld + c4); }
    };
    const int nblk = nblk_in ? nblk_in : gdim_;
    const int nmov = 1408 + 704 + nint * 16 + 256;
    const int count = mode == 0 ? total : (mode == 1 ? nmov : 2112);
    auto tile_of = [&](int j) -> int {
        if (mode == 0) return j;
        if (mode == 1) return j < 1408 ? j : (j < 2112 ? 2816 + (j - 1408) : 4224 + (j - 2112));
        return j < 1408 ? 1408 + j : 3520 + (j - 1408);
    };
    const int j0 = bid_ - blk_off;
    if (j0 < count) issue(tile_of(j0));
    for (int j = j0; j < count; j += nblk) {
        const float4 c0 = nx[0], c1 = nx[1]; bf16_t* dst = ndst; const int ldd = nldd;
        if (j + nblk < count) issue(tile_of(j + nblk));
        { const int k = (tid >> 4), c4 = (tid & 15) * 4;
          tile[k * 65 + c4] = c0.x; tile[k * 65 + c4 + 1] = c0.y; tile[k * 65 + c4 + 2] = c0.z; tile[k * 65 + c4 + 3] = c0.w;
          tile[(k + 32) * 65 + c4] = c1.x; tile[(k + 32) * 65 + c4 + 1] = c1.y; tile[(k + 32) * 65 + c4 + 2] = c1.z; tile[(k + 32) * 65 + c4 + 3] = c1.w; }
        __syncthreads();
        const int n = tid >> 3, ks = (tid & 7) * 8;
        uint4 o;
        o.x = pk2(tile[(ks + 0) * 65 + n], tile[(ks + 1) * 65 + n]); o.y = pk2(tile[(ks + 2) * 65 + n], tile[(ks + 3) * 65 + n]);
        o.z = pk2(tile[(ks + 4) * 65 + n], tile[(ks + 5) * 65 + n]); o.w = pk2(tile[(ks + 6) * 65 + n], tile[(ks + 7) * 65 + n]);
        *(uint4*)(dst + (size_t)n * ldd + ks) = o;
        __syncthreads();
    }
}

__device__ __forceinline__ void filt_gen(const Params& p, unsigned char* smem) {
    PH_PRO
    float* z = (float*)smem;
    float* h1 = z + 64 * 33;
    float* h2 = h1 + 64 * 65;
    const int tid = tid_, lane = tid & 63, wid = __builtin_amdgcn_readfirstlane(tid >> 6);
    bf16_t* FT = (bf16_t*)(WS_ + WS_FT);
    for (int item = (bid_ + gdim_ / 2) % gdim_; item < 2 * 36 * 4; item += gdim_) {
        const int e = item / 144; int r = item % 144; const int cg = r & 3; r >>= 2;
        const int seg = r >= 32; const int jb = seg ? r - 32 : r;
        const int L = seg ? 256 : 2048;
        const float* w1 = IN(15) + e * 33 * 64; const float* b1 = IN(16) + e * 64; const float* f1 = IN(17) + e * 64;
        const float* w2 = IN(18) + e * 64 * 64; const float* b2 = IN(19) + e * 64; const float* f2 = IN(20) + e * 64;
        const float* w3 = IN(21) + (size_t)e * 64 * 2048; const float* skip = IN(22) + e * 1024;
        __syncthreads();
        for (int idx = tid; idx < 64 * 33; idx += NTHR) {
            const int jj = idx / 33, i = idx % 33; const int j = jb * 64 + jj;
            float v;
            if (i == 0) v = (float)j / (float)(L - 1);
            else { const int bi = (i - 1) & 15; const float f = 1e-4f + (float)bi * ((15.f - 1e-4f) / 15.f); const float w = 6.283185307179586f * (float)j / (float)L; v = (i <= 16) ? cosf(f * w) : -sinf(f * w); }
            z[idx] = v;
        }
        __syncthreads();
        for (int idx = tid; idx < 4096; idx += NTHR) {
            const int jj = idx >> 6, o = idx & 63; float a = b1[o];
            for (int i = 0; i < 33; ++i) a += z[jj * 33 + i] * w1[i * 64 + o];
            h1[jj * 65 + o] = sinf(f1[o] * a);
        }
        __syncthreads();
        for (int idx = tid; idx < 4096; idx += NTHR) {
            const int jj = idx >> 6, o = idx & 63; float a = b2[o];
            for (int k = 0; k < 64; ++k) a += h1[jj * 65 + k] * w2[k * 64 + o];
            h2[jj * 65 + o] = sinf(f2[o] * a);
        }
        __syncthreads();
        bf16_t* base = FT + (size_t)e * FT_E + (seg ? FT_LAT : 0);
#pragma unroll 1
        for (int ps = 0; ps < 2; ++ps) {
            const int col0 = cg * 512 + ps * 256 + 4 * lane;
            float acc[8][4];
#pragma unroll
            for (int i = 0; i < 8; ++i)
#pragma unroll
                for (int c = 0; c < 4; ++c) acc[i][c] = 0.f;
#pragma unroll 4
            for (int k = 0; k < 64; ++k) {
                const float4 wv = *(const float4*)(w3 + (size_t)k * 2048 + col0);
#pragma unroll
                for (int i = 0; i < 8; ++i) { const float hv = h2[(8 * wid + i) * 65 + k]; acc[i][0] += hv * wv.x; acc[i][1] += hv * wv.y; acc[i][2] += hv * wv.z; acc[i][3] += hv * wv.w; }
            }
            const int ord = col0 >> 10, dir = (col0 >> 9) & 1;
            const float lo = -4.605170185988091f / 1.5f, hi = -4.605170185988091f / 0.3f;
#pragma unroll
            for (int c = 0; c < 4; ++c) {
                const int ch = (col0 + c) & 511;
                const float adl = fabsf(lo + (hi - lo) * (float)ch / 511.f);
                bf16_t* fp = base + ((size_t)ord * 512 + ch) * (2 * L);
#pragma unroll
                for (int i = 0; i < 8; ++i) {
                    const int j = jb * 64 + 8 * wid + i; const float tj = (float)j / (float)(L - 1);
                    float v = acc[i][c] * __expf(-tj * adl);
                    if (dir == 0 && j == 0) v += skip[ord * 512 + ch];
                    if (!(dir == 1 && j == 0)) fp[dir == 0 ? (L - 1 - j) : (L - 1 + j)] = f2bf(v);
                }
            }
        }
    }
    __syncthreads();
}

__device__ __forceinline__ void row_phase(const Params& p, int mode, int l_ln, int which, int l_mod, int sidx, bool fin, int nrows_in = MTOT, int row_begin = 0, int blk_off = 0, int nblk_in = 0) {
    PH_PRO
    const int lane = tid_ & 63, wid = tid_ >> 6;
    float* H = (float*)(WS_ + WS_H); bf16_t* A = (bf16_t*)(WS_ + WS_A);
    const float* MOD = (const float*)(WS_ + WS_MOD);
    const float* lg = IN(6) + (l_ln * 3 + which) * 1024; const float* lb = IN(7) + (l_ln * 3 + which) * 1024;
    const int nrows = fin ? MLAT : nrows_in;
    constexpr int RU = 1;
    const int nblk = nblk_in ? nblk_in : gdim_;
    for (int rowb = row_begin + (bid_ - blk_off) * 8 + wid; rowb < nrows; rowb += nblk * 8 * RU) {
        float4 v[RU][4]; int rows[RU]; bool okr[RU];
#pragma unroll
        for (int u = 0; u < RU; ++u) {
            const int row = rowb + u * nblk * 8; okr[u] = row < nrows; rows[u] = okr[u] ? row : rowb;
            const float* src = mode ? H + (size_t)rows[u] * D : (rows[u] < MLAT ? IN(0) + (size_t)rows[u] * D : IN(2) + (size_t)(rows[u] - MLAT) * D);
#pragma unroll
            for (int i = 0; i < 4; ++i) v[u][i] = *(const float4*)(src + 4 * lane + 256 * i);
        }
#pragma unroll
        for (int u = 0; u < RU; ++u) {
            const int row = rows[u];
            if (mode) {
                float s = 0.f;
#pragma unroll
                for (int i = 0; i < 4; ++i) s += v[u][i].x + v[u][i].y + v[u][i].z + v[u][i].w;
                const float mu = wsum(s) * (1.f / 1024.f);
                float q = 0.f;
#pragma unroll
                for (int i = 0; i < 4; ++i) { v[u][i].x -= mu; v[u][i].y -= mu; v[u][i].z -= mu; v[u][i].w -= mu; q += v[u][i].x * v[u][i].x + v[u][i].y * v[u][i].y + v[u][i].z * v[u][i].z + v[u][i].w * v[u][i].w; }
                const float rstd = rsqrtf(wsum(q) * (1.f / 1024.f) + 1e-6f);
                if (lane == 0 && !fin && okr[u]) *(float2*)((float*)(WS_ + WS_STATS) + 2 * (size_t)row) = make_float2(mu, rstd);
#pragma unroll
                for (int i = 0; i < 4; ++i) {
                    const float4 g = *(const float4*)(lg + 4 * lane + 256 * i), b = *(const float4*)(lb + 4 * lane + 256 * i);
                    v[u][i].x = v[u][i].x * rstd * g.x + b.x; v[u][i].y = v[u][i].y * rstd * g.y + b.y; v[u][i].z = v[u][i].z * rstd * g.z + b.z; v[u][i].w = v[u][i].w * rstd * g.w + b.w;
                }
            }
            if (!okr[u]) continue;
            if (fin) {
#pragma unroll
                for (int i = 0; i < 4; ++i) *(float4*)(OUT_ + (size_t)row * D + 4 * lane + 256 * i) = v[u][i];
            } else {
                const int midx = row < MLAT ? (row >> 11) : 16;
                const float* mp = MOD + ((size_t)l_mod * 17 + midx) * 9216 + sidx * 1024;
#pragma unroll
                for (int i = 0; i < 4; ++i) {
                    const float4 sh = *(const float4*)(mp + 4 * lane + 256 * i), sc = *(const float4*)(mp + 1024 + 4 * lane + 256 * i);
                    uint2 o; o.x = pk2(v[u][i].x * (1.f + sc.x) + sh.x, v[u][i].y * (1.f + sc.y) + sh.y); o.y = pk2(v[u][i].z * (1.f + sc.z) + sh.z, v[u][i].w * (1.f + sc.w) + sh.w);
                    *(uint2*)(A + (size_t)row * D + 4 * lane + 256 * i) = o;
                }
            }
        }
    }
}
template <int L>
__device__ __forceinline__ void hyena_item(const Params& p, int e, int c, int segbase, const bf16_t* ft, unsigned char* smem) {
    PH_PRO
    constexpr int CPS = 2 * L + 16, UTS = L + 8, TPW = (L / 16) / 8;
    bf16_t* COP = (bf16_t*)smem;
    bf16_t* UT = COP + 8 * CPS;
    const int tid = tid_, lane = tid & 63, wid = tid >> 6;
    bf16_t* ZHT = (bf16_t*)(WS_ + WS_BIG);
    bf16_t* zv = ZHT + (size_t)c * MTOT + segbase;
    const bf16_t* zx1 = ZHT + (size_t)(512 + c) * MTOT + segbase;
    const bf16_t* zx2 = ZHT + (size_t)(1024 + c) * MTOT + segbase;
    const float* cw = IN(13) + e * 3 * 1536; const float* cbp = IN(14) + e * 1536;
    const float vw0 = cw[c], vw1 = cw[1536 + c], vw2 = cw[3072 + c], vb = cbp[c];
    const float aw0 = cw[512 + c], aw1 = cw[1536 + 512 + c], aw2 = cw[3072 + 512 + c], ab = cbp[512 + c];
    const float bw0 = cw[1024 + c], bw1 = cw[1536 + 1024 + c], bw2 = cw[3072 + 1024 + c], bb = cbp[1024 + c];
    auto conv4 = [&](const bf16_t* q, int t0, float w0, float w1, float w2, float bias, float (&y)[4]) {
        const uint2 mid = *(const uint2*)(q + t0);
        float zm = bf2f(q[t0 > 0 ? t0 - 1 : 0]); zm = t0 > 0 ? zm : 0.f;
        float zq = bf2f(q[t0 + 4 < L ? t0 + 4 : L - 1]); zq = t0 + 4 < L ? zq : 0.f;
        const float z0 = __uint_as_float(mid.x << 16), z1 = __uint_as_float(mid.x & 0xffff0000u), z2 = __uint_as_float(mid.y << 16), z3 = __uint_as_float(mid.y & 0xffff0000u);
        y[0] = zm * w0 + z0 * w1 + z1 * w2 + bias; y[1] = z0 * w0 + z1 * w1 + z2 * w2 + bias;
        y[2] = z1 * w0 + z2 * w1 + z3 * w2 + bias; y[3] = z2 * w0 + z3 * w1 + zq * w2 + bias;
    };
#pragma unroll 4
    for (int idx = tid; idx < 4 * L; idx += NTHR) {
        const int b = idx / (L / 4), s4 = (idx % (L / 4)) * 4;
        float y[4]; conv4(zv + b * L, s4, vw0, vw1, vw2, vb, y);
        uint2 o; o.x = pk2(y[0], y[1]); o.y = pk2(y[2], y[3]);
        *(uint2*)(UT + b * UTS + s4) = o;
    }
    const int r = lane & 15, g = lane >> 4, a = 7 - (r & 7);
    const bf16_t* cop_a = COP + a * CPS;
    f32x4 acc[TPW];
#pragma unroll 1
    for (int ord = 0; ord < 2; ++ord) {
        const bf16_t* fo = ft + ((size_t)ord * 512 + c) * (2 * L);
        for (int cidx = tid; cidx < (2 * L) / 8; cidx += NTHR) {
            const uint4 raw = *(const uint4*)(fo + 8 * cidx);
            unsigned short v[8] = {(unsigned short)(raw.x & 0xffffu), (unsigned short)(raw.x >> 16), (unsigned short)(raw.y & 0xffffu), (unsigned short)(raw.y >> 16),
                                   (unsigned short)(raw.z & 0xffffu), (unsigned short)(raw.z >> 16), (unsigned short)(raw.w & 0xffffu), (unsigned short)(raw.w >> 16)};
            if (cidx == (2 * L) / 8 - 1) v[7] = 0;
#pragma unroll
            for (int ca = 0; ca < 8; ++ca)
#pragma unroll
                for (int j = 0; j < 8; ++j) { const int x = 8 * cidx - ca + j; COP[ca * CPS + (x < 0 ? 0 : x)] = v[j]; }
        }
        __syncthreads();
#pragma unroll
        for (int i = 0; i < TPW; ++i) acc[i] = (f32x4){0.f, 0.f, 0.f, 0.f};
        if constexpr (TPW == 16) {
            const bf16_t* fbase = cop_a + (8 * g - r + L - 1 - a) - wid * 256;
            bf16x8 F[16];
#pragma unroll
            for (int dd = -15; dd <= 0; ++dd) F[dd & 15] = *(const bf16x8*)(fbase + 16 * dd);
#pragma unroll 1
            for (int S0 = 0; S0 < L / 32; S0 += 8) {
#pragma unroll
                for (int u = 0; u < 8; ++u) {
                    const int S = S0 + u;
                    if (S > 0) { F[(2 * u) & 15] = *(const bf16x8*)(fbase + 32 * S); F[(2 * u - 1) & 15] = *(const bf16x8*)(fbase + 32 * S - 16); }
                    const bf16x8 bfr = *(const bf16x8*)(UT + r * UTS + 32 * S + 8 * g);
#pragma unroll
                    for (int i = 0; i < 16; ++i) acc[i] = __builtin_amdgcn_mfma_f32_16x16x32_bf16(F[(2 * u - i) & 15], bfr, acc[i], 0, 0, 0);
                }
            }
        } else {
        for (int s0 = 0; s0 < L; s0 += 32) {
            const bf16x8 bfr = *(const bf16x8*)(UT + r * UTS + s0 + 8 * g);
#pragma unroll
            for (int i = 0; i < TPW; ++i) {
                const int t0 = (wid * TPW + i) * 16;
                const int n8 = s0 - t0 + 8 * g - r + L - 1 - a;
                const bf16x8 afr = *(const bf16x8*)(cop_a + n8);
                acc[i] = __builtin_amdgcn_mfma_f32_16x16x32_bf16(afr, bfr, acc[i], 0, 0, 0);
            }
        }
        }
        __syncthreads();
        int rl = r * L, tb0 = wid * TPW * 16 + 4 * g; asm volatile("" : "+v"(rl), "+v"(tb0));
        if (ord == 0) {
#pragma unroll
            for (int i = 0; i < TPW; ++i) {
                const int t0 = tb0 + i * 16;
                float y[4]; conv4(zx1 + rl, t0, aw0, aw1, aw2, ab, y);
                uint2 o; o.x = pk2(y[0] * acc[i][0], y[1] * acc[i][1]); o.y = pk2(y[2] * acc[i][2], y[3] * acc[i][3]);
                *(uint2*)(UT + r * UTS + t0) = o;
                if ((i & 3) == 3) __builtin_amdgcn_sched_barrier(0);
            }
        } else {
#pragma unroll
            for (int i = 0; i < TPW; ++i) {
                const int t0 = tb0 + i * 16;
                float y[4]; conv4(zx2 + rl, t0, bw0, bw1, bw2, bb, y);
                uint2 o; o.x = pk2(y[0] * acc[i][0], y[1] * acc[i][1]); o.y = pk2(y[2] * acc[i][2], y[3] * acc[i][3]);
                *(uint2*)(zv + rl + t0) = o;
                if ((i & 3) == 3) __builtin_amdgcn_sched_barrier(0);
            }
        }
    }
    __syncthreads();
}
__device__ __forceinline__ void hyena_phase(const Params& p, int e, unsigned char* smem) {
    PH_PRO
    const bf16_t* FT = (const bf16_t*)(WS_ + WS_FT) + (size_t)e * FT_E;
    for (int item = bid_; item < 1024; item += gdim_) {
        if (item < 512) hyena_item<2048>(p, e, item, 0, FT, smem);
        else hyena_item<256>(p, e, item - 512, MLAT, FT + FT_LAT, smem);
    }
}

__device__ __forceinline__ void rwkv_scan_phase(const Params& p, int e, unsigned char* smem) {
    PH_PRO
    const int chain = bid_; if (chain >= 256) return;
    const int xcd_ = chain & 7, jx_ = chain >> 3;
    const int b = 2 * xcd_ + (jx_ >> 4), d = (jx_ >> 3) & 1, h = jx_ & 7;
    const int tid = tid_, lane = tid & 63, wid = tid >> 6;
    constexpr int LRS = 72;
    bf16_t* WUPT = (bf16_t*)smem;
    bf16_t* AUPT = WUPT + 64 * LRS;
    float* sBONp = (float*)(AUPT + 64 * LRS);
    constexpr int SOPS = 336;
    float* sOP = (float*)smem + 8192;
    float* sR = sOP;
    float* sKK = sR + 4096;
    float* sW = sKK + 4096;
    float* sKD = sW + 4096;
    float* sKKA = sKD + 4096;
    float* sV = sOP + 64 * SOPS;
    float* sO = sV + 4096;
    bf16_t* TWb = (bf16_t*)sO;
    bf16_t* ADb = TWb + 64 * LRS;
    const bf16_t* ZR = (const bf16_t*)(WS_ + WS_BIG + BIG_ZR);
    bf16_t* ORW = (bf16_t*)(WS_ + WS_BIG + BIG_ORW) + (size_t)d * MTOT * 512;
    float* BON = (float*)(WS_ + WS_BON) + (size_t)d * MTOT * 8;
    const float* mu = IN(23) + e * 1920;
    const float* w0 = IN(24) + (e * 2 + d) * 512 + 64 * h;
    const float* a0 = IN(26) + (e * 2 + d) * 512 + 64 * h;
    const float* wup_g = IN(25) + (size_t)(e * 2 + d) * 64 * 512 + 64 * h;
    const float* aup_g = IN(27) + (size_t)(e * 2 + d) * 64 * 512 + 64 * h;
    const float kk_c = IN(29)[e * 512 + 64 * h + lane];
    const float mu_r = mu[64 * h + lane], mu_k = mu[512 + 64 * h + lane], mu_v = mu[1024 + 64 * h + lane], mu_w = mu[1536 + 64 * d + lane], mu_a = mu[1664 + 64 * d + lane];
    for (int idx = tid; idx < 4096; idx += NTHR) { const int j = idx >> 6, k = idx & 63; WUPT[k * LRS + j] = f2bf(wup_g[(size_t)j * 512 + k]); AUPT[k * LRS + j] = f2bf(aup_g[(size_t)j * 512 + k]); }
    const int r16 = lane & 15, g4 = lane >> 4, tr = wid & 3, tcb = 2 * (wid >> 2);
    float c_w0[2], c_a0[2], c_ka[2], c_rk[2];
#pragma unroll
    for (int jt = 0; jt < 2; ++jt) { const int kc = 16 * (tcb + jt) + r16; c_w0[jt] = w0[kc]; c_a0[jt] = a0[kc]; c_ka[jt] = IN(30)[e * 512 + 64 * h + kc]; c_rk[jt] = IN(31)[e * 512 + 64 * h + kc]; }
    typedef float f32x2 __attribute__((ext_vector_type(2)));
    f32x2 S2[4];
#pragma unroll
    for (int k = 0; k < 4; ++k) S2[k] = (f32x2){0.f, 0.f};
    __syncthreads();
    bf16_t pr_[10], pk_[10], pv_[10], pw_[10], pa_[10];
    auto issue = [&](int cidx) {
        const int seg = cidx >= 4; const int L = seg ? TL : TCX; const int rowbase = seg ? b * TL : MLAT + b * TCX; const int ch = seg ? cidx - 4 : cidx;
        const int tlo = d ? (L - 1 - (ch * 64 + 8 * wid + 7)) : (ch * 64 + 8 * wid);
#pragma unroll
        for (int q = 0; q < 10; ++q) {
            const int t = tlo - 1 + q; const int tc = t < 0 ? 0 : (t > L - 1 ? L - 1 : t);
            const bf16_t* zr = ZR + (size_t)(rowbase + tc) * 1920;
            pr_[q] = zr[64 * h + lane]; pk_[q] = zr[512 + 64 * h + lane]; pv_[q] = zr[1024 + 64 * h + lane]; pw_[q] = zr[1536 + 64 * d + lane]; pa_[q] = zr[1664 + 64 * d + lane];
        }
    };
    issue(0);
#pragma unroll 1
    for (int cidx = 0; cidx < 36; ++cidx) {
        {
            const int seg = cidx >= 4; const int L = seg ? TL : TCX; const int rowbase = seg ? b * TL : MLAT + b * TCX; const int ch = seg ? cidx - 4 : cidx;
            const int tlo = d ? (L - 1 - (ch * 64 + 8 * wid + 7)) : (ch * 64 + 8 * wid);
            {
                float zr_[10], zk_[10], zv_[10], zw_[10], za_[10];
#pragma unroll
                for (int q = 0; q < 10; ++q) {
                    const int t = tlo - 1 + q; const bool ok = (t >= 0) && (t < L);
                    const float a0 = bf2f(pr_[q]), a1 = bf2f(pk_[q]), a2 = bf2f(pv_[q]), a3 = bf2f(pw_[q]), a4 = bf2f(pa_[q]);
                    zr_[q] = ok ? a0 : 0.f; zk_[q] = ok ? a1 : 0.f; zv_[q] = ok ? a2 : 0.f; zw_[q] = ok ? a3 : 0.f; za_[q] = ok ? a4 : 0.f;
                }
#pragma unroll
                for (int sl = 0; sl < 8; ++sl) {
                    const int tau = 8 * wid + (d ? 7 - sl : sl);
#define ZS(arr, muv) (arr[sl + 1] + (muv) * (0.5f * (arr[sl] + arr[sl + 2]) - arr[sl + 1]))
                    const float rr = ZS(zr_, mu_r), kr = ZS(zk_, mu_k), vv = ZS(zv_, mu_v), wd = ZS(zw_, mu_w), ad = ZS(za_, mu_a);
#undef ZS
                    const float kkv = kr * kk_c; const float n2 = wsum(kkv * kkv);
                    const float kk = kkv * __builtin_amdgcn_rcpf(fmaxf(__builtin_amdgcn_sqrtf(n2), 1e-12f));
                    sOP[tau * SOPS + 0 + lane] = rr; sOP[tau * SOPS + 64 + lane] = kk; sV[tau * 64 + lane] = vv; sOP[tau * SOPS + 192 + lane] = kr;
                    TWb[tau * LRS + lane] = f2bf(tanh_(wd)); ADb[tau * LRS + lane] = f2bf(ad);
                }
            }
            __syncthreads();
            {
                const bf16x8 aw0 = *(const bf16x8*)(TWb + (16 * tr + r16) * LRS + 8 * g4), aw1 = *(const bf16x8*)(TWb + (16 * tr + r16) * LRS + 32 + 8 * g4);
                const bf16x8 aa0 = *(const bf16x8*)(ADb + (16 * tr + r16) * LRS + 8 * g4), aa1 = *(const bf16x8*)(ADb + (16 * tr + r16) * LRS + 32 + 8 * g4);
                float bonp[4] = {0.f, 0.f, 0.f, 0.f};
#pragma unroll
                for (int jt = 0; jt < 2; ++jt) {
                    const int kc = 16 * (tcb + jt) + r16;
                    const bf16x8 bw0 = *(const bf16x8*)(WUPT + kc * LRS + 8 * g4), bw1 = *(const bf16x8*)(WUPT + kc * LRS + 32 + 8 * g4);
                    const bf16x8 ba0 = *(const bf16x8*)(AUPT + kc * LRS + 8 * g4), ba1 = *(const bf16x8*)(AUPT + kc * LRS + 32 + 8 * g4);
                    f32x4 cw = (f32x4){0.f, 0.f, 0.f, 0.f}, ca = (f32x4){0.f, 0.f, 0.f, 0.f};
                    cw = __builtin_amdgcn_mfma_f32_16x16x32_bf16(aw0, bw0, cw, 0, 0, 0); cw = __builtin_amdgcn_mfma_f32_16x16x32_bf16(aw1, bw1, cw, 0, 0, 0);
                    ca = __builtin_amdgcn_mfma_f32_16x16x32_bf16(aa0, ba0, ca, 0, 0, 0); ca = __builtin_amdgcn_mfma_f32_16x16x32_bf16(aa1, ba1, ca, 0, 0, 0);
#pragma unroll
                    for (int q = 0; q < 4; ++q) {
                        const int tau = 16 * tr + 4 * g4 + q;
                        const float wlog = -softplus_(-(c_w0[jt] + cw[q])) - 0.5f;
                        const float dec = __expf(-__expf(wlog));
                        const float av = sigm(c_a0[jt] + ca[q]);
                        const float kd = sOP[tau * SOPS + 192 + kc] * (1.f + (av - 1.f) * c_ka[jt]);
                        bonp[q] += sOP[tau * SOPS + 0 + kc] * kd * c_rk[jt];
                        sOP[tau * SOPS + 128 + kc] = dec; sOP[tau * SOPS + 192 + kc] = kd; sOP[tau * SOPS + 256 + kc] = sOP[tau * SOPS + 64 + kc] * av;
                    }
                }
#pragma unroll
                for (int q = 0; q < 4; ++q) {
                    float v = bonp[q];
                    v += DPPF(v, 0xB1); v += DPPF(v, 0x4E); v += DPPF(v, 0x141); v += DPPF(v, 0x140);
                    if (r16 == 0) sBONp[(16 * tr + 4 * g4 + q) * 2 + (wid >> 2)] = v;
                }
            }
            __syncthreads();
            if (tid < 64) { const int pp = ch * 64 + tid; const int t = d ? (L - 1 - pp) : pp; BON[(size_t)(rowbase + t) * 8 + h] = sBONp[2 * tid] + sBONp[2 * tid + 1]; }
            if (cidx + 1 < 36) issue(cidx + 1);
            {
                const int vrow = 8 * wid + (lane >> 3), kq = lane & 7;
                const float* pb = sOP + 8 * kq;
                constexpr int O_R = 0, O_KK = 64, O_W = 128, O_KD = 192, O_KA = 256;
                struct Ops { float4 kk0, kk1, w0, w1, ka0, ka1, kd0, kd1, r0, r1; float vv; };
                auto ldops = [&](Ops& o, int tau) {
                    const float* q = pb + tau * SOPS;
                    o.kk0 = *(const float4*)(q + O_KK); o.kk1 = *(const float4*)(q + O_KK + 4); o.w0 = *(const float4*)(q + O_W); o.w1 = *(const float4*)(q + O_W + 4);
                    o.ka0 = *(const float4*)(q + O_KA); o.ka1 = *(const float4*)(q + O_KA + 4); o.kd0 = *(const float4*)(q + O_KD); o.kd1 = *(const float4*)(q + O_KD + 4);
                    o.r0 = *(const float4*)(q + O_R); o.r1 = *(const float4*)(q + O_R + 4); o.vv = sV[tau * 64 + vrow];
                };
                auto step = [&](const Ops& o, int tau) -> float {
                    const f32x2 kk[4] = {{o.kk0.x, o.kk0.y}, {o.kk0.z, o.kk0.w}, {o.kk1.x, o.kk1.y}, {o.kk1.z, o.kk1.w}};
                    const f32x2 w[4] = {{o.w0.x, o.w0.y}, {o.w0.z, o.w0.w}, {o.w1.x, o.w1.y}, {o.w1.z, o.w1.w}};
                    const f32x2 ka[4] = {{o.ka0.x, o.ka0.y}, {o.ka0.z, o.ka0.w}, {o.ka1.x, o.ka1.y}, {o.ka1.z, o.ka1.w}};
                    const f32x2 kd[4] = {{o.kd0.x, o.kd0.y}, {o.kd0.z, o.kd0.w}, {o.kd1.x, o.kd1.y}, {o.kd1.z, o.kd1.w}};
                    const f32x2 rr[4] = {{o.r0.x, o.r0.y}, {o.r0.z, o.r0.w}, {o.r1.x, o.r1.y}, {o.r1.z, o.r1.w}};
                    f32x2 da = S2[0] * kk[0] + S2[1] * kk[1]; f32x2 db = S2[2] * kk[2] + S2[3] * kk[3]; da = da + db;
                    float dt = da.x + da.y;
                    dt += DPPF(dt, 0xB1); dt += DPPF(dt, 0x4E); dt += DPPF(dt, 0x141);
                    const f32x2 sa2 = {-dt, -dt}; const f32x2 vv2 = {o.vv, o.vv};
#pragma unroll
                    for (int q = 0; q < 4; ++q) S2[q] = S2[q] * w[q] + (sa2 * ka[q] + vv2 * kd[q]);
                    f32x2 oa = S2[0] * rr[0] + S2[1] * rr[1]; f32x2 ob = S2[2] * rr[2] + S2[3] * rr[3]; oa = oa + ob;
                    return oa.x + oa.y;
                };
                Ops oa_, ob_;
                ldops(oa_, 0);
                const bool b1_ = (kq & 2) != 0, b0_ = (kq & 1) != 0;
#pragma unroll 1
                for (int t4 = 0; t4 < 64; t4 += 4) {
                    float po[4];
#pragma unroll
                    for (int u = 0; u < 4; u += 2) {
                        ldops(ob_, t4 + u + 1);
                        po[u] = step(oa_, t4 + u);
                        ldops(oa_, t4 + u + 2 < 64 ? t4 + u + 2 : 63);
                        po[u + 1] = step(ob_, t4 + u + 1);
                    }
                    float a2[2];
#pragma unroll
                    for (int j = 0; j < 2; ++j) { const float send = b1_ ? po[j] : po[j + 2], keep = b1_ ? po[j + 2] : po[j]; a2[j] = keep + DPPF(send, 0x4E); }
                    const float send = b0_ ? a2[0] : a2[1], keep = b0_ ? a2[1] : a2[0];
                    float r_ = keep + DPPF(send, 0xB1);
                    r_ += __builtin_bit_cast(float, __builtin_amdgcn_ds_swizzle(__builtin_bit_cast(int, r_), 0x101F));
                    sO[(t4 + (kq & 3)) * 64 + vrow] = r_;
                }
            }
            __syncthreads();
#pragma unroll
            for (int i = 0; i < 8; ++i) {
                const int tau = wid + 8 * i; const int pp = ch * 64 + tau; const int t = d ? (L - 1 - pp) : pp;
                ORW[(size_t)(rowbase + t) * 512 + 64 * h + lane] = f2bf(sO[tau * 64 + lane]);
            }
            __syncthreads();
        }
    }
}

__device__ __forceinline__ void even_readout_phase(const Params& p, int e, unsigned char* smem) {
    PH_PRO
    const int tid = tid_, lane = tid & 63, wid = __builtin_amdgcn_readfirstlane(tid >> 6);
    constexpr int SGS = 136, GGS = 80;
    bf16_t* SGb = (bf16_t*)smem;
    float* GG = (float*)(SGb + 64 * SGS);
    bf16_t* GUT = (bf16_t*)(GG + 64 * GGS);
    bf16_t* TT = GUT + 64 * SGS;
    const int r16 = lane & 15, g4 = lane >> 4, tr = wid & 3, tcb = 2 * (wid >> 2);
    const bf16_t* ZR = (const bf16_t*)(WS_ + WS_BIG + BIG_ZR);
    const bf16_t* ORW = (const bf16_t*)(WS_ + WS_BIG + BIG_ORW);
    const bf16_t* YT = (const bf16_t*)(WS_ + WS_BIG);
    const float* BON = (const float*)(WS_ + WS_BON);
    bf16_t* YM = (bf16_t*)(WS_ + WS_A);
    const float* mu = IN(23) + e * 1920;
    const int h = bid_ & 7;
    {
        const float* gup = IN(28) + (size_t)e * 128 * 512 + 64 * h;
        for (int idx = tid; idx < 128 * 64; idx += NTHR) { const int j = idx >> 6, k = idx & 63; GUT[k * SGS + j] = f2bf(gup[(size_t)j * 512 + k]); }
    }
    const float gng = IN(32)[e * 512 + 64 * h + lane], gnb = IN(33)[e * 512 + 64 * h + lane], muv = mu[1024 + 64 * h + lane];
    bf16_t rz_[18], rv_[10], rof_[8], rob_[8]; float rbf_[8], rbb_[8];
    auto issue = [&](int item) {
        const int tb = item >> 3, hh = item & 7; const int row0 = tb * 64;
        const int L = row0 < MLAT ? TL : TCX; const int t0 = row0 < MLAT ? (row0 & (TL - 1)) : ((row0 - MLAT) & (TCX - 1));
        const int j = tid & 127, tq = wid >> 1;
#pragma unroll
        for (int q = 0; q < 18; ++q) { const int t = t0 + 16 * tq - 1 + q; const int tc = t < 0 ? 0 : (t > L - 1 ? L - 1 : t); rz_[q] = ZR[(size_t)(row0 - t0 + tc) * 1920 + 1792 + j]; }
#pragma unroll
        for (int q = 0; q < 10; ++q) { const int t = t0 + 8 * wid - 1 + q; const int tc = t < 0 ? 0 : (t > L - 1 ? L - 1 : t); rv_[q] = ZR[(size_t)(row0 - t0 + tc) * 1920 + 1024 + 64 * hh + lane]; }
#pragma unroll
        for (int i = 0; i < 8; ++i) {
            const int row = row0 + 8 * wid + i;
            rof_[i] = ORW[(size_t)row * 512 + 64 * hh + lane]; rob_[i] = ORW[(size_t)(MTOT + row) * 512 + 64 * hh + lane];
            rbf_[i] = BON[(size_t)row * 8 + hh]; rbb_[i] = BON[(size_t)(MTOT + row) * 8 + hh];
        }
    };
    if (bid_ < 4608) issue(bid_);
    for (int item = bid_; item < 4608; item += gdim_) {
        const int tb = item >> 3; const int row0 = tb * 64;
        const int hh = item & 7;
        const int L = row0 < MLAT ? TL : TCX; const int t0 = row0 < MLAT ? (row0 & (TL - 1)) : ((row0 - MLAT) & (TCX - 1));
        __syncthreads();
        if (hh != h) {
            const float* gup = IN(28) + (size_t)e * 128 * 512 + 64 * hh;
            for (int idx = tid; idx < 128 * 64; idx += NTHR) { const int j = idx >> 6, k = idx & 63; GUT[k * SGS + j] = f2bf(gup[(size_t)j * 512 + k]); }
        }
        {
            const int j = tid & 127, tq = wid >> 1; const float muj = mu[1792 + j];
            float zz[18];
#pragma unroll
            for (int q = 0; q < 18; ++q) { const int t = t0 + 16 * tq - 1 + q; const bool ok = (t >= 0) && (t < L); zz[q] = ok ? bf2f(rz_[q]) : 0.f; }
#pragma unroll
            for (int i = 0; i < 16; ++i) SGb[(16 * tq + i) * SGS + j] = f2bf(sigm(zz[i + 1] + muj * (0.5f * (zz[i] + zz[i + 2]) - zz[i + 1])));
        }
        float ov[8], vv[8], bon[8];
        const float gngh = hh == h ? gng : IN(32)[e * 512 + 64 * hh + lane], gnbh = hh == h ? gnb : IN(33)[e * 512 + 64 * hh + lane], muvh = hh == h ? muv : mu[1024 + 64 * hh + lane];
        {
            float zv[10];
#pragma unroll
            for (int q = 0; q < 10; ++q) { const int t = t0 + 8 * wid - 1 + q; const bool ok = (t >= 0) && (t < L); zv[q] = ok ? bf2f(rv_[q]) : 0.f; }
#pragma unroll
            for (int i = 0; i < 8; ++i) {
                ov[i] = bf2f(rof_[i]) + bf2f(rob_[i]);
                vv[i] = zv[i + 1] + muvh * (0.5f * (zv[i] + zv[i + 2]) - zv[i + 1]);
                bon[i] = rbf_[i] + rbb_[i];
            }
        }
        __syncthreads();
        if (item + gdim_ < 4608) issue(item + gdim_);
        {
            f32x4 c0 = (f32x4){0.f, 0.f, 0.f, 0.f}, c1 = (f32x4){0.f, 0.f, 0.f, 0.f};
#pragma unroll
            for (int ks = 0; ks < 4; ++ks) {
                const bf16x8 af = *(const bf16x8*)(SGb + (16 * tr + r16) * SGS + 32 * ks + 8 * g4);
                const bf16x8 b0 = *(const bf16x8*)(GUT + (16 * tcb + r16) * SGS + 32 * ks + 8 * g4), b1 = *(const bf16x8*)(GUT + (16 * (tcb + 1) + r16) * SGS + 32 * ks + 8 * g4);
                c0 = __builtin_amdgcn_mfma_f32_16x16x32_bf16(af, b0, c0, 0, 0, 0); c1 = __builtin_amdgcn_mfma_f32_16x16x32_bf16(af, b1, c1, 0, 0, 0);
            }
#pragma unroll
            for (int q = 0; q < 4; ++q) { GG[(16 * tr + 4 * g4 + q) * GGS + 16 * tcb + r16] = c0[q]; GG[(16 * tr + 4 * g4 + q) * GGS + 16 * (tcb + 1) + r16] = c1[q]; }
        }
        __syncthreads();
        float gg[8];
#pragma unroll
        for (int i = 0; i < 8; ++i) gg[i] = GG[(8 * wid + i) * GGS + lane];
#pragma unroll
        for (int i = 0; i < 8; ++i) {
            const int row = row0 + 8 * wid + i;
            const float mean = wsum(ov[i]) * (1.f / 64.f); const float dd = ov[i] - mean; const float var = wsum(dd * dd) * (1.f / 64.f);
            const float y = dd * rsqrtf(var + 64e-5f) * gngh + gnbh;
            YM[(size_t)row * D + 512 + 64 * hh + lane] = f2bf((y + bon[i] * vv[i]) * gg[i]);
        }
    }
    __syncthreads();
    bf16_t tr_[8];
    auto issueT = [&](int it) {
        const int tb = it >> 3, cb = it & 7; const int row0 = tb * 64;
#pragma unroll
        for (int i = 0; i < 8; ++i) tr_[i] = YT[(size_t)(cb * 64 + wid + 8 * i) * MTOT + row0 + lane];
    };
    if (bid_ < 4608) issueT(bid_);
    for (int it = bid_; it < 4608; it += gdim_) {
        const int tb = it >> 3, cb = it & 7; const int row0 = tb * 64;
#pragma unroll
        for (int i = 0; i < 8; ++i) TT[(wid + 8 * i) * 72 + lane] = tr_[i];
        __syncthreads();
        if (it + gdim_ < 4608) issueT(it + gdim_);
#pragma unroll
        for (int i = 0; i < 8; ++i) { const int tau = wid + 8 * i; YM[(size_t)(row0 + tau) * D + cb * 64 + lane] = TT[lane * 72 + tau]; }
        __syncthreads();
    }
}
__device__ __forceinline__ void gla_phase(const Params& p, int o_idx, unsigned char* smem) {
    PH_PRO
    const int item = bid_; if (item >= 256) return;
    const int xcd_ = item & 7, jx_ = item >> 3;
    const int b = 2 * xcd_ + (jx_ >> 4), h = (jx_ >> 2) & 3, d = (jx_ >> 1) & 1, dvh = jx_ & 1;
    const int tid = tid_, lane = tid & 63, wid = __builtin_amdgcn_readfirstlane(tid >> 6), r = lane & 15, g = lane >> 4;
    constexpr int QST = 136, SST = 68;
    bf16_t* QS = (bf16_t*)smem;
    bf16_t* KS = QS + 64 * QST;
    bf16_t* ST = KS + 64 * QST;
    bf16_t* KST = ST + 128 * QST;
    bf16_t* VT = KST + 128 * SST;
    bf16_t* PP = VT + 128 * SST;
    float* GD = (float*)(PP + 64 * SST);
    float* DL = GD + 64 * 16;
    float* E1 = DL + 128;
    float* E2 = E1 + 128;
    float* TOT = E2 + 128;
    float* BR = TOT + 512;
    int* ROWS = (int*)(BR + 128);
    const bf16_t* Z = (const bf16_t*)(WS_ + WS_BIG);
    bf16_t* OG = d ? (bf16_t*)OUT_ : (bf16_t*)(WS_ + WS_BIG + BIG_OGL);
    const float qscale = 0.08838834764831845f;
    const int k = tid & 127, tq = wid >> 1, tr = wid >> 1, tcb = 4 * (wid & 1);
    auto rowof = [&](int c, int tau) -> int {
        const int seg = c >= 4; const int L = seg ? TL : TCX; const int pf = (seg ? c - 4 : c) * 64 + tau; const int pp = d ? (L - 1 - pf) : pf;
        return seg ? (b * TL + (pp & 31) * 64 + (pp >> 5)) : (MLAT + b * TCX + pp);
    };
    bf16_t nq[16], nk[16], nv[16], ngd[2];
    auto prefetch = [&](int c) {
        const long r0 = rowof(c, 16 * tq); const long st = (long)(c >= 4 ? 64 : 1) * (d ? -1 : 1) * 3104;
        const bf16_t* zb = Z + r0 * 3104 + 128 * h + k;
#pragma unroll
        for (int i = 0; i < 16; ++i) { const bf16_t* zr = zb + i * st; nq[i] = zr[0]; nk[i] = zr[512]; nv[i] = zr[1024 + 128 * h + 128 * dvh]; }
#pragma unroll
        for (int i = 0; i < 2; ++i) { const int idx = tid + NTHR * i; ngd[i] = Z[(size_t)rowof(c, idx >> 4) * 3104 + 2048 + 16 * d + (idx & 15)]; }
    };
    f32x4 Sacc[8];
#pragma unroll
    for (int j = 0; j < 8; ++j) Sacc[j] = (f32x4){0.f, 0.f, 0.f, 0.f};
    float gu[16];
    {
        const float* gup_g = IN(36) + (size_t)(o_idx * 2 + d) * 16 * 512 + 128 * h + k;
#pragma unroll
        for (int j = 0; j < 16; ++j) gu[j] = gup_g[(size_t)j * 512];
    }
    const float gbv = IN(37)[(o_idx * 2 + d) * 512 + 128 * h + k];
    prefetch(0);
#pragma unroll 1
    for (int c = 0; c < 36; ++c) {
        __syncthreads();
        if (tid < 64) ROWS[tid] = rowof(c, tid);
#pragma unroll
        for (int i = 0; i < 2; ++i) GD[tid + NTHR * i] = bf2f(ngd[i]);
#pragma unroll
        for (int i = 0; i < 16; ++i) VT[k * SST + 16 * tq + i] = nv[i];
        bf16_t cq[16], ck[16];
#pragma unroll
        for (int i = 0; i < 16; ++i) { cq[i] = nq[i]; ck[i] = nk[i]; }
        __syncthreads();
        if (c + 1 < 36) prefetch(c + 1);
        float bl[16]; float run = 0.f;
#pragma unroll
        for (int i = 0; i < 16; ++i) {
            const float4* gd4 = (const float4*)(GD + (16 * tq + i) * 16);
            const float4 g0 = gd4[0], g1 = gd4[1], g2 = gd4[2], g3 = gd4[3];
            float a = gbv + g0.x * gu[0] + g0.y * gu[1] + g0.z * gu[2] + g0.w * gu[3] + g1.x * gu[4] + g1.y * gu[5] + g1.z * gu[6] + g1.w * gu[7]
                    + g2.x * gu[8] + g2.y * gu[9] + g2.z * gu[10] + g2.w * gu[11] + g3.x * gu[12] + g3.y * gu[13] + g3.z * gu[14] + g3.w * gu[15];
            run -= __logf(1.f + __expf(-a)) * (1.f / 16.f);
            bl[i] = run;
        }
        TOT[tq * 128 + k] = run; if (tq == 2) BR[k] = bl[0];
        __syncthreads();
        {
            const float t0 = TOT[k], t1 = TOT[128 + k], t2 = TOT[256 + k], t3 = TOT[384 + k];
            const float off = tq == 0 ? 0.f : (tq == 1 ? t0 : (tq == 2 ? t0 + t1 : t0 + t1 + t2));
            const float bref = BR[k] + t0 + t1, blast = t0 + t1 + t2 + t3;
            if (tq == 0) { DL[k] = __expf(blast); E1[k] = __expf(bref); E2[k] = __expf(blast - bref); }
#pragma unroll
            for (int i = 0; i < 16; ++i) {
                const int tau = 16 * tq + i;
                const float bb = bl[i] + off; const float ef = __expf(bb - bref);
                const bf16_t ksv = f2bf(bf2f(ck[i]) * __builtin_amdgcn_rcpf(ef));
                QS[tau * QST + k] = f2bf(bf2f(cq[i]) * qscale * ef); KS[tau * QST + k] = ksv; KST[k * SST + tau] = ksv;
            }
        }
        __syncthreads();
        {
            float e1v[4];
#pragma unroll
            for (int q = 0; q < 4; ++q) e1v[q] = E1[16 * wid + 4 * g + q];
#pragma unroll
            for (int j = 0; j < 8; ++j) {
                uint2 o; o.x = pk2(Sacc[j][0] * e1v[0], Sacc[j][1] * e1v[1]); o.y = pk2(Sacc[j][2] * e1v[2], Sacc[j][3] * e1v[3]);
                *(uint2*)(ST + (16 * j + r) * QST + 16 * wid + 4 * g) = o;
            }
        }
        f32x4 sc[2];
#pragma unroll
        for (int j = 0; j < 2; ++j) sc[j] = (f32x4){0.f, 0.f, 0.f, 0.f};
#pragma unroll
        for (int ks = 0; ks < 4; ++ks) {
            const bf16x8 af = *(const bf16x8*)(QS + (16 * tr + r) * QST + 32 * ks + 8 * g);
#pragma unroll
            for (int j = 0; j < 2; ++j) {
                const bf16x8 bfr = *(const bf16x8*)(KS + (16 * (2 * (wid & 1) + j) + r) * QST + 32 * ks + 8 * g);
                sc[j] = __builtin_amdgcn_mfma_f32_16x16x32_bf16(af, bfr, sc[j], 0, 0, 0);
            }
        }
#pragma unroll
        for (int j = 0; j < 2; ++j) {
            const int sidx = 16 * (2 * (wid & 1) + j) + r;
#pragma unroll
            for (int q = 0; q < 4; ++q) { const int ci = 16 * tr + 4 * g + q; PP[ci * SST + sidx] = f2bf(sidx <= ci ? sc[j][q] : 0.f); }
        }
        __syncthreads();
        f32x4 oc[4];
#pragma unroll
        for (int j = 0; j < 4; ++j) oc[j] = (f32x4){0.f, 0.f, 0.f, 0.f};
#pragma unroll
        for (int ks = 0; ks < 2; ++ks) {
            const bf16x8 af = ld8(PP + (16 * tr + r) * SST + 32 * ks + 8 * g);
#pragma unroll
            for (int j = 0; j < 4; ++j) {
                const bf16x8 bfr = ld8(VT + (16 * (tcb + j) + r) * SST + 32 * ks + 8 * g);
                oc[j] = __builtin_amdgcn_mfma_f32_16x16x32_bf16(af, bfr, oc[j], 0, 0, 0);
            }
        }
#pragma unroll
        for (int ks = 0; ks < 4; ++ks) {
            const bf16x8 af = *(const bf16x8*)(QS + (16 * tr + r) * QST + 32 * ks + 8 * g);
#pragma unroll
            for (int j = 0; j < 4; ++j) {
                const bf16x8 bfr = *(const bf16x8*)(ST + (16 * (tcb + j) + r) * QST + 32 * ks + 8 * g);
                oc[j] = __builtin_amdgcn_mfma_f32_16x16x32_bf16(af, bfr, oc[j], 0, 0, 0);
            }
        }
#pragma unroll
        for (int j = 0; j < 4; ++j) {
            const int dv = 16 * (tcb + j) + r;
#pragma unroll
            for (int q = 0; q < 4; ++q) OG[(size_t)ROWS[16 * tr + 4 * g + q] * D + 256 * h + 128 * dvh + dv] = f2bf(oc[j][q]);
        }
        {
            f32x4 kv[8];
#pragma unroll
            for (int j = 0; j < 8; ++j) kv[j] = (f32x4){0.f, 0.f, 0.f, 0.f};
#pragma unroll
            for (int ks = 0; ks < 2; ++ks) {
                const bf16x8 af = ld8(KST + (16 * wid + r) * SST + 32 * ks + 8 * g);
#pragma unroll
                for (int j = 0; j < 8; ++j) {
                    const bf16x8 bfr = ld8(VT + (16 * j + r) * SST + 32 * ks + 8 * g);
                    kv[j] = __builtin_amdgcn_mfma_f32_16x16x32_bf16(af, bfr, kv[j], 0, 0, 0);
                }
            }
            float dl[4], e2[4];
#pragma unroll
            for (int q = 0; q < 4; ++q) { dl[q] = DL[16 * wid + 4 * g + q]; e2[q] = E2[16 * wid + 4 * g + q]; }
#pragma unroll
            for (int j = 0; j < 8; ++j)
#pragma unroll
                for (int q = 0; q < 4; ++q) Sacc[j][q] = Sacc[j][q] * dl[q] + e2[q] * kv[j][q];
        }
    }
    __syncthreads();
}

__device__ __forceinline__ void odd_readout_phase(const Params& p, int o_idx) {
    PH_PRO
    const int lane = tid_ & 63, wid = tid_ >> 6;
    const bf16_t* Z = (const bf16_t*)(WS_ + WS_BIG);
    const bf16_t* OGL = (const bf16_t*)(WS_ + WS_BIG + BIG_OGL);
    const bf16_t* OGB = (const bf16_t*)OUT_;
    bf16_t* YM = (bf16_t*)(WS_ + WS_A);
    const float4 ng = *(const float4*)(IN(38) + o_idx * 256 + 4 * lane);
    uint2 novs[4], nows[4], ngvs[4];
    auto issueR = [&](int row) {
#pragma unroll
        for (int hh = 0; hh < 4; ++hh) {
            novs[hh] = *(const uint2*)(OGL + (size_t)row * D + 256 * hh + 4 * lane);
            nows[hh] = *(const uint2*)(OGB + (size_t)row * D + 256 * hh + 4 * lane);
            ngvs[hh] = *(const uint2*)(Z + (size_t)row * 3104 + 2080 + 256 * hh + 4 * lane);
        }
    };
    if (bid_ * 8 + wid < MTOT) issueR(bid_ * 8 + wid);
    for (int row = bid_ * 8 + wid; row < MTOT; row += gdim_ * 8) {
        uint2 ovs[4], ows[4], gvs[4];
#pragma unroll
        for (int hh = 0; hh < 4; ++hh) { ovs[hh] = novs[hh]; ows[hh] = nows[hh]; gvs[hh] = ngvs[hh]; }
        if (row + gdim_ * 8 < MTOT) issueR(row + gdim_ * 8);
#pragma unroll
        for (int hh = 0; hh < 4; ++hh) {
            const uint2 ov = ovs[hh], ow = ows[hh], gv = gvs[hh];
            const float o0 = __uint_as_float(ov.x << 16) + __uint_as_float(ow.x << 16), o1 = __uint_as_float(ov.x & 0xffff0000u) + __uint_as_float(ow.x & 0xffff0000u), o2 = __uint_as_float(ov.y << 16) + __uint_as_float(ow.y << 16), o3 = __uint_as_float(ov.y & 0xffff0000u) + __uint_as_float(ow.y & 0xffff0000u);
            const float g0 = __uint_as_float(gv.x << 16), g1 = __uint_as_float(gv.x & 0xffff0000u), g2 = __uint_as_float(gv.y << 16), g3 = __uint_as_float(gv.y & 0xffff0000u);
            const float ms = wsum(o0 * o0 + o1 * o1 + o2 * o2 + o3 * o3) * (1.f / 256.f);
            const float rs = rsqrtf(ms + 1e-5f);
            uint2 y; y.x = pk2(o0 * rs * ng.x * silu_(g0), o1 * rs * ng.y * silu_(g1)); y.y = pk2(o2 * rs * ng.z * silu_(g2), o3 * rs * ng.w * silu_(g3));
            *(uint2*)(YM + (size_t)row * D + 256 * hh + 4 * lane) = y;
        }
    }
}

#ifndef REP_UP
#define REP_UP 1
#endif
#ifndef REP_SCAN
#define REP_SCAN 1
#endif
#ifndef REP_GLA
#define REP_GLA 1
#endif
#ifndef REP_HY
#define REP_HY 1
#endif
#define REPEAT(n) for (int rep_ = 0, nrep_ = ({ int t_ = (n); asm volatile("" : "+s"(t_)); t_; }); rep_ < nrep_; ++rep_)
#ifndef REP_LN
#define REP_LN 1
#endif
#ifndef REP_P0
#define REP_P0 1
#endif
#ifndef REP_MISC
#define REP_MISC 1
#endif
#ifndef REP_SYNC
#define REP_SYNC 1
#endif
#define GSYNC() do { for (int s_ = 0; s_ < REP_SYNC; ++s_) { XcdBarrier xb_; xb_.bar = (unsigned*)IN(40); xb_.x = xb_xcc_id(); xb_.st = (volatile XB_LAS unsigned*)(smem_g + TBL_OFF + 448); xcd_barrier(xb_); } } while (0)
#define LAUNDER() do { bid_ = blockIdx.x; asm volatile("" : "+s"(bid_)); gdim_ = gridDim.x; asm volatile("" : "+s"(gdim_)); } while (0)
__global__ void __launch_bounds__(NTHR, 2) mega(Params p) {
    unsigned char* smem = smem_g;
    cg::grid_group grid = cg::this_grid();
    int bid_, gdim_; LAUNDER();
    if (threadIdx.x == 0) {
        const float** tb = (const float**)(smem_g + TBL_OFF);
#pragma unroll
        for (int i = 0; i < 41; ++i) tb[i] = p.in[i];
        *(uint4*)(smem_g + TBL_OFF + 448) = make_uint4(0u, 0u, 0u, 0u);
    }
    unsigned* bar_ = (unsigned*)p.in[40];
    if (blockIdx.x == 0) for (int i = threadIdx.x; i < XCD_BAR_WORDS; i += NTHR) bar_[i] = 0u;
    __syncthreads();
    grid.sync();
    (void)xcd_barrier_post(bar_, (volatile XB_LAS unsigned*)(smem_g + TBL_OFF + 448));
    REPEAT(REP_P0) {
    phase_mod(p, smem);
    __syncthreads();
    conv_weights(p, 0, smem);
    filt_gen(p, smem);
    GSYNC();
    }
    row_phase(p, 0, 0, 0, 0, 0, false);
    GSYNC();
#pragma unroll 1
    for (int l = 0; l < 4; ++l) {
#pragma unroll 1
        for (int f = 0; f < 2; ++f) {
            if (f == 1) {
                if (!(l & 1)) {
                    const int e = l >> 1;
                    REPEAT(REP_HY) {
                    LAUNDER();
                    { EpiStore E; E.O = (bf16_t*)(WS_ + WS_BIG); E.ldc = MTOT; E.nvalid = MTOT; run_gemm(smem, (const bf16_t*)(WS_ + WS_WIN), (const bf16_t*)(WS_ + WS_A), 1536, MTOT, 1024, E, bid_, gdim_); }
                    LAUNDER();
                    { EpiStore E; E.O = (bf16_t*)(WS_ + WS_BIG + BIG_ZR); E.ldc = 1920; E.nvalid = 1920; run_gemm(smem, (const bf16_t*)(WS_ + WS_A), (const bf16_t*)(WS_ + WS_WIN) + (size_t)1536 * 1024, MTOT, 2048, 1024, E, gdim_ - 1 - bid_, gdim_); }
                    GSYNC();
                    hyena_phase(p, e, smem);
                    if (rep_ + 1 < nrep_) GSYNC();
                    }
                    REPEAT(REP_SCAN) rwkv_scan_phase(p, e, smem);
                    GSYNC();
                    REPEAT(REP_MISC) even_readout_phase(p, e, smem);
                    GSYNC();
                } else {
                    const int o = l >> 1;
                    LAUNDER();
                    { EpiStore E; E.O = (bf16_t*)(WS_ + WS_BIG); E.ldc = 3104; E.nvalid = 3104; run_gemm(smem, (const bf16_t*)(WS_ + WS_A), (const bf16_t*)(WS_ + WS_WIN), MTOT, 3328, 1024, E, bid_, gdim_); }
                    GSYNC();
                    REPEAT(REP_GLA) gla_phase(p, o, smem);
                    GSYNC();
                    REPEAT(REP_MISC) odd_readout_phase(p, o);
                    GSYNC();
                }
                LAUNDER();
                { EpiResid E; E.gate_off = l * 17 * 9216 + 5 * 1024; E.wgt = 1.0f; E.ln_idx = l * 3 + 0; E.pm_off = 0; run_gemm(smem, (const bf16_t*)(WS_ + WS_A), (const bf16_t*)(WS_ + WS_WOUT), l == 3 ? MLAT : MTOT, 1024, 1024, E, bid_, gdim_); }
                GSYNC();
                REPEAT(REP_LN) row_phase(p, 1, l, 1, l, 6, false, l == 3 ? MLAT : MTOT);
                GSYNC();
            }
            const bool latonly = (l == 3 && f == 1);
#pragma unroll 1
            for (int s = 0; s < 4; ++s) {
                if (s == 3 && latonly) break;
                LAUNDER();
                if ((s == 1) || (s == 2 && !latonly && bid_ < 64)) {
                    const int part = s - 1;
                    EpiResid E; E.gate_off = l * 17 * 9216 + (f ? 8 : 2) * 1024; E.wgt = 0.5f; E.ln_idx = f ? (l * 3 + 1) : (l * 3 - 1); E.pm_off = part ? 128 : 0;
                    run_gemm(smem, (const bf16_t*)(WS_ + WS_BIG) + (size_t)part * MLAT * FF, (const bf16_t*)(WS_ + WS_WDN) + (size_t)f * 1024 * FF, part ? MCTX : MLAT, 1024, FF, E, bid_, part ? 64 : gdim_);
                }
                if (s == 0 || (s == 1 && !latonly)) {
                    LAUNDER();
                    EpiSwiglu E; E.G = (bf16_t*)(WS_ + WS_BIG); E.pm_off = s ? 128 : 0;
                    run_gemm(smem, (const bf16_t*)(WS_ + WS_A) + (size_t)s * MLAT * 1024, (const bf16_t*)(WS_ + WS_WUP) + (size_t)f * 5632 * 1024, s ? MCTX : MLAT, 5632, 1024, E, bid_, gdim_);
                }
                if (s == 2) {
                    if (latonly) row_phase(p, 1, l, 2, 0, 0, true);
                    else if (bid_ >= 64) { if (f == 0) row_phase(p, 1, l, 0, l, 3, false, MLAT, 0, 64, gdim_ - 64); else row_phase(p, 1, l, 2, l + 1, 0, false, MLAT, 0, 64, gdim_ - 64); }
                }
                if (s == 3) {
                    if (f == 0) row_phase(p, 1, l, 0, l, 3, false, MTOT, MLAT);
                    else { if (l < 3) { row_phase(p, 1, l, 2, l + 1, 0, false, MTOT, MLAT); conv_weights(p, l + 1, smem); } else row_phase(p, 1, l, 2, 0, 0, false, MTOT, MLAT); }
                }
                GSYNC();
            }
        }
    }
}

extern "C" void kernel_launch(void* const* d_in, const int* in_sizes, int n_in, void* d_out, int out_size, void* d_ws, size_t ws_size, hipStream_t stream) {
    static int grid = 0;
    if (grid == 0) {
        if (n_in != 39 || ws_size < WS_END) { fprintf(stderr, "kernel_launch: need 39 inputs and %zu bytes of workspace; got %d, %zu\n", (size_t)WS_END, n_in, ws_size); grid = -1; return; }
        int dev = 0, cus = 0, per_cu = 0;
        (void)hipGetDevice(&dev);
        (void)hipDeviceGetAttribute(&cus, hipDeviceAttributeMultiprocessorCount, dev);
        if (hipFuncSetAttribute((const void*)mega, hipFuncAttributeMaxDynamicSharedMemorySize, LDS_BYTES) != hipSuccess) { fprintf(stderr, "kernel_launch: hipFuncSetAttribute failed\n"); grid = -1; return; }
        (void)hipOccupancyMaxActiveBlocksPerMultiprocessor(&per_cu, (const void*)mega, NTHR, LDS_BYTES);
        if (per_cu < 1) fprintf(stderr, "kernel_launch: occupancy query says %d blocks/CU\n", per_cu);
        (void)hipGetLastError();
        grid = cus;
        if (grid > 256) grid = 256;
    }
    if (grid < 0) return;
    Params p{};
    for (int i = 0; i < 39; ++i) p.in[i] = (const float*)d_in[i];
    p.in[39] = (const float*)d_out; p.in[40] = (const float*)d_ws;
    void* args[] = {&p};
    hipError_t e = hipLaunchCooperativeKernel((const void*)mega, dim3(grid), dim3(NTHR), args, LDS_BYTES, stream);
    if (e != hipSuccess) fprintf(stderr, "cooperative launch failed: %s (grid %d)\n", hipGetErrorString(e), grid);
}
```
